# Optimizing an MI355X kernel written in HIP

```python
import jax, jax.numpy as jnp
from jax import lax
import numpy as np

D_MODEL = 1024
BATCH = 2
SEQ = 8192
DEPTH = 1

SB_HEADS = 8
SB_HEAD_DIM = 64
SB_BLOCK = 128
SB_W = SB_HEADS * SB_HEAD_DIM
GDN_HEADS = 8
GDN_DK = 64
GDN_DV = 64
GDN_CONV = 4
GDN_CHUNK = 64
GDN_QK_W = GDN_HEADS * GDN_DK
GDN_V_W = GDN_HEADS * GDN_DV
GDN_CONV_W = 2 * GDN_QK_W + GDN_V_W
IN_WIDTHS = (SB_W, SB_W, SB_W, GDN_CONV_W, GDN_HEADS, GDN_HEADS, GDN_V_W, 2 * D_MODEL)
IN_W = sum(IN_WIDTHS)
PEER_HEADS = 8
PEER_NKEYS = 128
PEER_N_EXPERTS = PEER_NKEYS * PEER_NKEYS
PEER_QDIM = 256
PEER_HALF = PEER_QDIM // 2
PEER_TOPK = 16
PEER_BLOCK = 128
EPS = 1e-6

kernel_name = "hybrid_sb_gdn_peer_block"


def rmsnorm(x, w):
    x32 = x.astype(jnp.float32)
    y = x32 * lax.rsqrt(jnp.mean(x32 * x32, axis=-1, keepdims=True) + EPS) * w.astype(jnp.float32)
    return y.astype(x.dtype)


def l2norm(x):
    return x * lax.rsqrt(jnp.sum(x * x, axis=-1, keepdims=True) + EPS)


def modulate(h, shift, scale):
    return h * (1.0 + scale[:, None, :]) + shift[:, None, :]


def stick_breaking_attention(q, k, v):
    B, S, H, d = q.shape
    nb = S // SB_BLOCK
    qh = q.astype(jnp.float32).transpose(0, 2, 1, 3) * (d ** -0.5)
    kh = k.astype(jnp.float32).transpose(0, 2, 1, 3)
    vh = v.astype(jnp.float32).transpose(0, 2, 1, 3)
    qb = qh.reshape(B, H, nb, SB_BLOCK, d).transpose(2, 0, 1, 3, 4)
    key_pos = jnp.arange(S)

    def block(args):
        q_blk, start = args
        z = jnp.einsum('bhqd,bhkd->bhqk', q_blk, kh)
        qpos = start + jnp.arange(SB_BLOCK)
        causal = key_pos[None, :] < qpos[:, None]
        log_keep = jnp.where(causal, jax.nn.log_sigmoid(-z), 0.0)
        log_stick = lax.cumsum(log_keep, axis=3, reverse=True) - log_keep
        attn = jnp.where(causal, jnp.exp(jax.nn.log_sigmoid(z) + log_stick), 0.0)
        return jnp.einsum('bhqk,bhkd->bhqd', attn, vh)

    starts = jnp.arange(nb) * SB_BLOCK
    out = lax.map(block, (qb, starts))
    out = out.transpose(1, 0, 3, 2, 4).reshape(B, S, H * d)
    return out.astype(q.dtype)


def chunk_gated_delta_rule(q, k, v, g, beta):
    B, H, L, dk = q.shape
    dv = v.shape[-1]
    C = GDN_CHUNK
    N = L // C
    q = q.reshape(B, H, N, C, dk)
    k = k.reshape(B, H, N, C, dk)
    v = v.reshape(B, H, N, C, dv)
    g = g.reshape(B, H, N, C)
    beta = beta.reshape(B, H, N, C)
    G = jnp.cumsum(g, axis=-1)
    idx = jnp.arange(C)
    incl = idx[:, None] >= idx[None, :]
    strict = idx[:, None] > idx[None, :]
    decay = jnp.exp(jnp.where(incl, G[..., :, None] - G[..., None, :], -jnp.inf))
    kk = jnp.einsum('bhncd,bhnsd->bhncs', k, k)
    A = jnp.where(strict, beta[..., :, None] * kk * decay, 0.0)
    M = jnp.eye(C, dtype=jnp.float32) + A
    rhs = jnp.concatenate([v * beta[..., None], k * (beta * jnp.exp(G))[..., None]], axis=-1)
    sol = lax.linalg.triangular_solve(M, rhs, left_side=True, lower=True, unit_diagonal=True)
    u, w = sol[..., :dv], sol[..., dv:]
    qk = jnp.einsum('bhncd,bhnsd->bhncs', q, k) * decay
    q_dec = q * jnp.exp(G)[..., None]
    k_dec = k * jnp.exp(G[..., -1:] - G)[..., None]
    chunk_decay = jnp.exp(G[..., -1])

    def step(S, inp):
        u_c, w_c, qk_c, qd_c, kd_c, cd_c = inp
        v_new = u_c - jnp.einsum('bhcd,bhde->bhce', w_c, S)
        o = jnp.einsum('bhcd,bhde->bhce', qd_c, S) + jnp.einsum('bhcs,bhse->bhce', qk_c, v_new)
        S = S * cd_c[..., None, None] + jnp.einsum('bhcd,bhce->bhde', kd_c, v_new)
        return S, o

    xs = tuple(jnp.moveaxis(t, 2, 0) for t in (u, w, qk, q_dec, k_dec, chunk_decay))
    S0 = jnp.zeros((B, H, dk, dv), jnp.float32)
    _, o = lax.scan(step, S0, xs)
    return jnp.moveaxis(o, 0, 2).reshape(B, H, L, dv)


def gated_deltanet(qkv, a, b, z, conv_w, A_log, dt_bias, o_norm_w):
    B, S, _ = qkv.shape
    dtype = qkv.dtype
    conv = lax.conv_general_dilated(
        qkv.astype(jnp.float32), conv_w.astype(jnp.float32)[:, None, :],
        window_strides=(1,), padding=[(GDN_CONV - 1, 0)],
        dimension_numbers=('NWC', 'WIO', 'NWC'), feature_group_count=GDN_CONV_W)
    conv = jax.nn.silu(conv)
    q = conv[..., :GDN_QK_W].reshape(B, S, GDN_HEADS, GDN_DK)
    k = conv[..., GDN_QK_W:2 * GDN_QK_W].reshape(B, S, GDN_HEADS, GDN_DK)
    v = conv[..., 2 * GDN_QK_W:].reshape(B, S, GDN_HEADS, GDN_DV)
    q = l2norm(q) * (GDN_DK ** -0.5)
    k = l2norm(k)
    beta = jax.nn.sigmoid(b.astype(jnp.float32))
    g = -jnp.exp(A_log.astype(jnp.float32)) * jax.nn.softplus(a.astype(jnp.float32) + dt_bias.astype(jnp.float32))
    o = chunk_gated_delta_rule(q.transpose(0, 2, 1, 3), k.transpose(0, 2, 1, 3), v.transpose(0, 2, 1, 3),
                               g.transpose(0, 2, 1), beta.transpose(0, 2, 1))
    o = o.transpose(0, 2, 1, 3)
    o = rmsnorm(o, o_norm_w) * jax.nn.silu(z.astype(jnp.float32).reshape(B, S, GDN_HEADS, GDN_DV))
    return o.reshape(B, S, GDN_V_W).astype(dtype)


def peer_ffn(h, w_q, sub_keys, u_tab, v_tab):
    B, S, D = h.shape
    T = B * S
    hf = h.reshape(T, D)
    q = (hf @ w_q).astype(jnp.float32).reshape(T, PEER_HEADS, 2, PEER_HALF)
    s = jnp.einsum('thpd,hpkd->thpk', q, sub_keys.astype(jnp.float32))
    s1, i1 = lax.top_k(s[:, :, 0], PEER_TOPK)
    s2, i2 = lax.top_k(s[:, :, 1], PEER_TOPK)
    cand = (s1[..., :, None] + s2[..., None, :]).reshape(T, PEER_HEADS, PEER_TOPK * PEER_TOPK)
    cidx = (i1[..., :, None] * PEER_NKEYS + i2[..., None, :]).reshape(T, PEER_HEADS, PEER_TOPK * PEER_TOPK)
    top, pos = lax.top_k(cand, PEER_TOPK)
    eidx = jnp.take_along_axis(cidx, pos, axis=-1).reshape(T, PEER_HEADS * PEER_TOPK)
    gate = jax.nn.softmax(top, axis=-1).reshape(T, PEER_HEADS * PEER_TOPK)
    nb = T // PEER_BLOCK

    def block(args):
        h_b, idx_b, g_b = args
        u_sel = u_tab[idx_b]
        act = jax.nn.gelu(jnp.einsum('tkd,td->tk', u_sel, h_b).astype(jnp.float32), approximate=False)
        coef = (g_b * act).astype(h_b.dtype)
        return jnp.einsum('tk,tkd->td', coef, v_tab[idx_b])

    out = lax.map(block, (hf.reshape(nb, PEER_BLOCK, D),
                          eidx.reshape(nb, PEER_BLOCK, PEER_HEADS * PEER_TOPK),
                          gate.reshape(nb, PEER_BLOCK, PEER_HEADS * PEER_TOPK)))
    return out.reshape(B, S, D)


def setup_inputs(seed: int = 0) -> dict:
    key = jax.random.key(seed)
    ks = jax.random.split(key, 24)
    f32 = jnp.float32
    D = D_MODEL
    nrm = lambda k, shape, s: jax.random.normal(k, shape, f32) * s
    dt = jnp.exp(jax.random.uniform(ks[10], (DEPTH, GDN_HEADS), f32, np.log(1e-3), np.log(1e-1)))
    return {
        "x": nrm(ks[0], (BATCH, SEQ, D), 1.0),
        "c": nrm(ks[1], (BATCH, D), 1.0),
        "w_ada": nrm(ks[2], (DEPTH, D, 6 * D), 0.5 * D ** -0.5),
        "b_ada": nrm(ks[3], (DEPTH, 6 * D), 0.02),
        "norm1_w": 1.0 + nrm(ks[4], (DEPTH, D), 0.02),
        "w_in": nrm(ks[5], (DEPTH, D, IN_W), D ** -0.5),
        "sb_q_norm_w": 1.0 + nrm(ks[6], (DEPTH, SB_HEAD_DIM), 0.02),
        "sb_k_norm_w": 1.0 + nrm(ks[7], (DEPTH, SB_HEAD_DIM), 0.02),
        "gdn_conv_w": nrm(ks[8], (DEPTH, GDN_CONV, GDN_CONV_W), 0.5),
        "gdn_A_log": jnp.log(jax.random.uniform(ks[9], (DEPTH, GDN_HEADS), f32, 1.0, 16.0)),
        "gdn_dt_bias": dt + jnp.log(-jnp.expm1(-dt)),
        "gdn_o_norm_w": 1.0 + nrm(ks[11], (DEPTH, GDN_DV), 0.02),
        "w_proj_sb": nrm(ks[12], (DEPTH, SB_W, D), SB_W ** -0.5),
        "w_proj_gdn": nrm(ks[13], (DEPTH, GDN_V_W, D), GDN_V_W ** -0.5),
        "w_o": nrm(ks[14], (DEPTH, D, D), D ** -0.5),
        "norm2_w": 1.0 + nrm(ks[15], (DEPTH, D), 0.02),
        "peer_w_q": nrm(ks[16], (DEPTH, D, PEER_HEADS * PEER_QDIM), D ** -0.5),
        "peer_sub_keys": nrm(ks[17], (DEPTH, PEER_HEADS, 2, PEER_NKEYS, PEER_HALF), PEER_HALF ** -0.5),
        "peer_u": nrm(ks[18], (DEPTH, PEER_N_EXPERTS, D), D ** -0.5),
        "peer_v": nrm(ks[19], (DEPTH, PEER_N_EXPERTS, D), PEER_HEADS ** -0.5),
    }


def reference(x, c, w_ada, b_ada, norm1_w, w_in, sb_q_norm_w, sb_k_norm_w, gdn_conv_w, gdn_A_log,
              gdn_dt_bias, gdn_o_norm_w, w_proj_sb, w_proj_gdn, w_o, norm2_w, peer_w_q, peer_sub_keys,
              peer_u, peer_v):
    B, S, D = x.shape
    split_at = np.cumsum(IN_WIDTHS)[:-1].tolist()
    for l in range(DEPTH):
        mod = (jax.nn.silu(c) @ w_ada[l] + b_ada[l]).reshape(B, 6, D)
        shift1, scale1, gate1, shift2, scale2, gate2 = [mod[:, i] for i in range(6)]

        h = modulate(rmsnorm(x, norm1_w[l]), shift1, scale1)
        proj = h @ w_in[l]
        sb_q, sb_k, sb_v, gdn_qkv, gdn_a, gdn_b, gdn_z, gate_logits = jnp.split(proj, split_at, axis=-1)
        sb_q = rmsnorm(sb_q.reshape(B, S, SB_HEADS, SB_HEAD_DIM), sb_q_norm_w[l])
        sb_k = rmsnorm(sb_k.reshape(B, S, SB_HEADS, SB_HEAD_DIM), sb_k_norm_w[l])
        sb_v = sb_v.reshape(B, S, SB_HEADS, SB_HEAD_DIM)
        y_sb = stick_breaking_attention(sb_q, sb_k, sb_v)
        y_gdn = gated_deltanet(gdn_qkv, gdn_a, gdn_b, gdn_z, gdn_conv_w[l], gdn_A_log[l],
                               gdn_dt_bias[l], gdn_o_norm_w[l])
        gates = jax.nn.sigmoid(gate_logits.astype(jnp.float32)).astype(x.dtype).reshape(B, S, 2, D)
        merged = gates[:, :, 0] * (y_sb @ w_proj_sb[l]) + gates[:, :, 1] * (y_gdn @ w_proj_gdn[l])
        x = x + gate1[:, None, :] * (merged @ w_o[l])

        h2 = modulate(rmsnorm(x, norm2_w[l]), shift2, scale2)
        x = x + gate2[:, None, :] * peer_ffn(h2, peer_w_q[l], peer_sub_keys[l], peer_u[l], peer_v[l])
    return x
```

```cpp
#include <hip/hip_runtime.h>
#include <cstdio>
#include <cstdint>
#include <cmath>

constexpr int D = 1024, BATCH = 2, SEQ = 8192, M = BATCH * SEQ;
constexpr int SBH = 8, SBD = 64, SBW = 512;
constexpr int GH = 8, GDK = 64, GDV = 64, GCONVW = 1536;
constexpr int INW = 5648, INWP = 5888;
constexpr int PH = 8, PNK = 128, PQD = 256, PHALF = 128, PTOPK = 16, PNE = 16384, PQW = PH * PQD;
constexpr float EPS = 1e-6f;

namespace pg8 {
#define PG8_LAS __attribute__((address_space(3)))
typedef unsigned short bf16_t;
typedef short bf16x8 __attribute__((ext_vector_type(8)));
typedef float f32x4 __attribute__((ext_vector_type(4)));
typedef unsigned u32x4 __attribute__((ext_vector_type(4)));
constexpr int BM = 256, BK = 64, HALF = 128, HTB = HALF * BK * 2  , STAGE_BYTES = 8 * HTB, NXCD = 8, WGM = 8;

__host__ __device__ __forceinline__ int lds_byte(int r, int c) { const int st = (r >> 4) * 2 + (c >> 5), rr = r & 15, cc = c & 31, ob = rr * 64 + cc * 2; return st * 1024 + (ob ^ (((ob >> 9) & 1) << 5)); }
__host__ __device__ __forceinline__ void stage_rc(int b, int& R, int& C) { const int st = b / 1024, sb = b % 1024, swz = sb ^ (((sb >> 9) & 1) << 5); R = (st >> 1) * 16 + swz / 64; C = (st & 1) * 32 + (swz % 64) / 2; }
__host__ __device__ __forceinline__ int perm32(int rho) { const int n = rho >> 4, i = rho & 15; return 8 * (i >> 2) + 4 * n + (i & 3); }

struct Unit { int pm, pn; };
struct Gemm { const bf16_t* A; const bf16_t* Bt; int M, N, K; };

struct StaticOrder {
    int nM, nN, nwg, G, c;
    __host__ __device__ void init(int M, int N, int G_, int c_) { nM = M / BM; nN = N / BM; nwg = nM * nN; G = G_; c = c_; }
    __host__ __device__ bool next(int i, Unit& u) const {
        const long L = (long)i * G + c; if (L >= nwg) return false;
        int wgid = (int)L; { const int q = nwg / NXCD, r = nwg % NXCD, xcd = wgid % NXCD, off = wgid / NXCD; wgid = (xcd < r ? xcd * (q + 1) : r * (q + 1) + (xcd - r) * q) + off; }
        const int nig = WGM * nN, gid = wgid / nig, fm = gid * WGM, gsz = (nM - fm) < WGM ? (nM - fm) : WGM;
        u.pm = fm + ((wgid % nig) % gsz); u.pn = (wgid % nig) / gsz; return true;
    }
    __device__ __forceinline__ void a_ready(const Unit&) const {}
    __device__ __forceinline__ void done(const Unit&) const {}
};

__device__ __forceinline__ unsigned cvt_pk_bf16(float lo, float hi) { unsigned r; asm volatile("v_cvt_pk_bf16_f32 %0, %1, %2" : "=v"(r) : "v"(lo), "v"(hi)); return r; }
typedef float f32x2 __attribute__((ext_vector_type(2)));
__device__ __forceinline__ f32x2 gelu_pk(f32x2 v) {
    const f32x2 av = __builtin_elementwise_abs(v), d = av * 0.2316418882f + 1.0f;
    f32x2 t; t.x = __builtin_amdgcn_rcpf(d.x); t.y = __builtin_amdgcn_rcpf(d.y);
    f32x2 q = t * 0.5307027145f + (-0.7265760135f); q = q * t + 0.7107068705f; q = q * t + (-0.142248368f); q = q * t + 0.127414796f; q = q * t;
    const f32x2 s = (v * v) * (-0.72134752044f);
    f32x2 e; e.x = __builtin_amdgcn_exp2f(s.x); e.y = __builtin_amdgcn_exp2f(s.y);
    const f32x2 m = v * (q * e), r = v - m;
    f32x2 o; o.x = v.x < 0.f ? m.x : r.x; o.y = v.y < 0.f ? m.y : r.y; return o;
}

template <int ACT  > struct EpiBf16 {
    static constexpr bool PERM = true, AFTER_DRAIN = false; static_assert(ACT == 0 || ACT == 1, "EpiBf16: ACT is 0 (none) or 1 (gelu_pk)");
    bf16_t* O; int ldc; const float* bias; int split_cols; size_t split_stride; float scale0;
    __device__ __forceinline__ void operator()(const f32x4 (&acc)[2][2][4][2], const Unit& u, int wr, int wc, int fr, int fq) const {
        const int row0 = u.pm * BM + wr * 64 + fr; int colt = u.pn * BM; bf16_t* base = O;
        float sc = 1.f; if (split_cols) { const int t = colt / split_cols; base += (size_t)t * split_stride; colt -= t * split_cols; if (t == 0) sc = scale0; }
        const int col0 = colt + wc * 32 + 8 * fq, bcol0 = u.pn * BM + wc * 32 + 8 * fq;
        f32x4 bv[2][2];
#pragma unroll
        for (int bj = 0; bj < 2; ++bj)
#pragma unroll
            for (int n = 0; n < 2; ++n) bv[bj][n] = bias ? *(const f32x4*)(bias + bcol0 + bj * HALF + 4 * n) : (f32x4){0.f, 0.f, 0.f, 0.f};
#pragma unroll
        for (int ai = 0; ai < 2; ++ai)
#pragma unroll
            for (int m = 0; m < 4; ++m) { bf16_t* rowp = base + (size_t)(row0 + ai * HALF + m * 16) * ldc + col0;
#pragma unroll
                for (int bj = 0; bj < 2; ++bj) { f32x4 v0 = acc[ai][bj][m][0] + bv[bj][0], v1 = acc[ai][bj][m][1] + bv[bj][1];
                    if (ACT == 1) { f32x2 a = gelu_pk((f32x2){v0[0], v0[1]}), b = gelu_pk((f32x2){v0[2], v0[3]}), c = gelu_pk((f32x2){v1[0], v1[1]}), d = gelu_pk((f32x2){v1[2], v1[3]});
                        v0 = (f32x4){a.x, a.y, b.x, b.y}; v1 = (f32x4){c.x, c.y, d.x, d.y}; }
                    v0 = v0 * sc; v1 = v1 * sc; u32x4 w; w.x = cvt_pk_bf16(v0[0], v0[1]); w.y = cvt_pk_bf16(v0[2], v0[3]); w.z = cvt_pk_bf16(v1[0], v1[1]); w.w = cvt_pk_bf16(v1[2], v1[3]);
                    *(u32x4*)(rowp + bj * HALF) = w; } }
    }
};

__device__ __forceinline__ float sigmoidf_(float x) { return __builtin_amdgcn_rcpf(1.0f + __expf(-x)); }
__device__ __forceinline__ float bf2f(unsigned short h) { return __uint_as_float((unsigned)h << 16); }
__device__ __forceinline__ float bflo(unsigned w) { return __uint_as_float(w << 16); }
__device__ __forceinline__ float bfhi(unsigned w) { return __uint_as_float(w & 0xffff0000u); }

struct EpiInProj {
    static constexpr bool PERM = true, AFTER_DRAIN = false;
    bf16_t *q, *k, *v, *graw, *z, *gates; float* ab;
    __device__ __forceinline__ void operator()(const f32x4 (&acc)[2][2][4][2], const Unit& u, int wr, int wc, int fr, int fq) const {
        const int pn = u.pn; bf16_t* base; int ldc, ct; bool sig = false;
        if (pn < 2) { base = q; ldc = 512; ct = pn; } else if (pn < 4) { base = k; ldc = 512; ct = pn - 2; } else if (pn < 6) { base = v; ldc = 512; ct = pn - 4; }
        else if (pn < 12) { base = graw; ldc = 1536; ct = pn - 6; } else if (pn < 14) { base = z; ldc = 512; ct = pn - 12; } else if (pn < 22) { base = gates; ldc = 2048; ct = pn - 14; sig = true; }
        else {
            if (wc == 0 && fq < 2) {
#pragma unroll
                for (int ai = 0; ai < 2; ++ai)
#pragma unroll
                    for (int m = 0; m < 4; ++m) { const int r = u.pm * BM + ai * HALF + wr * 64 + m * 16 + fr; float* p = ab + (size_t)r * 16 + 8 * fq;
                        *(f32x4*)p = acc[ai][0][m][0]; *(f32x4*)(p + 4) = acc[ai][0][m][1]; }
            }
            return;
        }
        const int row0 = u.pm * BM + wr * 64 + fr, col0 = ct * BM + wc * 32 + 8 * fq;
#pragma unroll
        for (int ai = 0; ai < 2; ++ai)
#pragma unroll
            for (int m = 0; m < 4; ++m) { bf16_t* rowp = base + (size_t)(row0 + ai * HALF + m * 16) * ldc + col0;
#pragma unroll
                for (int bj = 0; bj < 2; ++bj) { f32x4 v0 = acc[ai][bj][m][0], v1 = acc[ai][bj][m][1];
                    if (sig) { v0 = (f32x4){sigmoidf_(v0[0]), sigmoidf_(v0[1]), sigmoidf_(v0[2]), sigmoidf_(v0[3])}; v1 = (f32x4){sigmoidf_(v1[0]), sigmoidf_(v1[1]), sigmoidf_(v1[2]), sigmoidf_(v1[3])}; }
                    u32x4 w; w.x = cvt_pk_bf16(v0[0], v0[1]); w.y = cvt_pk_bf16(v0[2], v0[3]); w.z = cvt_pk_bf16(v1[0], v1[1]); w.w = cvt_pk_bf16(v1[2], v1[3]);
                    *(u32x4*)(rowp + bj * HALF) = w; } }
    }
};
template <int MODE> struct EpiMerge {
    static constexpr bool PERM = true, AFTER_DRAIN = false;
    const bf16_t* gates; bf16_t* merged;
    __device__ __forceinline__ void operator()(const f32x4 (&acc)[2][2][4][2], const Unit& u, int wr, int wc, int fr, int fq) const {
        const int row0 = u.pm * BM + wr * 64 + fr, col0 = u.pn * BM + wc * 32 + 8 * fq;
#pragma unroll
        for (int ai = 0; ai < 2; ++ai)
#pragma unroll
            for (int m = 0; m < 4; ++m) { const size_t r = (size_t)(row0 + ai * HALF + m * 16);
#pragma unroll
                for (int bj = 0; bj < 2; ++bj) { const int c = col0 + bj * HALF;
                    const u32x4 g = *(const u32x4*)(gates + r * 2048 + MODE * 1024 + c);
                    f32x4 v0 = acc[ai][bj][m][0], v1 = acc[ai][bj][m][1];
                    v0 = v0 * (f32x4){bflo(g.x), bfhi(g.x), bflo(g.y), bfhi(g.y)}; v1 = v1 * (f32x4){bflo(g.z), bfhi(g.z), bflo(g.w), bfhi(g.w)};
                    if (MODE == 1) { const u32x4 p = *(const u32x4*)(merged + r * 1024 + c);
                        v0 = v0 + (f32x4){bflo(p.x), bfhi(p.x), bflo(p.y), bfhi(p.y)}; v1 = v1 + (f32x4){bflo(p.z), bfhi(p.z), bflo(p.w), bfhi(p.w)}; }
                    u32x4 w; w.x = cvt_pk_bf16(v0[0], v0[1]); w.y = cvt_pk_bf16(v0[2], v0[3]); w.z = cvt_pk_bf16(v1[0], v1[1]); w.w = cvt_pk_bf16(v1[2], v1[3]);
                    *(u32x4*)(merged + r * 1024 + c) = w; } }
    }
};
struct EpiWo {
    static constexpr bool PERM = true, AFTER_DRAIN = false;
    const float* x; const float* mod; float* out;
    __device__ __forceinline__ void operator()(const f32x4 (&acc)[2][2][4][2], const Unit& u, int wr, int wc, int fr, int fq) const {
        const int row0 = u.pm * BM + wr * 64 + fr, col0 = u.pn * BM + wc * 32 + 8 * fq; const int b = (u.pm * BM) >> 13;
        const float* g1 = mod + (size_t)b * 6 * 1024 + 2 * 1024;
#pragma unroll
        for (int bj = 0; bj < 2; ++bj) { const int c = col0 + bj * HALF; const f32x4 ga = *(const f32x4*)(g1 + c), gb = *(const f32x4*)(g1 + c + 4);
#pragma unroll
            for (int ai = 0; ai < 2; ++ai)
#pragma unroll
                for (int m = 0; m < 4; ++m) { const size_t off = (size_t)(row0 + ai * HALF + m * 16) * 1024 + c;
                    const f32x4 xa = *(const f32x4*)(x + off), xb = *(const f32x4*)(x + off + 4);
                    *(f32x4*)(out + off) = xa + ga * acc[ai][bj][m][0]; *(f32x4*)(out + off + 4) = xb + gb * acc[ai][bj][m][1]; } }
    }
};
template <class Epi, class Sched, bool ALIGN_EPI = false, bool SP2 = false>
__device__ __forceinline__ void gemm_phase(PG8_LAS unsigned char* lds, const Gemm g, const Sched& S, const Epi& E) {
    const int tid = threadIdx.x, wid = __builtin_amdgcn_readfirstlane(tid >> 6), lane = tid & 63, wr = wid >> 2, wc = wid & 3, fr = lane & 15, fq = lane >> 4;
    const int K = g.K, nt = K / BK;
    unsigned voffA[2], voffB[2];
#pragma unroll
    for (int i = 0; i < 2; ++i) { int R, C; stage_rc(tid * 16 + i * 8192, R, C); const int Rb = Epi::PERM ? ((R & ~31) + perm32(R & 31)) : R;
        voffA[i] = (unsigned)(R * K + C) * 2u; voffB[i] = (unsigned)(Rb * K + C) * 2u; }
    const size_t kstep = (size_t)(BK * 2);
    const size_t hstep = (size_t)HALF * K * 2;
    const size_t tstep = 2 * hstep;
    const unsigned ldsw = (unsigned)wid * 1024u;
    const int aoff = lds_byte(wr * 64 + fr, fq * 8), boff = lds_byte(wc * 32 + fr, fq * 8);
#define PG8_SA(b, h) (((b) * 2 + (h)) * HTB)
#define PG8_SB(b, h) ((4 + (b) * 2 + (h)) * HTB)
#define PG8_STAGE(bufoff, gbase, voff) do { _Pragma("unroll") for (int _i = 0; _i < 2; ++_i) \
        __builtin_amdgcn_global_load_lds((const unsigned*)((const char*)(gbase) + (voff)[_i]), (PG8_LAS unsigned*)(lds + (bufoff) + ldsw + _i * 8192), 16, 0, 0); } while (0)
#define PG8_LDA(dst, b, h) do { _Pragma("unroll") for (int m = 0; m < 4; ++m) _Pragma("unroll") for (int k = 0; k < 2; ++k) dst[m][k] = *(const PG8_LAS bf16x8*)(lds + PG8_SA(b, h) + aoff + m * 2048 + k * 1024); } while (0)
#define PG8_LDB(dst, b, h) do { _Pragma("unroll") for (int n = 0; n < 2; ++n) _Pragma("unroll") for (int k = 0; k < 2; ++k) dst[n][k] = *(const PG8_LAS bf16x8*)(lds + PG8_SB(b, h) + boff + n * 2048 + k * 1024); } while (0)
#define PG8_MMA(ai, bj, At, Bt) do { __builtin_amdgcn_s_setprio(1); _Pragma("unroll") for (int m = 0; m < 4; ++m) _Pragma("unroll") for (int n = 0; n < 2; ++n) _Pragma("unroll") for (int k = 0; k < 2; ++k) \
        acc[ai][bj][m][n] = __builtin_amdgcn_mfma_f32_16x16x32_bf16(Bt[n][k], At[m][k], acc[ai][bj][m][n], 0, 0, 0); __builtin_amdgcn_s_setprio(0); } while (0)
#define PG8_WAIT_V(n) asm volatile("s_waitcnt vmcnt(" #n ")" ::: "memory")
#define PG8_WAIT_L(n) asm volatile("s_waitcnt lgkmcnt(" #n ")" ::: "memory")
#define PG8_BAR __builtin_amdgcn_s_barrier()
#define PG8_SCHED __builtin_amdgcn_sched_barrier(0)
    Unit cur, nxt; int ui = 0;
    if (!S.next(0, cur)) return;
    f32x4 acc[2][2][4][2];
#pragma unroll
    for (int a = 0; a < 2; ++a)
#pragma unroll
        for (int b = 0; b < 2; ++b)
#pragma unroll
            for (int m = 0; m < 4; ++m)
#pragma unroll
                for (int n = 0; n < 2; ++n) acc[a][b][m][n] = (f32x4){0.f, 0.f, 0.f, 0.f};
    bf16x8 At[4][2], B0[2][2], B1[2][2];
    const char* cA = (const char*)g.A + (size_t)cur.pm * tstep; const char* cB = (const char*)g.Bt + (size_t)cur.pn * tstep;
    S.a_ready(cur);
    if constexpr (SP2) {
        PG8_STAGE(PG8_SB(0, 0), cB, voffB); PG8_STAGE(PG8_SB(0, 1), cB + hstep, voffB); PG8_STAGE(PG8_SA(0, 0), cA, voffA); PG8_STAGE(PG8_SA(0, 1), cA + hstep, voffA);
        if (wr == 1) PG8_BAR;
        PG8_WAIT_V(2); PG8_BAR;
        PG8_STAGE(PG8_SB(1, 0), cB + kstep, voffB); PG8_STAGE(PG8_SA(1, 0), cA + kstep, voffA); PG8_STAGE(PG8_SB(1, 1), cB + hstep + kstep, voffB);
        PG8_WAIT_V(6); PG8_BAR;
    } else {
        PG8_STAGE(PG8_SB(0, 0), cB, voffB); PG8_STAGE(PG8_SA(0, 0), cA, voffA); PG8_STAGE(PG8_SB(0, 1), cB + hstep, voffB); PG8_STAGE(PG8_SA(0, 1), cA + hstep, voffA);
        if (wr == 1) PG8_BAR;
        PG8_WAIT_V(4); PG8_BAR;
        PG8_STAGE(PG8_SB(1, 0), cB + kstep, voffB); PG8_STAGE(PG8_SA(1, 0), cA + kstep, voffA); PG8_STAGE(PG8_SB(1, 1), cB + hstep + kstep, voffB);
        PG8_WAIT_V(6); PG8_BAR;
    }
    for (;;) {
        const bool has_next = S.next(ui + 1, nxt);
        const char* nA = has_next ? (const char*)g.A + (size_t)nxt.pm * tstep : cA; const char* nB = has_next ? (const char*)g.Bt + (size_t)nxt.pn * tstep : cB;
        for (int t = 0; t < nt; t += 2) {
            const bool last = (t == nt - 2);
            const char* a1 = cA + (size_t)(t + 1) * kstep;
            const char* a2 = last ? nA : cA + (size_t)(t + 2) * kstep; const char* b2 = last ? nB : cB + (size_t)(t + 2) * kstep;
            const char* a3 = a2 + kstep; const char* b3 = b2 + kstep;
            if (last && has_next) S.a_ready(nxt);
            if constexpr (SP2) {
            PG8_LDB(B0, 0, 0); PG8_LDB(B1, 0, 1); PG8_SCHED; PG8_LDA(At, 0, 0); PG8_STAGE(PG8_SA(1, 1), a1 + hstep, voffA);
            PG8_WAIT_V(8); PG8_WAIT_L(0); PG8_BAR; PG8_MMA(0, 0, At, B0); PG8_MMA(0, 1, At, B1); PG8_BAR; PG8_SCHED;
            PG8_LDA(At, 0, 1); PG8_STAGE(PG8_SB(0, 0), b2, voffB); PG8_STAGE(PG8_SB(0, 1), b2 + hstep, voffB); PG8_STAGE(PG8_SA(0, 0), a2, voffA);
            PG8_WAIT_V(8); PG8_WAIT_L(0); PG8_BAR; PG8_MMA(1, 0, At, B0); PG8_MMA(1, 1, At, B1); PG8_BAR; PG8_SCHED;
            PG8_LDB(B0, 1, 0); PG8_LDB(B1, 1, 1); PG8_SCHED; PG8_LDA(At, 1, 0); PG8_STAGE(PG8_SA(0, 1), a2 + hstep, voffA);
            PG8_WAIT_V(8); PG8_WAIT_L(0); PG8_BAR; PG8_MMA(0, 0, At, B0); PG8_MMA(0, 1, At, B1); PG8_BAR; PG8_SCHED;
            PG8_LDA(At, 1, 1); PG8_STAGE(PG8_SB(1, 0), b3, voffB); PG8_STAGE(PG8_SB(1, 1), b3 + hstep, voffB); PG8_STAGE(PG8_SA(1, 0), a3, voffA);
            PG8_WAIT_V(8); PG8_WAIT_L(0); PG8_BAR; PG8_MMA(1, 0, At, B0); PG8_MMA(1, 1, At, B1); PG8_BAR; PG8_SCHED;
            } else {
            PG8_LDB(B0, 0, 0); PG8_SCHED; PG8_LDA(At, 0, 0); PG8_STAGE(PG8_SA(1, 1), a1 + hstep, voffA);
            PG8_WAIT_L(8); PG8_BAR; PG8_WAIT_L(0); PG8_MMA(0, 0, At, B0); PG8_BAR; PG8_SCHED;
            PG8_LDB(B1, 0, 1); PG8_STAGE(PG8_SB(0, 0), b2, voffB);
            PG8_BAR; PG8_WAIT_L(0); PG8_MMA(0, 1, At, B1); PG8_BAR;
            PG8_LDA(At, 0, 1); PG8_STAGE(PG8_SA(0, 0), a2, voffA);
            PG8_BAR; PG8_WAIT_L(0); PG8_MMA(1, 0, At, B0); PG8_BAR; PG8_SCHED;
            PG8_STAGE(PG8_SB(0, 1), b2 + hstep, voffB);
            PG8_WAIT_V(6); PG8_BAR; PG8_MMA(1, 1, At, B1); PG8_BAR;
            PG8_LDB(B0, 1, 0); PG8_SCHED; PG8_LDA(At, 1, 0); PG8_STAGE(PG8_SA(0, 1), a2 + hstep, voffA);
            PG8_WAIT_L(8); PG8_BAR; PG8_WAIT_L(0); PG8_MMA(0, 0, At, B0); PG8_BAR; PG8_SCHED;
            PG8_LDB(B1, 1, 1); PG8_STAGE(PG8_SB(1, 0), b3, voffB);
            PG8_BAR; PG8_WAIT_L(0); PG8_MMA(0, 1, At, B1); PG8_BAR;
            PG8_LDA(At, 1, 1); PG8_STAGE(PG8_SA(1, 0), a3, voffA);
            PG8_BAR; PG8_WAIT_L(0); PG8_MMA(1, 0, At, B0); PG8_BAR; PG8_SCHED;
            PG8_STAGE(PG8_SB(1, 1), b3 + hstep, voffB);
            PG8_WAIT_V(6); PG8_BAR; PG8_MMA(1, 1, At, B1); PG8_BAR;
            }
        }
        if constexpr (ALIGN_EPI) { if (wr == 0) PG8_BAR; }
        if constexpr (!Epi::AFTER_DRAIN) { E(acc, cur, wr, wc, fr, fq); S.done(cur); }
        if (!has_next) break;
#pragma unroll
        for (int a = 0; a < 2; ++a)
#pragma unroll
            for (int b = 0; b < 2; ++b)
#pragma unroll
                for (int m = 0; m < 4; ++m)
#pragma unroll
                    for (int n = 0; n < 2; ++n) acc[a][b][m][n] = (f32x4){0.f, 0.f, 0.f, 0.f};
        cur = nxt; cA = nA; cB = nB; ++ui;
        if constexpr (ALIGN_EPI) { if (wr == 1) PG8_BAR; }
    }
    PG8_WAIT_V(0);
    if constexpr (!ALIGN_EPI) { if (wr == 0) PG8_BAR; }
    PG8_BAR;
    if constexpr (Epi::AFTER_DRAIN) { E.fused(acc, cur, wr, wc, fr, fq, lds, wid, lane); S.done(cur); }
#undef PG8_SA
#undef PG8_SB
#undef PG8_STAGE
#undef PG8_LDA
#undef PG8_LDB
#undef PG8_MMA
#undef PG8_WAIT_V
#undef PG8_WAIT_L
#undef PG8_BAR
#undef PG8_SCHED
}
}

constexpr int NWAVES = 8;
#define GAS __attribute__((address_space(1)))
#define LAS __attribute__((address_space(3)))
typedef unsigned short bf16;
typedef unsigned v4u __attribute__((ext_vector_type(4)));
typedef unsigned v2u __attribute__((ext_vector_type(2)));
typedef float f32x4 __attribute__((ext_vector_type(4)));
typedef float f32x2 __attribute__((ext_vector_type(2)));
typedef short bf16x8 __attribute__((ext_vector_type(8)));
typedef GAS unsigned gu32;
#define RLX_AGENT __ATOMIC_RELAXED, __HIP_MEMORY_SCOPE_AGENT
#define LDS_WAIT() asm volatile("s_waitcnt lgkmcnt(0)" ::: "memory")
#define VM_WAIT() asm volatile("s_waitcnt vmcnt(0)" ::: "memory")
__device__ __forceinline__ unsigned f2bf(float f) { unsigned u = __builtin_bit_cast(unsigned, f); return (u + 0x7fffu + ((u >> 16) & 1u)) >> 16; }
__device__ __forceinline__ unsigned pk2(float lo, float hi) { return f2bf(lo) | (f2bf(hi) << 16); }
__device__ __forceinline__ float bf2f(unsigned short h) { return __uint_as_float((unsigned)h << 16); }
__device__ __forceinline__ float bflo(unsigned w) { return __uint_as_float(w << 16); }
__device__ __forceinline__ float bfhi(unsigned w) { return __uint_as_float(w & 0xffff0000u); }
__device__ __forceinline__ float sigm(float x) { return 1.0f / (1.0f + __expf(-x)); }
__device__ __forceinline__ float siluf(float x) { return x / (1.0f + __expf(-x)); }
__device__ __forceinline__ float softplusf(float x) { return fmaxf(x, 0.f) + log1pf(__expf(-fabsf(x))); }
__device__ __forceinline__ float wave_sum(float v) {
#pragma unroll
    for (int o = 1; o < 64; o <<= 1) v += __shfl_xor(v, o);
    return v;
}

constexpr size_t MiB = 1u << 20;
constexpr size_t WS_CTL = 0, CTL_ZERO_BYTES = 1 * MiB;
constexpr size_t WS_MOD = 1 * MiB;
constexpr size_t WS_SKEY = 1 * MiB + 256 * 1024;
constexpr size_t WS_WIN = 2 * MiB;
constexpr size_t WS_WSB = 14 * MiB, WS_WGDN = 15 * MiB, WS_WO = 16 * MiB, WS_WQ = 18 * MiB;
constexpr size_t WS_AB = 22 * MiB;
constexpr size_t WS_GB = 23 * MiB;
constexpr size_t WS_XN = 24 * MiB;
constexpr size_t WS_Q = 56 * MiB, WS_K = 72 * MiB, WS_V = 88 * MiB;
constexpr size_t WS_GRAW = 104 * MiB;
constexpr size_t WS_Z = 152 * MiB;
constexpr size_t WS_YSB = 168 * MiB, WS_YGDN = 184 * MiB;
constexpr size_t WS_MERGED = 200 * MiB;
constexpr size_t WS_VG = 232 * MiB;
constexpr size_t WS_QP = 56 * MiB;
constexpr size_t WS_EIDX = 120 * MiB, WS_GATE = 128 * MiB;
constexpr size_t WS_END = 256 * MiB;
constexpr int CW_BAR = 4096;

constexpr int RING_OFF = 0, RING_BYTES = 131072;
constexpr int LDSCTL_OFF = RING_BYTES, MISC_OFF = LDSCTL_OFF + 320;
constexpr int LDS_BYTES = 147456;
#define XB_TMO      128
#define XB_XCNT(j)  (256  + 64 * (j))
#define XB_XSUB(j)  (1280 + 64 * (j))
#define XB_XGEN(j)  (2304 + 64 * (j))
#define XB_TOP      3328
#define XB_TOPGEN   3392
#define XCD_BAR_WORDS 3456
#define XB_SPIN_CAP (1u << 18)

__device__ __forceinline__ unsigned xb_ld(unsigned* p)              { return __hip_atomic_load(p, __ATOMIC_RELAXED, __HIP_MEMORY_SCOPE_AGENT); }
__device__ __forceinline__ unsigned xb_add(unsigned* p, unsigned v) { return __hip_atomic_fetch_add(p, v, __ATOMIC_RELAXED, __HIP_MEMORY_SCOPE_AGENT); }
__device__ __forceinline__ unsigned xb_xcc_id() { return (unsigned)__builtin_amdgcn_s_getreg((3 << 11) | 20) & 0xFu; }
#define XB_SPIN(cond, bar) do { unsigned _sp = 0; while (cond) { __builtin_amdgcn_s_sleep(1); \
    if ((++_sp & 255u) == 0u) { if (xb_ld(&(bar)[XB_TMO])) break; if (_sp > XB_SPIN_CAP) { atomicAdd(&(bar)[XB_TMO], 1u); break; } } } } while (0)

struct XcdBarrier {
    unsigned* bar; unsigned x;
    volatile LAS unsigned* st;
};

__device__ __forceinline__ XcdBarrier xcd_barrier_post(unsigned* bar, volatile LAS unsigned* st) {
    XcdBarrier b; b.bar = bar; b.x = xb_xcc_id(); b.st = st;
    if (threadIdx.x == 0) (void)xb_add(&bar[XB_XCNT(b.x)], 1u);
    return b;
}
__device__ __forceinline__ void xcd_barrier_complete(unsigned* bar, unsigned x, unsigned& nloc, unsigned& nx) {
    const unsigned G = gridDim.x * gridDim.y * gridDim.z;
    unsigned sum, cnt, mine, sp = 0u;
    for (;;) {
        sum = 0u; cnt = 0u; mine = 0u;
#pragma unroll
        for (unsigned j = 0; j < 16; ++j) { const unsigned c = xb_ld(&bar[XB_XCNT(j)]); sum += c; cnt += (c > 0u) ? 1u : 0u; mine = (j == x) ? c : mine; }
        if (sum == G) break;
        __builtin_amdgcn_s_sleep(1);
        if ((++sp & 255u) == 0u) { if (xb_ld(&bar[XB_TMO])) break; if (sp > XB_SPIN_CAP) { atomicAdd(&bar[XB_TMO], 1u); break; } }
    }
    nloc = mine > 0u ? mine : 1u; nx = cnt > 0u ? cnt : 1u;
}

__device__ __forceinline__ void xcd_barrier(const XcdBarrier& b) {
    asm volatile("s_waitcnt vmcnt(0)" ::: "memory");
    __syncthreads();
    if (threadIdx.x == 0) {
        unsigned* bar = b.bar;
        __builtin_amdgcn_s_waitcnt(0);
        unsigned nloc = b.st[0], nx = b.st[1];
        if (nloc == 0u) { xcd_barrier_complete(bar, b.x, nloc, nx); b.st[0] = nloc; b.st[1] = nx; }
        const unsigned old = xb_add(&bar[XB_XSUB(b.x)], 1u);
        const unsigned gen = old / nloc;
        if (old + 1u == (gen + 1u) * nloc) {
            __builtin_amdgcn_fence(__ATOMIC_RELEASE, "agent");
            asm volatile("s_waitcnt vmcnt(0)" ::: "memory");
            const unsigned og = xb_add(&bar[XB_TOP], 1u);
            const unsigned tg = og / nx;
            if (og + 1u == (tg + 1u) * nx) xb_add(&bar[XB_TOPGEN], 1u);
            else XB_SPIN(xb_ld(&bar[XB_TOPGEN]) == tg, bar);
            __builtin_amdgcn_fence(__ATOMIC_ACQUIRE, "agent");
            xb_add(&bar[XB_XGEN(b.x)], 1u);
            asm volatile("s_waitcnt vmcnt(0)" ::: "memory");
        } else {
            XB_SPIN(xb_ld(&bar[XB_XGEN(b.x)]) == gen, bar);
            __builtin_amdgcn_fence(__ATOMIC_ACQUIRE, "agent");
            asm volatile("s_waitcnt vmcnt(0)" ::: "memory");
        }
    }
    __syncthreads();
}

struct Args { const float* in[20]; float* out; unsigned char* ws; int ph_lo, ph_hi, li, pad; };

struct Frame {
    LAS unsigned char* lds;
    volatile LAS unsigned* MISC;
    gu32* ctl;
    int tid, lane, wave, G;
};

__device__ __forceinline__ int inproj_src_col(int n) { if (n < 3072) return n; if (n < 5632) return n + 16; if (n < 5648) return n - 5632 + 3072; return -1; }
template <bool MAP>
__device__ __forceinline__ void p0_transpose_item(const float* W, int K, int Nsrc, int Ndst, bf16* WT, LAS float* scr, int item, int lane) {
    const int nblk = Ndst / 32, kb = item / nblk, nb = item % nblk, k0 = 64 * kb, n0 = 32 * nb;
    const int nsrc = MAP ? inproj_src_col(n0 + (lane & 31)) : n0 + (lane & 31);
#pragma unroll 8
    for (int i = 0; i < 32; ++i) { const int kk = 2 * i + (lane >> 5); scr[kk * 33 + (lane & 31)] = nsrc >= 0 ? W[(size_t)(k0 + kk) * Nsrc + nsrc] : 0.f; }
    LDS_WAIT(); asm volatile("" ::: "memory");
    const int c = lane & 7;
#pragma unroll
    for (int j = 0; j < 4; ++j) { const int n = (lane >> 3) + 8 * j; const LAS float* s = scr + (8 * c) * 33 + n;
        v4u o; o.x = pk2(s[0 * 33], s[1 * 33]); o.y = pk2(s[2 * 33], s[3 * 33]); o.z = pk2(s[4 * 33], s[5 * 33]); o.w = pk2(s[6 * 33], s[7 * 33]);
        *(GAS v4u*)(WT + (size_t)(n0 + n) * K + k0 + 8 * c) = o; }
    LDS_WAIT(); asm volatile("" ::: "memory");
}
__device__ __forceinline__ void p0_prologue(Frame& F, const Args& a) {
    unsigned char* ws = a.ws;
    LAS float* scr = (LAS float*)(F.lds + RING_OFF + F.wave * 16384);
    const int gw = blockIdx.x * NWAVES + F.wave, NGW = F.G * NWAVES;
    constexpr int I_IN = (D / 64) * (INWP / 32), I_SB = (512 / 64) * (D / 32), I_O = (D / 64) * (D / 32), I_Q = (D / 64) * (PQW / 32);
    constexpr int NITEMS = I_IN + 2 * I_SB + I_O + I_Q;
    for (int it = gw; it < NITEMS; it += NGW) {
        int r = it;
        if (r < I_IN) { p0_transpose_item<true>(a.in[5], D, INW, INWP, (bf16*)(ws + WS_WIN), scr, r, F.lane); continue; } r -= I_IN;
        if (r < I_SB) { p0_transpose_item<false>(a.in[12], 512, D, D, (bf16*)(ws + WS_WSB), scr, r, F.lane); continue; } r -= I_SB;
        if (r < I_SB) { p0_transpose_item<false>(a.in[13], 512, D, D, (bf16*)(ws + WS_WGDN), scr, r, F.lane); continue; } r -= I_SB;
        if (r < I_O) { p0_transpose_item<false>(a.in[14], D, D, D, (bf16*)(ws + WS_WO), scr, r, F.lane); continue; } r -= I_O;
        p0_transpose_item<false>(a.in[16], D, PQW, PQW, (bf16*)(ws + WS_WQ), scr, r, F.lane);
    }
    { const float* sk = a.in[17]; bf16* o = (bf16*)(ws + WS_SKEY);
      for (int i = (blockIdx.x * 512 + F.tid) * 4; i < PH * 2 * PNK * PHALF; i += F.G * 512 * 4) { const f32x4 v = *(const f32x4*)(sk + i); v2u w; w.x = pk2(v.x, v.y); w.y = pk2(v.z, v.w); *(v2u*)(o + i) = w; } }
    { const float* c = a.in[1]; const float* wa = a.in[2]; const float* ba = a.in[3]; float* mod = (float*)(ws + WS_MOD);
      LAS float* red = (LAS float*)(F.lds + RING_OFF);
      for (int it = blockIdx.x; it < 6 * D / 64; it += F.G) {
          const int n = it * 64 + F.lane; float a0 = 0.f, a1 = 0.f;
          __syncthreads();
          for (int k = F.wave * 128; k < F.wave * 128 + 128; ++k) { const float w = wa[(size_t)k * (6 * D) + n]; a0 += siluf(c[k]) * w; a1 += siluf(c[D + k]) * w; }
          red[(F.wave * 2 + 0) * 64 + F.lane] = a0; red[(F.wave * 2 + 1) * 64 + F.lane] = a1;
          __syncthreads();
          if (F.wave < 2) { float s = 0.f;
#pragma unroll
              for (int w = 0; w < 8; ++w) s += red[(w * 2 + F.wave) * 64 + F.lane];
              mod[(size_t)F.wave * 6 * D + n] = s + ba[n]; }
      }
      __syncthreads(); }
}
__device__ __forceinline__ void norm_mod_rows(Frame& F, const float* x, const float* nw, const float* mod, int ch_shift, bf16* o) {
    const int gw = blockIdx.x * NWAVES + F.wave, NGW = F.G * NWAVES;
    for (int m = gw; m < M; m += NGW) {
        const GAS f32x4* xr = (const GAS f32x4*)(x + (size_t)m * D) + F.lane;
        f32x4 v[4]; float s = 0.f;
#pragma unroll
        for (int j = 0; j < 4; ++j) { v[j] = xr[64 * j]; s += (v[j].x * v[j].x + v[j].y * v[j].y) + (v[j].z * v[j].z + v[j].w * v[j].w); }
        const float rstd = 1.0f / sqrtf(wave_sum(s) * (1.f / D) + EPS);
        const float* sh = mod + (size_t)(m >> 13) * 6 * D + ch_shift * D; const float* sc = sh + D;
        GAS v2u* o8 = (GAS v2u*)(o + (size_t)m * D) + F.lane;
#pragma unroll
        for (int j = 0; j < 4; ++j) { const int c = 4 * F.lane + 256 * j; const f32x4 w = *(const f32x4*)(nw + c), a = *(const f32x4*)(sc + c), b = *(const f32x4*)(sh + c);
            const f32x4 y = v[j] * rstd * w * (a + 1.0f) + b; v2u p; p.x = pk2(y.x, y.y); p.y = pk2(y.z, y.w); o8[64 * j] = p; }
    }
}
__device__ __forceinline__ float gelu_erf(float v) { return 0.5f * v * (1.0f + erff(v * 0.70710678118654752f)); }
__device__ __forceinline__ void p10_peer(Frame& F, const Args& a) {
    unsigned char* ws = a.ws;
    const bf16* h2 = (const bf16*)(ws + WS_XN); const int* eidx = (const int*)(ws + WS_EIDX); const float* gate = (const float*)(ws + WS_GATE);
    const float* ut = a.in[18]; const float* vt = a.in[19]; const float* mod = (const float*)(ws + WS_MOD); float* out = a.out;
    LAS float* acts = (LAS float*)(F.lds + RING_OFF + F.wave * 1024); LAS float* coefs = acts + 128;
    const int gw = blockIdx.x * NWAVES + F.wave, NGW = F.G * NWAVES, g = F.lane >> 4, sub = F.lane & 15;
    for (int t = gw; t < M; t += NGW) {
        f32x4 h[16];
#pragma unroll
        for (int j = 0; j < 16; ++j) { const v2u w = *(const v2u*)(h2 + (size_t)t * D + sub * 4 + 64 * j); h[j] = (f32x4){bflo(w.x), bfhi(w.x), bflo(w.y), bfhi(w.y)}; }
        const int* et = eidx + (size_t)t * 128;
#pragma unroll 2
        for (int i = 0; i < 32; ++i) {
            const int e = et[4 * i + g]; const float* ur = ut + (size_t)e * D + sub * 4; float s = 0.f;
#pragma unroll
            for (int j = 0; j < 16; ++j) { const f32x4 u = *(const f32x4*)(ur + 64 * j); s += (u.x * h[j].x + u.y * h[j].y) + (u.z * h[j].z + u.w * h[j].w); }
            s += __shfl_xor(s, 1); s += __shfl_xor(s, 2); s += __shfl_xor(s, 4); s += __shfl_xor(s, 8);
            if (sub == 0) acts[4 * i + g] = s;
        }
        LDS_WAIT(); asm volatile("" ::: "memory");
        { const float a0 = acts[F.lane], a1 = acts[64 + F.lane];
          coefs[F.lane] = gate[(size_t)t * 128 + F.lane] * gelu_erf(a0); coefs[64 + F.lane] = gate[(size_t)t * 128 + 64 + F.lane] * gelu_erf(a1); }
        LDS_WAIT(); asm volatile("" ::: "memory");
        f32x4 acc[4] = {(f32x4){0.f, 0.f, 0.f, 0.f}, (f32x4){0.f, 0.f, 0.f, 0.f}, (f32x4){0.f, 0.f, 0.f, 0.f}, (f32x4){0.f, 0.f, 0.f, 0.f}};
#pragma unroll 8
        for (int e = 0; e < 128; ++e) { const float cf = coefs[e]; const float* vr = vt + (size_t)et[e] * D + 4 * F.lane;
#pragma unroll
            for (int j = 0; j < 4; ++j) acc[j] += cf * *(const f32x4*)(vr + 256 * j); }
        const float* g2 = mod + (size_t)(t >> 13) * 6 * D + 5 * D;
#pragma unroll
        for (int j = 0; j < 4; ++j) { const int c = 4 * F.lane + 256 * j; float* op = out + (size_t)t * D + c; *(f32x4*)op = *(const f32x4*)op + *(const f32x4*)(g2 + c) * acc[j]; }
        LDS_WAIT(); asm volatile("" ::: "memory");
    }
}

__global__ void __launch_bounds__(NWAVES * 64, 2) mk_fwd(Args args) {
    extern __shared__ __attribute__((aligned(16))) unsigned char lds[];
    Frame F;
    F.lds = (LAS unsigned char*)lds;
    F.MISC = (volatile LAS unsigned*)(F.lds + MISC_OFF);
    F.tid = threadIdx.x; F.lane = F.tid & 63; F.wave = __builtin_amdgcn_readfirstlane(F.tid >> 6);
    F.G = gridDim.x;
    unsigned char* ws = args.ws;
    F.ctl = (gu32*)(ws + WS_CTL);
    for (int u = F.tid; u < (LDS_BYTES - LDSCTL_OFF) / 4; u += NWAVES * 64) ((LAS unsigned*)(F.lds + LDSCTL_OFF))[u] = 0u;
    __syncthreads();
    const bool multi = (args.ph_hi - args.ph_lo) > 1;
    XcdBarrier bar; bar.bar = (unsigned*)(F.ctl + CW_BAR); bar.x = 0; bar.st = nullptr;
    if (multi) bar = xcd_barrier_post((unsigned*)(F.ctl + CW_BAR), F.MISC + 8);
    const int lo = args.ph_lo, hi = args.ph_hi;
#define IN(k) (lo <= (k) && (k) < hi)
#define SEAM(k) do { if (IN(k) && (k) + 1 < hi) xcd_barrier(bar); } while (0)
    const float* mod = (const float*)(ws + WS_MOD);

    if (IN(0)) { p0_prologue(F, args); } SEAM(0);
    if (IN(1)) { norm_mod_rows(F, args.in[0], args.in[4], mod, 0, (bf16*)(ws + WS_XN)); } SEAM(1);
    if (IN(2)) {
        pg8::Gemm g{(const bf16*)(ws + WS_XN), (const bf16*)(ws + WS_WIN), M, INWP, D}; pg8::StaticOrder S; S.init(M, INWP, F.G, (int)blockIdx.x);
        pg8::EpiInProj E{(bf16*)(ws + WS_Q), (bf16*)(ws + WS_K), (bf16*)(ws + WS_V), (bf16*)(ws + WS_GRAW), (bf16*)(ws + WS_Z), (bf16*)args.out, (float*)(ws + WS_AB)};
        pg8::gemm_phase<pg8::EpiInProj, pg8::StaticOrder, true, true>(F.lds + RING_OFF, g, S, E);
    } SEAM(2);
    SEAM(3); SEAM(4);
    if (IN(5)) {
        { pg8::Gemm g{(const bf16*)(ws + WS_YSB), (const bf16*)(ws + WS_WSB), M, D, 512}; pg8::StaticOrder S; S.init(M, D, F.G, (int)blockIdx.x);
          pg8::EpiMerge<0> E{(const bf16*)args.out, (bf16*)(ws + WS_MERGED)};
          pg8::gemm_phase<pg8::EpiMerge<0>, pg8::StaticOrder, true, true>(F.lds + RING_OFF, g, S, E); }
        VM_WAIT(); __syncthreads();
        if (F.tid == 0) { __builtin_amdgcn_fence(__ATOMIC_ACQ_REL, "agent"); VM_WAIT(); }
        __syncthreads();
        { pg8::Gemm g{(const bf16*)(ws + WS_YGDN), (const bf16*)(ws + WS_WGDN), M, D, 512}; pg8::StaticOrder S; S.init(M, D, F.G, (int)blockIdx.x);
          pg8::EpiMerge<1> E{(const bf16*)args.out, (bf16*)(ws + WS_MERGED)};
          pg8::gemm_phase<pg8::EpiMerge<1>, pg8::StaticOrder, true, true>(F.lds + RING_OFF, g, S, E); }
    } SEAM(5);
    if (IN(6)) {
        pg8::Gemm g{(const bf16*)(ws + WS_MERGED), (const bf16*)(ws + WS_WO), M, D, D}; pg8::StaticOrder S; S.init(M, D, F.G, (int)blockIdx.x);
        pg8::EpiWo E{args.in[0], mod, args.out};
        pg8::gemm_phase<pg8::EpiWo, pg8::StaticOrder, true, true>(F.lds + RING_OFF, g, S, E);
    } SEAM(6);
    if (IN(7)) { norm_mod_rows(F, args.out, args.in[15], mod, 3, (bf16*)(ws + WS_XN)); } SEAM(7);
    if (IN(8)) {
        pg8::Gemm g{(const bf16*)(ws + WS_XN), (const bf16*)(ws + WS_WQ), M, PQW, D}; pg8::StaticOrder S; S.init(M, PQW, F.G, (int)blockIdx.x);
        pg8::EpiBf16<0> E{(bf16*)(ws + WS_QP), PQW, nullptr, 0, 0, 1.f};
        pg8::gemm_phase<pg8::EpiBf16<0>, pg8::StaticOrder, true, true>(F.lds + RING_OFF, g, S, E);
    } SEAM(8);
    SEAM(9);
    if (IN(10)) { p10_peer(F, args); }
#undef IN
#undef SEAM
}

__global__ void __launch_bounds__(256) nv_prep(Args a) {
    unsigned char* ws = a.ws; const int lane = threadIdx.x & 63, t = blockIdx.x * 4 + (threadIdx.x >> 6);
    if (t >= M) return;
    const float* qnw = a.in[6]; const float* knw = a.in[7];
#pragma unroll
    for (int which = 0; which < 2; ++which) {
        bf16* p = (bf16*)(ws + (which ? WS_K : WS_Q)) + (size_t)t * 512 + 8 * lane; const float* nw = which ? knw : qnw;
        const v4u w = *(const v4u*)p; float v[8] = {bflo(w.x), bfhi(w.x), bflo(w.y), bfhi(w.y), bflo(w.z), bfhi(w.z), bflo(w.w), bfhi(w.w)};
        float s = 0.f;
#pragma unroll
        for (int i = 0; i < 8; ++i) s += v[i] * v[i];
        s += __shfl_xor(s, 1); s += __shfl_xor(s, 2); s += __shfl_xor(s, 4);
        const float r = 1.0f / sqrtf(s * (1.f / 64.f) + EPS) * (which ? 1.0f : 0.125f);
        const int d0 = (8 * lane) & 63;
#pragma unroll
        for (int i = 0; i < 8; ++i) v[i] = v[i] * r * nw[d0 + i];
        v4u o; o.x = pk2(v[0], v[1]); o.y = pk2(v[2], v[3]); o.z = pk2(v[4], v[5]); o.w = pk2(v[6], v[7]); *(v4u*)p = o;
    }
    const bf16* graw = (const bf16*)(ws + WS_GRAW); const float* cw = a.in[8]; const int tl = t & (SEQ - 1);
#pragma unroll
    for (int part = 0; part < 3; ++part) {
        const int c0 = part * 512 + 8 * lane; float acc[8] = {0.f, 0.f, 0.f, 0.f, 0.f, 0.f, 0.f, 0.f};
#pragma unroll
        for (int j = 0; j < 4; ++j) { const int tt = tl - 3 + j; if (tt < 0) continue;
            const v4u w = *(const v4u*)(graw + (size_t)(t - 3 + j) * 1536 + c0); const float* cwj = cw + j * 1536 + c0;
            const float v[8] = {bflo(w.x), bfhi(w.x), bflo(w.y), bfhi(w.y), bflo(w.z), bfhi(w.z), bflo(w.w), bfhi(w.w)};
#pragma unroll
            for (int i = 0; i < 8; ++i) acc[i] += v[i] * cwj[i]; }
#pragma unroll
        for (int i = 0; i < 8; ++i) acc[i] = siluf(acc[i]);
        if (part < 2) { float s = 0.f;
#pragma unroll
            for (int i = 0; i < 8; ++i) s += acc[i] * acc[i];
            s += __shfl_xor(s, 1); s += __shfl_xor(s, 2); s += __shfl_xor(s, 4);
            const float r = 1.0f / sqrtf(s + EPS) * (part == 0 ? 0.125f : 1.0f);
#pragma unroll
            for (int i = 0; i < 8; ++i) acc[i] *= r; }
        bf16* dst = (bf16*)(ws + (part == 0 ? WS_XN : part == 1 ? WS_XN + 16 * MiB : WS_VG)) + (size_t)t * 512 + 8 * lane;
        v4u o; o.x = pk2(acc[0], acc[1]); o.y = pk2(acc[2], acc[3]); o.z = pk2(acc[4], acc[5]); o.w = pk2(acc[6], acc[7]); *(v4u*)dst = o;
    }
    if (lane < 8) { const float* ab = (const float*)(ws + WS_AB) + (size_t)t * 16; float* gb = (float*)(ws + WS_GB);
        const float av = ab[lane], bv = ab[8 + lane];
        gb[(size_t)t * 8 + lane] = -__expf(a.in[9][lane]) * softplusf(av + a.in[10][lane]);
        gb[(size_t)M * 8 + (size_t)t * 8 + lane] = sigm(bv); }
}
__global__ void __launch_bounds__(64) nv_attn(Args a) {
    unsigned char* ws = a.ws; const int gid = blockIdx.x * 64 + threadIdx.x;
    const int t = gid & (SEQ - 1), bh = gid >> 13, h = bh & 7, b = bh >> 3;
    const bf16* Q = (const bf16*)(ws + WS_Q); const bf16* K = (const bf16*)(ws + WS_K); const bf16* V = (const bf16*)(ws + WS_V);
    const size_t row = (size_t)b * SEQ + t;
    float q[64], o[64];
#pragma unroll
    for (int i = 0; i < 8; ++i) { const v4u w = *(const v4u*)(Q + row * 512 + h * 64 + 8 * i);
        q[8 * i] = bflo(w.x); q[8 * i + 1] = bfhi(w.x); q[8 * i + 2] = bflo(w.y); q[8 * i + 3] = bfhi(w.y); q[8 * i + 4] = bflo(w.z); q[8 * i + 5] = bfhi(w.z); q[8 * i + 6] = bflo(w.w); q[8 * i + 7] = bfhi(w.w); }
#pragma unroll
    for (int i = 0; i < 64; ++i) o[i] = 0.f;
    float R = 0.f;
    for (int s = t - 1; s >= 0; --s) {
        const size_t kr = ((size_t)b * SEQ + s) * 512 + h * 64; float z = 0.f;
#pragma unroll
        for (int i = 0; i < 8; ++i) { const v4u w = *(const v4u*)(K + kr + 8 * i);
            z += q[8 * i] * bflo(w.x) + q[8 * i + 1] * bfhi(w.x) + q[8 * i + 2] * bflo(w.y) + q[8 * i + 3] * bfhi(w.y) + q[8 * i + 4] * bflo(w.z) + q[8 * i + 5] * bfhi(w.z) + q[8 * i + 6] * bflo(w.w) + q[8 * i + 7] * bfhi(w.w); }
        const float sp = softplusf(z); const float p = __expf(z - sp - R); R += sp;
#pragma unroll
        for (int i = 0; i < 8; ++i) { const v4u w = *(const v4u*)(V + kr + 8 * i);
            o[8 * i] += p * bflo(w.x); o[8 * i + 1] += p * bfhi(w.x); o[8 * i + 2] += p * bflo(w.y); o[8 * i + 3] += p * bfhi(w.y); o[8 * i + 4] += p * bflo(w.z); o[8 * i + 5] += p * bfhi(w.z); o[8 * i + 6] += p * bflo(w.w); o[8 * i + 7] += p * bfhi(w.w); }
        if (R > 105.f) break;
    }
    bf16* y = (bf16*)(ws + WS_YSB) + row * 512 + h * 64;
#pragma unroll
    for (int i = 0; i < 8; ++i) { v4u w; w.x = pk2(o[8 * i], o[8 * i + 1]); w.y = pk2(o[8 * i + 2], o[8 * i + 3]); w.z = pk2(o[8 * i + 4], o[8 * i + 5]); w.w = pk2(o[8 * i + 6], o[8 * i + 7]); *(v4u*)(y + 8 * i) = w; }
}
__global__ void __launch_bounds__(256) nv_gdn(Args a) {
    unsigned char* ws = a.ws; const int bh = blockIdx.x, h = bh & 7, b = bh >> 3, j = threadIdx.x & 63, r = threadIdx.x >> 6;
    const bf16* QG = (const bf16*)(ws + WS_XN); const bf16* KG = (const bf16*)(ws + WS_XN + 16 * MiB); const bf16* VG = (const bf16*)(ws + WS_VG);
    const bf16* Z = (const bf16*)(ws + WS_Z); const float* gb = (const float*)(ws + WS_GB); const float* onw = a.in[11];
    bf16* Y = (bf16*)(ws + WS_YGDN);
    __shared__ float qs[2][64], ks[2][64], part[4][64], part2[4][64];
    float S[16];
#pragma unroll
    for (int i = 0; i < 16; ++i) S[i] = 0.f;
    for (int t = 0; t < SEQ; ++t) {
        const size_t row = (size_t)b * SEQ + t; const int bufi = t & 1;
        if (r == 0) qs[bufi][j] = bf2f(QG[row * 512 + h * 64 + j]); else if (r == 1) ks[bufi][j] = bf2f(KG[row * 512 + h * 64 + j]);
        const float v = bf2f(VG[row * 512 + h * 64 + j]); const float g = gb[row * 8 + h], beta = gb[(size_t)M * 8 + row * 8 + h];
        __syncthreads();
        const float eg = __expf(g); float ps = 0.f;
#pragma unroll
        for (int i = 0; i < 16; ++i) { S[i] *= eg; ps += ks[bufi][16 * r + i] * S[i]; }
        part[r][j] = ps;
        __syncthreads();
        const float kS = (part[0][j] + part[1][j]) + (part[2][j] + part[3][j]); const float dlt = beta * (v - kS); float po = 0.f;
#pragma unroll
        for (int i = 0; i < 16; ++i) { S[i] += ks[bufi][16 * r + i] * dlt; po += qs[bufi][16 * r + i] * S[i]; }
        part2[r][j] = po;
        __syncthreads();
        if (r == 0) { const float o = (part2[0][j] + part2[1][j]) + (part2[2][j] + part2[3][j]);
            const float ms = wave_sum(o * o) * (1.f / 64.f); const float y = o * (1.0f / sqrtf(ms + EPS)) * onw[j] * siluf(bf2f(Z[row * 512 + h * 64 + j]));
            Y[row * 512 + h * 64 + j] = (bf16)f2bf(y); }
    }
}
__global__ void __launch_bounds__(64) nv_topk(Args a) {
    unsigned char* ws = a.ws; const int h = blockIdx.x & 7, t = (blockIdx.x >> 3) * 64 + threadIdx.x, tid = threadIdx.x;
    const bf16* QP = (const bf16*)(ws + WS_QP); const bf16* SK = (const bf16*)(ws + WS_SKEY);
    __shared__ float sv[2][16][64]; __shared__ int si[2][16][64]; __shared__ unsigned short keys[128 * 128]; __shared__ int ptr[16][64];
    for (int p = 0; p < 2; ++p) {
        __syncthreads();
        for (int i = tid; i < 128 * 128 / 8; i += 64) ((v4u*)keys)[i] = ((const v4u*)(SK + (size_t)(h * 2 + p) * 128 * 128))[i];
        __syncthreads();
        unsigned qreg[64];
#pragma unroll
        for (int i = 0; i < 16; ++i) { const v4u w = *(const v4u*)(QP + (size_t)t * PQW + h * 256 + p * 128 + 8 * i); qreg[4 * i] = w.x; qreg[4 * i + 1] = w.y; qreg[4 * i + 2] = w.z; qreg[4 * i + 3] = w.w; }
        int cnt = 0;
        for (int key = 0; key < 128; ++key) {
            float s = 0.f;
#pragma unroll
            for (int i = 0; i < 16; ++i) { const v4u w = *(const v4u*)(keys + key * 128 + 8 * i);
                s += bflo(qreg[4 * i]) * bflo(w.x) + bfhi(qreg[4 * i]) * bfhi(w.x) + bflo(qreg[4 * i + 1]) * bflo(w.y) + bfhi(qreg[4 * i + 1]) * bfhi(w.y)
                   + bflo(qreg[4 * i + 2]) * bflo(w.z) + bfhi(qreg[4 * i + 2]) * bfhi(w.z) + bflo(qreg[4 * i + 3]) * bflo(w.w) + bfhi(qreg[4 * i + 3]) * bfhi(w.w); }
            int pos = cnt < 16 ? cnt : 16;
            while (pos > 0 && s > sv[p][pos - 1][tid]) { if (pos < 16) { sv[p][pos][tid] = sv[p][pos - 1][tid]; si[p][pos][tid] = si[p][pos - 1][tid]; } --pos; }
            if (pos < 16) { sv[p][pos][tid] = s; si[p][pos][tid] = key; }
            if (cnt < 16) ++cnt;
        }
    }
    for (int i = 0; i < 16; ++i) ptr[i][tid] = 0;
    float top[16]; int eid[16];
#pragma unroll
    for (int rnk = 0; rnk < 16; ++rnk) {
        float best = -INFINITY; int bi = 0;
        for (int i = 0; i < 16; ++i) { const int jj = ptr[i][tid]; if (jj < 16) { const float c = sv[0][i][tid] + sv[1][jj][tid]; if (c > best) { best = c; bi = i; } } }
        const int bj = ptr[bi][tid]; ptr[bi][tid] = bj + 1;
        top[rnk] = best; eid[rnk] = si[0][bi][tid] * 128 + si[1][bj][tid];
    }
    float mx = top[0], den = 0.f;
#pragma unroll
    for (int rnk = 0; rnk < 16; ++rnk) { top[rnk] = __expf(top[rnk] - mx); den += top[rnk]; }
    int* eo = (int*)(ws + WS_EIDX) + (size_t)t * 128 + h * 16; float* go = (float*)(ws + WS_GATE) + (size_t)t * 128 + h * 16;
#pragma unroll
    for (int rnk = 0; rnk < 16; ++rnk) { eo[rnk] = eid[rnk]; go[rnk] = top[rnk] / den; }
}

extern "C" void kernel_launch(void* const* d_in, const int* in_sizes, int n_in, void* d_out, int out_size, void* d_ws, size_t ws_size, hipStream_t stream) {
    static int grid = 0;
    if (grid == 0) {
        if (n_in != 20 || out_size != M * D || ws_size < WS_END) { fprintf(stderr, "kernel_launch: unexpected shapes n_in %d out %d ws %zu\n", n_in, out_size, ws_size); grid = -1; return; }
        int dev = 0, cus = 0;
        if (hipGetDevice(&dev) != hipSuccess || hipDeviceGetAttribute(&cus, hipDeviceAttributeMultiprocessorCount, dev) != hipSuccess) { grid = -1; return; }
        if (hipFuncSetAttribute((const void*)mk_fwd, hipFuncAttributeMaxDynamicSharedMemorySize, LDS_BYTES) != hipSuccess) { fprintf(stderr, "kernel_launch: hipFuncSetAttribute failed\n"); grid = -1; return; }
        (void)hipGetLastError();
        grid = cus;
    }
    if (grid < 0) return;
    (void)hipMemsetAsync((char*)d_ws + WS_CTL, 0, CTL_ZERO_BYTES, stream);
    Args a{};
    for (int i = 0; i < 20; ++i) a.in[i] = (const float*)d_in[i];
    a.out = (float*)d_out; a.ws = (unsigned char*)d_ws;
    auto mk = [&](int lo, int hi) { a.ph_lo = lo; a.ph_hi = hi; a.li = 0; hipLaunchKernelGGL(mk_fwd, dim3(grid), dim3(NWAVES * 64), LDS_BYTES, stream, a); };
    mk(0, 1); mk(1, 2); mk(2, 3);
    hipLaunchKernelGGL(nv_prep, dim3(M / 4), dim3(256), 0, stream, a);
    hipLaunchKernelGGL(nv_attn, dim3(BATCH * SBH * SEQ / 64), dim3(64), 0, stream, a);
    hipLaunchKernelGGL(nv_gdn, dim3(BATCH * GH), dim3(256), 0, stream, a);
    mk(5, 6); mk(6, 7); mk(7, 8); mk(8, 9);
    hipLaunchKernelGGL(nv_topk, dim3(M / 64 * PH), dim3(64), 0, stream, a);
    mk(10, 11);
}
```

```cpp
#include <hip/hip_runtime.h>
#include <cstdio>
#include <cstdint>
#include <cmath>

constexpr int D = 1024, BATCH = 2, SEQ = 8192, M = BATCH * SEQ;
constexpr int SBH = 8, SBD = 64, SBW = 512;
constexpr int GH = 8, GDK = 64, GDV = 64, GCONVW = 1536;
constexpr int INW = 5648, INWP = 5888;
constexpr int PH = 8, PNK = 128, PQD = 256, PHALF = 128, PTOPK = 16, PNE = 16384, PQW = PH * PQD;
constexpr float EPS = 1e-6f;

namespace pg8 {
#define PG8_LAS __attribute__((address_space(3)))
typedef unsigned short bf16_t;
typedef short bf16x8 __attribute__((ext_vector_type(8)));
typedef float f32x4 __attribute__((ext_vector_type(4)));
typedef unsigned u32x4 __attribute__((ext_vector_type(4)));
constexpr int BM = 256, BK = 64, HALF = 128, HTB = HALF * BK * 2  , STAGE_BYTES = 8 * HTB, NXCD = 8, WGM = 8;

__host__ __device__ __forceinline__ int lds_byte(int r, int c) { const int st = (r >> 4) * 2 + (c >> 5), rr = r & 15, cc = c & 31, ob = rr * 64 + cc * 2; return st * 1024 + (ob ^ (((ob >> 9) & 1) << 5)); }
__host__ __device__ __forceinline__ void stage_rc(int b, int& R, int& C) { const int st = b / 1024, sb = b % 1024, swz = sb ^ (((sb >> 9) & 1) << 5); R = (st >> 1) * 16 + swz / 64; C = (st & 1) * 32 + (swz % 64) / 2; }
__host__ __device__ __forceinline__ int perm32(int rho) { const int n = rho >> 4, i = rho & 15; return 8 * (i >> 2) + 4 * n + (i & 3); }

struct Unit { int pm, pn; };
struct Gemm { const bf16_t* A; const bf16_t* Bt; int M, N, K; };

struct StaticOrder {
    int nM, nN, nwg, G, c;
    __host__ __device__ void init(int M, int N, int G_, int c_) { nM = M / BM; nN = N / BM; nwg = nM * nN; G = G_; c = c_; }
    __host__ __device__ bool next(int i, Unit& u) const {
        const long L = (long)i * G + c; if (L >= nwg) return false;
        int wgid = (int)L; { const int q = nwg / NXCD, r = nwg % NXCD, xcd = wgid % NXCD, off = wgid / NXCD; wgid = (xcd < r ? xcd * (q + 1) : r * (q + 1) + (xcd - r) * q) + off; }
        const int nig = WGM * nN, gid = wgid / nig, fm = gid * WGM, gsz = (nM - fm) < WGM ? (nM - fm) : WGM;
        u.pm = fm + ((wgid % nig) % gsz); u.pn = (wgid % nig) / gsz; return true;
    }
    __device__ __forceinline__ void a_ready(const Unit&) const {}
    __device__ __forceinline__ void done(const Unit&) const {}
};

__device__ __forceinline__ unsigned cvt_pk_bf16(float lo, float hi) { unsigned r; asm volatile("v_cvt_pk_bf16_f32 %0, %1, %2" : "=v"(r) : "v"(lo), "v"(hi)); return r; }
typedef float f32x2 __attribute__((ext_vector_type(2)));
__device__ __forceinline__ f32x2 gelu_pk(f32x2 v) {
    const f32x2 av = __builtin_elementwise_abs(v), d = av * 0.2316418882f + 1.0f;
    f32x2 t; t.x = __builtin_amdgcn_rcpf(d.x); t.y = __builtin_amdgcn_rcpf(d.y);
    f32x2 q = t * 0.5307027145f + (-0.7265760135f); q = q * t + 0.7107068705f; q = q * t + (-0.142248368f); q = q * t + 0.127414796f; q = q * t;
    const f32x2 s = (v * v) * (-0.72134752044f);
    f32x2 e; e.x = __builtin_amdgcn_exp2f(s.x); e.y = __builtin_amdgcn_exp2f(s.y);
    const f32x2 m = v * (q * e), r = v - m;
    f32x2 o; o.x = v.x < 0.f ? m.x : r.x; o.y = v.y < 0.f ? m.y : r.y; return o;
}

template <int ACT  > struct EpiBf16 {
    static constexpr bool PERM = true, AFTER_DRAIN = false; static_assert(ACT == 0 || ACT == 1, "EpiBf16: ACT is 0 (none) or 1 (gelu_pk)");
    bf16_t* O; int ldc; const float* bias; int split_cols; size_t split_stride; float scale0;
    __device__ __forceinline__ void operator()(const f32x4 (&acc)[2][2][4][2], const Unit& u, int wr, int wc, int fr, int fq) const {
        const int row0 = u.pm * BM + wr * 64 + fr; int colt = u.pn * BM; bf16_t* base = O;
        float sc = 1.f; if (split_cols) { const int t = colt / split_cols; base += (size_t)t * split_stride; colt -= t * split_cols; if (t == 0) sc = scale0; }
        const int col0 = colt + wc * 32 + 8 * fq, bcol0 = u.pn * BM + wc * 32 + 8 * fq;
        f32x4 bv[2][2];
#pragma unroll
        for (int bj = 0; bj < 2; ++bj)
#pragma unroll
            for (int n = 0; n < 2; ++n) bv[bj][n] = bias ? *(const f32x4*)(bias + bcol0 + bj * HALF + 4 * n) : (f32x4){0.f, 0.f, 0.f, 0.f};
#pragma unroll
        for (int ai = 0; ai < 2; ++ai)
#pragma unroll
            for (int m = 0; m < 4; ++m) { bf16_t* rowp = base + (size_t)(row0 + ai * HALF + m * 16) * ldc + col0;
#pragma unroll
                for (int bj = 0; bj < 2; ++bj) { f32x4 v0 = acc[ai][bj][m][0] + bv[bj][0], v1 = acc[ai][bj][m][1] + bv[bj][1];
                    if (ACT == 1) { f32x2 a = gelu_pk((f32x2){v0[0], v0[1]}), b = gelu_pk((f32x2){v0[2], v0[3]}), c = gelu_pk((f32x2){v1[0], v1[1]}), d = gelu_pk((f32x2){v1[2], v1[3]});
                        v0 = (f32x4){a.x, a.y, b.x, b.y}; v1 = (f32x4){c.x, c.y, d.x, d.y}; }
                    v0 = v0 * sc; v1 = v1 * sc; u32x4 w; w.x = cvt_pk_bf16(v0[0], v0[1]); w.y = cvt_pk_bf16(v0[2], v0[3]); w.z = cvt_pk_bf16(v1[0], v1[1]); w.w = cvt_pk_bf16(v1[2], v1[3]);
                    *(u32x4*)(rowp + bj * HALF) = w; } }
    }
};

__device__ __forceinline__ float sigmoidf_(float x) { return __builtin_amdgcn_rcpf(1.0f + __expf(-x)); }
__device__ __forceinline__ float bf2f(unsigned short h) { return __uint_as_float((unsigned)h << 16); }
__device__ __forceinline__ float bflo(unsigned w) { return __uint_as_float(w << 16); }
__device__ __forceinline__ float bfhi(unsigned w) { return __uint_as_float(w & 0xffff0000u); }

struct EpiInProj {
    static constexpr bool PERM = true, AFTER_DRAIN = false;
    bf16_t *q, *k, *v, *graw, *z, *gates; float* ab;
    __device__ __forceinline__ void operator()(const f32x4 (&acc)[2][2][4][2], const Unit& u, int wr, int wc, int fr, int fq) const {
        const int pn = u.pn; bf16_t* base; int ldc, ct; bool sig = false;
        if (pn < 2) { base = q; ldc = 512; ct = pn; } else if (pn < 4) { base = k; ldc = 512; ct = pn - 2; } else if (pn < 6) { base = v; ldc = 512; ct = pn - 4; }
        else if (pn < 12) { base = graw; ldc = 1536; ct = pn - 6; } else if (pn < 14) { base = z; ldc = 512; ct = pn - 12; } else if (pn < 22) { base = gates; ldc = 2048; ct = pn - 14; sig = true; }
        else {
            if (wc == 0 && fq < 2) {
#pragma unroll
                for (int ai = 0; ai < 2; ++ai)
#pragma unroll
                    for (int m = 0; m < 4; ++m) { const int r = u.pm * BM + ai * HALF + wr * 64 + m * 16 + fr; float* p = ab + (size_t)r * 16 + 8 * fq;
                        *(f32x4*)p = acc[ai][0][m][0]; *(f32x4*)(p + 4) = acc[ai][0][m][1]; }
            }
            return;
        }
        const int row0 = u.pm * BM + wr * 64 + fr, col0 = ct * BM + wc * 32 + 8 * fq;
#pragma unroll
        for (int ai = 0; ai < 2; ++ai)
#pragma unroll
            for (int m = 0; m < 4; ++m) { bf16_t* rowp = base + (size_t)(row0 + ai * HALF + m * 16) * ldc + col0;
#pragma unroll
                for (int bj = 0; bj < 2; ++bj) { f32x4 v0 = acc[ai][bj][m][0], v1 = acc[ai][bj][m][1];
                    if (sig) { v0 = (f32x4){sigmoidf_(v0[0]), sigmoidf_(v0[1]), sigmoidf_(v0[2]), sigmoidf_(v0[3])}; v1 = (f32x4){sigmoidf_(v1[0]), sigmoidf_(v1[1]), sigmoidf_(v1[2]), sigmoidf_(v1[3])}; }
                    u32x4 w; w.x = cvt_pk_bf16(v0[0], v0[1]); w.y = cvt_pk_bf16(v0[2], v0[3]); w.z = cvt_pk_bf16(v1[0], v1[1]); w.w = cvt_pk_bf16(v1[2], v1[3]);
                    *(u32x4*)(rowp + bj * HALF) = w; } }
    }
};
template <int MODE> struct EpiMerge {
    static constexpr bool PERM = true, AFTER_DRAIN = false;
    const bf16_t* gates; bf16_t* merged;
    __device__ __forceinline__ void operator()(const f32x4 (&acc)[2][2][4][2], const Unit& u, int wr, int wc, int fr, int fq) const {
        const int row0 = u.pm * BM + wr * 64 + fr, col0 = u.pn * BM + wc * 32 + 8 * fq;
#pragma unroll
        for (int ai = 0; ai < 2; ++ai)
#pragma unroll
            for (int m = 0; m < 4; ++m) { const size_t r = (size_t)(row0 + ai * HALF + m * 16);
#pragma unroll
                for (int bj = 0; bj < 2; ++bj) { const int c = col0 + bj * HALF;
                    const u32x4 g = *(const u32x4*)(gates + r * 2048 + MODE * 1024 + c);
                    f32x4 v0 = acc[ai][bj][m][0], v1 = acc[ai][bj][m][1];
                    v0 = v0 * (f32x4){bflo(g.x), bfhi(g.x), bflo(g.y), bfhi(g.y)}; v1 = v1 * (f32x4){bflo(g.z), bfhi(g.z), bflo(g.w), bfhi(g.w)};
                    if (MODE == 1) { const u32x4 p = *(const u32x4*)(merged + r * 1024 + c);
                        v0 = v0 + (f32x4){bflo(p.x), bfhi(p.x), bflo(p.y), bfhi(p.y)}; v1 = v1 + (f32x4){bflo(p.z), bfhi(p.z), bflo(p.w), bfhi(p.w)}; }
                    u32x4 w; w.x = cvt_pk_bf16(v0[0], v0[1]); w.y = cvt_pk_bf16(v0[2], v0[3]); w.z = cvt_pk_bf16(v1[0], v1[1]); w.w = cvt_pk_bf16(v1[2], v1[3]);
                    *(u32x4*)(merged + r * 1024 + c) = w; } }
    }
};
struct EpiWo {
    static constexpr bool PERM = true, AFTER_DRAIN = false;
    const float* x; const float* mod; float* out;
    __device__ __forceinline__ void operator()(const f32x4 (&acc)[2][2][4][2], const Unit& u, int wr, int wc, int fr, int fq) const {
        const int row0 = u.pm * BM + wr * 64 + fr, col0 = u.pn * BM + wc * 32 + 8 * fq; const int b = (u.pm * BM) >> 13;
        const float* g1 = mod + (size_t)b * 6 * 1024 + 2 * 1024;
#pragma unroll
        for (int bj = 0; bj < 2; ++bj) { const int c = col0 + bj * HALF; const f32x4 ga = *(const f32x4*)(g1 + c), gb = *(const f32x4*)(g1 + c + 4);
#pragma unroll
            for (int ai = 0; ai < 2; ++ai)
#pragma unroll
                for (int m = 0; m < 4; ++m) { const size_t off = (size_t)(row0 + ai * HALF + m * 16) * 1024 + c;
                    const f32x4 xa = *(const f32x4*)(x + off), xb = *(const f32x4*)(x + off + 4);
                    *(f32x4*)(out + off) = xa + ga * acc[ai][bj][m][0]; *(f32x4*)(out + off + 4) = xb + gb * acc[ai][bj][m][1]; } }
    }
};
template <class Epi, class Sched, bool ALIGN_EPI = false, bool SP2 = false>
__device__ __forceinline__ void gemm_phase(PG8_LAS unsigned char* lds, const Gemm g, const Sched& S, const Epi& E) {
    const int tid = threadIdx.x, wid = __builtin_amdgcn_readfirstlane(tid >> 6), lane = tid & 63, wr = wid >> 2, wc = wid & 3, fr = lane & 15, fq = lane >> 4;
    const int K = g.K, nt = K / BK;
    unsigned voffA[2], voffB[2];
#pragma unroll
    for (int i = 0; i < 2; ++i) { int R, C; stage_rc(tid * 16 + i * 8192, R, C); const int Rb = Epi::PERM ? ((R & ~31) + perm32(R & 31)) : R;
        voffA[i] = (unsigned)(R * K + C) * 2u; voffB[i] = (unsigned)(Rb * K + C) * 2u; }
    const size_t kstep = (size_t)(BK * 2);
    const size_t hstep = (size_t)HALF * K * 2;
    const size_t tstep = 2 * hstep;
    const unsigned ldsw = (unsigned)wid * 1024u;
    const int aoff = lds_byte(wr * 64 + fr, fq * 8), boff = lds_byte(wc * 32 + fr, fq * 8);
#define PG8_SA(b, h) (((b) * 2 + (h)) * HTB)
#define PG8_SB(b, h) ((4 + (b) * 2 + (h)) * HTB)
#define PG8_STAGE(bufoff, gbase, voff) do { _Pragma("unroll") for (int _i = 0; _i < 2; ++_i) \
        __builtin_amdgcn_global_load_lds((const unsigned*)((const char*)(gbase) + (voff)[_i]), (PG8_LAS unsigned*)(lds + (bufoff) + ldsw + _i * 8192), 16, 0, 0); } while (0)
#define PG8_LDA(dst, b, h) do { _Pragma("unroll") for (int m = 0; m < 4; ++m) _Pragma("unroll") for (int k = 0; k < 2; ++k) dst[m][k] = *(const PG8_LAS bf16x8*)(lds + PG8_SA(b, h) + aoff + m * 2048 + k * 1024); } while (0)
#define PG8_LDB(dst, b, h) do { _Pragma("unroll") for (int n = 0; n < 2; ++n) _Pragma("unroll") for (int k = 0; k < 2; ++k) dst[n][k] = *(const PG8_LAS bf16x8*)(lds + PG8_SB(b, h) + boff + n * 2048 + k * 1024); } while (0)
#define PG8_MMA(ai, bj, At, Bt) do { __builtin_amdgcn_s_setprio(1); _Pragma("unroll") for (int m = 0; m < 4; ++m) _Pragma("unroll") for (int n = 0; n < 2; ++n) _Pragma("unroll") for (int k = 0; k < 2; ++k) \
        acc[ai][bj][m][n] = __builtin_amdgcn_mfma_f32_16x16x32_bf16(Bt[n][k], At[m][k], acc[ai][bj][m][n], 0, 0, 0); __builtin_amdgcn_s_setprio(0); } while (0)
#define PG8_WAIT_V(n) asm volatile("s_waitcnt vmcnt(" #n ")" ::: "memory")
#define PG8_WAIT_L(n) asm volatile("s_waitcnt lgkmcnt(" #n ")" ::: "memory")
#define PG8_BAR __builtin_amdgcn_s_barrier()
#define PG8_SCHED __builtin_amdgcn_sched_barrier(0)
    Unit cur, nxt; int ui = 0;
    if (!S.next(0, cur)) return;
    f32x4 acc[2][2][4][2];
#pragma unroll
    for (int a = 0; a < 2; ++a)
#pragma unroll
        for (int b = 0; b < 2; ++b)
#pragma unroll
            for (int m = 0; m < 4; ++m)
#pragma unroll
                for (int n = 0; n < 2; ++n) acc[a][b][m][n] = (f32x4){0.f, 0.f, 0.f, 0.f};
    bf16x8 At[4][2], B0[2][2], B1[2][2];
    const char* cA = (const char*)g.A + (size_t)cur.pm * tstep; const char* cB = (const char*)g.Bt + (size_t)cur.pn * tstep;
    S.a_ready(cur);
    if constexpr (SP2) {
        PG8_STAGE(PG8_SB(0, 0), cB, voffB); PG8_STAGE(PG8_SB(0, 1), cB + hstep, voffB); PG8_STAGE(PG8_SA(0, 0), cA, voffA); PG8_STAGE(PG8_SA(0, 1), cA + hstep, voffA);
        if (wr == 1) PG8_BAR;
        PG8_WAIT_V(2); PG8_BAR;
        PG8_STAGE(PG8_SB(1, 0), cB + kstep, voffB); PG8_STAGE(PG8_SA(1, 0), cA + kstep, voffA); PG8_STAGE(PG8_SB(1, 1), cB + hstep + kstep, voffB);
        PG8_WAIT_V(6); PG8_BAR;
    } else {
        PG8_STAGE(PG8_SB(0, 0), cB, voffB); PG8_STAGE(PG8_SA(0, 0), cA, voffA); PG8_STAGE(PG8_SB(0, 1), cB + hstep, voffB); PG8_STAGE(PG8_SA(0, 1), cA + hstep, voffA);
        if (wr == 1) PG8_BAR;
        PG8_WAIT_V(4); PG8_BAR;
        PG8_STAGE(PG8_SB(1, 0), cB + kstep, voffB); PG8_STAGE(PG8_SA(1, 0), cA + kstep, voffA); PG8_STAGE(PG8_SB(1, 1), cB + hstep + kstep, voffB);
        PG8_WAIT_V(6); PG8_BAR;
    }
    for (;;) {
        const bool has_next = S.next(ui + 1, nxt);
        const char* nA = has_next ? (const char*)g.A + (size_t)nxt.pm * tstep : cA; const char* nB = has_next ? (const char*)g.Bt + (size_t)nxt.pn * tstep : cB;
        for (int t = 0; t < nt; t += 2) {
            const bool last = (t == nt - 2);
            const char* a1 = cA + (size_t)(t + 1) * kstep;
            const char* a2 = last ? nA : cA + (size_t)(t + 2) * kstep; const char* b2 = last ? nB : cB + (size_t)(t + 2) * kstep;
            const char* a3 = a2 + kstep; const char* b3 = b2 + kstep;
            if (last && has_next) S.a_ready(nxt);
            if constexpr (SP2) {
            PG8_LDB(B0, 0, 0); PG8_LDB(B1, 0, 1); PG8_SCHED; PG8_LDA(At, 0, 0); PG8_STAGE(PG8_SA(1, 1), a1 + hstep, voffA);
            PG8_WAIT_V(8); PG8_WAIT_L(0); PG8_BAR; PG8_MMA(0, 0, At, B0); PG8_MMA(0, 1, At, B1); PG8_BAR; PG8_SCHED;
            PG8_LDA(At, 0, 1); PG8_STAGE(PG8_SB(0, 0), b2, voffB); PG8_STAGE(PG8_SB(0, 1), b2 + hstep, voffB); PG8_STAGE(PG8_SA(0, 0), a2, voffA);
            PG8_WAIT_V(8); PG8_WAIT_L(0); PG8_BAR; PG8_MMA(1, 0, At, B0); PG8_MMA(1, 1, At, B1); PG8_BAR; PG8_SCHED;
            PG8_LDB(B0, 1, 0); PG8_LDB(B1, 1, 1); PG8_SCHED; PG8_LDA(At, 1, 0); PG8_STAGE(PG8_SA(0, 1), a2 + hstep, voffA);
            PG8_WAIT_V(8); PG8_WAIT_L(0); PG8_BAR; PG8_MMA(0, 0, At, B0); PG8_MMA(0, 1, At, B1); PG8_BAR; PG8_SCHED;
            PG8_LDA(At, 1, 1); PG8_STAGE(PG8_SB(1, 0), b3, voffB); PG8_STAGE(PG8_SB(1, 1), b3 + hstep, voffB); PG8_STAGE(PG8_SA(1, 0), a3, voffA);
            PG8_WAIT_V(8); PG8_WAIT_L(0); PG8_BAR; PG8_MMA(1, 0, At, B0); PG8_MMA(1, 1, At, B1); PG8_BAR; PG8_SCHED;
            } else {
            PG8_LDB(B0, 0, 0); PG8_SCHED; PG8_LDA(At, 0, 0); PG8_STAGE(PG8_SA(1, 1), a1 + hstep, voffA);
            PG8_WAIT_L(8); PG8_BAR; PG8_WAIT_L(0); PG8_MMA(0, 0, At, B0); PG8_BAR; PG8_SCHED;
            PG8_LDB(B1, 0, 1); PG8_STAGE(PG8_SB(0, 0), b2, voffB);
            PG8_BAR; PG8_WAIT_L(0); PG8_MMA(0, 1, At, B1); PG8_BAR;
            PG8_LDA(At, 0, 1); PG8_STAGE(PG8_SA(0, 0), a2, voffA);
            PG8_BAR; PG8_WAIT_L(0); PG8_MMA(1, 0, At, B0); PG8_BAR; PG8_SCHED;
            PG8_STAGE(PG8_SB(0, 1), b2 + hstep, voffB);
            PG8_WAIT_V(6); PG8_BAR; PG8_MMA(1, 1, At, B1); PG8_BAR;
            PG8_LDB(B0, 1, 0); PG8_SCHED; PG8_LDA(At, 1, 0); PG8_STAGE(PG8_SA(0, 1), a2 + hstep, voffA);
            PG8_WAIT_L(8); PG8_BAR; PG8_WAIT_L(0); PG8_MMA(0, 0, At, B0); PG8_BAR; PG8_SCHED;
            PG8_LDB(B1, 1, 1); PG8_STAGE(PG8_SB(1, 0), b3, voffB);
            PG8_BAR; PG8_WAIT_L(0); PG8_MMA(0, 1, At, B1); PG8_BAR;
            PG8_LDA(At, 1, 1); PG8_STAGE(PG8_SA(1, 0), a3, voffA);
            PG8_BAR; PG8_WAIT_L(0); PG8_MMA(1, 0, At, B0); PG8_BAR; PG8_SCHED;
            PG8_STAGE(PG8_SB(1, 1), b3 + hstep, voffB);
            PG8_WAIT_V(6); PG8_BAR; PG8_MMA(1, 1, At, B1); PG8_BAR;
            }
        }
        if constexpr (ALIGN_EPI) { if (wr == 0) PG8_BAR; }
        if constexpr (!Epi::AFTER_DRAIN) { E(acc, cur, wr, wc, fr, fq); S.done(cur); }
        if (!has_next) break;
#pragma unroll
        for (int a = 0; a < 2; ++a)
#pragma unroll
            for (int b = 0; b < 2; ++b)
#pragma unroll
                for (int m = 0; m < 4; ++m)
#pragma unroll
                    for (int n = 0; n < 2; ++n) acc[a][b][m][n] = (f32x4){0.f, 0.f, 0.f, 0.f};
        cur = nxt; cA = nA; cB = nB; ++ui;
        if constexpr (ALIGN_EPI) { if (wr == 1) PG8_BAR; }
    }
    PG8_WAIT_V(0);
    if constexpr (!ALIGN_EPI) { if (wr == 0) PG8_BAR; }
    PG8_BAR;
    if constexpr (Epi::AFTER_DRAIN) { E.fused(acc, cur, wr, wc, fr, fq, lds, wid, lane); S.done(cur); }
#undef PG8_SA
#undef PG8_SB
#undef PG8_STAGE
#undef PG8_LDA
#undef PG8_LDB
#undef PG8_MMA
#undef PG8_WAIT_V
#undef PG8_WAIT_L
#undef PG8_BAR
#undef PG8_SCHED
}
}

constexpr int NWAVES = 8;
#define GAS __attribute__((address_space(1)))
#define LAS __attribute__((address_space(3)))
typedef unsigned short bf16;
typedef unsigned v4u __attribute__((ext_vector_type(4)));
typedef unsigned v2u __attribute__((ext_vector_type(2)));
typedef float f32x4 __attribute__((ext_vector_type(4)));
typedef float f32x2 __attribute__((ext_vector_type(2)));
typedef short bf16x8 __attribute__((ext_vector_type(8)));
typedef GAS unsigned gu32;
#define RLX_AGENT __ATOMIC_RELAXED, __HIP_MEMORY_SCOPE_AGENT
#define LDS_WAIT() asm volatile("s_waitcnt lgkmcnt(0)" ::: "memory")
#define VM_WAIT() asm volatile("s_waitcnt vmcnt(0)" ::: "memory")
__device__ __forceinline__ unsigned f2bf(float f) { unsigned u = __builtin_bit_cast(unsigned, f); return (u + 0x7fffu + ((u >> 16) & 1u)) >> 16; }
__device__ __forceinline__ unsigned pk2(float lo, float hi) { return f2bf(lo) | (f2bf(hi) << 16); }
__device__ __forceinline__ float bf2f(unsigned short h) { return __uint_as_float((unsigned)h << 16); }
__device__ __forceinline__ float bflo(unsigned w) { return __uint_as_float(w << 16); }
__device__ __forceinline__ float bfhi(unsigned w) { return __uint_as_float(w & 0xffff0000u); }
__device__ __forceinline__ float sigm(float x) { return 1.0f / (1.0f + __expf(-x)); }
__device__ __forceinline__ float siluf(float x) { return x / (1.0f + __expf(-x)); }
__device__ __forceinline__ float softplusf(float x) { return fmaxf(x, 0.f) + log1pf(__expf(-fabsf(x))); }
__device__ __forceinline__ float wave_sum(float v) {
#pragma unroll
    for (int o = 1; o < 64; o <<= 1) v += __shfl_xor(v, o);
    return v;
}

constexpr size_t MiB = 1u << 20;
constexpr size_t WS_CTL = 0, CTL_ZERO_BYTES = 1 * MiB;
constexpr size_t WS_MOD = 1 * MiB;
constexpr size_t WS_SKEY = 1 * MiB + 256 * 1024;
constexpr size_t WS_WIN = 2 * MiB;
constexpr size_t WS_WSB = 14 * MiB, WS_WGDN = 15 * MiB, WS_WO = 16 * MiB, WS_WQ = 18 * MiB;
constexpr size_t WS_AB = 22 * MiB;
constexpr size_t WS_GB = 23 * MiB;
constexpr size_t WS_XN = 24 * MiB;
constexpr size_t WS_Q = 56 * MiB, WS_K = 72 * MiB, WS_V = 88 * MiB;
constexpr size_t WS_GRAW = 104 * MiB;
constexpr size_t WS_Z = 152 * MiB;
constexpr size_t WS_YSB = 168 * MiB, WS_YGDN = 184 * MiB;
constexpr size_t WS_MERGED = 200 * MiB;
constexpr size_t WS_VG = 232 * MiB;
constexpr size_t WS_QP = 56 * MiB;
constexpr size_t WS_EIDX = 120 * MiB, WS_GATE = 128 * MiB;
constexpr size_t WS_END = 256 * MiB;
constexpr int CW_BAR = 4096;

constexpr int RING_OFF = 0, RING_BYTES = 131072;
constexpr int LDSCTL_OFF = RING_BYTES, MISC_OFF = LDSCTL_OFF + 320;
constexpr int LDS_BYTES = 147456;
#define XB_TMO      128
#define XB_XCNT(j)  (256  + 64 * (j))
#define XB_XSUB(j)  (1280 + 64 * (j))
#define XB_XGEN(j)  (2304 + 64 * (j))
#define XB_TOP      3328
#define XB_TOPGEN   3392
#define XCD_BAR_WORDS 3456
#define XB_SPIN_CAP (1u << 18)

__device__ __forceinline__ unsigned xb_ld(unsigned* p)              { return __hip_atomic_load(p, __ATOMIC_RELAXED, __HIP_MEMORY_SCOPE_AGENT); }
__device__ __forceinline__ unsigned xb_add(unsigned* p, unsigned v) { return __hip_atomic_fetch_add(p, v, __ATOMIC_RELAXED, __HIP_MEMORY_SCOPE_AGENT); }
__device__ __forceinline__ unsigned xb_xcc_id() { return (unsigned)__builtin_amdgcn_s_getreg((3 << 11) | 20) & 0xFu; }
#define XB_SPIN(cond, bar) do { unsigned _sp = 0; while (cond) { __builtin_amdgcn_s_sleep(1); \
    if ((++_sp & 255u) == 0u) { if (xb_ld(&(bar)[XB_TMO])) break; if (_sp > XB_SPIN_CAP) { atomicAdd(&(bar)[XB_TMO], 1u); break; } } } } while (0)

struct XcdBarrier {
    unsigned* bar; unsigned x;
    volatile LAS unsigned* st;
};

__device__ __forceinline__ XcdBarrier xcd_barrier_post(unsigned* bar, volatile LAS unsigned* st) {
    XcdBarrier b; b.bar = bar; b.x = xb_xcc_id(); b.st = st;
    if (threadIdx.x == 0) (void)xb_add(&bar[XB_XCNT(b.x)], 1u);
    return b;
}
__device__ __forceinline__ void xcd_barrier_complete(unsigned* bar, unsigned x, unsigned& nloc, unsigned& nx) {
    const unsigned G = gridDim.x * gridDim.y * gridDim.z;
    unsigned sum, cnt, mine, sp = 0u;
    for (;;) {
        sum = 0u; cnt = 0u; mine = 0u;
#pragma unroll
        for (unsigned j = 0; j < 16; ++j) { const unsigned c = xb_ld(&bar[XB_XCNT(j)]); sum += c; cnt += (c > 0u) ? 1u : 0u; mine = (j == x) ? c : mine; }
        if (sum == G) break;
        __builtin_amdgcn_s_sleep(1);
        if ((++sp & 255u) == 0u) { if (xb_ld(&bar[XB_TMO])) break; if (sp > XB_SPIN_CAP) { atomicAdd(&bar[XB_TMO], 1u); break; } }
    }
    nloc = mine > 0u ? mine : 1u; nx = cnt > 0u ? cnt : 1u;
}

__device__ __forceinline__ void xcd_barrier(const XcdBarrier& b) {
    asm volatile("s_waitcnt vmcnt(0)" ::: "memory");
    __syncthreads();
    if (threadIdx.x == 0) {
        unsigned* bar = b.bar;
        __builtin_amdgcn_s_waitcnt(0);
        unsigned nloc = b.st[0], nx = b.st[1];
        if (nloc == 0u) { xcd_barrier_complete(bar, b.x, nloc, nx); b.st[0] = nloc; b.st[1] = nx; }
        const unsigned old = xb_add(&bar[XB_XSUB(b.x)], 1u);
        const unsigned gen = old / nloc;
        if (old + 1u == (gen + 1u) * nloc) {
            __builtin_amdgcn_fence(__ATOMIC_RELEASE, "agent");
            asm volatile("s_waitcnt vmcnt(0)" ::: "memory");
            const unsigned og = xb_add(&bar[XB_TOP], 1u);
            const unsigned tg = og / nx;
            if (og + 1u == (tg + 1u) * nx) xb_add(&bar[XB_TOPGEN], 1u);
            else XB_SPIN(xb_ld(&bar[XB_TOPGEN]) == tg, bar);
            __builtin_amdgcn_fence(__ATOMIC_ACQUIRE, "agent");
            xb_add(&bar[XB_XGEN(b.x)], 1u);
            asm volatile("s_waitcnt vmcnt(0)" ::: "memory");
        } else {
            XB_SPIN(xb_ld(&bar[XB_XGEN(b.x)]) == gen, bar);
            __builtin_amdgcn_fence(__ATOMIC_ACQUIRE, "agent");
            asm volatile("s_waitcnt vmcnt(0)" ::: "memory");
        }
    }
    __syncthreads();
}

struct Args { const float* in[20]; float* out; unsigned char* ws; int ph_lo, ph_hi, li, pad; };

struct Frame {
    LAS unsigned char* lds;
    volatile LAS unsigned* MISC;
    gu32* ctl;
    int tid, lane, wave, G;
};

__device__ __forceinline__ int inproj_src_col(int n) { if (n < 3072) return n; if (n < 5632) return n + 16; if (n < 5648) return n - 5632 + 3072; return -1; }
template <bool MAP>
__device__ __forceinline__ void p0_transpose_item(const float* W, int K, int Nsrc, int Ndst, bf16* WT, LAS float* scr, int item, int lane) {
    const int nblk = Ndst / 32, kb = item / nblk, nb = item % nblk, k0 = 64 * kb, n0 = 32 * nb;
    const int nsrc = MAP ? inproj_src_col(n0 + (lane & 31)) : n0 + (lane & 31);
#pragma unroll 8
    for (int i = 0; i < 32; ++i) { const int kk = 2 * i + (lane >> 5); scr[kk * 33 + (lane & 31)] = nsrc >= 0 ? W[(size_t)(k0 + kk) * Nsrc + nsrc] : 0.f; }
    LDS_WAIT(); asm volatile("" ::: "memory");
    const int c = lane & 7;
#pragma unroll
    for (int j = 0; j < 4; ++j) { const int n = (lane >> 3) + 8 * j; const LAS float* s = scr + (8 * c) * 33 + n;
        v4u o; o.x = pk2(s[0 * 33], s[1 * 33]); o.y = pk2(s[2 * 33], s[3 * 33]); o.z = pk2(s[4 * 33], s[5 * 33]); o.w = pk2(s[6 * 33], s[7 * 33]);
        *(GAS v4u*)(WT + (size_t)(n0 + n) * K + k0 + 8 * c) = o; }
    LDS_WAIT(); asm volatile("" ::: "memory");
}
__device__ __forceinline__ void p0_prologue(Frame& F, const Args& a) {
    unsigned char* ws = a.ws;
    LAS float* scr = (LAS float*)(F.lds + RING_OFF + F.wave * 16384);
    const int gw = blockIdx.x * NWAVES + F.wave, NGW = F.G * NWAVES;
    constexpr int I_IN = (D / 64) * (INWP / 32), I_SB = (512 / 64) * (D / 32), I_O = (D / 64) * (D / 32), I_Q = (D / 64) * (PQW / 32);
    constexpr int NITEMS = I_IN + 2 * I_SB + I_O + I_Q;
    for (int it = gw; it < NITEMS; it += NGW) {
        int r = it;
        if (r < I_IN) { p0_transpose_item<true>(a.in[5], D, INW, INWP, (bf16*)(ws + WS_WIN), scr, r, F.lane); continue; } r -= I_IN;
        if (r < I_SB) { p0_transpose_item<false>(a.in[12], 512, D, D, (bf16*)(ws + WS_WSB), scr, r, F.lane); continue; } r -= I_SB;
        if (r < I_SB) { p0_transpose_item<false>(a.in[13], 512, D, D, (bf16*)(ws + WS_WGDN), scr, r, F.lane); continue; } r -= I_SB;
        if (r < I_O) { p0_transpose_item<false>(a.in[14], D, D, D, (bf16*)(ws + WS_WO), scr, r, F.lane); continue; } r -= I_O;
        p0_transpose_item<false>(a.in[16], D, PQW, PQW, (bf16*)(ws + WS_WQ), scr, r, F.lane);
    }
    { const float* sk = a.in[17]; bf16* o = (bf16*)(ws + WS_SKEY);
      for (int i = (blockIdx.x * 512 + F.tid) * 4; i < PH * 2 * PNK * PHALF; i += F.G * 512 * 4) { const f32x4 v = *(const f32x4*)(sk + i); v2u w; w.x = pk2(v.x, v.y); w.y = pk2(v.z, v.w); *(v2u*)(o + i) = w; } }
    { const float* c = a.in[1]; const float* wa = a.in[2]; const float* ba = a.in[3]; float* mod = (float*)(ws + WS_MOD);
      LAS float* red = (LAS float*)(F.lds + RING_OFF);
      for (int it = blockIdx.x; it < 6 * D / 64; it += F.G) {
          const int n = it * 64 + F.lane; float a0 = 0.f, a1 = 0.f;
          __syncthreads();
          for (int k = F.wave * 128; k < F.wave * 128 + 128; ++k) { const float w = wa[(size_t)k * (6 * D) + n]; a0 += siluf(c[k]) * w; a1 += siluf(c[D + k]) * w; }
          red[(F.wave * 2 + 0) * 64 + F.lane] = a0; red[(F.wave * 2 + 1) * 64 + F.lane] = a1;
          __syncthreads();
          if (F.wave < 2) { float s = 0.f;
#pragma unroll
              for (int w = 0; w < 8; ++w) s += red[(w * 2 + F.wave) * 64 + F.lane];
              mod[(size_t)F.wave * 6 * D + n] = s + ba[n]; }
      }
      __syncthreads(); }
}
__device__ __forceinline__ void norm_mod_rows(Frame& F, const float* x, const float* nw, const float* mod, int ch_shift, bf16* o) {
    const int gw = blockIdx.x * NWAVES + F.wave, NGW = F.G * NWAVES;
    for (int m = gw; m < M; m += NGW) {
        const GAS f32x4* xr = (const GAS f32x4*)(x + (size_t)m * D) + F.lane;
        f32x4 v[4]; float s = 0.f;
#pragma unroll
        for (int j = 0; j < 4; ++j) { v[j] = xr[64 * j]; s += (v[j].x * v[j].x + v[j].y * v[j].y) + (v[j].z * v[j].z + v[j].w * v[j].w); }
        const float rstd = 1.0f / sqrtf(wave_sum(s) * (1.f / D) + EPS);
        const float* sh = mod + (size_t)(m >> 13) * 6 * D + ch_shift * D; const float* sc = sh + D;
        GAS v2u* o8 = (GAS v2u*)(o + (size_t)m * D) + F.lane;
#pragma unroll
        for (int j = 0; j < 4; ++j) { const int c = 4 * F.lane + 256 * j; const f32x4 w = *(const f32x4*)(nw + c), a = *(const f32x4*)(sc + c), b = *(const f32x4*)(sh + c);
            const f32x4 y = v[j] * rstd * w * (a + 1.0f) + b; v2u p; p.x = pk2(y.x, y.y); p.y = pk2(y.z, y.w); o8[64 * j] = p; }
    }
}
__device__ __forceinline__ float gelu_erf(float v) { return 0.5f * v * (1.0f + erff(v * 0.70710678118654752f)); }
__device__ __forceinline__ void p10_peer(Frame& F, const Args& a) {
    unsigned char* ws = a.ws;
    const bf16* h2 = (const bf16*)(ws + WS_XN); const int* eidx = (const int*)(ws + WS_EIDX); const float* gate = (const float*)(ws + WS_GATE);
    const float* ut = a.in[18]; const float* vt = a.in[19]; const float* mod = (const float*)(ws + WS_MOD); float* out = a.out;
    LAS float* acts = (LAS float*)(F.lds + RING_OFF + F.wave * 1024); LAS float* coefs = acts + 128;
    const int gw = blockIdx.x * NWAVES + F.wave, NGW = F.G * NWAVES, g = F.lane >> 4, sub = F.lane & 15;
    for (int t = gw; t < M; t += NGW) {
        f32x4 h[16];
#pragma unroll
        for (int j = 0; j < 16; ++j) { const v2u w = *(const v2u*)(h2 + (size_t)t * D + sub * 4 + 64 * j); h[j] = (f32x4){bflo(w.x), bfhi(w.x), bflo(w.y), bfhi(w.y)}; }
        const int* et = eidx + (size_t)t * 128;
#pragma unroll 2
        for (int i = 0; i < 32; ++i) {
            const int e = et[4 * i + g]; const float* ur = ut + (size_t)e * D + sub * 4; float s = 0.f;
#pragma unroll
            for (int j = 0; j < 16; ++j) { const f32x4 u = *(const f32x4*)(ur + 64 * j); s += (u.x * h[j].x + u.y * h[j].y) + (u.z * h[j].z + u.w * h[j].w); }
            s += __shfl_xor(s, 1); s += __shfl_xor(s, 2); s += __shfl_xor(s, 4); s += __shfl_xor(s, 8);
            if (sub == 0) acts[4 * i + g] = s;
        }
        LDS_WAIT(); asm volatile("" ::: "memory");
        { const float a0 = acts[F.lane], a1 = acts[64 + F.lane];
          coefs[F.lane] = gate[(size_t)t * 128 + F.lane] * gelu_erf(a0); coefs[64 + F.lane] = gate[(size_t)t * 128 + 64 + F.lane] * gelu_erf(a1); }
        LDS_WAIT(); asm volatile("" ::: "memory");
        f32x4 acc[4] = {(f32x4){0.f, 0.f, 0.f, 0.f}, (f32x4){0.f, 0.f, 0.f, 0.f}, (f32x4){0.f, 0.f, 0.f, 0.f}, (f32x4){0.f, 0.f, 0.f, 0.f}};
#pragma unroll 8
        for (int e = 0; e < 128; ++e) { const float cf = coefs[e]; const float* vr = vt + (size_t)et[e] * D + 4 * F.lane;
#pragma unroll
            for (int j = 0; j < 4; ++j) acc[j] += cf * *(const f32x4*)(vr + 256 * j); }
        const float* g2 = mod + (size_t)(t >> 13) * 6 * D + 5 * D;
#pragma unroll
        for (int j = 0; j < 4; ++j) { const int c = 4 * F.lane + 256 * j; float* op = out + (size_t)t * D + c; *(f32x4*)op = *(const f32x4*)op + *(const f32x4*)(g2 + c) * acc[j]; }
        LDS_WAIT(); asm volatile("" ::: "memory");
    }
}


__device__ __forceinline__ void p3_prep_naive(Frame& F, const Args& a) {
    unsigned char* ws = a.ws; const int lane = F.lane;
    const int gw = blockIdx.x * NWAVES + F.wave, NGW = F.G * NWAVES;
    const float* qnw = a.in[6]; const float* knw = a.in[7];
    for (int t = gw; t < M; t += NGW) {
#pragma unroll
        for (int which = 0; which < 2; ++which) {
            bf16* p = (bf16*)(ws + (which ? WS_K : WS_Q)) + (size_t)t * 512 + 8 * lane; const float* nw = which ? knw : qnw;
            const v4u w = *(const v4u*)p; float v[8] = {bflo(w.x), bfhi(w.x), bflo(w.y), bfhi(w.y), bflo(w.z), bfhi(w.z), bflo(w.w), bfhi(w.w)};
            float s = 0.f;
#pragma unroll
            for (int i = 0; i < 8; ++i) s += v[i] * v[i];
            s += __shfl_xor(s, 1); s += __shfl_xor(s, 2); s += __shfl_xor(s, 4);
            const float r = 1.0f / sqrtf(s * (1.f / 64.f) + EPS) * (which ? 1.0f : 0.125f);
            const int d0 = (8 * lane) & 63;
#pragma unroll
            for (int i = 0; i < 8; ++i) v[i] = v[i] * r * nw[d0 + i];
            v4u o; o.x = pk2(v[0], v[1]); o.y = pk2(v[2], v[3]); o.z = pk2(v[4], v[5]); o.w = pk2(v[6], v[7]); *(v4u*)p = o;
        }
        const bf16* graw = (const bf16*)(ws + WS_GRAW); const float* cw = a.in[8]; const int tl = t & (SEQ - 1);
#pragma unroll
        for (int part = 0; part < 3; ++part) {
            const int c0 = part * 512 + 8 * lane; float acc[8] = {0.f, 0.f, 0.f, 0.f, 0.f, 0.f, 0.f, 0.f};
#pragma unroll
            for (int j = 0; j < 4; ++j) { const int tt = tl - 3 + j; if (tt < 0) continue;
                const v4u w = *(const v4u*)(graw + (size_t)(t - 3 + j) * 1536 + c0); const float* cwj = cw + j * 1536 + c0;
                const float v[8] = {bflo(w.x), bfhi(w.x), bflo(w.y), bfhi(w.y), bflo(w.z), bfhi(w.z), bflo(w.w), bfhi(w.w)};
#pragma unroll
                for (int i = 0; i < 8; ++i) acc[i] += v[i] * cwj[i]; }
#pragma unroll
            for (int i = 0; i < 8; ++i) acc[i] = siluf(acc[i]);
            if (part < 2) { float s = 0.f;
#pragma unroll
                for (int i = 0; i < 8; ++i) s += acc[i] * acc[i];
                s += __shfl_xor(s, 1); s += __shfl_xor(s, 2); s += __shfl_xor(s, 4);
                const float r = 1.0f / sqrtf(s + EPS) * (part == 0 ? 0.125f : 1.0f);
#pragma unroll
                for (int i = 0; i < 8; ++i) acc[i] *= r; }
            bf16* dst = (bf16*)(ws + (part == 0 ? WS_XN : part == 1 ? WS_XN + 16 * MiB : WS_VG)) + (size_t)t * 512 + 8 * lane;
            v4u o; o.x = pk2(acc[0], acc[1]); o.y = pk2(acc[2], acc[3]); o.z = pk2(acc[4], acc[5]); o.w = pk2(acc[6], acc[7]); *(v4u*)dst = o;
        }
        if (lane < 8) { const float* ab = (const float*)(ws + WS_AB) + (size_t)t * 16; float* gb = (float*)(ws + WS_GB);
            const float av = ab[lane], bv = ab[8 + lane];
            gb[(size_t)t * 8 + lane] = -__expf(a.in[9][lane]) * softplusf(av + a.in[10][lane]);
            gb[(size_t)M * 8 + (size_t)t * 8 + lane] = sigm(bv); }
    }
}
__device__ __forceinline__ void p4_attn_naive(Frame& F, const Args& a, int blk, int nblk) {
    unsigned char* ws = a.ws;
    const bf16* Q = (const bf16*)(ws + WS_Q); const bf16* K = (const bf16*)(ws + WS_K); const bf16* V = (const bf16*)(ws + WS_V);
    for (int gid = blk * 512 + F.tid; gid < BATCH * SBH * SEQ; gid += nblk * 512) {
        const int t = gid & (SEQ - 1), bh = gid >> 13, h = bh & 7, b = bh >> 3;
        const size_t row = (size_t)b * SEQ + t;
        float q[64], o[64];
#pragma unroll
        for (int i = 0; i < 8; ++i) { const v4u w = *(const v4u*)(Q + row * 512 + h * 64 + 8 * i);
            q[8 * i] = bflo(w.x); q[8 * i + 1] = bfhi(w.x); q[8 * i + 2] = bflo(w.y); q[8 * i + 3] = bfhi(w.y); q[8 * i + 4] = bflo(w.z); q[8 * i + 5] = bfhi(w.z); q[8 * i + 6] = bflo(w.w); q[8 * i + 7] = bfhi(w.w); }
#pragma unroll
        for (int i = 0; i < 64; ++i) o[i] = 0.f;
        float R = 0.f;
        for (int s = t - 1; s >= 0; --s) {
            const size_t kr = ((size_t)b * SEQ + s) * 512 + h * 64; float z = 0.f;
#pragma unroll
            for (int i = 0; i < 8; ++i) { const v4u w = *(const v4u*)(K + kr + 8 * i);
                z += q[8 * i] * bflo(w.x) + q[8 * i + 1] * bfhi(w.x) + q[8 * i + 2] * bflo(w.y) + q[8 * i + 3] * bfhi(w.y) + q[8 * i + 4] * bflo(w.z) + q[8 * i + 5] * bfhi(w.z) + q[8 * i + 6] * bflo(w.w) + q[8 * i + 7] * bfhi(w.w); }
            const float sp = softplusf(z); const float p = __expf(z - sp - R); R += sp;
#pragma unroll
            for (int i = 0; i < 8; ++i) { const v4u w = *(const v4u*)(V + kr + 8 * i);
                o[8 * i] += p * bflo(w.x); o[8 * i + 1] += p * bfhi(w.x); o[8 * i + 2] += p * bflo(w.y); o[8 * i + 3] += p * bfhi(w.y); o[8 * i + 4] += p * bflo(w.z); o[8 * i + 5] += p * bfhi(w.z); o[8 * i + 6] += p * bflo(w.w); o[8 * i + 7] += p * bfhi(w.w); }
            if (R > 105.f) break;
        }
        bf16* y = (bf16*)(ws + WS_YSB) + row * 512 + h * 64;
#pragma unroll
        for (int i = 0; i < 8; ++i) { v4u w; w.x = pk2(o[8 * i], o[8 * i + 1]); w.y = pk2(o[8 * i + 2], o[8 * i + 3]); w.z = pk2(o[8 * i + 4], o[8 * i + 5]); w.w = pk2(o[8 * i + 6], o[8 * i + 7]); *(v4u*)(y + 8 * i) = w; }
    }
}
__device__ __forceinline__ void p4_gdn_naive(Frame& F, const Args& a, int bh) {
    unsigned char* ws = a.ws; const int h = bh & 7, b = bh >> 3, j = F.tid & 63, r = F.tid >> 6;
    const bf16* QG = (const bf16*)(ws + WS_XN); const bf16* KG = (const bf16*)(ws + WS_XN + 16 * MiB); const bf16* VG = (const bf16*)(ws + WS_VG);
    const bf16* Z = (const bf16*)(ws + WS_Z); const float* gb = (const float*)(ws + WS_GB); const float* onw = a.in[11];
    bf16* Y = (bf16*)(ws + WS_YGDN);
    LAS float* qs = (LAS float*)(F.lds + RING_OFF); LAS float* ks = qs + 128; LAS float* part = ks + 128; LAS float* part2 = part + 256;
    float S[16];
#pragma unroll
    for (int i = 0; i < 16; ++i) S[i] = 0.f;
    for (int t = 0; t < SEQ; ++t) {
        const size_t row = (size_t)b * SEQ + t; const int bufi = t & 1;
        float v = 0.f, g = 0.f, beta = 0.f;
        if (r == 0) qs[bufi * 64 + j] = bf2f(QG[row * 512 + h * 64 + j]); else if (r == 1) ks[bufi * 64 + j] = bf2f(KG[row * 512 + h * 64 + j]);
        if (r < 4) { v = bf2f(VG[row * 512 + h * 64 + j]); g = gb[row * 8 + h]; beta = gb[(size_t)M * 8 + row * 8 + h]; }
        __syncthreads();
        if (r < 4) { const float eg = __expf(g); float ps = 0.f;
#pragma unroll
            for (int i = 0; i < 16; ++i) { S[i] *= eg; ps += ks[bufi * 64 + 16 * r + i] * S[i]; }
            part[r * 64 + j] = ps; }
        __syncthreads();
        if (r < 4) { const float kS = (part[j] + part[64 + j]) + (part[128 + j] + part[192 + j]); const float dlt = beta * (v - kS); float po = 0.f;
#pragma unroll
            for (int i = 0; i < 16; ++i) { S[i] += ks[bufi * 64 + 16 * r + i] * dlt; po += qs[bufi * 64 + 16 * r + i] * S[i]; }
            part2[r * 64 + j] = po; }
        __syncthreads();
        if (r == 0) { const float o = (part2[j] + part2[64 + j]) + (part2[128 + j] + part2[192 + j]);
            const float ms = wave_sum(o * o) * (1.f / 64.f); const float y = o * (1.0f / sqrtf(ms + EPS)) * onw[j] * siluf(bf2f(Z[row * 512 + h * 64 + j]));
            Y[row * 512 + h * 64 + j] = (bf16)f2bf(y); }
    }
}
__device__ __forceinline__ void p9_topk_naive(Frame& F, const Args& a) {
    unsigned char* ws = a.ws; const int tid = F.tid;
    const bf16* QP = (const bf16*)(ws + WS_QP); const bf16* SK = (const bf16*)(ws + WS_SKEY);
    LAS float* sv = (LAS float*)(F.lds + RING_OFF);
    LAS int* si = (LAS int*)(sv + 2 * 16 * 256);
    LAS int* ptr = si + 2 * 16 * 256;
    LAS unsigned short* keys = (LAS unsigned short*)(ptr + 16 * 256);
    const bool act = tid < 256;
    for (int it = blockIdx.x; it < (M / 256) * PH; it += F.G) {
        const int h = it & 7, t = (it >> 3) * 256 + (tid & 255);
        for (int p = 0; p < 2; ++p) {
            __syncthreads();
            for (int i = tid; i < 128 * 128 / 8; i += 512) ((LAS v4u*)keys)[i] = ((const v4u*)(SK + (size_t)(h * 2 + p) * 128 * 128))[i];
            __syncthreads();
            if (act) {
                unsigned qreg[64];
#pragma unroll
                for (int i = 0; i < 16; ++i) { const v4u w = *(const v4u*)(QP + (size_t)t * PQW + h * 256 + p * 128 + 8 * i); qreg[4 * i] = w.x; qreg[4 * i + 1] = w.y; qreg[4 * i + 2] = w.z; qreg[4 * i + 3] = w.w; }
                int cnt = 0;
                for (int key = 0; key < 128; ++key) {
                    float s = 0.f;
#pragma unroll
                    for (int i = 0; i < 16; ++i) { const v4u w = *(const LAS v4u*)(keys + key * 128 + 8 * i);
                        s += bflo(qreg[4 * i]) * bflo(w.x) + bfhi(qreg[4 * i]) * bfhi(w.x) + bflo(qreg[4 * i + 1]) * bflo(w.y) + bfhi(qreg[4 * i + 1]) * bfhi(w.y)
                           + bflo(qreg[4 * i + 2]) * bflo(w.z) + bfhi(qreg[4 * i + 2]) * bfhi(w.z) + bflo(qreg[4 * i + 3]) * bflo(w.w) + bfhi(qreg[4 * i + 3]) * bfhi(w.w); }
                    int pos = cnt < 16 ? cnt : 16;
                    while (pos > 0 && s > sv[(p * 16 + pos - 1) * 256 + tid]) { if (pos < 16) { sv[(p * 16 + pos) * 256 + tid] = sv[(p * 16 + pos - 1) * 256 + tid]; si[(p * 16 + pos) * 256 + tid] = si[(p * 16 + pos - 1) * 256 + tid]; } --pos; }
                    if (pos < 16) { sv[(p * 16 + pos) * 256 + tid] = s; si[(p * 16 + pos) * 256 + tid] = key; }
                    if (cnt < 16) ++cnt;
                }
            }
        }
        if (act) {
            for (int i = 0; i < 16; ++i) ptr[i * 256 + tid] = 0;
            float top[16]; int eid[16];
#pragma unroll
            for (int rnk = 0; rnk < 16; ++rnk) {
                float best = -INFINITY; int bi = 0;
                for (int i = 0; i < 16; ++i) { const int jj = ptr[i * 256 + tid]; if (jj < 16) { const float c = sv[i * 256 + tid] + sv[(16 + jj) * 256 + tid]; if (c > best) { best = c; bi = i; } } }
                const int bj = ptr[bi * 256 + tid]; ptr[bi * 256 + tid] = bj + 1;
                top[rnk] = best; eid[rnk] = si[bi * 256 + tid] * 128 + si[(16 + bj) * 256 + tid];
            }
            float mx = top[0], den = 0.f;
#pragma unroll
            for (int rnk = 0; rnk < 16; ++rnk) { top[rnk] = __expf(top[rnk] - mx); den += top[rnk]; }
            int* eo = (int*)(ws + WS_EIDX) + (size_t)t * 128 + h * 16; float* go = (float*)(ws + WS_GATE) + (size_t)t * 128 + h * 16;
#pragma unroll
            for (int rnk = 0; rnk < 16; ++rnk) { eo[rnk] = eid[rnk]; go[rnk] = top[rnk] / den; }
        }
    }
    __syncthreads();
}
__global__ void __launch_bounds__(NWAVES * 64, 2) mk_fwd(Args args) {
    extern __shared__ __attribute__((aligned(16))) unsigned char lds[];
    Frame F;
    F.lds = (LAS unsigned char*)lds;
    F.MISC = (volatile LAS unsigned*)(F.lds + MISC_OFF);
    F.tid = threadIdx.x; F.lane = F.tid & 63; F.wave = __builtin_amdgcn_readfirstlane(F.tid >> 6);
    F.G = gridDim.x;
    unsigned char* ws = args.ws;
    F.ctl = (gu32*)(ws + WS_CTL);
    for (int u = F.tid; u < (LDS_BYTES - LDSCTL_OFF) / 4; u += NWAVES * 64) ((LAS unsigned*)(F.lds + LDSCTL_OFF))[u] = 0u;
    __syncthreads();
    const bool multi = (args.ph_hi - args.ph_lo) > 1;
    XcdBarrier bar; bar.bar = (unsigned*)(F.ctl + CW_BAR); bar.x = 0; bar.st = nullptr;
    if (multi) bar = xcd_barrier_post((unsigned*)(F.ctl + CW_BAR), F.MISC + 8);
    const int lo = args.ph_lo, hi = args.ph_hi;
#define IN(k) (lo <= (k) && (k) < hi)
#define SEAM(k) do { if (IN(k) && (k) + 1 < hi) xcd_barrier(bar); } while (0)
    const float* mod = (const float*)(ws + WS_MOD);

    if (IN(0)) { p0_prologue(F, args); } SEAM(0);
    if (IN(1)) { norm_mod_rows(F, args.in[0], args.in[4], mod, 0, (bf16*)(ws + WS_XN)); } SEAM(1);
    if (IN(2)) {
        pg8::Gemm g{(const bf16*)(ws + WS_XN), (const bf16*)(ws + WS_WIN), M, INWP, D}; pg8::StaticOrder S; S.init(M, INWP, F.G, (int)blockIdx.x);
        pg8::EpiInProj E{(bf16*)(ws + WS_Q), (bf16*)(ws + WS_K), (bf16*)(ws + WS_V), (bf16*)(ws + WS_GRAW), (bf16*)(ws + WS_Z), (bf16*)args.out, (float*)(ws + WS_AB)};
        pg8::gemm_phase<pg8::EpiInProj, pg8::StaticOrder, true, true>(F.lds + RING_OFF, g, S, E);
    } SEAM(2);
    if (IN(3)) { p3_prep_naive(F, args); } SEAM(3);
    if (IN(4)) { if (blockIdx.x < BATCH * GH) p4_gdn_naive(F, args, (int)blockIdx.x); else p4_attn_naive(F, args, (int)blockIdx.x - BATCH * GH, F.G - BATCH * GH); } SEAM(4);
    if (IN(5)) {
        { pg8::Gemm g{(const bf16*)(ws + WS_YSB), (const bf16*)(ws + WS_WSB), M, D, 512}; pg8::StaticOrder S; S.init(M, D, F.G, (int)blockIdx.x);
          pg8::EpiMerge<0> E{(const bf16*)args.out, (bf16*)(ws + WS_MERGED)};
          pg8::gemm_phase<pg8::EpiMerge<0>, pg8::StaticOrder, true, true>(F.lds + RING_OFF, g, S, E); }
        VM_WAIT(); __syncthreads();
        if (F.tid == 0) { __builtin_amdgcn_fence(__ATOMIC_ACQ_REL, "agent"); VM_WAIT(); }
        __syncthreads();
        { pg8::Gemm g{(const bf16*)(ws + WS_YGDN), (const bf16*)(ws + WS_WGDN), M, D, 512}; pg8::StaticOrder S; S.init(M, D, F.G, (int)blockIdx.x);
          pg8::EpiMerge<1> E{(const bf16*)args.out, (bf16*)(ws + WS_MERGED)};
          pg8::gemm_phase<pg8::EpiMerge<1>, pg8::StaticOrder, true, true>(F.lds + RING_OFF, g, S, E); }
    } SEAM(5);
    if (IN(6)) {
        pg8::Gemm g{(const bf16*)(ws + WS_MERGED), (const bf16*)(ws + WS_WO), M, D, D}; pg8::StaticOrder S; S.init(M, D, F.G, (int)blockIdx.x);
        pg8::EpiWo E{args.in[0], mod, args.out};
        pg8::gemm_phase<pg8::EpiWo, pg8::StaticOrder, true, true>(F.lds + RING_OFF, g, S, E);
    } SEAM(6);
    if (IN(7)) { norm_mod_rows(F, args.out, args.in[15], mod, 3, (bf16*)(ws + WS_XN)); } SEAM(7);
    if (IN(8)) {
        pg8::Gemm g{(const bf16*)(ws + WS_XN), (const bf16*)(ws + WS_WQ), M, PQW, D}; pg8::StaticOrder S; S.init(M, PQW, F.G, (int)blockIdx.x);
        pg8::EpiBf16<0> E{(bf16*)(ws + WS_QP), PQW, nullptr, 0, 0, 1.f};
        pg8::gemm_phase<pg8::EpiBf16<0>, pg8::StaticOrder, true, true>(F.lds + RING_OFF, g, S, E);
    } SEAM(8);
    if (IN(9)) { p9_topk_naive(F, args); } SEAM(9);
    if (IN(10)) { p10_peer(F, args); }
#undef IN
#undef SEAM
}
extern "C" void kernel_launch(void* const* d_in, const int* in_sizes, int n_in, void* d_out, int out_size, void* d_ws, size_t ws_size, hipStream_t stream) {
    static int grid = 0;
    if (grid == 0) {
        if (n_in != 20 || out_size != M * D || ws_size < WS_END) { fprintf(stderr, "kernel_launch: unexpected shapes n_in %d out %d ws %zu\n", n_in, out_size, ws_size); grid = -1; return; }
        int dev = 0, cus = 0;
        if (hipGetDevice(&dev) != hipSuccess || hipDeviceGetAttribute(&cus, hipDeviceAttributeMultiprocessorCount, dev) != hipSuccess) { grid = -1; return; }
        if (hipFuncSetAttribute((const void*)mk_fwd, hipFuncAttributeMaxDynamicSharedMemorySize, LDS_BYTES) != hipSuccess) { fprintf(stderr, "kernel_launch: hipFuncSetAttribute failed\n"); grid = -1; return; }
        (void)hipGetLastError();
        grid = cus;
    }
    if (grid < 0) return;
    (void)hipMemsetAsync((char*)d_ws + WS_CTL, 0, CTL_ZERO_BYTES, stream);
    Args a{};
    for (int i = 0; i < 20; ++i) a.in[i] = (const float*)d_in[i];
    a.out = (float*)d_out; a.ws = (unsigned char*)d_ws;
    auto mk = [&](int lo, int hi) { a.ph_lo = lo; a.ph_hi = hi; a.li = 0; hipLaunchKernelGGL(mk_fwd, dim3(grid), dim3(NWAVES * 64), LDS_BYTES, stream, a); };
    mk(0, 11);
}
```

```cpp
#include <hip/hip_runtime.h>
#include <cstdio>
#include <cstdint>
#include <cmath>

constexpr int D = 1024, BATCH = 2, SEQ = 8192, M = BATCH * SEQ;
constexpr int SBH = 8, SBD = 64, SBW = 512;
constexpr int GH = 8, GDK = 64, GDV = 64, GCONVW = 1536;
constexpr int INW = 5648, INWP = 5888;
constexpr int PH = 8, PNK = 128, PQD = 256, PHALF = 128, PTOPK = 16, PNE = 16384, PQW = PH * PQD;
constexpr float EPS = 1e-6f;

namespace pg8 {
#define PG8_LAS __attribute__((address_space(3)))
typedef unsigned short bf16_t;
typedef short bf16x8 __attribute__((ext_vector_type(8)));
typedef float f32x4 __attribute__((ext_vector_type(4)));
typedef unsigned u32x4 __attribute__((ext_vector_type(4)));
constexpr int BM = 256, BK = 64, HALF = 128, HTB = HALF * BK * 2  , STAGE_BYTES = 8 * HTB, NXCD = 8, WGM = 8;

__host__ __device__ __forceinline__ int lds_byte(int r, int c) { const int st = (r >> 4) * 2 + (c >> 5), rr = r & 15, cc = c & 31, ob = rr * 64 + cc * 2; return st * 1024 + (ob ^ (((ob >> 9) & 1) << 5)); }
__host__ __device__ __forceinline__ void stage_rc(int b, int& R, int& C) { const int st = b / 1024, sb = b % 1024, swz = sb ^ (((sb >> 9) & 1) << 5); R = (st >> 1) * 16 + swz / 64; C = (st & 1) * 32 + (swz % 64) / 2; }
__host__ __device__ __forceinline__ int perm32(int rho) { const int n = rho >> 4, i = rho & 15; return 8 * (i >> 2) + 4 * n + (i & 3); }

struct Unit { int pm, pn; };
struct Gemm { const bf16_t* A; const bf16_t* Bt; int M, N, K; };

struct StaticOrder {
    int nM, nN, nwg, G, c;
    __host__ __device__ void init(int M, int N, int G_, int c_) { nM = M / BM; nN = N / BM; nwg = nM * nN; G = G_; c = c_; }
    __host__ __device__ bool next(int i, Unit& u) const {
        const long L = (long)i * G + c; if (L >= nwg) return false;
        int wgid = (int)L; { const int q = nwg / NXCD, r = nwg % NXCD, xcd = wgid % NXCD, off = wgid / NXCD; wgid = (xcd < r ? xcd * (q + 1) : r * (q + 1) + (xcd - r) * q) + off; }
        const int nig = WGM * nN, gid = wgid / nig, fm = gid * WGM, gsz = (nM - fm) < WGM ? (nM - fm) : WGM;
        u.pm = fm + ((wgid % nig) % gsz); u.pn = (wgid % nig) / gsz; return true;
    }
    __device__ __forceinline__ void a_ready(const Unit&) const {}
    __device__ __forceinline__ void done(const Unit&) const {}
};

__device__ __forceinline__ unsigned cvt_pk_bf16(float lo, float hi) { unsigned r; asm volatile("v_cvt_pk_bf16_f32 %0, %1, %2" : "=v"(r) : "v"(lo), "v"(hi)); return r; }
typedef float f32x2 __attribute__((ext_vector_type(2)));
__device__ __forceinline__ f32x2 gelu_pk(f32x2 v) {
    const f32x2 av = __builtin_elementwise_abs(v), d = av * 0.2316418882f + 1.0f;
    f32x2 t; t.x = __builtin_amdgcn_rcpf(d.x); t.y = __builtin_amdgcn_rcpf(d.y);
    f32x2 q = t * 0.5307027145f + (-0.7265760135f); q = q * t + 0.7107068705f; q = q * t + (-0.142248368f); q = q * t + 0.127414796f; q = q * t;
    const f32x2 s = (v * v) * (-0.72134752044f);
    f32x2 e; e.x = __builtin_amdgcn_exp2f(s.x); e.y = __builtin_amdgcn_exp2f(s.y);
    const f32x2 m = v * (q * e), r = v - m;
    f32x2 o; o.x = v.x < 0.f ? m.x : r.x; o.y = v.y < 0.f ? m.y : r.y; return o;
}

template <int ACT  > struct EpiBf16 {
    static constexpr bool PERM = true, AFTER_DRAIN = false; static_assert(ACT == 0 || ACT == 1, "EpiBf16: ACT is 0 (none) or 1 (gelu_pk)");
    bf16_t* O; int ldc; const float* bias; int split_cols; size_t split_stride; float scale0;
    __device__ __forceinline__ void operator()(const f32x4 (&acc)[2][2][4][2], const Unit& u, int wr, int wc, int fr, int fq) const {
        const int row0 = u.pm * BM + wr * 64 + fr; int colt = u.pn * BM; bf16_t* base = O;
        float sc = 1.f; if (split_cols) { const int t = colt / split_cols; base += (size_t)t * split_stride; colt -= t * split_cols; if (t == 0) sc = scale0; }
        const int col0 = colt + wc * 32 + 8 * fq, bcol0 = u.pn * BM + wc * 32 + 8 * fq;
        f32x4 bv[2][2];
#pragma unroll
        for (int bj = 0; bj < 2; ++bj)
#pragma unroll
            for (int n = 0; n < 2; ++n) bv[bj][n] = bias ? *(const f32x4*)(bias + bcol0 + bj * HALF + 4 * n) : (f32x4){0.f, 0.f, 0.f, 0.f};
#pragma unroll
        for (int ai = 0; ai < 2; ++ai)
#pragma unroll
            for (int m = 0; m < 4; ++m) { bf16_t* rowp = base + (size_t)(row0 + ai * HALF + m * 16) * ldc + col0;
#pragma unroll
                for (int bj = 0; bj < 2; ++bj) { f32x4 v0 = acc[ai][bj][m][0] + bv[bj][0], v1 = acc[ai][bj][m][1] + bv[bj][1];
                    if (ACT == 1) { f32x2 a = gelu_pk((f32x2){v0[0], v0[1]}), b = gelu_pk((f32x2){v0[2], v0[3]}), c = gelu_pk((f32x2){v1[0], v1[1]}), d = gelu_pk((f32x2){v1[2], v1[3]});
                        v0 = (f32x4){a.x, a.y, b.x, b.y}; v1 = (f32x4){c.x, c.y, d.x, d.y}; }
                    v0 = v0 * sc; v1 = v1 * sc; u32x4 w; w.x = cvt_pk_bf16(v0[0], v0[1]); w.y = cvt_pk_bf16(v0[2], v0[3]); w.z = cvt_pk_bf16(v1[0], v1[1]); w.w = cvt_pk_bf16(v1[2], v1[3]);
                    *(u32x4*)(rowp + bj * HALF) = w; } }
    }
};

__device__ __forceinline__ float sigmoidf_(float x) { return __builtin_amdgcn_rcpf(1.0f + __expf(-x)); }
__device__ __forceinline__ float bf2f(unsigned short h) { return __uint_as_float((unsigned)h << 16); }
__device__ __forceinline__ float bflo(unsigned w) { return __uint_as_float(w << 16); }
__device__ __forceinline__ float bfhi(unsigned w) { return __uint_as_float(w & 0xffff0000u); }

struct EpiInProj {
    static constexpr bool PERM = true, AFTER_DRAIN = false;
    bf16_t *q, *k, *v, *graw, *z, *gates; float* ab;
    __device__ __forceinline__ void operator()(const f32x4 (&acc)[2][2][4][2], const Unit& u, int wr, int wc, int fr, int fq) const {
        const int pn = u.pn; bf16_t* base; int ldc, ct; bool sig = false;
        if (pn < 2) { base = q; ldc = 512; ct = pn; } else if (pn < 4) { base = k; ldc = 512; ct = pn - 2; } else if (pn < 6) { base = v; ldc = 512; ct = pn - 4; }
        else if (pn < 12) { base = graw; ldc = 1536; ct = pn - 6; } else if (pn < 14) { base = z; ldc = 512; ct = pn - 12; } else if (pn < 22) { base = gates; ldc = 2048; ct = pn - 14; sig = true; }
        else {
            if (wc == 0 && fq < 2) {
#pragma unroll
                for (int ai = 0; ai < 2; ++ai)
#pragma unroll
                    for (int m = 0; m < 4; ++m) { const int r = u.pm * BM + ai * HALF + wr * 64 + m * 16 + fr; float* p = ab + (size_t)r * 16 + 8 * fq;
                        *(f32x4*)p = acc[ai][0][m][0]; *(f32x4*)(p + 4) = acc[ai][0][m][1]; }
            }
            return;
        }
        const int row0 = u.pm * BM + wr * 64 + fr, col0 = ct * BM + wc * 32 + 8 * fq;
#pragma unroll
        for (int ai = 0; ai < 2; ++ai)
#pragma unroll
            for (int m = 0; m < 4; ++m) { bf16_t* rowp = base + (size_t)(row0 + ai * HALF + m * 16) * ldc + col0;
#pragma unroll
                for (int bj = 0; bj < 2; ++bj) { f32x4 v0 = acc[ai][bj][m][0], v1 = acc[ai][bj][m][1];
                    if (sig) { v0 = (f32x4){sigmoidf_(v0[0]), sigmoidf_(v0[1]), sigmoidf_(v0[2]), sigmoidf_(v0[3])}; v1 = (f32x4){sigmoidf_(v1[0]), sigmoidf_(v1[1]), sigmoidf_(v1[2]), sigmoidf_(v1[3])}; }
                    u32x4 w; w.x = cvt_pk_bf16(v0[0], v0[1]); w.y = cvt_pk_bf16(v0[2], v0[3]); w.z = cvt_pk_bf16(v1[0], v1[1]); w.w = cvt_pk_bf16(v1[2], v1[3]);
                    *(u32x4*)(rowp + bj * HALF) = w; } }
    }
};
template <int MODE> struct EpiMerge {
    static constexpr bool PERM = true, AFTER_DRAIN = false;
    const bf16_t* gates; bf16_t* merged;
    __device__ __forceinline__ void operator()(const f32x4 (&acc)[2][2][4][2], const Unit& u, int wr, int wc, int fr, int fq) const {
        const int row0 = u.pm * BM + wr * 64 + fr, col0 = u.pn * BM + wc * 32 + 8 * fq;
#pragma unroll
        for (int ai = 0; ai < 2; ++ai)
#pragma unroll
            for (int m = 0; m < 4; ++m) { const size_t r = (size_t)(row0 + ai * HALF + m * 16);
#pragma unroll
                for (int bj = 0; bj < 2; ++bj) { const int c = col0 + bj * HALF;
                    const u32x4 g = *(const u32x4*)(gates + r * 2048 + MODE * 1024 + c);
                    f32x4 v0 = acc[ai][bj][m][0], v1 = acc[ai][bj][m][1];
                    v0 = v0 * (f32x4){bflo(g.x), bfhi(g.x), bflo(g.y), bfhi(g.y)}; v1 = v1 * (f32x4){bflo(g.z), bfhi(g.z), bflo(g.w), bfhi(g.w)};
                    if (MODE == 1) { const u32x4 p = *(const u32x4*)(merged + r * 1024 + c);
                        v0 = v0 + (f32x4){bflo(p.x), bfhi(p.x), bflo(p.y), bfhi(p.y)}; v1 = v1 + (f32x4){bflo(p.z), bfhi(p.z), bflo(p.w), bfhi(p.w)}; }
                    u32x4 w; w.x = cvt_pk_bf16(v0[0], v0[1]); w.y = cvt_pk_bf16(v0[2], v0[3]); w.z = cvt_pk_bf16(v1[0], v1[1]); w.w = cvt_pk_bf16(v1[2], v1[3]);
                    *(u32x4*)(merged + r * 1024 + c) = w; } }
    }
};
struct EpiWo {
    static constexpr bool PERM = true, AFTER_DRAIN = false;
    const float* x; const float* mod; float* out;
    __device__ __forceinline__ void operator()(const f32x4 (&acc)[2][2][4][2], const Unit& u, int wr, int wc, int fr, int fq) const {
        const int row0 = u.pm * BM + wr * 64 + fr, col0 = u.pn * BM + wc * 32 + 8 * fq; const int b = (u.pm * BM) >> 13;
        const float* g1 = mod + (size_t)b * 6 * 1024 + 2 * 1024;
#pragma unroll
        for (int bj = 0; bj < 2; ++bj) { const int c = col0 + bj * HALF; const f32x4 ga = *(const f32x4*)(g1 + c), gb = *(const f32x4*)(g1 + c + 4);
#pragma unroll
            for (int ai = 0; ai < 2; ++ai)
#pragma unroll
                for (int m = 0; m < 4; ++m) { const size_t off = (size_t)(row0 + ai * HALF + m * 16) * 1024 + c;
                    const f32x4 xa = *(const f32x4*)(x + off), xb = *(const f32x4*)(x + off + 4);
                    *(f32x4*)(out + off) = xa + ga * acc[ai][bj][m][0]; *(f32x4*)(out + off + 4) = xb + gb * acc[ai][bj][m][1]; } }
    }
};
template <class Epi, class Sched, bool ALIGN_EPI = false, bool SP2 = false>
__device__ __forceinline__ void gemm_phase(PG8_LAS unsigned char* lds, const Gemm g, const Sched& S, const Epi& E) {
    const int tid = threadIdx.x, wid = __builtin_amdgcn_readfirstlane(tid >> 6), lane = tid & 63, wr = wid >> 2, wc = wid & 3, fr = lane & 15, fq = lane >> 4;
    const int K = g.K, nt = K / BK;
    unsigned voffA[2], voffB[2];
#pragma unroll
    for (int i = 0; i < 2; ++i) { int R, C; stage_rc(tid * 16 + i * 8192, R, C); const int Rb = Epi::PERM ? ((R & ~31) + perm32(R & 31)) : R;
        voffA[i] = (unsigned)(R * K + C) * 2u; voffB[i] = (unsigned)(Rb * K + C) * 2u; }
    const size_t kstep = (size_t)(BK * 2);
    const size_t hstep = (size_t)HALF * K * 2;
    const size_t tstep = 2 * hstep;
    const unsigned ldsw = (unsigned)wid * 1024u;
    const int aoff = lds_byte(wr * 64 + fr, fq * 8), boff = lds_byte(wc * 32 + fr, fq * 8);
#define PG8_SA(b, h) (((b) * 2 + (h)) * HTB)
#define PG8_SB(b, h) ((4 + (b) * 2 + (h)) * HTB)
#define PG8_STAGE(bufoff, gbase, voff) do { _Pragma("unroll") for (int _i = 0; _i < 2; ++_i) \
        __builtin_amdgcn_global_load_lds((const unsigned*)((const char*)(gbase) + (voff)[_i]), (PG8_LAS unsigned*)(lds + (bufoff) + ldsw + _i * 8192), 16, 0, 0); } while (0)
#define PG8_LDA(dst, b, h) do { _Pragma("unroll") for (int m = 0; m < 4; ++m) _Pragma("unroll") for (int k = 0; k < 2; ++k) dst[m][k] = *(const PG8_LAS bf16x8*)(lds + PG8_SA(b, h) + aoff + m * 2048 + k * 1024); } while (0)
#define PG8_LDB(dst, b, h) do { _Pragma("unroll") for (int n = 0; n < 2; ++n) _Pragma("unroll") for (int k = 0; k < 2; ++k) dst[n][k] = *(const PG8_LAS bf16x8*)(lds + PG8_SB(b, h) + boff + n * 2048 + k * 1024); } while (0)
#define PG8_MMA(ai, bj, At, Bt) do { __builtin_amdgcn_s_setprio(1); _Pragma("unroll") for (int m = 0; m < 4; ++m) _Pragma("unroll") for (int n = 0; n < 2; ++n) _Pragma("unroll") for (int k = 0; k < 2; ++k) \
        acc[ai][bj][m][n] = __builtin_amdgcn_mfma_f32_16x16x32_bf16(Bt[n][k], At[m][k], acc[ai][bj][m][n], 0, 0, 0); __builtin_amdgcn_s_setprio(0); } while (0)
#define PG8_WAIT_V(n) asm volatile("s_waitcnt vmcnt(" #n ")" ::: "memory")
#define PG8_WAIT_L(n) asm volatile("s_waitcnt lgkmcnt(" #n ")" ::: "memory")
#define PG8_BAR __builtin_amdgcn_s_barrier()
#define PG8_SCHED __builtin_amdgcn_sched_barrier(0)
    Unit cur, nxt; int ui = 0;
    if (!S.next(0, cur)) return;
    f32x4 acc[2][2][4][2];
#pragma unroll
    for (int a = 0; a < 2; ++a)
#pragma unroll
        for (int b = 0; b < 2; ++b)
#pragma unroll
            for (int m = 0; m < 4; ++m)
#pragma unroll
                for (int n = 0; n < 2; ++n) acc[a][b][m][n] = (f32x4){0.f, 0.f, 0.f, 0.f};
    bf16x8 At[4][2], B0[2][2], B1[2][2];
    const char* cA = (const char*)g.A + (size_t)cur.pm * tstep; const char* cB = (const char*)g.Bt + (size_t)cur.pn * tstep;
    S.a_ready(cur);
    if constexpr (SP2) {
        PG8_STAGE(PG8_SB(0, 0), cB, voffB); PG8_STAGE(PG8_SB(0, 1), cB + hstep, voffB); PG8_STAGE(PG8_SA(0, 0), cA, voffA); PG8_STAGE(PG8_SA(0, 1), cA + hstep, voffA);
        if (wr == 1) PG8_BAR;
        PG8_WAIT_V(2); PG8_BAR;
        PG8_STAGE(PG8_SB(1, 0), cB + kstep, voffB); PG8_STAGE(PG8_SA(1, 0), cA + kstep, voffA); PG8_STAGE(PG8_SB(1, 1), cB + hstep + kstep, voffB);
        PG8_WAIT_V(6); PG8_BAR;
    } else {
        PG8_STAGE(PG8_SB(0, 0), cB, voffB); PG8_STAGE(PG8_SA(0, 0), cA, voffA); PG8_STAGE(PG8_SB(0, 1), cB + hstep, voffB); PG8_STAGE(PG8_SA(0, 1), cA + hstep, voffA);
        if (wr == 1) PG8_BAR;
        PG8_WAIT_V(4); PG8_BAR;
        PG8_STAGE(PG8_SB(1, 0), cB + kstep, voffB); PG8_STAGE(PG8_SA(1, 0), cA + kstep, voffA); PG8_STAGE(PG8_SB(1, 1), cB + hstep + kstep, voffB);
        PG8_WAIT_V(6); PG8_BAR;
    }
    for (;;) {
        const bool has_next = S.next(ui + 1, nxt);
        const char* nA = has_next ? (const char*)g.A + (size_t)nxt.pm * tstep : cA; const char* nB = has_next ? (const char*)g.Bt + (size_t)nxt.pn * tstep : cB;
        for (int t = 0; t < nt; t += 2) {
            const bool last = (t == nt - 2);
            const char* a1 = cA + (size_t)(t + 1) * kstep;
            const char* a2 = last ? nA : cA + (size_t)(t + 2) * kstep; const char* b2 = last ? nB : cB + (size_t)(t + 2) * kstep;
            const char* a3 = a2 + kstep; const char* b3 = b2 + kstep;
            if (last && has_next) S.a_ready(nxt);
            if constexpr (SP2) {
            PG8_LDB(B0, 0, 0); PG8_LDB(B1, 0, 1); PG8_SCHED; PG8_LDA(At, 0, 0); PG8_STAGE(PG8_SA(1, 1), a1 + hstep, voffA);
            PG8_WAIT_V(8); PG8_WAIT_L(0); PG8_BAR; PG8_MMA(0, 0, At, B0); PG8_MMA(0, 1, At, B1); PG8_BAR; PG8_SCHED;
            PG8_LDA(At, 0, 1); PG8_STAGE(PG8_SB(0, 0), b2, voffB); PG8_STAGE(PG8_SB(0, 1), b2 + hstep, voffB); PG8_STAGE(PG8_SA(0, 0), a2, voffA);
            PG8_WAIT_V(8); PG8_WAIT_L(0); PG8_BAR; PG8_MMA(1, 0, At, B0); PG8_MMA(1, 1, At, B1); PG8_BAR; PG8_SCHED;
            PG8_LDB(B0, 1, 0); PG8_LDB(B1, 1, 1); PG8_SCHED; PG8_LDA(At, 1, 0); PG8_STAGE(PG8_SA(0, 1), a2 + hstep, voffA);
            PG8_WAIT_V(8); PG8_WAIT_L(0); PG8_BAR; PG8_MMA(0, 0, At, B0); PG8_MMA(0, 1, At, B1); PG8_BAR; PG8_SCHED;
            PG8_LDA(At, 1, 1); PG8_STAGE(PG8_SB(1, 0), b3, voffB); PG8_STAGE(PG8_SB(1, 1), b3 + hstep, voffB); PG8_STAGE(PG8_SA(1, 0), a3, voffA);
            PG8_WAIT_V(8); PG8_WAIT_L(0); PG8_BAR; PG8_MMA(1, 0, At, B0); PG8_MMA(1, 1, At, B1); PG8_BAR; PG8_SCHED;
            } else {
            PG8_LDB(B0, 0, 0); PG8_SCHED; PG8_LDA(At, 0, 0); PG8_STAGE(PG8_SA(1, 1), a1 + hstep, voffA);
            PG8_WAIT_L(8); PG8_BAR; PG8_WAIT_L(0); PG8_MMA(0, 0, At, B0); PG8_BAR; PG8_SCHED;
            PG8_LDB(B1, 0, 1); PG8_STAGE(PG8_SB(0, 0), b2, voffB);
            PG8_BAR; PG8_WAIT_L(0); PG8_MMA(0, 1, At, B1); PG8_BAR;
            PG8_LDA(At, 0, 1); PG8_STAGE(PG8_SA(0, 0), a2, voffA);
            PG8_BAR; PG8_WAIT_L(0); PG8_MMA(1, 0, At, B0); PG8_BAR; PG8_SCHED;
            PG8_STAGE(PG8_SB(0, 1), b2 + hstep, voffB);
            PG8_WAIT_V(6); PG8_BAR; PG8_MMA(1, 1, At, B1); PG8_BAR;
            PG8_LDB(B0, 1, 0); PG8_SCHED; PG8_LDA(At, 1, 0); PG8_STAGE(PG8_SA(0, 1), a2 + hstep, voffA);
            PG8_WAIT_L(8); PG8_BAR; PG8_WAIT_L(0); PG8_MMA(0, 0, At, B0); PG8_BAR; PG8_SCHED;
            PG8_LDB(B1, 1, 1); PG8_STAGE(PG8_SB(1, 0), b3, voffB);
            PG8_BAR; PG8_WAIT_L(0); PG8_MMA(0, 1, At, B1); PG8_BAR;
            PG8_LDA(At, 1, 1); PG8_STAGE(PG8_SA(1, 0), a3, voffA);
            PG8_BAR; PG8_WAIT_L(0); PG8_MMA(1, 0, At, B0); PG8_BAR; PG8_SCHED;
            PG8_STAGE(PG8_SB(1, 1), b3 + hstep, voffB);
            PG8_WAIT_V(6); PG8_BAR; PG8_MMA(1, 1, At, B1); PG8_BAR;
            }
        }
        if constexpr (ALIGN_EPI) { if (wr == 0) PG8_BAR; }
        if constexpr (!Epi::AFTER_DRAIN) { E(acc, cur, wr, wc, fr, fq); S.done(cur); }
        if (!has_next) break;
#pragma unroll
        for (int a = 0; a < 2; ++a)
#pragma unroll
            for (int b = 0; b < 2; ++b)
#pragma unroll
                for (int m = 0; m < 4; ++m)
#pragma unroll
                    for (int n = 0; n < 2; ++n) acc[a][b][m][n] = (f32x4){0.f, 0.f, 0.f, 0.f};
        cur = nxt; cA = nA; cB = nB; ++ui;
        if constexpr (ALIGN_EPI) { if (wr == 1) PG8_BAR; }
    }
    PG8_WAIT_V(0);
    if constexpr (!ALIGN_EPI) { if (wr == 0) PG8_BAR; }
    PG8_BAR;
    if constexpr (Epi::AFTER_DRAIN) { E.fused(acc, cur, wr, wc, fr, fq, lds, wid, lane); S.done(cur); }
#undef PG8_SA
#undef PG8_SB
#undef PG8_STAGE
#undef PG8_LDA
#undef PG8_LDB
#undef PG8_MMA
#undef PG8_WAIT_V
#undef PG8_WAIT_L
#undef PG8_BAR
#undef PG8_SCHED
}
}

constexpr int NWAVES = 8;
#define GAS __attribute__((address_space(1)))
#define LAS __attribute__((address_space(3)))
typedef unsigned short bf16;
typedef unsigned v4u __attribute__((ext_vector_type(4)));
typedef unsigned v2u __attribute__((ext_vector_type(2)));
typedef float f32x4 __attribute__((ext_vector_type(4)));
typedef float f32x2 __attribute__((ext_vector_type(2)));
typedef short bf16x8 __attribute__((ext_vector_type(8)));
typedef GAS unsigned gu32;
#define RLX_AGENT __ATOMIC_RELAXED, __HIP_MEMORY_SCOPE_AGENT
#define LDS_WAIT() asm volatile("s_waitcnt lgkmcnt(0)" ::: "memory")
#define VM_WAIT() asm volatile("s_waitcnt vmcnt(0)" ::: "memory")
__device__ __forceinline__ unsigned f2bf(float f) { unsigned u = __builtin_bit_cast(unsigned, f); return (u + 0x7fffu + ((u >> 16) & 1u)) >> 16; }
__device__ __forceinline__ unsigned pk2(float lo, float hi) { return f2bf(lo) | (f2bf(hi) << 16); }
__device__ __forceinline__ float bf2f(unsigned short h) { return __uint_as_float((unsigned)h << 16); }
__device__ __forceinline__ float bflo(unsigned w) { return __uint_as_float(w << 16); }
__device__ __forceinline__ float bfhi(unsigned w) { return __uint_as_float(w & 0xffff0000u); }
__device__ __forceinline__ float sigm(float x) { return 1.0f / (1.0f + __expf(-x)); }
__device__ __forceinline__ float siluf(float x) { return x / (1.0f + __expf(-x)); }
__device__ __forceinline__ float softplusf(float x) { return fmaxf(x, 0.f) + log1pf(__expf(-fabsf(x))); }
__device__ __forceinline__ float wave_sum(float v) {
#pragma unroll
    for (int o = 1; o < 64; o <<= 1) v += __shfl_xor(v, o);
    return v;
}

constexpr size_t MiB = 1u << 20;
constexpr size_t WS_CTL = 0, CTL_ZERO_BYTES = 1 * MiB;
constexpr size_t WS_MOD = 1 * MiB;
constexpr size_t WS_SKEY = 1 * MiB + 256 * 1024;
constexpr size_t WS_WIN = 2 * MiB;
constexpr size_t WS_WSB = 14 * MiB, WS_WGDN = 15 * MiB, WS_WO = 16 * MiB, WS_WQ = 18 * MiB;
constexpr size_t WS_AB = 22 * MiB;
constexpr size_t WS_GB = 23 * MiB;
constexpr size_t WS_XN = 24 * MiB;
constexpr size_t WS_Q = 56 * MiB, WS_K = 72 * MiB, WS_V = 88 * MiB;
constexpr size_t WS_GRAW = 104 * MiB;
constexpr size_t WS_Z = 152 * MiB;
constexpr size_t WS_YSB = 24 * MiB, WS_YGDN = 40 * MiB;
constexpr size_t WS_MERGED = 56 * MiB;
constexpr size_t WS_CH = 168 * MiB;
constexpr size_t WS_CD = 248 * MiB;
constexpr size_t WS_QP = 56 * MiB;
constexpr size_t WS_EIDX = 120 * MiB, WS_GATE = 128 * MiB;
constexpr size_t WS_END = 256 * MiB;
constexpr int CW_BAR = 4096;

constexpr int RING_OFF = 0, RING_BYTES = 131072;
constexpr int LDSCTL_OFF = RING_BYTES, MISC_OFF = LDSCTL_OFF + 320;
constexpr int LDS_BYTES = 147456;
#define XB_TMO      128
#define XB_XCNT(j)  (256  + 64 * (j))
#define XB_XSUB(j)  (1280 + 64 * (j))
#define XB_XGEN(j)  (2304 + 64 * (j))
#define XB_TOP      3328
#define XB_TOPGEN   3392
#define XCD_BAR_WORDS 3456
#define XB_SPIN_CAP (1u << 18)

__device__ __forceinline__ unsigned xb_ld(unsigned* p)              { return __hip_atomic_load(p, __ATOMIC_RELAXED, __HIP_MEMORY_SCOPE_AGENT); }
__device__ __forceinline__ unsigned xb_add(unsigned* p, unsigned v) { return __hip_atomic_fetch_add(p, v, __ATOMIC_RELAXED, __HIP_MEMORY_SCOPE_AGENT); }
__device__ __forceinline__ unsigned xb_xcc_id() { return (unsigned)__builtin_amdgcn_s_getreg((3 << 11) | 20) & 0xFu; }
#define XB_SPIN(cond, bar) do { unsigned _sp = 0; while (cond) { __builtin_amdgcn_s_sleep(1); \
    if ((++_sp & 255u) == 0u) { if (xb_ld(&(bar)[XB_TMO])) break; if (_sp > XB_SPIN_CAP) { atomicAdd(&(bar)[XB_TMO], 1u); break; } } } } while (0)

struct XcdBarrier {
    unsigned* bar; unsigned x;
    volatile LAS unsigned* st;
};

__device__ __forceinline__ XcdBarrier xcd_barrier_post(unsigned* bar, volatile LAS unsigned* st) {
    XcdBarrier b; b.bar = bar; b.x = xb_xcc_id(); b.st = st;
    if (threadIdx.x == 0) (void)xb_add(&bar[XB_XCNT(b.x)], 1u);
    return b;
}
__device__ __forceinline__ void xcd_barrier_complete(unsigned* bar, unsigned x, unsigned& nloc, unsigned& nx) {
    const unsigned G = gridDim.x * gridDim.y * gridDim.z;
    unsigned sum, cnt, mine, sp = 0u;
    for (;;) {
        sum = 0u; cnt = 0u; mine = 0u;
#pragma unroll
        for (unsigned j = 0; j < 16; ++j) { const unsigned c = xb_ld(&bar[XB_XCNT(j)]); sum += c; cnt += (c > 0u) ? 1u : 0u; mine = (j == x) ? c : mine; }
        if (sum == G) break;
        __builtin_amdgcn_s_sleep(1);
        if ((++sp & 255u) == 0u) { if (xb_ld(&bar[XB_TMO])) break; if (sp > XB_SPIN_CAP) { atomicAdd(&bar[XB_TMO], 1u); break; } }
    }
    nloc = mine > 0u ? mine : 1u; nx = cnt > 0u ? cnt : 1u;
}

__device__ __forceinline__ void xcd_barrier(const XcdBarrier& b) {
    asm volatile("s_waitcnt vmcnt(0)" ::: "memory");
    __syncthreads();
    if (threadIdx.x == 0) {
        unsigned* bar = b.bar;
        __builtin_amdgcn_s_waitcnt(0);
        unsigned nloc = b.st[0], nx = b.st[1];
        if (nloc == 0u) { xcd_barrier_complete(bar, b.x, nloc, nx); b.st[0] = nloc; b.st[1] = nx; }
        const unsigned old = xb_add(&bar[XB_XSUB(b.x)], 1u);
        const unsigned gen = old / nloc;
        if (old + 1u == (gen + 1u) * nloc) {
            __builtin_amdgcn_fence(__ATOMIC_RELEASE, "agent");
            asm volatile("s_waitcnt vmcnt(0)" ::: "memory");
            const unsigned og = xb_add(&bar[XB_TOP], 1u);
            const unsigned tg = og / nx;
            if (og + 1u == (tg + 1u) * nx) xb_add(&bar[XB_TOPGEN], 1u);
            else XB_SPIN(xb_ld(&bar[XB_TOPGEN]) == tg, bar);
            __builtin_amdgcn_fence(__ATOMIC_ACQUIRE, "agent");
            xb_add(&bar[XB_XGEN(b.x)], 1u);
            asm volatile("s_waitcnt vmcnt(0)" ::: "memory");
        } else {
            XB_SPIN(xb_ld(&bar[XB_XGEN(b.x)]) == gen, bar);
            __builtin_amdgcn_fence(__ATOMIC_ACQUIRE, "agent");
            asm volatile("s_waitcnt vmcnt(0)" ::: "memory");
        }
    }
    __syncthreads();
}

struct Args { const float* in[20]; float* out; unsigned char* ws; int ph_lo, ph_hi, li, pad; };

struct Frame {
    LAS unsigned char* lds;
    volatile LAS unsigned* MISC;
    gu32* ctl;
    int tid, lane, wave, G;
};

__device__ __forceinline__ int inproj_src_col(int n) { if (n < 3072) return n; if (n < 5632) return n + 16; if (n < 5648) return n - 5632 + 3072; return -1; }
template <bool MAP>
__device__ __forceinline__ void p0_transpose_item(const float* W, int K, int Nsrc, int Ndst, bf16* WT, LAS float* scr, int item, int lane) {
    const int nblk = Ndst / 32, kb = item / nblk, nb = item % nblk, k0 = 64 * kb, n0 = 32 * nb;
    const int nsrc = MAP ? inproj_src_col(n0 + (lane & 31)) : n0 + (lane & 31);
#pragma unroll 8
    for (int i = 0; i < 32; ++i) { const int kk = 2 * i + (lane >> 5); scr[kk * 33 + (lane & 31)] = nsrc >= 0 ? W[(size_t)(k0 + kk) * Nsrc + nsrc] : 0.f; }
    LDS_WAIT(); asm volatile("" ::: "memory");
    const int c = lane & 7;
#pragma unroll
    for (int j = 0; j < 4; ++j) { const int n = (lane >> 3) + 8 * j; const LAS float* s = scr + (8 * c) * 33 + n;
        v4u o; o.x = pk2(s[0 * 33], s[1 * 33]); o.y = pk2(s[2 * 33], s[3 * 33]); o.z = pk2(s[4 * 33], s[5 * 33]); o.w = pk2(s[6 * 33], s[7 * 33]);
        *(GAS v4u*)(WT + (size_t)(n0 + n) * K + k0 + 8 * c) = o; }
    LDS_WAIT(); asm volatile("" ::: "memory");
}
__device__ __forceinline__ void p0_prologue(Frame& F, const Args& a) {
    unsigned char* ws = a.ws;
    LAS float* scr = (LAS float*)(F.lds + RING_OFF + F.wave * 16384);
    const int gw = blockIdx.x * NWAVES + F.wave, NGW = F.G * NWAVES;
    constexpr int I_IN = (D / 64) * (INWP / 32), I_SB = (512 / 64) * (D / 32), I_O = (D / 64) * (D / 32), I_Q = (D / 64) * (PQW / 32);
    constexpr int NITEMS = I_IN + 2 * I_SB + I_O + I_Q;
    for (int it = gw; it < NITEMS; it += NGW) {
        int r = it;
        if (r < I_IN) { p0_transpose_item<true>(a.in[5], D, INW, INWP, (bf16*)(ws + WS_WIN), scr, r, F.lane); continue; } r -= I_IN;
        if (r < I_SB) { p0_transpose_item<false>(a.in[12], 512, D, D, (bf16*)(ws + WS_WSB), scr, r, F.lane); continue; } r -= I_SB;
        if (r < I_SB) { p0_transpose_item<false>(a.in[13], 512, D, D, (bf16*)(ws + WS_WGDN), scr, r, F.lane); continue; } r -= I_SB;
        if (r < I_O) { p0_transpose_item<false>(a.in[14], D, D, D, (bf16*)(ws + WS_WO), scr, r, F.lane); continue; } r -= I_O;
        p0_transpose_item<false>(a.in[16], D, PQW, PQW, (bf16*)(ws + WS_WQ), scr, r, F.lane);
    }
    { const float* sk = a.in[17]; bf16* o = (bf16*)(ws + WS_SKEY);
      for (int i = (blockIdx.x * 512 + F.tid) * 4; i < PH * 2 * PNK * PHALF; i += F.G * 512 * 4) { const f32x4 v = *(const f32x4*)(sk + i); v2u w; w.x = pk2(v.x, v.y); w.y = pk2(v.z, v.w); *(v2u*)(o + i) = w; } }
    { const float* c = a.in[1]; const float* wa = a.in[2]; const float* ba = a.in[3]; float* mod = (float*)(ws + WS_MOD);
      LAS float* red = (LAS float*)(F.lds + RING_OFF);
      for (int it = blockIdx.x; it < 6 * D / 64; it += F.G) {
          const int n = it * 64 + F.lane; float a0 = 0.f, a1 = 0.f;
          __syncthreads();
          for (int k = F.wave * 128; k < F.wave * 128 + 128; ++k) { const float w = wa[(size_t)k * (6 * D) + n]; a0 += siluf(c[k]) * w; a1 += siluf(c[D + k]) * w; }
          red[(F.wave * 2 + 0) * 64 + F.lane] = a0; red[(F.wave * 2 + 1) * 64 + F.lane] = a1;
          __syncthreads();
          if (F.wave < 2) { float s = 0.f;
#pragma unroll
              for (int w = 0; w < 8; ++w) s += red[(w * 2 + F.wave) * 64 + F.lane];
              mod[(size_t)F.wave * 6 * D + n] = s + ba[n]; }
      }
      __syncthreads(); }
}
__device__ __forceinline__ void norm_mod_rows(Frame& F, const float* x, const float* nw, const float* mod, int ch_shift, bf16* o) {
    const int gw = blockIdx.x * NWAVES + F.wave, NGW = F.G * NWAVES;
    for (int m = gw; m < M; m += NGW) {
        const GAS f32x4* xr = (const GAS f32x4*)(x + (size_t)m * D) + F.lane;
        f32x4 v[4]; float s = 0.f;
#pragma unroll
        for (int j = 0; j < 4; ++j) { v[j] = xr[64 * j]; s += (v[j].x * v[j].x + v[j].y * v[j].y) + (v[j].z * v[j].z + v[j].w * v[j].w); }
        const float rstd = 1.0f / sqrtf(wave_sum(s) * (1.f / D) + EPS);
        const float* sh = mod + (size_t)(m >> 13) * 6 * D + ch_shift * D; const float* sc = sh + D;
        GAS v2u* o8 = (GAS v2u*)(o + (size_t)m * D) + F.lane;
#pragma unroll
        for (int j = 0; j < 4; ++j) { const int c = 4 * F.lane + 256 * j; const f32x4 w = *(const f32x4*)(nw + c), a = *(const f32x4*)(sc + c), b = *(const f32x4*)(sh + c);
            const f32x4 y = v[j] * rstd * w * (a + 1.0f) + b; v2u p; p.x = pk2(y.x, y.y); p.y = pk2(y.z, y.w); o8[64 * j] = p; }
    }
}
__device__ __forceinline__ float gelu_erf(float v) { return 0.5f * v * (1.0f + erff(v * 0.70710678118654752f)); }
__device__ __forceinline__ void p10_peer(Frame& F, const Args& a) {
    unsigned char* ws = a.ws;
    const bf16* h2 = (const bf16*)(ws + WS_XN); const int* eidx = (const int*)(ws + WS_EIDX); const float* gate = (const float*)(ws + WS_GATE);
    const float* ut = a.in[18]; const float* vt = a.in[19]; const float* mod = (const float*)(ws + WS_MOD); float* out = a.out;
    LAS float* acts = (LAS float*)(F.lds + RING_OFF + F.wave * 1024); LAS float* coefs = acts + 128;
    const int gw = blockIdx.x * NWAVES + F.wave, NGW = F.G * NWAVES, g = F.lane >> 4, sub = F.lane & 15;
    for (int t = gw; t < M; t += NGW) {
        f32x4 h[16];
#pragma unroll
        for (int j = 0; j < 16; ++j) { const v2u w = *(const v2u*)(h2 + (size_t)t * D + sub * 4 + 64 * j); h[j] = (f32x4){bflo(w.x), bfhi(w.x), bflo(w.y), bfhi(w.y)}; }
        const int* et = eidx + (size_t)t * 128;
#pragma unroll 2
        for (int i = 0; i < 32; ++i) {
            const int e = et[4 * i + g]; const float* ur = ut + (size_t)e * D + sub * 4; float s = 0.f;
#pragma unroll
            for (int j = 0; j < 16; ++j) { const f32x4 u = *(const f32x4*)(ur + 64 * j); s += (u.x * h[j].x + u.y * h[j].y) + (u.z * h[j].z + u.w * h[j].w); }
            s += __shfl_xor(s, 1); s += __shfl_xor(s, 2); s += __shfl_xor(s, 4); s += __shfl_xor(s, 8);
            if (sub == 0) acts[4 * i + g] = s;
        }
        LDS_WAIT(); asm volatile("" ::: "memory");
        { const float a0 = acts[F.lane], a1 = acts[64 + F.lane];
          coefs[F.lane] = gate[(size_t)t * 128 + F.lane] * gelu_erf(a0); coefs[64 + F.lane] = gate[(size_t)t * 128 + 64 + F.lane] * gelu_erf(a1); }
        LDS_WAIT(); asm volatile("" ::: "memory");
        f32x4 acc[4] = {(f32x4){0.f, 0.f, 0.f, 0.f}, (f32x4){0.f, 0.f, 0.f, 0.f}, (f32x4){0.f, 0.f, 0.f, 0.f}, (f32x4){0.f, 0.f, 0.f, 0.f}};
#pragma unroll 8
        for (int e = 0; e < 128; ++e) { const float cf = coefs[e]; const float* vr = vt + (size_t)et[e] * D + 4 * F.lane;
#pragma unroll
            for (int j = 0; j < 4; ++j) acc[j] += cf * *(const f32x4*)(vr + 256 * j); }
        const float* g2 = mod + (size_t)(t >> 13) * 6 * D + 5 * D;
#pragma unroll
        for (int j = 0; j < 4; ++j) { const int c = 4 * F.lane + 256 * j; float* op = out + (size_t)t * D + c; *(f32x4*)op = *(const f32x4*)op + *(const f32x4*)(g2 + c) * acc[j]; }
        LDS_WAIT(); asm volatile("" ::: "memory");
    }
}


__device__ __forceinline__ void p4_attn_naive(Frame& F, const Args& a, int blk, int nblk) {
    unsigned char* ws = a.ws;
    const bf16* Q = (const bf16*)(ws + WS_Q); const bf16* K = (const bf16*)(ws + WS_K); const bf16* V = (const bf16*)(ws + WS_V);
    for (int gid = blk * 512 + F.tid; gid < BATCH * SBH * SEQ; gid += nblk * 512) {
        const int t = gid & (SEQ - 1), bh = gid >> 13, h = bh & 7, b = bh >> 3;
        const size_t row = (size_t)b * SEQ + t;
        float q[64], o[64];
#pragma unroll
        for (int i = 0; i < 8; ++i) { const v4u w = *(const v4u*)(Q + row * 512 + h * 64 + 8 * i);
            q[8 * i] = bflo(w.x); q[8 * i + 1] = bfhi(w.x); q[8 * i + 2] = bflo(w.y); q[8 * i + 3] = bfhi(w.y); q[8 * i + 4] = bflo(w.z); q[8 * i + 5] = bfhi(w.z); q[8 * i + 6] = bflo(w.w); q[8 * i + 7] = bfhi(w.w); }
#pragma unroll
        for (int i = 0; i < 64; ++i) o[i] = 0.f;
        float R = 0.f;
        for (int s = t - 1; s >= 0; --s) {
            const size_t kr = ((size_t)b * SEQ + s) * 512 + h * 64; float z = 0.f;
#pragma unroll
            for (int i = 0; i < 8; ++i) { const v4u w = *(const v4u*)(K + kr + 8 * i);
                z += q[8 * i] * bflo(w.x) + q[8 * i + 1] * bfhi(w.x) + q[8 * i + 2] * bflo(w.y) + q[8 * i + 3] * bfhi(w.y) + q[8 * i + 4] * bflo(w.z) + q[8 * i + 5] * bfhi(w.z) + q[8 * i + 6] * bflo(w.w) + q[8 * i + 7] * bfhi(w.w); }
            const float sp = softplusf(z); const float p = __expf(z - sp - R); R += sp;
#pragma unroll
            for (int i = 0; i < 8; ++i) { const v4u w = *(const v4u*)(V + kr + 8 * i);
                o[8 * i] += p * bflo(w.x); o[8 * i + 1] += p * bfhi(w.x); o[8 * i + 2] += p * bflo(w.y); o[8 * i + 3] += p * bfhi(w.y); o[8 * i + 4] += p * bflo(w.z); o[8 * i + 5] += p * bfhi(w.z); o[8 * i + 6] += p * bflo(w.w); o[8 * i + 7] += p * bfhi(w.w); }
            if (R > 105.f) break;
        }
        bf16* y = (bf16*)(ws + WS_YSB) + row * 512 + h * 64;
#pragma unroll
        for (int i = 0; i < 8; ++i) { v4u w; w.x = pk2(o[8 * i], o[8 * i + 1]); w.y = pk2(o[8 * i + 2], o[8 * i + 3]); w.z = pk2(o[8 * i + 4], o[8 * i + 5]); w.w = pk2(o[8 * i + 6], o[8 * i + 7]); *(v4u*)(y + 8 * i) = w; }
    }
}
__device__ __forceinline__ void p9_topk_naive(Frame& F, const Args& a) {
    unsigned char* ws = a.ws; const int tid = F.tid;
    const bf16* QP = (const bf16*)(ws + WS_QP); const bf16* SK = (const bf16*)(ws + WS_SKEY);
    LAS float* sv = (LAS float*)(F.lds + RING_OFF);
    LAS int* si = (LAS int*)(sv + 2 * 16 * 256);
    LAS int* ptr = si + 2 * 16 * 256;
    LAS unsigned short* keys = (LAS unsigned short*)(ptr + 16 * 256);
    const bool act = tid < 256;
    for (int it = blockIdx.x; it < (M / 256) * PH; it += F.G) {
        const int h = it & 7, t = (it >> 3) * 256 + (tid & 255);
        for (int p = 0; p < 2; ++p) {
            __syncthreads();
            for (int i = tid; i < 128 * 128 / 8; i += 512) ((LAS v4u*)keys)[i] = ((const v4u*)(SK + (size_t)(h * 2 + p) * 128 * 128))[i];
            __syncthreads();
            if (act) {
                unsigned qreg[64];
#pragma unroll
                for (int i = 0; i < 16; ++i) { const v4u w = *(const v4u*)(QP + (size_t)t * PQW + h * 256 + p * 128 + 8 * i); qreg[4 * i] = w.x; qreg[4 * i + 1] = w.y; qreg[4 * i + 2] = w.z; qreg[4 * i + 3] = w.w; }
                int cnt = 0;
                for (int key = 0; key < 128; ++key) {
                    float s = 0.f;
#pragma unroll
                    for (int i = 0; i < 16; ++i) { const v4u w = *(const LAS v4u*)(keys + key * 128 + 8 * i);
                        s += bflo(qreg[4 * i]) * bflo(w.x) + bfhi(qreg[4 * i]) * bfhi(w.x) + bflo(qreg[4 * i + 1]) * bflo(w.y) + bfhi(qreg[4 * i + 1]) * bfhi(w.y)
                           + bflo(qreg[4 * i + 2]) * bflo(w.z) + bfhi(qreg[4 * i + 2]) * bfhi(w.z) + bflo(qreg[4 * i + 3]) * bflo(w.w) + bfhi(qreg[4 * i + 3]) * bfhi(w.w); }
                    int pos = cnt < 16 ? cnt : 16;
                    while (pos > 0 && s > sv[(p * 16 + pos - 1) * 256 + tid]) { if (pos < 16) { sv[(p * 16 + pos) * 256 + tid] = sv[(p * 16 + pos - 1) * 256 + tid]; si[(p * 16 + pos) * 256 + tid] = si[(p * 16 + pos - 1) * 256 + tid]; } --pos; }
                    if (pos < 16) { sv[(p * 16 + pos) * 256 + tid] = s; si[(p * 16 + pos) * 256 + tid] = key; }
                    if (cnt < 16) ++cnt;
                }
            }
        }
        if (act) {
            for (int i = 0; i < 16; ++i) ptr[i * 256 + tid] = 0;
            float top[16]; int eid[16];
#pragma unroll
            for (int rnk = 0; rnk < 16; ++rnk) {
                float best = -INFINITY; int bi = 0;
                for (int i = 0; i < 16; ++i) { const int jj = ptr[i * 256 + tid]; if (jj < 16) { const float c = sv[i * 256 + tid] + sv[(16 + jj) * 256 + tid]; if (c > best) { best = c; bi = i; } } }
                const int bj = ptr[bi * 256 + tid]; ptr[bi * 256 + tid] = bj + 1;
                top[rnk] = best; eid[rnk] = si[bi * 256 + tid] * 128 + si[(16 + bj) * 256 + tid];
            }
            float mx = top[0], den = 0.f;
#pragma unroll
            for (int rnk = 0; rnk < 16; ++rnk) { top[rnk] = __expf(top[rnk] - mx); den += top[rnk]; }
            int* eo = (int*)(ws + WS_EIDX) + (size_t)t * 128 + h * 16; float* go = (float*)(ws + WS_GATE) + (size_t)t * 128 + h * 16;
#pragma unroll
            for (int rnk = 0; rnk < 16; ++rnk) { eo[rnk] = eid[rnk]; go[rnk] = top[rnk] / den; }
        }
    }
    __syncthreads();
}

constexpr int CH_BYTES = 40960, CH_W = 0, CH_QD = 8192, CH_QK = 16384, CH_KDT = 24576, CH_U = 32768;
constexpr int PST = 68;
typedef __attribute__((address_space(3))) float lf32;

__device__ __forceinline__ void store_afrag(const lf32* src, const lf32* rowscale, unsigned char* dst, int tid) {
    const int blk = tid >> 6, lane = tid & 63, mt = blk >> 1, ks = blk & 1, r = lane & 15, g = lane >> 4, row = 16 * mt + r, k0 = 32 * ks + 4 * g;
    f32x4 v0 = *(const LAS f32x4*)(src + row * PST + k0), v1 = *(const LAS f32x4*)(src + row * PST + k0 + 16);
    const float rs = rowscale ? rowscale[row] : 1.0f; v0 = v0 * rs; v1 = v1 * rs;
    v4u o; o.x = pk2(v0.x, v0.y); o.y = pk2(v0.z, v0.w); o.z = pk2(v1.x, v1.y); o.w = pk2(v1.z, v1.w);
    *(v4u*)(dst + tid * 16) = o;
}
__device__ __forceinline__ void store_afrag_T(const lf32* src, const lf32* kscale, unsigned char* dst, int tid) {
    const int blk = tid >> 6, lane = tid & 63, mt = blk >> 1, ks = blk & 1, r = lane & 15, g = lane >> 4, row = 16 * mt + r, k0 = 32 * ks + 4 * g;
    float v[8];
#pragma unroll
    for (int i = 0; i < 4; ++i) { v[i] = src[(k0 + i) * PST + row] * kscale[k0 + i]; v[4 + i] = src[(k0 + 16 + i) * PST + row] * kscale[k0 + 16 + i]; }
    v4u o; o.x = pk2(v[0], v[1]); o.y = pk2(v[2], v[3]); o.z = pk2(v[4], v[5]); o.w = pk2(v[6], v[7]);
    *(v4u*)(dst + tid * 16) = o;
}
__device__ __forceinline__ void store_cfrag(const lf32* src, unsigned char* dst, int tid) {
#pragma unroll
    for (int rep = 0; rep < 2; ++rep) { const int q = tid + 512 * rep, sm = q >> 6, lane = q & 63, sl = sm >> 2, mt = sm & 3, col = lane & 15, g = lane >> 4;
        const lf32* p = src + (16 * mt + 4 * g) * PST + 16 * sl + col;
        v2u o; o.x = pk2(p[0], p[PST]); o.y = pk2(p[2 * PST], p[3 * PST]); *(v2u*)(dst + q * 8) = o; }
}

__device__ __forceinline__ void p3_gdn_prep(Frame& F, const Args& a) {
    unsigned char* ws = a.ws; const int tid = F.tid;
    const bf16* graw = (const bf16*)(ws + WS_GRAW); const float* ab = (const float*)(ws + WS_AB); const float* cw = a.in[8];
    lf32* Qs = (lf32*)(F.lds + RING_OFF); lf32* Ks = Qs + 64 * PST; lf32* Vs = Ks + 64 * PST; lf32* As = Vs + 64 * PST; lf32* QKs = As + 64 * PST; lf32* Us = QKs + 64 * PST; lf32* Ws = Us + 64 * PST;
    lf32* vG = Ws + 64 * PST; lf32* vbeta = vG + 64; lf32* veG = vbeta + 64; lf32* veGl = veG + 64; lf32* vqn = veGl + 64; lf32* vkn = vqn + 64; lf32* vbw = vkn + 64;
    for (int it = blockIdx.x; it < BATCH * GH * (SEQ / 64); it += F.G) {
        const int n = it & 127, bh = it >> 7, h = bh & 7, b = bh >> 3; const size_t row0 = (size_t)b * SEQ + n * 64; const int tl0 = n * 64;
        __syncthreads();
        { const int c = tid & 63, tg = tid >> 6;
#pragma unroll
          for (int part = 0; part < 3; ++part) { const int ch = part * 512 + h * 64 + c; const bf16* src = graw + ch; lf32* dst = part == 0 ? Qs : part == 1 ? Ks : Vs;
              const float w0 = cw[ch], w1 = cw[1536 + ch], w2 = cw[2 * 1536 + ch], w3 = cw[3 * 1536 + ch];
              float xv[11];
#pragma unroll
              for (int i = 0; i < 11; ++i) { const int tt = tl0 + 8 * tg - 3 + i; xv[i] = tt >= 0 ? bf2f(src[(row0 + 8 * tg - 3 + i) * 1536]) : 0.f; }
#pragma unroll
              for (int i = 0; i < 8; ++i) dst[(8 * tg + i) * PST + c] = siluf(w0 * xv[i] + w1 * xv[i + 1] + w2 * xv[i + 2] + w3 * xv[i + 3]); } }
        __syncthreads();
        if (tid < 128) { const int row = tid & 63; const lf32* src = (tid < 64 ? Qs : Ks) + row * PST; float ss = 0.f;
#pragma unroll
            for (int i = 0; i < 16; ++i) { const f32x4 v = *(const LAS f32x4*)(src + 4 * i); ss += (v.x * v.x + v.y * v.y) + (v.z * v.z + v.w * v.w); }
            const float inv = 1.0f / sqrtf(ss + EPS); if (tid < 64) vqn[row] = inv * 0.125f; else vkn[row] = inv; }
        else if (tid < 192) { const int t = tid & 63; const float av = ab[(row0 + t) * 16 + h], bv = ab[(row0 + t) * 16 + 8 + h];
            const float g = -__expf(a.in[9][h]) * softplusf(av + a.in[10][h]); float G = g;
#pragma unroll
            for (int o = 1; o < 64; o <<= 1) { const float up = __shfl_up(G, o); if (t >= o) G += up; }
            const float Gl = __shfl(G, 63);
            vG[t] = G; { const float be = sigm(bv); vbeta[t] = be; vbw[t] = be * __expf(G); } veG[t] = __expf(G); veGl[t] = __expf(Gl - G);
            if (t == 63) ((float*)(ws + WS_CD))[it] = __expf(Gl); }
        __syncthreads();
        { const int c = tid & 63, tg = tid >> 6;
#pragma unroll
          for (int i = 0; i < 8; ++i) { const int t = 8 * tg + i; Qs[t * PST + c] *= vqn[t]; Ks[t * PST + c] *= vkn[t]; } }
        __syncthreads();
        { const int c = tid >> 3, sg = tid & 7; float kk[8], qk[8];
#pragma unroll
          for (int j = 0; j < 8; ++j) { kk[j] = 0.f; qk[j] = 0.f; }
#pragma unroll 4
          for (int i = 0; i < 16; ++i) { const f32x4 kc = *(const LAS f32x4*)(Ks + c * PST + 4 * i), qc = *(const LAS f32x4*)(Qs + c * PST + 4 * i);
#pragma unroll
              for (int j = 0; j < 8; ++j) { const f32x4 kv = *(const LAS f32x4*)(Ks + (sg + 8 * j) * PST + 4 * i);
                  kk[j] += (kc.x * kv.x + kc.y * kv.y) + (kc.z * kv.z + kc.w * kv.w); qk[j] += (qc.x * kv.x + qc.y * kv.y) + (qc.z * kv.z + qc.w * kv.w); } }
          const float Gc = vG[c], bc = vbeta[c];
#pragma unroll
          for (int j = 0; j < 8; ++j) { const int s = sg + 8 * j; const float dec = __expf(fminf(Gc - vG[s], 0.f));
              As[c * PST + s] = (c > s) ? bc * kk[j] * dec : 0.f; QKs[c * PST + s] = (c >= s) ? qk[j] * dec : 0.f; } }
        __syncthreads();
        if (tid < 128) { const int j = tid & 63; const bool isw = tid >= 64; const lf32* src = isw ? Ks : Vs; const lf32* sc = isw ? vbw : vbeta; float x[64];
#pragma unroll
            for (int i = 0; i < 64; ++i) { float acc = src[i * PST + j] * sc[i];
#pragma unroll
                for (int jj = 0; jj < (i & ~3); jj += 4) { const f32x4 av = *(const LAS f32x4*)(As + i * PST + jj); acc -= av.x * x[jj]; acc -= av.y * x[jj + 1]; acc -= av.z * x[jj + 2]; acc -= av.w * x[jj + 3]; }
                if (i & 3) { const f32x4 av = *(const LAS f32x4*)(As + i * PST + (i & ~3)); acc -= av.x * x[(i & ~3)]; if ((i & 3) > 1) acc -= av.y * x[(i & ~3) + 1]; if ((i & 3) > 2) acc -= av.z * x[(i & ~3) + 2]; }
                x[i] = acc; asm volatile("" ::: "memory"); }
            lf32* dst = isw ? Ws : Us;
#pragma unroll
            for (int i = 0; i < 64; ++i) dst[i * PST + j] = x[i]; }
        __syncthreads();
        { unsigned char* ch = ws + WS_CH + (size_t)it * CH_BYTES;
          store_afrag(Ws, nullptr, ch + CH_W, tid); store_afrag(Qs, veG, ch + CH_QD, tid); store_afrag(QKs, nullptr, ch + CH_QK, tid); store_afrag_T(Ks, veGl, ch + CH_KDT, tid); store_cfrag(Us, ch + CH_U, tid); }
    }
    __syncthreads();
}

__device__ __forceinline__ void p3_qknorm(Frame& F, const Args& a) {
    unsigned char* ws = a.ws; const int lane = F.lane;
    const int gw = blockIdx.x * NWAVES + F.wave, NGW = F.G * NWAVES;
    const float* qnw = a.in[6]; const float* knw = a.in[7];
    for (int t = gw; t < M; t += NGW) {
#pragma unroll
        for (int which = 0; which < 2; ++which) {
            bf16* p = (bf16*)(ws + (which ? WS_K : WS_Q)) + (size_t)t * 512 + 8 * lane; const float* nw = which ? knw : qnw;
            const v4u w = *(const v4u*)p; float v[8] = {bflo(w.x), bfhi(w.x), bflo(w.y), bfhi(w.y), bflo(w.z), bfhi(w.z), bflo(w.w), bfhi(w.w)};
            float s = 0.f;
#pragma unroll
            for (int i = 0; i < 8; ++i) s += v[i] * v[i];
            s += __shfl_xor(s, 1); s += __shfl_xor(s, 2); s += __shfl_xor(s, 4);
            const float r = 1.0f / sqrtf(s * (1.f / 64.f) + EPS) * (which ? 1.0f : 0.125f);
            const int d0 = (8 * lane) & 63;
#pragma unroll
            for (int i = 0; i < 8; ++i) v[i] = v[i] * r * nw[d0 + i];
            v4u o; o.x = pk2(v[0], v[1]); o.y = pk2(v[2], v[3]); o.z = pk2(v[4], v[5]); o.w = pk2(v[6], v[7]); *(v4u*)p = o;
        }
    }
}

__device__ __forceinline__ bf16x8 pack8(const f32x4& x, const f32x4& y) { v4u w; w.x = pg8::cvt_pk_bf16(x.x, x.y); w.y = pg8::cvt_pk_bf16(x.z, x.w); w.z = pg8::cvt_pk_bf16(y.x, y.y); w.w = pg8::cvt_pk_bf16(y.z, y.w); return __builtin_bit_cast(bf16x8, w); }
constexpr int OST = 68;
constexpr int SC_OP = 0, SC_OB = 2 * CH_BYTES;
__device__ __forceinline__ void scan_load(v4u (&set)[10], const unsigned char* ch, int ht) {
#pragma unroll
    for (int r = 0; r < 10; ++r) set[r] = *(const v4u*)(ch + (r * 256 + ht) * 16);
}
__device__ __forceinline__ void scan_put(const v4u (&set)[10], LAS unsigned char* dst, int ht) {
#pragma unroll
    for (int r = 0; r < 10; ++r) *(LAS v4u*)(dst + (r * 256 + ht) * 16) = set[r];
}
__device__ __forceinline__ void scan_post(const lf32* ob, const bf16* Z, bf16* Y, const float* onw, size_t row0, int h, int ht) {
    const int row = ht >> 2, q4 = ht & 3; const lf32* p = ob + row * OST + 16 * q4; f32x4 o[4]; float ss = 0.f;
#pragma unroll
    for (int i = 0; i < 4; ++i) { o[i] = *(const LAS f32x4*)(p + 4 * i); ss += (o[i].x * o[i].x + o[i].y * o[i].y) + (o[i].z * o[i].z + o[i].w * o[i].w); }
    ss += __shfl_xor(ss, 1); ss += __shfl_xor(ss, 2);
    const float rstd = 1.0f / sqrtf(ss * (1.f / 64.f) + EPS);
    const size_t off = (row0 + row) * 512 + h * 64 + 16 * q4;
    const v4u z0 = *(const v4u*)(Z + off), z1 = *(const v4u*)(Z + off + 8);
    const float zz[16] = {bflo(z0.x), bfhi(z0.x), bflo(z0.y), bfhi(z0.y), bflo(z0.z), bfhi(z0.z), bflo(z0.w), bfhi(z0.w), bflo(z1.x), bfhi(z1.x), bflo(z1.y), bfhi(z1.y), bflo(z1.z), bfhi(z1.z), bflo(z1.w), bfhi(z1.w)};
    float y[16];
#pragma unroll
    for (int i = 0; i < 4; ++i) { const f32x4 w = *(const f32x4*)(onw + 16 * q4 + 4 * i);
        y[4 * i] = o[i].x * rstd * w.x * siluf(zz[4 * i]); y[4 * i + 1] = o[i].y * rstd * w.y * siluf(zz[4 * i + 1]); y[4 * i + 2] = o[i].z * rstd * w.z * siluf(zz[4 * i + 2]); y[4 * i + 3] = o[i].w * rstd * w.w * siluf(zz[4 * i + 3]); }
    v4u w0, w1; w0.x = pk2(y[0], y[1]); w0.y = pk2(y[2], y[3]); w0.z = pk2(y[4], y[5]); w0.w = pk2(y[6], y[7]); w1.x = pk2(y[8], y[9]); w1.y = pk2(y[10], y[11]); w1.z = pk2(y[12], y[13]); w1.w = pk2(y[14], y[15]);
    *(v4u*)(Y + off) = w0; *(v4u*)(Y + off + 8) = w1;
}
__device__ __forceinline__ void scan_step(LAS unsigned char* lds, f32x4 (&S)[4], float cdv, int n, int sl, int lane) {
    const LAS unsigned char* ob = lds + SC_OP + (n & 1) * CH_BYTES; lf32* ot = (lf32*)(lds + SC_OB) + (n & 1) * 64 * OST;
    const f32x4 zero = {0.f, 0.f, 0.f, 0.f};
    const bf16x8 Sb0 = pack8(S[0], S[1]), Sb1 = pack8(S[2], S[3]);
    f32x4 vn[4], o[4];
#pragma unroll
    for (int mt = 0; mt < 4; ++mt) { const bf16x8 a0 = *(const LAS bf16x8*)(ob + CH_W + (mt * 2) * 1024 + lane * 16), a1 = *(const LAS bf16x8*)(ob + CH_W + (mt * 2 + 1) * 1024 + lane * 16);
        f32x4 acc = __builtin_amdgcn_mfma_f32_16x16x32_bf16(a0, Sb0, zero, 0, 0, 0); acc = __builtin_amdgcn_mfma_f32_16x16x32_bf16(a1, Sb1, acc, 0, 0, 0);
        const v2u uu = *(const LAS v2u*)(ob + CH_U + ((sl * 4 + mt) * 64 + lane) * 8);
        vn[mt] = (f32x4){bflo(uu.x), bfhi(uu.x), bflo(uu.y), bfhi(uu.y)} - acc; }
    const bf16x8 Vb0 = pack8(vn[0], vn[1]), Vb1 = pack8(vn[2], vn[3]);
#pragma unroll
    for (int mt = 0; mt < 4; ++mt) { const bf16x8 q0 = *(const LAS bf16x8*)(ob + CH_QD + (mt * 2) * 1024 + lane * 16), q1 = *(const LAS bf16x8*)(ob + CH_QD + (mt * 2 + 1) * 1024 + lane * 16);
        const bf16x8 k0 = *(const LAS bf16x8*)(ob + CH_QK + (mt * 2) * 1024 + lane * 16), k1 = *(const LAS bf16x8*)(ob + CH_QK + (mt * 2 + 1) * 1024 + lane * 16);
        f32x4 acc = __builtin_amdgcn_mfma_f32_16x16x32_bf16(q0, Sb0, zero, 0, 0, 0); acc = __builtin_amdgcn_mfma_f32_16x16x32_bf16(q1, Sb1, acc, 0, 0, 0);
        acc = __builtin_amdgcn_mfma_f32_16x16x32_bf16(k0, Vb0, acc, 0, 0, 0); acc = __builtin_amdgcn_mfma_f32_16x16x32_bf16(k1, Vb1, acc, 0, 0, 0); o[mt] = acc; }
#pragma unroll
    for (int mt = 0; mt < 4; ++mt) { const bf16x8 t0 = *(const LAS bf16x8*)(ob + CH_KDT + (mt * 2) * 1024 + lane * 16), t1 = *(const LAS bf16x8*)(ob + CH_KDT + (mt * 2 + 1) * 1024 + lane * 16);
        f32x4 acc = S[mt] * cdv; acc = __builtin_amdgcn_mfma_f32_16x16x32_bf16(t0, Vb0, acc, 0, 0, 0); acc = __builtin_amdgcn_mfma_f32_16x16x32_bf16(t1, Vb1, acc, 0, 0, 0); S[mt] = acc; }
    const int col = lane & 15, g = lane >> 4;
#pragma unroll
    for (int mt = 0; mt < 4; ++mt) { lf32* p = ot + (16 * mt + 4 * g) * OST + 16 * sl + col; p[0] = o[mt].x; p[OST] = o[mt].y; p[2 * OST] = o[mt].z; p[3 * OST] = o[mt].w; }
}
__device__ __forceinline__ void p4_gdn_scan(Frame& F, const Args& a, int bh) {
    unsigned char* ws = a.ws; const int h = bh & 7, b = bh >> 3, wave = F.wave, lane = F.lane, ht = F.tid - 256;
    const unsigned char* chb = ws + WS_CH + (size_t)bh * 128 * CH_BYTES; const float* cd = (const float*)(ws + WS_CD) + bh * 128;
    const bf16* Z = (const bf16*)(ws + WS_Z); bf16* Y = (bf16*)(ws + WS_YGDN); const float* onw = a.in[11];
    LAS unsigned char* lds = F.lds + RING_OFF; const size_t rowb = (size_t)b * SEQ;
    f32x4 S[4] = {(f32x4){0.f, 0.f, 0.f, 0.f}, (f32x4){0.f, 0.f, 0.f, 0.f}, (f32x4){0.f, 0.f, 0.f, 0.f}, (f32x4){0.f, 0.f, 0.f, 0.f}};
    v4u setA[10], setB[10];
    __syncthreads();
    if (wave >= 4) { scan_load(setA, chb, ht); scan_put(setA, lds + SC_OP, ht); scan_load(setA, chb + CH_BYTES, ht); scan_load(setB, chb + 2 * CH_BYTES, ht); }
    __syncthreads();
    for (int n = 0; n < 128; n += 2) {
        if (wave < 4) scan_step(lds, S, cd[n], n, wave, lane);
        else { scan_put(setA, lds + SC_OP + CH_BYTES, ht); if (n + 3 < 128) scan_load(setA, chb + (size_t)(n + 3) * CH_BYTES, ht);
               if (n >= 1) scan_post((const lf32*)(lds + SC_OB) + 64 * OST, Z, Y, onw, rowb + (size_t)(n - 1) * 64, h, ht); }
        __syncthreads();
        if (wave < 4) scan_step(lds, S, cd[n + 1], n + 1, wave, lane);
        else { if (n + 2 < 128) scan_put(setB, lds + SC_OP, ht); if (n + 4 < 128) scan_load(setB, chb + (size_t)(n + 4) * CH_BYTES, ht);
               scan_post((const lf32*)(lds + SC_OB), Z, Y, onw, rowb + (size_t)n * 64, h, ht); }
        __syncthreads();
    }
    if (wave >= 4) scan_post((const lf32*)(lds + SC_OB) + 64 * OST, Z, Y, onw, rowb + (size_t)127 * 64, h, ht);
    __syncthreads();
}
__global__ void __launch_bounds__(NWAVES * 64, 2) mk_fwd(Args args) {
    extern __shared__ __attribute__((aligned(16))) unsigned char lds[];
    Frame F;
    F.lds = (LAS unsigned char*)lds;
    F.MISC = (volatile LAS unsigned*)(F.lds + MISC_OFF);
    F.tid = threadIdx.x; F.lane = F.tid & 63; F.wave = __builtin_amdgcn_readfirstlane(F.tid >> 6);
    F.G = gridDim.x;
    unsigned char* ws = args.ws;
    F.ctl = (gu32*)(ws + WS_CTL);
    for (int u = F.tid; u < (LDS_BYTES - LDSCTL_OFF) / 4; u += NWAVES * 64) ((LAS unsigned*)(F.lds + LDSCTL_OFF))[u] = 0u;
    __syncthreads();
    const bool multi = (args.ph_hi - args.ph_lo) > 1;
    XcdBarrier bar; bar.bar = (unsigned*)(F.ctl + CW_BAR); bar.x = 0; bar.st = nullptr;
    if (multi) bar = xcd_barrier_post((unsigned*)(F.ctl + CW_BAR), F.MISC + 8);
    const int lo = args.ph_lo, hi = args.ph_hi;
#define IN(k) (lo <= (k) && (k) < hi)
#define SEAM(k) do { if (IN(k) && (k) + 1 < hi) xcd_barrier(bar); } while (0)
    const float* mod = (const float*)(ws + WS_MOD);

    if (IN(0)) { p0_prologue(F, args); } SEAM(0);
    if (IN(1)) { norm_mod_rows(F, args.in[0], args.in[4], mod, 0, (bf16*)(ws + WS_XN)); } SEAM(1);
    if (IN(2)) {
        pg8::Gemm g{(const bf16*)(ws + WS_XN), (const bf16*)(ws + WS_WIN), M, INWP, D}; pg8::StaticOrder S; S.init(M, INWP, F.G, (int)blockIdx.x);
        pg8::EpiInProj E{(bf16*)(ws + WS_Q), (bf16*)(ws + WS_K), (bf16*)(ws + WS_V), (bf16*)(ws + WS_GRAW), (bf16*)(ws + WS_Z), (bf16*)args.out, (float*)(ws + WS_AB)};
        pg8::gemm_phase<pg8::EpiInProj, pg8::StaticOrder, true, true>(F.lds + RING_OFF, g, S, E);
    } SEAM(2);
    if (IN(3)) { p3_gdn_prep(F, args); p3_qknorm(F, args); } SEAM(3);
    if (IN(4)) { if (blockIdx.x < BATCH * GH) p4_gdn_scan(F, args, (int)blockIdx.x); else p4_attn_naive(F, args, (int)blockIdx.x - BATCH * GH, F.G - BATCH * GH); } SEAM(4);
    if (IN(5)) {
        { pg8::Gemm g{(const bf16*)(ws + WS_YSB), (const bf16*)(ws + WS_WSB), M, D, 512}; pg8::StaticOrder S; S.init(M, D, F.G, (int)blockIdx.x);
          pg8::EpiMerge<0> E{(const bf16*)args.out, (bf16*)(ws + WS_MERGED)};
          pg8::gemm_phase<pg8::EpiMerge<0>, pg8::StaticOrder, true, true>(F.lds + RING_OFF, g, S, E); }
        VM_WAIT(); __syncthreads();
        if (F.tid == 0) { __builtin_amdgcn_fence(__ATOMIC_ACQ_REL, "agent"); VM_WAIT(); }
        __syncthreads();
        { pg8::Gemm g{(const bf16*)(ws + WS_YGDN), (const bf16*)(ws + WS_WGDN), M, D, 512}; pg8::StaticOrder S; S.init(M, D, F.G, (int)blockIdx.x);
          pg8::EpiMerge<1> E{(const bf16*)args.out, (bf16*)(ws + WS_MERGED)};
          pg8::gemm_phase<pg8::EpiMerge<1>, pg8::StaticOrder, true, true>(F.lds + RING_OFF, g, S, E); }
    } SEAM(5);
    if (IN(6)) {
        pg8::Gemm g{(const bf16*)(ws + WS_MERGED), (const bf16*)(ws + WS_WO), M, D, D}; pg8::StaticOrder S; S.init(M, D, F.G, (int)blockIdx.x);
        pg8::EpiWo E{args.in[0], mod, args.out};
        pg8::gemm_phase<pg8::EpiWo, pg8::StaticOrder, true, true>(F.lds + RING_OFF, g, S, E);
    } SEAM(6);
    if (IN(7)) { norm_mod_rows(F, args.out, args.in[15], mod, 3, (bf16*)(ws + WS_XN)); } SEAM(7);
    if (IN(8)) {
        pg8::Gemm g{(const bf16*)(ws + WS_XN), (const bf16*)(ws + WS_WQ), M, PQW, D}; pg8::StaticOrder S; S.init(M, PQW, F.G, (int)blockIdx.x);
        pg8::EpiBf16<0> E{(bf16*)(ws + WS_QP), PQW, nullptr, 0, 0, 1.f};
        pg8::gemm_phase<pg8::EpiBf16<0>, pg8::StaticOrder, true, true>(F.lds + RING_OFF, g, S, E);
    } SEAM(8);
    if (IN(9)) { p9_topk_naive(F, args); } SEAM(9);
    if (IN(10)) { p10_peer(F, args); }
#undef IN
#undef SEAM
}
extern "C" void kernel_launch(void* const* d_in, const int* in_sizes, int n_in, void* d_out, int out_size, void* d_ws, size_t ws_size, hipStream_t stream) {
    static int grid = 0;
    if (grid == 0) {
        if (n_in != 20 || out_size != M * D || ws_size < WS_END) { fprintf(stderr, "kernel_launch: unexpected shapes n_in %d out %d ws %zu\n", n_in, out_size, ws_size); grid = -1; return; }
        int dev = 0, cus = 0;
        if (hipGetDevice(&dev) != hipSuccess || hipDeviceGetAttribute(&cus, hipDeviceAttributeMultiprocessorCount, dev) != hipSuccess) { grid = -1; return; }
        if (hipFuncSetAttribute((const void*)mk_fwd, hipFuncAttributeMaxDynamicSharedMemorySize, LDS_BYTES) != hipSuccess) { fprintf(stderr, "kernel_launch: hipFuncSetAttribute failed\n"); grid = -1; return; }
        (void)hipGetLastError();
        grid = cus;
    }
    if (grid < 0) return;
    (void)hipMemsetAsync((char*)d_ws + WS_CTL, 0, CTL_ZERO_BYTES, stream);
    Args a{};
    for (int i = 0; i < 20; ++i) a.in[i] = (const float*)d_in[i];
    a.out = (float*)d_out; a.ws = (unsigned char*)d_ws;
    auto mk = [&](int lo, int hi) { a.ph_lo = lo; a.ph_hi = hi; a.li = 0; hipLaunchKernelGGL(mk_fwd, dim3(grid), dim3(NWAVES * 64), LDS_BYTES, stream, a); };
    mk(0, 11);
}
```

```cpp
#include <hip/hip_runtime.h>
#include <cstdio>
#include <cstdint>
#include <cmath>

constexpr int D = 1024, BATCH = 2, SEQ = 8192, M = BATCH * SEQ;
constexpr int SBH = 8, SBD = 64, SBW = 512;
constexpr int GH = 8, GDK = 64, GDV = 64, GCONVW = 1536;
constexpr int INW = 5648, INWP = 5888;
constexpr int PH = 8, PNK = 128, PQD = 256, PHALF = 128, PTOPK = 16, PNE = 16384, PQW = PH * PQD;
constexpr float EPS = 1e-6f;

namespace pg8 {
#define PG8_LAS __attribute__((address_space(3)))
typedef unsigned short bf16_t;
typedef short bf16x8 __attribute__((ext_vector_type(8)));
typedef float f32x4 __attribute__((ext_vector_type(4)));
typedef unsigned u32x4 __attribute__((ext_vector_type(4)));
constexpr int BM = 256, BK = 64, HALF = 128, HTB = HALF * BK * 2  , STAGE_BYTES = 8 * HTB, NXCD = 8, WGM = 8;

__host__ __device__ __forceinline__ int lds_byte(int r, int c) { const int st = (r >> 4) * 2 + (c >> 5), rr = r & 15, cc = c & 31, ob = rr * 64 + cc * 2; return st * 1024 + (ob ^ (((ob >> 9) & 1) << 5)); }
__host__ __device__ __forceinline__ void stage_rc(int b, int& R, int& C) { const int st = b / 1024, sb = b % 1024, swz = sb ^ (((sb >> 9) & 1) << 5); R = (st >> 1) * 16 + swz / 64; C = (st & 1) * 32 + (swz % 64) / 2; }
__host__ __device__ __forceinline__ int perm32(int rho) { const int n = rho >> 4, i = rho & 15; return 8 * (i >> 2) + 4 * n + (i & 3); }

struct Unit { int pm, pn; };
struct Gemm { const bf16_t* A; const bf16_t* Bt; int M, N, K; };

struct StaticOrder {
    int nM, nN, nwg, G, c;
    __host__ __device__ void init(int M, int N, int G_, int c_) { nM = M / BM; nN = N / BM; nwg = nM * nN; G = G_; c = c_; }
    __host__ __device__ bool next(int i, Unit& u) const {
        const long L = (long)i * G + c; if (L >= nwg) return false;
        int wgid = (int)L; { const int q = nwg / NXCD, r = nwg % NXCD, xcd = wgid % NXCD, off = wgid / NXCD; wgid = (xcd < r ? xcd * (q + 1) : r * (q + 1) + (xcd - r) * q) + off; }
        const int nig = WGM * nN, gid = wgid / nig, fm = gid * WGM, gsz = (nM - fm) < WGM ? (nM - fm) : WGM;
        u.pm = fm + ((wgid % nig) % gsz); u.pn = (wgid % nig) / gsz; return true;
    }
    __device__ __forceinline__ void a_ready(const Unit&) const {}
    __device__ __forceinline__ void done(const Unit&) const {}
};

__device__ __forceinline__ unsigned cvt_pk_bf16(float lo, float hi) { unsigned r; asm volatile("v_cvt_pk_bf16_f32 %0, %1, %2" : "=v"(r) : "v"(lo), "v"(hi)); return r; }
typedef float f32x2 __attribute__((ext_vector_type(2)));
__device__ __forceinline__ f32x2 gelu_pk(f32x2 v) {
    const f32x2 av = __builtin_elementwise_abs(v), d = av * 0.2316418882f + 1.0f;
    f32x2 t; t.x = __builtin_amdgcn_rcpf(d.x); t.y = __builtin_amdgcn_rcpf(d.y);
    f32x2 q = t * 0.5307027145f + (-0.7265760135f); q = q * t + 0.7107068705f; q = q * t + (-0.142248368f); q = q * t + 0.127414796f; q = q * t;
    const f32x2 s = (v * v) * (-0.72134752044f);
    f32x2 e; e.x = __builtin_amdgcn_exp2f(s.x); e.y = __builtin_amdgcn_exp2f(s.y);
    const f32x2 m = v * (q * e), r = v - m;
    f32x2 o; o.x = v.x < 0.f ? m.x : r.x; o.y = v.y < 0.f ? m.y : r.y; return o;
}

template <int ACT  > struct EpiBf16 {
    static constexpr bool PERM = true, AFTER_DRAIN = false; static_assert(ACT == 0 || ACT == 1, "EpiBf16: ACT is 0 (none) or 1 (gelu_pk)");
    bf16_t* O; int ldc; const float* bias; int split_cols; size_t split_stride; float scale0;
    __device__ __forceinline__ void operator()(const f32x4 (&acc)[2][2][4][2], const Unit& u, int wr, int wc, int fr, int fq) const {
        const int row0 = u.pm * BM + wr * 64 + fr; int colt = u.pn * BM; bf16_t* base = O;
        float sc = 1.f; if (split_cols) { const int t = colt / split_cols; base += (size_t)t * split_stride; colt -= t * split_cols; if (t == 0) sc = scale0; }
        const int col0 = colt + wc * 32 + 8 * fq, bcol0 = u.pn * BM + wc * 32 + 8 * fq;
        f32x4 bv[2][2];
#pragma unroll
        for (int bj = 0; bj < 2; ++bj)
#pragma unroll
            for (int n = 0; n < 2; ++n) bv[bj][n] = bias ? *(const f32x4*)(bias + bcol0 + bj * HALF + 4 * n) : (f32x4){0.f, 0.f, 0.f, 0.f};
#pragma unroll
        for (int ai = 0; ai < 2; ++ai)
#pragma unroll
            for (int m = 0; m < 4; ++m) { bf16_t* rowp = base + (size_t)(row0 + ai * HALF + m * 16) * ldc + col0;
#pragma unroll
                for (int bj = 0; bj < 2; ++bj) { f32x4 v0 = acc[ai][bj][m][0] + bv[bj][0], v1 = acc[ai][bj][m][1] + bv[bj][1];
                    if (ACT == 1) { f32x2 a = gelu_pk((f32x2){v0[0], v0[1]}), b = gelu_pk((f32x2){v0[2], v0[3]}), c = gelu_pk((f32x2){v1[0], v1[1]}), d = gelu_pk((f32x2){v1[2], v1[3]});
                        v0 = (f32x4){a.x, a.y, b.x, b.y}; v1 = (f32x4){c.x, c.y, d.x, d.y}; }
                    v0 = v0 * sc; v1 = v1 * sc; u32x4 w; w.x = cvt_pk_bf16(v0[0], v0[1]); w.y = cvt_pk_bf16(v0[2], v0[3]); w.z = cvt_pk_bf16(v1[0], v1[1]); w.w = cvt_pk_bf16(v1[2], v1[3]);
                    *(u32x4*)(rowp + bj * HALF) = w; } }
    }
};

__device__ __forceinline__ float sigmoidf_(float x) { return __builtin_amdgcn_rcpf(1.0f + __expf(-x)); }
__device__ __forceinline__ float bf2f(unsigned short h) { return __uint_as_float((unsigned)h << 16); }
__device__ __forceinline__ float bflo(unsigned w) { return __uint_as_float(w << 16); }
__device__ __forceinline__ float bfhi(unsigned w) { return __uint_as_float(w & 0xffff0000u); }

struct EpiInProj {
    static constexpr bool PERM = true, AFTER_DRAIN = false;
    bf16_t *q, *k, *v, *graw, *z, *gates; float* ab;
    __device__ __forceinline__ void operator()(const f32x4 (&acc)[2][2][4][2], const Unit& u, int wr, int wc, int fr, int fq) const {
        const int pn = u.pn; bf16_t* base; int ldc, ct; bool sig = false;
        if (pn < 2) { base = q; ldc = 512; ct = pn; } else if (pn < 4) { base = k; ldc = 512; ct = pn - 2; } else if (pn < 6) { base = v; ldc = 512; ct = pn - 4; }
        else if (pn < 12) { base = graw; ldc = 1536; ct = pn - 6; } else if (pn < 14) { base = z; ldc = 512; ct = pn - 12; } else if (pn < 22) { base = gates; ldc = 2048; ct = pn - 14; sig = true; }
        else {
            if (wc == 0 && fq < 2) {
#pragma unroll
                for (int ai = 0; ai < 2; ++ai)
#pragma unroll
                    for (int m = 0; m < 4; ++m) { const int r = u.pm * BM + ai * HALF + wr * 64 + m * 16 + fr; float* p = ab + (size_t)r * 16 + 8 * fq;
                        *(f32x4*)p = acc[ai][0][m][0]; *(f32x4*)(p + 4) = acc[ai][0][m][1]; }
            }
            return;
        }
        const int row0 = u.pm * BM + wr * 64 + fr, col0 = ct * BM + wc * 32 + 8 * fq;
#pragma unroll
        for (int ai = 0; ai < 2; ++ai)
#pragma unroll
            for (int m = 0; m < 4; ++m) { bf16_t* rowp = base + (size_t)(row0 + ai * HALF + m * 16) * ldc + col0;
#pragma unroll
                for (int bj = 0; bj < 2; ++bj) { f32x4 v0 = acc[ai][bj][m][0], v1 = acc[ai][bj][m][1];
                    if (sig) { v0 = (f32x4){sigmoidf_(v0[0]), sigmoidf_(v0[1]), sigmoidf_(v0[2]), sigmoidf_(v0[3])}; v1 = (f32x4){sigmoidf_(v1[0]), sigmoidf_(v1[1]), sigmoidf_(v1[2]), sigmoidf_(v1[3])}; }
                    u32x4 w; w.x = cvt_pk_bf16(v0[0], v0[1]); w.y = cvt_pk_bf16(v0[2], v0[3]); w.z = cvt_pk_bf16(v1[0], v1[1]); w.w = cvt_pk_bf16(v1[2], v1[3]);
                    *(u32x4*)(rowp + bj * HALF) = w; } }
    }
};
template <int MODE> struct EpiMerge {
    static constexpr bool PERM = true, AFTER_DRAIN = false;
    const bf16_t* gates; bf16_t* merged;
    __device__ __forceinline__ void operator()(const f32x4 (&acc)[2][2][4][2], const Unit& u, int wr, int wc, int fr, int fq) const {
        const int row0 = u.pm * BM + wr * 64 + fr, col0 = u.pn * BM + wc * 32 + 8 * fq;
#pragma unroll
        for (int ai = 0; ai < 2; ++ai)
#pragma unroll
            for (int m = 0; m < 4; ++m) { const size_t r = (size_t)(row0 + ai * HALF + m * 16);
#pragma unroll
                for (int bj = 0; bj < 2; ++bj) { const int c = col0 + bj * HALF;
                    const u32x4 g = *(const u32x4*)(gates + r * 2048 + MODE * 1024 + c);
                    f32x4 v0 = acc[ai][bj][m][0], v1 = acc[ai][bj][m][1];
                    v0 = v0 * (f32x4){bflo(g.x), bfhi(g.x), bflo(g.y), bfhi(g.y)}; v1 = v1 * (f32x4){bflo(g.z), bfhi(g.z), bflo(g.w), bfhi(g.w)};
                    if (MODE == 1) { const u32x4 p = *(const u32x4*)(merged + r * 1024 + c);
                        v0 = v0 + (f32x4){bflo(p.x), bfhi(p.x), bflo(p.y), bfhi(p.y)}; v1 = v1 + (f32x4){bflo(p.z), bfhi(p.z), bflo(p.w), bfhi(p.w)}; }
                    u32x4 w; w.x = cvt_pk_bf16(v0[0], v0[1]); w.y = cvt_pk_bf16(v0[2], v0[3]); w.z = cvt_pk_bf16(v1[0], v1[1]); w.w = cvt_pk_bf16(v1[2], v1[3]);
                    *(u32x4*)(merged + r * 1024 + c) = w; } }
    }
};
struct EpiWo {
    static constexpr bool PERM = true, AFTER_DRAIN = false;
    const float* x; const float* mod; float* out;
    __device__ __forceinline__ void operator()(const f32x4 (&acc)[2][2][4][2], const Unit& u, int wr, int wc, int fr, int fq) const {
        const int row0 = u.pm * BM + wr * 64 + fr, col0 = u.pn * BM + wc * 32 + 8 * fq; const int b = (u.pm * BM) >> 13;
        const float* g1 = mod + (size_t)b * 6 * 1024 + 2 * 1024;
#pragma unroll
        for (int bj = 0; bj < 2; ++bj) { const int c = col0 + bj * HALF; const f32x4 ga = *(const f32x4*)(g1 + c), gb = *(const f32x4*)(g1 + c + 4);
#pragma unroll
            for (int ai = 0; ai < 2; ++ai)
#pragma unroll
                for (int m = 0; m < 4; ++m) { const size_t off = (size_t)(row0 + ai * HALF + m * 16) * 1024 + c;
                    const f32x4 xa = *(const f32x4*)(x + off), xb = *(const f32x4*)(x + off + 4);
                    *(f32x4*)(out + off) = xa + ga * acc[ai][bj][m][0]; *(f32x4*)(out + off + 4) = xb + gb * acc[ai][bj][m][1]; } }
    }
};
template <class Epi, class Sched, bool ALIGN_EPI = false, bool SP2 = false>
__device__ __forceinline__ void gemm_phase(PG8_LAS unsigned char* lds, const Gemm g, const Sched& S, const Epi& E) {
    const int tid = threadIdx.x, wid = __builtin_amdgcn_readfirstlane(tid >> 6), lane = tid & 63, wr = wid >> 2, wc = wid & 3, fr = lane & 15, fq = lane >> 4;
    const int K = g.K, nt = K / BK;
    unsigned voffA[2], voffB[2];
#pragma unroll
    for (int i = 0; i < 2; ++i) { int R, C; stage_rc(tid * 16 + i * 8192, R, C); const int Rb = Epi::PERM ? ((R & ~31) + perm32(R & 31)) : R;
        voffA[i] = (unsigned)(R * K + C) * 2u; voffB[i] = (unsigned)(Rb * K + C) * 2u; }
    const size_t kstep = (size_t)(BK * 2);
    const size_t hstep = (size_t)HALF * K * 2;
    const size_t tstep = 2 * hstep;
    const unsigned ldsw = (unsigned)wid * 1024u;
    const int aoff = lds_byte(wr * 64 + fr, fq * 8), boff = lds_byte(wc * 32 + fr, fq * 8);
#define PG8_SA(b, h) (((b) * 2 + (h)) * HTB)
#define PG8_SB(b, h) ((4 + (b) * 2 + (h)) * HTB)
#define PG8_STAGE(bufoff, gbase, voff) do { _Pragma("unroll") for (int _i = 0; _i < 2; ++_i) \
        __builtin_amdgcn_global_load_lds((const unsigned*)((const char*)(gbase) + (voff)[_i]), (PG8_LAS unsigned*)(lds + (bufoff) + ldsw + _i * 8192), 16, 0, 0); } while (0)
#define PG8_LDA(dst, b, h) do { _Pragma("unroll") for (int m = 0; m < 4; ++m) _Pragma("unroll") for (int k = 0; k < 2; ++k) dst[m][k] = *(const PG8_LAS bf16x8*)(lds + PG8_SA(b, h) + aoff + m * 2048 + k * 1024); } while (0)
#define PG8_LDB(dst, b, h) do { _Pragma("unroll") for (int n = 0; n < 2; ++n) _Pragma("unroll") for (int k = 0; k < 2; ++k) dst[n][k] = *(const PG8_LAS bf16x8*)(lds + PG8_SB(b, h) + boff + n * 2048 + k * 1024); } while (0)
#define PG8_MMA(ai, bj, At, Bt) do { __builtin_amdgcn_s_setprio(1); _Pragma("unroll") for (int m = 0; m < 4; ++m) _Pragma("unroll") for (int n = 0; n < 2; ++n) _Pragma("unroll") for (int k = 0; k < 2; ++k) \
        acc[ai][bj][m][n] = __builtin_amdgcn_mfma_f32_16x16x32_bf16(Bt[n][k], At[m][k], acc[ai][bj][m][n], 0, 0, 0); __builtin_amdgcn_s_setprio(0); } while (0)
#define PG8_WAIT_V(n) asm volatile("s_waitcnt vmcnt(" #n ")" ::: "memory")
#define PG8_WAIT_L(n) asm volatile("s_waitcnt lgkmcnt(" #n ")" ::: "memory")
#define PG8_BAR __builtin_amdgcn_s_barrier()
#define PG8_SCHED __builtin_amdgcn_sched_barrier(0)
    Unit cur, nxt; int ui = 0;
    if (!S.next(0, cur)) return;
    f32x4 acc[2][2][4][2];
#pragma unroll
    for (int a = 0; a < 2; ++a)
#pragma unroll
        for (int b = 0; b < 2; ++b)
#pragma unroll
            for (int m = 0; m < 4; ++m)
#pragma unroll
                for (int n = 0; n < 2; ++n) acc[a][b][m][n] = (f32x4){0.f, 0.f, 0.f, 0.f};
    bf16x8 At[4][2], B0[2][2], B1[2][2];
    const char* cA = (const char*)g.A + (size_t)cur.pm * tstep; const char* cB = (const char*)g.Bt + (size_t)cur.pn * tstep;
    S.a_ready(cur);
    if constexpr (SP2) {
        PG8_STAGE(PG8_SB(0, 0), cB, voffB); PG8_STAGE(PG8_SB(0, 1), cB + hstep, voffB); PG8_STAGE(PG8_SA(0, 0), cA, voffA); PG8_STAGE(PG8_SA(0, 1), cA + hstep, voffA);
        if (wr == 1) PG8_BAR;
        PG8_WAIT_V(2); PG8_BAR;
        PG8_STAGE(PG8_SB(1, 0), cB + kstep, voffB); PG8_STAGE(PG8_SA(1, 0), cA + kstep, voffA); PG8_STAGE(PG8_SB(1, 1), cB + hstep + kstep, voffB);
        PG8_WAIT_V(6); PG8_BAR;
    } else {
        PG8_STAGE(PG8_SB(0, 0), cB, voffB); PG8_STAGE(PG8_SA(0, 0), cA, voffA); PG8_STAGE(PG8_SB(0, 1), cB + hstep, voffB); PG8_STAGE(PG8_SA(0, 1), cA + hstep, voffA);
        if (wr == 1) PG8_BAR;
        PG8_WAIT_V(4); PG8_BAR;
        PG8_STAGE(PG8_SB(1, 0), cB + kstep, voffB); PG8_STAGE(PG8_SA(1, 0), cA + kstep, voffA); PG8_STAGE(PG8_SB(1, 1), cB + hstep + kstep, voffB);
        PG8_WAIT_V(6); PG8_BAR;
    }
    for (;;) {
        const bool has_next = S.next(ui + 1, nxt);
        const char* nA = has_next ? (const char*)g.A + (size_t)nxt.pm * tstep : cA; const char* nB = has_next ? (const char*)g.Bt + (size_t)nxt.pn * tstep : cB;
        for (int t = 0; t < nt; t += 2) {
            const bool last = (t == nt - 2);
            const char* a1 = cA + (size_t)(t + 1) * kstep;
            const char* a2 = last ? nA : cA + (size_t)(t + 2) * kstep; const char* b2 = last ? nB : cB + (size_t)(t + 2) * kstep;
            const char* a3 = a2 + kstep; const char* b3 = b2 + kstep;
            if (last && has_next) S.a_ready(nxt);
            if constexpr (SP2) {
            PG8_LDB(B0, 0, 0); PG8_LDB(B1, 0, 1); PG8_SCHED; PG8_LDA(At, 0, 0); PG8_STAGE(PG8_SA(1, 1), a1 + hstep, voffA);
            PG8_WAIT_V(8); PG8_WAIT_L(0); PG8_BAR; PG8_MMA(0, 0, At, B0); PG8_MMA(0, 1, At, B1); PG8_BAR; PG8_SCHED;
            PG8_LDA(At, 0, 1); PG8_STAGE(PG8_SB(0, 0), b2, voffB); PG8_STAGE(PG8_SB(0, 1), b2 + hstep, voffB); PG8_STAGE(PG8_SA(0, 0), a2, voffA);
            PG8_WAIT_V(8); PG8_WAIT_L(0); PG8_BAR; PG8_MMA(1, 0, At, B0); PG8_MMA(1, 1, At, B1); PG8_BAR; PG8_SCHED;
            PG8_LDB(B0, 1, 0); PG8_LDB(B1, 1, 1); PG8_SCHED; PG8_LDA(At, 1, 0); PG8_STAGE(PG8_SA(0, 1), a2 + hstep, voffA);
            PG8_WAIT_V(8); PG8_WAIT_L(0); PG8_BAR; PG8_MMA(0, 0, At, B0); PG8_MMA(0, 1, At, B1); PG8_BAR; PG8_SCHED;
            PG8_LDA(At, 1, 1); PG8_STAGE(PG8_SB(1, 0), b3, voffB); PG8_STAGE(PG8_SB(1, 1), b3 + hstep, voffB); PG8_STAGE(PG8_SA(1, 0), a3, voffA);
            PG8_WAIT_V(8); PG8_WAIT_L(0); PG8_BAR; PG8_MMA(1, 0, At, B0); PG8_MMA(1, 1, At, B1); PG8_BAR; PG8_SCHED;
            } else {
            PG8_LDB(B0, 0, 0); PG8_SCHED; PG8_LDA(At, 0, 0); PG8_STAGE(PG8_SA(1, 1), a1 + hstep, voffA);
            PG8_WAIT_L(8); PG8_BAR; PG8_WAIT_L(0); PG8_MMA(0, 0, At, B0); PG8_BAR; PG8_SCHED;
            PG8_LDB(B1, 0, 1); PG8_STAGE(PG8_SB(0, 0), b2, voffB);
            PG8_BAR; PG8_WAIT_L(0); PG8_MMA(0, 1, At, B1); PG8_BAR;
            PG8_LDA(At, 0, 1); PG8_STAGE(PG8_SA(0, 0), a2, voffA);
            PG8_BAR; PG8_WAIT_L(0); PG8_MMA(1, 0, At, B0); PG8_BAR; PG8_SCHED;
            PG8_STAGE(PG8_SB(0, 1), b2 + hstep, voffB);
            PG8_WAIT_V(6); PG8_BAR; PG8_MMA(1, 1, At, B1); PG8_BAR;
            PG8_LDB(B0, 1, 0); PG8_SCHED; PG8_LDA(At, 1, 0); PG8_STAGE(PG8_SA(0, 1), a2 + hstep, voffA);
            PG8_WAIT_L(8); PG8_BAR; PG8_WAIT_L(0); PG8_MMA(0, 0, At, B0); PG8_BAR; PG8_SCHED;
            PG8_LDB(B1, 1, 1); PG8_STAGE(PG8_SB(1, 0), b3, voffB);
            PG8_BAR; PG8_WAIT_L(0); PG8_MMA(0, 1, At, B1); PG8_BAR;
            PG8_LDA(At, 1, 1); PG8_STAGE(PG8_SA(1, 0), a3, voffA);
            PG8_BAR; PG8_WAIT_L(0); PG8_MMA(1, 0, At, B0); PG8_BAR; PG8_SCHED;
            PG8_STAGE(PG8_SB(1, 1), b3 + hstep, voffB);
            PG8_WAIT_V(6); PG8_BAR; PG8_MMA(1, 1, At, B1); PG8_BAR;
            }
        }
        if constexpr (ALIGN_EPI) { if (wr == 0) PG8_BAR; }
        if constexpr (!Epi::AFTER_DRAIN) { E(acc, cur, wr, wc, fr, fq); S.done(cur); }
        if (!has_next) break;
#pragma unroll
        for (int a = 0; a < 2; ++a)
#pragma unroll
            for (int b = 0; b < 2; ++b)
#pragma unroll
                for (int m = 0; m < 4; ++m)
#pragma unroll
                    for (int n = 0; n < 2; ++n) acc[a][b][m][n] = (f32x4){0.f, 0.f, 0.f, 0.f};
        cur = nxt; cA = nA; cB = nB; ++ui;
        if constexpr (ALIGN_EPI) { if (wr == 1) PG8_BAR; }
    }
    PG8_WAIT_V(0);
    if constexpr (!ALIGN_EPI) { if (wr == 0) PG8_BAR; }
    PG8_BAR;
    if constexpr (Epi::AFTER_DRAIN) { E.fused(acc, cur, wr, wc, fr, fq, lds, wid, lane); S.done(cur); }
#undef PG8_SA
#undef PG8_SB
#undef PG8_STAGE
#undef PG8_LDA
#undef PG8_LDB
#undef PG8_MMA
#undef PG8_WAIT_V
#undef PG8_WAIT_L
#undef PG8_BAR
#undef PG8_SCHED
}
}

constexpr int NWAVES = 8;
#define GAS __attribute__((address_space(1)))
#define LAS __attribute__((address_space(3)))
typedef unsigned short bf16;
typedef unsigned v4u __attribute__((ext_vector_type(4)));
typedef unsigned v2u __attribute__((ext_vector_type(2)));
typedef float f32x4 __attribute__((ext_vector_type(4)));
typedef float f32x2 __attribute__((ext_vector_type(2)));
typedef short bf16x8 __attribute__((ext_vector_type(8)));
typedef GAS unsigned gu32;
#define RLX_AGENT __ATOMIC_RELAXED, __HIP_MEMORY_SCOPE_AGENT
#define LDS_WAIT() asm volatile("s_waitcnt lgkmcnt(0)" ::: "memory")
#define VM_WAIT() asm volatile("s_waitcnt vmcnt(0)" ::: "memory")
__device__ __forceinline__ unsigned f2bf(float f) { unsigned u = __builtin_bit_cast(unsigned, f); return (u + 0x7fffu + ((u >> 16) & 1u)) >> 16; }
__device__ __forceinline__ unsigned pk2(float lo, float hi) { return f2bf(lo) | (f2bf(hi) << 16); }
__device__ __forceinline__ float bf2f(unsigned short h) { return __uint_as_float((unsigned)h << 16); }
__device__ __forceinline__ float bflo(unsigned w) { return __uint_as_float(w << 16); }
__device__ __forceinline__ float bfhi(unsigned w) { return __uint_as_float(w & 0xffff0000u); }
__device__ __forceinline__ float sigm(float x) { return 1.0f / (1.0f + __expf(-x)); }
__device__ __forceinline__ float siluf(float x) { return x / (1.0f + __expf(-x)); }
__device__ __forceinline__ float softplusf(float x) { return fmaxf(x, 0.f) + log1pf(__expf(-fabsf(x))); }
__device__ __forceinline__ float wave_sum(float v) {
#pragma unroll
    for (int o = 1; o < 64; o <<= 1) v += __shfl_xor(v, o);
    return v;
}

constexpr size_t MiB = 1u << 20;
constexpr size_t WS_CTL = 0, CTL_ZERO_BYTES = 1 * MiB;
constexpr size_t WS_MOD = 1 * MiB;
constexpr size_t WS_SKEY = 1 * MiB + 256 * 1024;
constexpr size_t WS_WIN = 2 * MiB;
constexpr size_t WS_WSB = 14 * MiB, WS_WGDN = 15 * MiB, WS_WO = 16 * MiB, WS_WQ = 18 * MiB;
constexpr size_t WS_AB = 22 * MiB;
constexpr size_t WS_GB = 23 * MiB;
constexpr size_t WS_XN = 24 * MiB;
constexpr size_t WS_Q = 56 * MiB, WS_K = 72 * MiB, WS_V = 88 * MiB;
constexpr size_t WS_GRAW = 104 * MiB;
constexpr size_t WS_Z = 152 * MiB;
constexpr size_t WS_YSB = 24 * MiB, WS_YGDN = 40 * MiB;
constexpr size_t WS_MERGED = 56 * MiB;
constexpr size_t WS_CH = 168 * MiB;
constexpr size_t WS_CD = 248 * MiB;
constexpr size_t WS_QP = 168 * MiB;
constexpr size_t WS_EIDX = 232 * MiB, WS_GATE = 240 * MiB;
constexpr size_t WS_UT8 = 104 * MiB, WS_VT8 = 120 * MiB;
constexpr size_t WS_END = 256 * MiB;
constexpr int CW_BAR = 4096;

constexpr int RING_OFF = 0, RING_BYTES = 131072;
constexpr int LDSCTL_OFF = RING_BYTES, MISC_OFF = LDSCTL_OFF + 320;
constexpr int LDS_BYTES = 147456;
#define XB_TMO      128
#define XB_XCNT(j)  (256  + 64 * (j))
#define XB_XSUB(j)  (1280 + 64 * (j))
#define XB_XGEN(j)  (2304 + 64 * (j))
#define XB_TOP      3328
#define XB_TOPGEN   3392
#define XCD_BAR_WORDS 3456
#define XB_SPIN_CAP (1u << 18)

__device__ __forceinline__ unsigned xb_ld(unsigned* p)              { return __hip_atomic_load(p, __ATOMIC_RELAXED, __HIP_MEMORY_SCOPE_AGENT); }
__device__ __forceinline__ unsigned xb_add(unsigned* p, unsigned v) { return __hip_atomic_fetch_add(p, v, __ATOMIC_RELAXED, __HIP_MEMORY_SCOPE_AGENT); }
__device__ __forceinline__ unsigned xb_xcc_id() { return (unsigned)__builtin_amdgcn_s_getreg((3 << 11) | 20) & 0xFu; }
#define XB_SPIN(cond, bar) do { unsigned _sp = 0; while (cond) { __builtin_amdgcn_s_sleep(1); \
    if ((++_sp & 255u) == 0u) { if (xb_ld(&(bar)[XB_TMO])) break; if (_sp > XB_SPIN_CAP) { atomicAdd(&(bar)[XB_TMO], 1u); break; } } } } while (0)

struct XcdBarrier {
    unsigned* bar; unsigned x;
    volatile LAS unsigned* st;
};

__device__ __forceinline__ XcdBarrier xcd_barrier_post(unsigned* bar, volatile LAS unsigned* st) {
    XcdBarrier b; b.bar = bar; b.x = xb_xcc_id(); b.st = st;
    if (threadIdx.x == 0) (void)xb_add(&bar[XB_XCNT(b.x)], 1u);
    return b;
}
__device__ __forceinline__ void xcd_barrier_complete(unsigned* bar, unsigned x, unsigned& nloc, unsigned& nx) {
    const unsigned G = gridDim.x * gridDim.y * gridDim.z;
    unsigned sum, cnt, mine, sp = 0u;
    for (;;) {
        sum = 0u; cnt = 0u; mine = 0u;
#pragma unroll
        for (unsigned j = 0; j < 16; ++j) { const unsigned c = xb_ld(&bar[XB_XCNT(j)]); sum += c; cnt += (c > 0u) ? 1u : 0u; mine = (j == x) ? c : mine; }
        if (sum == G) break;
        __builtin_amdgcn_s_sleep(1);
        if ((++sp & 255u) == 0u) { if (xb_ld(&bar[XB_TMO])) break; if (sp > XB_SPIN_CAP) { atomicAdd(&bar[XB_TMO], 1u); break; } }
    }
    nloc = mine > 0u ? mine : 1u; nx = cnt > 0u ? cnt : 1u;
}

__device__ __forceinline__ void xcd_barrier(const XcdBarrier& b) {
    asm volatile("s_waitcnt vmcnt(0)" ::: "memory");
    __syncthreads();
    if (threadIdx.x == 0) {
        unsigned* bar = b.bar;
        __builtin_amdgcn_s_waitcnt(0);
        unsigned nloc = b.st[0], nx = b.st[1];
        if (nloc == 0u) { xcd_barrier_complete(bar, b.x, nloc, nx); b.st[0] = nloc; b.st[1] = nx; }
        const unsigned old = xb_add(&bar[XB_XSUB(b.x)], 1u);
        const unsigned gen = old / nloc;
        if (old + 1u == (gen + 1u) * nloc) {
            __builtin_amdgcn_fence(__ATOMIC_RELEASE, "agent");
            asm volatile("s_waitcnt vmcnt(0)" ::: "memory");
            const unsigned og = xb_add(&bar[XB_TOP], 1u);
            const unsigned tg = og / nx;
            if (og + 1u == (tg + 1u) * nx) xb_add(&bar[XB_TOPGEN], 1u);
            else XB_SPIN(xb_ld(&bar[XB_TOPGEN]) == tg, bar);
            __builtin_amdgcn_fence(__ATOMIC_ACQUIRE, "agent");
            xb_add(&bar[XB_XGEN(b.x)], 1u);
            asm volatile("s_waitcnt vmcnt(0)" ::: "memory");
        } else {
            XB_SPIN(xb_ld(&bar[XB_XGEN(b.x)]) == gen, bar);
            __builtin_amdgcn_fence(__ATOMIC_ACQUIRE, "agent");
            asm volatile("s_waitcnt vmcnt(0)" ::: "memory");
        }
    }
    __syncthreads();
}

struct Args { const float* in[20]; float* out; unsigned char* ws; int ph_lo, ph_hi, li, pad; };

struct Frame {
    LAS unsigned char* lds;
    volatile LAS unsigned* MISC;
    gu32* ctl;
    int tid, lane, wave, G;
};

__device__ __forceinline__ int inproj_src_col(int n) { if (n < 3072) return n; if (n < 5632) return n + 16; if (n < 5648) return n - 5632 + 3072; return -1; }
template <bool MAP>
__device__ __forceinline__ void p0_transpose_item(const float* W, int K, int Nsrc, int Ndst, bf16* WT, LAS float* scr, int item, int lane) {
    const int nblk = Ndst / 32, kb = item / nblk, nb = item % nblk, k0 = 64 * kb, n0 = 32 * nb;
    const int nsrc = MAP ? inproj_src_col(n0 + (lane & 31)) : n0 + (lane & 31);
#pragma unroll 8
    for (int i = 0; i < 32; ++i) { const int kk = 2 * i + (lane >> 5); scr[kk * 33 + (lane & 31)] = nsrc >= 0 ? W[(size_t)(k0 + kk) * Nsrc + nsrc] : 0.f; }
    LDS_WAIT(); asm volatile("" ::: "memory");
    const int c = lane & 7;
#pragma unroll
    for (int j = 0; j < 4; ++j) { const int n = (lane >> 3) + 8 * j; const LAS float* s = scr + (8 * c) * 33 + n;
        v4u o; o.x = pk2(s[0 * 33], s[1 * 33]); o.y = pk2(s[2 * 33], s[3 * 33]); o.z = pk2(s[4 * 33], s[5 * 33]); o.w = pk2(s[6 * 33], s[7 * 33]);
        *(GAS v4u*)(WT + (size_t)(n0 + n) * K + k0 + 8 * c) = o; }
    LDS_WAIT(); asm volatile("" ::: "memory");
}
__device__ __forceinline__ void p0_prologue(Frame& F, const Args& a) {
    unsigned char* ws = a.ws;
    LAS float* scr = (LAS float*)(F.lds + RING_OFF + F.wave * 16384);
    const int gw = blockIdx.x * NWAVES + F.wave, NGW = F.G * NWAVES;
    constexpr int I_IN = (D / 64) * (INWP / 32), I_SB = (512 / 64) * (D / 32), I_O = (D / 64) * (D / 32), I_Q = (D / 64) * (PQW / 32);
    constexpr int NITEMS = I_IN + 2 * I_SB + I_O + I_Q;
    for (int it = gw; it < NITEMS; it += NGW) {
        int r = it;
        if (r < I_IN) { p0_transpose_item<true>(a.in[5], D, INW, INWP, (bf16*)(ws + WS_WIN), scr, r, F.lane); continue; } r -= I_IN;
        if (r < I_SB) { p0_transpose_item<false>(a.in[12], 512, D, D, (bf16*)(ws + WS_WSB), scr, r, F.lane); continue; } r -= I_SB;
        if (r < I_SB) { p0_transpose_item<false>(a.in[13], 512, D, D, (bf16*)(ws + WS_WGDN), scr, r, F.lane); continue; } r -= I_SB;
        if (r < I_O) { p0_transpose_item<false>(a.in[14], D, D, D, (bf16*)(ws + WS_WO), scr, r, F.lane); continue; } r -= I_O;
        p0_transpose_item<false>(a.in[16], D, PQW, PQW, (bf16*)(ws + WS_WQ), scr, r, F.lane);
    }
    { const float* sk = a.in[17]; bf16* o = (bf16*)(ws + WS_SKEY);
      for (int i = (blockIdx.x * 512 + F.tid) * 4; i < PH * 2 * PNK * PHALF; i += F.G * 512 * 4) { const f32x4 v = *(const f32x4*)(sk + i); v2u w; w.x = pk2(v.x, v.y); w.y = pk2(v.z, v.w); *(v2u*)(o + i) = w; } }
    { const float* c = a.in[1]; const float* wa = a.in[2]; const float* ba = a.in[3]; float* mod = (float*)(ws + WS_MOD);
      LAS float* red = (LAS float*)(F.lds + RING_OFF);
      for (int it = blockIdx.x; it < 6 * D / 64; it += F.G) {
          const int n = it * 64 + F.lane; float a0 = 0.f, a1 = 0.f;
          __syncthreads();
          for (int k = F.wave * 128; k < F.wave * 128 + 128; ++k) { const float w = wa[(size_t)k * (6 * D) + n]; a0 += siluf(c[k]) * w; a1 += siluf(c[D + k]) * w; }
          red[(F.wave * 2 + 0) * 64 + F.lane] = a0; red[(F.wave * 2 + 1) * 64 + F.lane] = a1;
          __syncthreads();
          if (F.wave < 2) { float s = 0.f;
#pragma unroll
              for (int w = 0; w < 8; ++w) s += red[(w * 2 + F.wave) * 64 + F.lane];
              mod[(size_t)F.wave * 6 * D + n] = s + ba[n]; }
      }
      __syncthreads(); }
}
__device__ __forceinline__ void norm_mod_rows(Frame& F, const float* x, const float* nw, const float* mod, int ch_shift, bf16* o) {
    const int gw = blockIdx.x * NWAVES + F.wave, NGW = F.G * NWAVES;
    for (int m = gw; m < M; m += NGW) {
        const GAS f32x4* xr = (const GAS f32x4*)(x + (size_t)m * D) + F.lane;
        f32x4 v[4]; float s = 0.f;
#pragma unroll
        for (int j = 0; j < 4; ++j) { v[j] = xr[64 * j]; s += (v[j].x * v[j].x + v[j].y * v[j].y) + (v[j].z * v[j].z + v[j].w * v[j].w); }
        const float rstd = 1.0f / sqrtf(wave_sum(s) * (1.f / D) + EPS);
        const float* sh = mod + (size_t)(m >> 13) * 6 * D + ch_shift * D; const float* sc = sh + D;
        GAS v2u* o8 = (GAS v2u*)(o + (size_t)m * D) + F.lane;
#pragma unroll
        for (int j = 0; j < 4; ++j) { const int c = 4 * F.lane + 256 * j; const f32x4 w = *(const f32x4*)(nw + c), a = *(const f32x4*)(sc + c), b = *(const f32x4*)(sh + c);
            const f32x4 y = v[j] * rstd * w * (a + 1.0f) + b; v2u p; p.x = pk2(y.x, y.y); p.y = pk2(y.z, y.w); o8[64 * j] = p; }
    }
}
constexpr float PEER_USCALE = 64.f, PEER_VSCALE = 8.f;
__device__ __forceinline__ void peer_tables_to_fp8(const Args& a, int blk, int nblk, int tid) {
    unsigned char* ws = a.ws;
    for (int which = 0; which < 2; ++which) { const float* src = a.in[18 + which]; v4u* dst = (v4u*)(ws + (which ? WS_VT8 : WS_UT8)); const float sc = which ? PEER_VSCALE : PEER_USCALE;
        for (int i = blk * 512 + tid; i < PNE * D / 16; i += nblk * 512) { const f32x4* p = (const f32x4*)src + (size_t)i * 4; const f32x4 a0 = p[0] * sc, a1 = p[1] * sc, a2 = p[2] * sc, a3 = p[3] * sc;
            int w0 = __builtin_amdgcn_cvt_pk_fp8_f32(a0.x, a0.y, 0, false); w0 = __builtin_amdgcn_cvt_pk_fp8_f32(a0.z, a0.w, w0, true);
            int w1 = __builtin_amdgcn_cvt_pk_fp8_f32(a1.x, a1.y, 0, false); w1 = __builtin_amdgcn_cvt_pk_fp8_f32(a1.z, a1.w, w1, true);
            int w2 = __builtin_amdgcn_cvt_pk_fp8_f32(a2.x, a2.y, 0, false); w2 = __builtin_amdgcn_cvt_pk_fp8_f32(a2.z, a2.w, w2, true);
            int w3 = __builtin_amdgcn_cvt_pk_fp8_f32(a3.x, a3.y, 0, false); w3 = __builtin_amdgcn_cvt_pk_fp8_f32(a3.z, a3.w, w3, true);
            dst[i] = (v4u){(unsigned)w0, (unsigned)w1, (unsigned)w2, (unsigned)w3}; } }
}
__device__ __forceinline__ float gelu_erf(float v) { return 0.5f * v * (1.0f + erff(v * 0.70710678118654752f)); }
__device__ __forceinline__ void fp8x16_to_f32(const v4u& w, f32x2 (&o)[8]) {
    o[0] = __builtin_amdgcn_cvt_pk_f32_fp8((int)w.x, false); o[1] = __builtin_amdgcn_cvt_pk_f32_fp8((int)w.x, true);
    o[2] = __builtin_amdgcn_cvt_pk_f32_fp8((int)w.y, false); o[3] = __builtin_amdgcn_cvt_pk_f32_fp8((int)w.y, true);
    o[4] = __builtin_amdgcn_cvt_pk_f32_fp8((int)w.z, false); o[5] = __builtin_amdgcn_cvt_pk_f32_fp8((int)w.z, true);
    o[6] = __builtin_amdgcn_cvt_pk_f32_fp8((int)w.w, false); o[7] = __builtin_amdgcn_cvt_pk_f32_fp8((int)w.w, true);
}
__device__ __forceinline__ void p10_peer(Frame& F, const Args& a) {
    unsigned char* ws = a.ws;
    const bf16* h2 = (const bf16*)(ws + WS_XN); const int* eidx = (const int*)(ws + WS_EIDX); const float* gate = (const float*)(ws + WS_GATE);
    const unsigned char* ut = ws + WS_UT8; const unsigned char* vt = ws + WS_VT8; const float* mod = (const float*)(ws + WS_MOD); float* out = a.out;
    LAS float* acts = (LAS float*)(F.lds + RING_OFF + F.wave * 1024); LAS float* coefs = acts + 128;
    const int gw = blockIdx.x * NWAVES + F.wave, NGW = F.G * NWAVES, lane = F.lane;
    for (int t = gw; t < M; t += NGW) {
        f32x2 h[8];
        { const v4u w0 = *(const v4u*)(h2 + (size_t)t * D + 16 * lane), w1 = *(const v4u*)(h2 + (size_t)t * D + 16 * lane + 8);
          h[0] = (f32x2){bflo(w0.x), bfhi(w0.x)}; h[1] = (f32x2){bflo(w0.y), bfhi(w0.y)}; h[2] = (f32x2){bflo(w0.z), bfhi(w0.z)}; h[3] = (f32x2){bflo(w0.w), bfhi(w0.w)};
          h[4] = (f32x2){bflo(w1.x), bfhi(w1.x)}; h[5] = (f32x2){bflo(w1.y), bfhi(w1.y)}; h[6] = (f32x2){bflo(w1.z), bfhi(w1.z)}; h[7] = (f32x2){bflo(w1.w), bfhi(w1.w)}; }
        const int* et = eidx + (size_t)t * 128;
        for (int i = 0; i < 16; ++i) {
            v4u rw[8];
#pragma unroll
            for (int k = 0; k < 8; ++k) rw[k] = *(const v4u*)(ut + (size_t)et[8 * i + k] * D + 16 * lane);
            float p[8];
#pragma unroll
            for (int k = 0; k < 8; ++k) { f32x2 u[8]; fp8x16_to_f32(rw[k], u); f32x2 s = u[0] * h[0];
#pragma unroll
                for (int j = 1; j < 8; ++j) s += u[j] * h[j];
                p[k] = s.x + s.y; }
            const bool hi32 = lane & 32, hi16 = lane & 16, hi8 = lane & 8;
            float q[4];
#pragma unroll
            for (int k = 0; k < 4; ++k) { const float mine = hi32 ? p[4 + k] : p[k], give = hi32 ? p[k] : p[4 + k]; q[k] = mine + __shfl_xor(give, 32); }
            float r2[2];
#pragma unroll
            for (int k = 0; k < 2; ++k) { const float mine = hi16 ? q[2 + k] : q[k], give = hi16 ? q[k] : q[2 + k]; r2[k] = mine + __shfl_xor(give, 16); }
            float s1; { const float mine = hi8 ? r2[1] : r2[0], give = hi8 ? r2[0] : r2[1]; s1 = mine + __shfl_xor(give, 8); }
            s1 += __shfl_xor(s1, 4); s1 += __shfl_xor(s1, 2); s1 += __shfl_xor(s1, 1);
            if ((lane & 7) == 0) acts[8 * i + ((lane >> 5) & 1) * 4 + ((lane >> 4) & 1) * 2 + ((lane >> 3) & 1)] = s1;
        }
        LDS_WAIT(); asm volatile("" ::: "memory");
        { const float a0 = acts[lane] * (1.0f / PEER_USCALE), a1 = acts[64 + lane] * (1.0f / PEER_USCALE);
          coefs[lane] = gate[(size_t)t * 128 + lane] * gelu_erf(a0) * (1.0f / PEER_VSCALE); coefs[64 + lane] = gate[(size_t)t * 128 + 64 + lane] * gelu_erf(a1) * (1.0f / PEER_VSCALE); }
        LDS_WAIT(); asm volatile("" ::: "memory");
        f32x2 acc[8];
#pragma unroll
        for (int j = 0; j < 8; ++j) acc[j] = (f32x2){0.f, 0.f};
        for (int i = 0; i < 16; ++i) {
            v4u rw[8];
#pragma unroll
            for (int k = 0; k < 8; ++k) rw[k] = *(const v4u*)(vt + (size_t)et[8 * i + k] * D + 16 * lane);
#pragma unroll
            for (int k = 0; k < 8; ++k) { f32x2 v[8]; fp8x16_to_f32(rw[k], v); const float cf = coefs[8 * i + k];
#pragma unroll
                for (int j = 0; j < 8; ++j) acc[j] += v[j] * cf; }
        }
        const float* g2 = mod + (size_t)(t >> 13) * 6 * D + 5 * D + 16 * lane; float* op = out + (size_t)t * D + 16 * lane;
#pragma unroll
        for (int j = 0; j < 4; ++j) { const f32x4 g = *(const f32x4*)(g2 + 4 * j); const f32x4 x1 = *(const f32x4*)(op + 4 * j);
            *(f32x4*)(op + 4 * j) = x1 + g * (f32x4){acc[2 * j].x, acc[2 * j].y, acc[2 * j + 1].x, acc[2 * j + 1].y}; }
        LDS_WAIT(); asm volatile("" ::: "memory");
    }
}

__device__ __forceinline__ void p4_attn_naive(Frame& F, const Args& a, int blk, int nblk) {
    unsigned char* ws = a.ws;
    const bf16* Q = (const bf16*)(ws + WS_Q); const bf16* K = (const bf16*)(ws + WS_K); const bf16* V = (const bf16*)(ws + WS_V);
    for (int gid = blk * 512 + F.tid; gid < BATCH * SBH * SEQ; gid += nblk * 512) {
        const int t = gid & (SEQ - 1), bh = gid >> 13, h = bh & 7, b = bh >> 3;
        const size_t row = (size_t)b * SEQ + t;
        float q[64], o[64];
#pragma unroll
        for (int i = 0; i < 8; ++i) { const v4u w = *(const v4u*)(Q + row * 512 + h * 64 + 8 * i);
            q[8 * i] = bflo(w.x); q[8 * i + 1] = bfhi(w.x); q[8 * i + 2] = bflo(w.y); q[8 * i + 3] = bfhi(w.y); q[8 * i + 4] = bflo(w.z); q[8 * i + 5] = bfhi(w.z); q[8 * i + 6] = bflo(w.w); q[8 * i + 7] = bfhi(w.w); }
#pragma unroll
        for (int i = 0; i < 64; ++i) o[i] = 0.f;
        float R = 0.f;
        for (int s = t - 1; s >= 0; --s) {
            const size_t kr = ((size_t)b * SEQ + s) * 512 + h * 64; float z = 0.f;
#pragma unroll
            for (int i = 0; i < 8; ++i) { const v4u w = *(const v4u*)(K + kr + 8 * i);
                z += q[8 * i] * bflo(w.x) + q[8 * i + 1] * bfhi(w.x) + q[8 * i + 2] * bflo(w.y) + q[8 * i + 3] * bfhi(w.y) + q[8 * i + 4] * bflo(w.z) + q[8 * i + 5] * bfhi(w.z) + q[8 * i + 6] * bflo(w.w) + q[8 * i + 7] * bfhi(w.w); }
            const float sp = softplusf(z); const float p = __expf(z - sp - R); R += sp;
#pragma unroll
            for (int i = 0; i < 8; ++i) { const v4u w = *(const v4u*)(V + kr + 8 * i);
                o[8 * i] += p * bflo(w.x); o[8 * i + 1] += p * bfhi(w.x); o[8 * i + 2] += p * bflo(w.y); o[8 * i + 3] += p * bfhi(w.y); o[8 * i + 4] += p * bflo(w.z); o[8 * i + 5] += p * bfhi(w.z); o[8 * i + 6] += p * bflo(w.w); o[8 * i + 7] += p * bfhi(w.w); }
            if (R > 105.f) break;
        }
        bf16* y = (bf16*)(ws + WS_YSB) + row * 512 + h * 64;
#pragma unroll
        for (int i = 0; i < 8; ++i) { v4u w; w.x = pk2(o[8 * i], o[8 * i + 1]); w.y = pk2(o[8 * i + 2], o[8 * i + 3]); w.z = pk2(o[8 * i + 4], o[8 * i + 5]); w.w = pk2(o[8 * i + 6], o[8 * i + 7]); *(v4u*)(y + 8 * i) = w; }
    }
}
__device__ __forceinline__ void p9_topk_naive(Frame& F, const Args& a) {
    unsigned char* ws = a.ws; const int tid = F.tid;
    const bf16* QP = (const bf16*)(ws + WS_QP); const bf16* SK = (const bf16*)(ws + WS_SKEY);
    LAS float* sv = (LAS float*)(F.lds + RING_OFF);
    LAS int* si = (LAS int*)(sv + 2 * 16 * 256);
    LAS int* ptr = si + 2 * 16 * 256;
    LAS unsigned short* keys = (LAS unsigned short*)(ptr + 16 * 256);
    const bool act = tid < 256;
    for (int it = blockIdx.x; it < (M / 256) * PH; it += F.G) {
        const int h = it & 7, t = (it >> 3) * 256 + (tid & 255);
        for (int p = 0; p < 2; ++p) {
            __syncthreads();
            for (int i = tid; i < 128 * 128 / 8; i += 512) ((LAS v4u*)keys)[i] = ((const v4u*)(SK + (size_t)(h * 2 + p) * 128 * 128))[i];
            __syncthreads();
            if (act) {
                unsigned qreg[64];
#pragma unroll
                for (int i = 0; i < 16; ++i) { const v4u w = *(const v4u*)(QP + (size_t)t * PQW + h * 256 + p * 128 + 8 * i); qreg[4 * i] = w.x; qreg[4 * i + 1] = w.y; qreg[4 * i + 2] = w.z; qreg[4 * i + 3] = w.w; }
                int cnt = 0;
                for (int key = 0; key < 128; ++key) {
                    float s = 0.f;
#pragma unroll
                    for (int i = 0; i < 16; ++i) { const v4u w = *(const LAS v4u*)(keys + key * 128 + 8 * i);
                        s += bflo(qreg[4 * i]) * bflo(w.x) + bfhi(qreg[4 * i]) * bfhi(w.x) + bflo(qreg[4 * i + 1]) * bflo(w.y) + bfhi(qreg[4 * i + 1]) * bfhi(w.y)
                           + bflo(qreg[4 * i + 2]) * bflo(w.z) + bfhi(qreg[4 * i + 2]) * bfhi(w.z) + bflo(qreg[4 * i + 3]) * bflo(w.w) + bfhi(qreg[4 * i + 3]) * bfhi(w.w); }
                    int pos = cnt < 16 ? cnt : 16;
                    while (pos > 0 && s > sv[(p * 16 + pos - 1) * 256 + tid]) { if (pos < 16) { sv[(p * 16 + pos) * 256 + tid] = sv[(p * 16 + pos - 1) * 256 + tid]; si[(p * 16 + pos) * 256 + tid] = si[(p * 16 + pos - 1) * 256 + tid]; } --pos; }
                    if (pos < 16) { sv[(p * 16 + pos) * 256 + tid] = s; si[(p * 16 + pos) * 256 + tid] = key; }
                    if (cnt < 16) ++cnt;
                }
            }
        }
        if (act) {
            for (int i = 0; i < 16; ++i) ptr[i * 256 + tid] = 0;
            float top[16]; int eid[16];
#pragma unroll
            for (int rnk = 0; rnk < 16; ++rnk) {
                float best = -INFINITY; int bi = 0;
                for (int i = 0; i < 16; ++i) { const int jj = ptr[i * 256 + tid]; if (jj < 16) { const float c = sv[i * 256 + tid] + sv[(16 + jj) * 256 + tid]; if (c > best) { best = c; bi = i; } } }
                const int bj = ptr[bi * 256 + tid]; ptr[bi * 256 + tid] = bj + 1;
                top[rnk] = best; eid[rnk] = si[bi * 256 + tid] * 128 + si[(16 + bj) * 256 + tid];
            }
            float mx = top[0], den = 0.f;
#pragma unroll
            for (int rnk = 0; rnk < 16; ++rnk) { top[rnk] = __expf(top[rnk] - mx); den += top[rnk]; }
            int* eo = (int*)(ws + WS_EIDX) + (size_t)t * 128 + h * 16; float* go = (float*)(ws + WS_GATE) + (size_t)t * 128 + h * 16;
#pragma unroll
            for (int rnk = 0; rnk < 16; ++rnk) { eo[rnk] = eid[rnk]; go[rnk] = top[rnk] / den; }
        }
    }
    __syncthreads();
}

constexpr int CH_BYTES = 40960, CH_W = 0, CH_QD = 8192, CH_QK = 16384, CH_KDT = 24576, CH_U = 32768;
constexpr int PST = 68;
typedef __attribute__((address_space(3))) float lf32;

__device__ __forceinline__ void store_afrag(const lf32* src, const lf32* rowscale, unsigned char* dst, int tid) {
    const int blk = tid >> 6, lane = tid & 63, mt = blk >> 1, ks = blk & 1, r = lane & 15, g = lane >> 4, row = 16 * mt + r, k0 = 32 * ks + 4 * g;
    f32x4 v0 = *(const LAS f32x4*)(src + row * PST + k0), v1 = *(const LAS f32x4*)(src + row * PST + k0 + 16);
    const float rs = rowscale ? rowscale[row] : 1.0f; v0 = v0 * rs; v1 = v1 * rs;
    v4u o; o.x = pk2(v0.x, v0.y); o.y = pk2(v0.z, v0.w); o.z = pk2(v1.x, v1.y); o.w = pk2(v1.z, v1.w);
    *(v4u*)(dst + tid * 16) = o;
}
__device__ __forceinline__ void store_afrag_T(const lf32* src, const lf32* kscale, unsigned char* dst, int tid) {
    const int blk = tid >> 6, lane = tid & 63, mt = blk >> 1, ks = blk & 1, r = lane & 15, g = lane >> 4, row = 16 * mt + r, k0 = 32 * ks + 4 * g;
    float v[8];
#pragma unroll
    for (int i = 0; i < 4; ++i) { v[i] = src[(k0 + i) * PST + row] * kscale[k0 + i]; v[4 + i] = src[(k0 + 16 + i) * PST + row] * kscale[k0 + 16 + i]; }
    v4u o; o.x = pk2(v[0], v[1]); o.y = pk2(v[2], v[3]); o.z = pk2(v[4], v[5]); o.w = pk2(v[6], v[7]);
    *(v4u*)(dst + tid * 16) = o;
}
__device__ __forceinline__ void store_cfrag(const lf32* src, unsigned char* dst, int tid) {
#pragma unroll
    for (int rep = 0; rep < 2; ++rep) { const int q = tid + 512 * rep, sm = q >> 6, lane = q & 63, sl = sm >> 2, mt = sm & 3, col = lane & 15, g = lane >> 4;
        const lf32* p = src + (16 * mt + 4 * g) * PST + 16 * sl + col;
        v2u o; o.x = pk2(p[0], p[PST]); o.y = pk2(p[2 * PST], p[3 * PST]); *(v2u*)(dst + q * 8) = o; }
}

__device__ __forceinline__ void p3_gdn_prep(Frame& F, const Args& a) {
    unsigned char* ws = a.ws; const int tid = F.tid;
    const bf16* graw = (const bf16*)(ws + WS_GRAW); const float* ab = (const float*)(ws + WS_AB); const float* cw = a.in[8];
    lf32* Qs = (lf32*)(F.lds + RING_OFF); lf32* Ks = Qs + 64 * PST; lf32* Vs = Ks + 64 * PST; lf32* As = Vs + 64 * PST; lf32* QKs = As + 64 * PST; lf32* Us = QKs + 64 * PST; lf32* Ws = Us + 64 * PST;
    lf32* vG = Ws + 64 * PST; lf32* vbeta = vG + 64; lf32* veG = vbeta + 64; lf32* veGl = veG + 64; lf32* vqn = veGl + 64; lf32* vkn = vqn + 64; lf32* vbw = vkn + 64;
    for (int it = blockIdx.x; it < BATCH * GH * (SEQ / 64); it += F.G) {
        const int n = it & 127, bh = it >> 7, h = bh & 7, b = bh >> 3; const size_t row0 = (size_t)b * SEQ + n * 64; const int tl0 = n * 64;
        __syncthreads();
        { const int c = tid & 63, tg = tid >> 6;
#pragma unroll
          for (int part = 0; part < 3; ++part) { const int ch = part * 512 + h * 64 + c; const bf16* src = graw + ch; lf32* dst = part == 0 ? Qs : part == 1 ? Ks : Vs;
              const float w0 = cw[ch], w1 = cw[1536 + ch], w2 = cw[2 * 1536 + ch], w3 = cw[3 * 1536 + ch];
              float xv[11];
#pragma unroll
              for (int i = 0; i < 11; ++i) { const int tt = tl0 + 8 * tg - 3 + i; xv[i] = tt >= 0 ? bf2f(src[(row0 + 8 * tg - 3 + i) * 1536]) : 0.f; }
#pragma unroll
              for (int i = 0; i < 8; ++i) dst[(8 * tg + i) * PST + c] = siluf(w0 * xv[i] + w1 * xv[i + 1] + w2 * xv[i + 2] + w3 * xv[i + 3]); } }
        __syncthreads();
        if (tid < 128) { const int row = tid & 63; const lf32* src = (tid < 64 ? Qs : Ks) + row * PST; float ss = 0.f;
#pragma unroll
            for (int i = 0; i < 16; ++i) { const f32x4 v = *(const LAS f32x4*)(src + 4 * i); ss += (v.x * v.x + v.y * v.y) + (v.z * v.z + v.w * v.w); }
            const float inv = 1.0f / sqrtf(ss + EPS); if (tid < 64) vqn[row] = inv * 0.125f; else vkn[row] = inv; }
        else if (tid < 192) { const int t = tid & 63; const float av = ab[(row0 + t) * 16 + h], bv = ab[(row0 + t) * 16 + 8 + h];
            const float g = -__expf(a.in[9][h]) * softplusf(av + a.in[10][h]); float G = g;
#pragma unroll
            for (int o = 1; o < 64; o <<= 1) { const float up = __shfl_up(G, o); if (t >= o) G += up; }
            const float Gl = __shfl(G, 63);
            vG[t] = G; { const float be = sigm(bv); vbeta[t] = be; vbw[t] = be * __expf(G); } veG[t] = __expf(G); veGl[t] = __expf(Gl - G);
            if (t == 63) ((float*)(ws + WS_CD))[it] = __expf(Gl); }
        __syncthreads();
        { const int c = tid & 63, tg = tid >> 6;
#pragma unroll
          for (int i = 0; i < 8; ++i) { const int t = 8 * tg + i; Qs[t * PST + c] *= vqn[t]; Ks[t * PST + c] *= vkn[t]; } }
        __syncthreads();
        { const int c = tid >> 3, sg = tid & 7; float kk[8], qk[8];
#pragma unroll
          for (int j = 0; j < 8; ++j) { kk[j] = 0.f; qk[j] = 0.f; }
#pragma unroll 4
          for (int i = 0; i < 16; ++i) { const f32x4 kc = *(const LAS f32x4*)(Ks + c * PST + 4 * i), qc = *(const LAS f32x4*)(Qs + c * PST + 4 * i);
#pragma unroll
              for (int j = 0; j < 8; ++j) { const f32x4 kv = *(const LAS f32x4*)(Ks + (sg + 8 * j) * PST + 4 * i);
                  kk[j] += (kc.x * kv.x + kc.y * kv.y) + (kc.z * kv.z + kc.w * kv.w); qk[j] += (qc.x * kv.x + qc.y * kv.y) + (qc.z * kv.z + qc.w * kv.w); } }
          const float Gc = vG[c], bc = vbeta[c];
#pragma unroll
          for (int j = 0; j < 8; ++j) { const int s = sg + 8 * j; const float dec = __expf(fminf(Gc - vG[s], 0.f));
              As[c * PST + s] = (c > s) ? bc * kk[j] * dec : 0.f; QKs[c * PST + s] = (c >= s) ? qk[j] * dec : 0.f; } }
        __syncthreads();
        if (tid < 128) { const int j = tid & 63; const bool isw = tid >= 64; const lf32* src = isw ? Ks : Vs; const lf32* sc = isw ? vbw : vbeta; float x[64];
#pragma unroll
            for (int i = 0; i < 64; ++i) { float acc = src[i * PST + j] * sc[i];
#pragma unroll
                for (int jj = 0; jj < (i & ~3); jj += 4) { const f32x4 av = *(const LAS f32x4*)(As + i * PST + jj); acc -= av.x * x[jj]; acc -= av.y * x[jj + 1]; acc -= av.z * x[jj + 2]; acc -= av.w * x[jj + 3]; }
                if (i & 3) { const f32x4 av = *(const LAS f32x4*)(As + i * PST + (i & ~3)); acc -= av.x * x[(i & ~3)]; if ((i & 3) > 1) acc -= av.y * x[(i & ~3) + 1]; if ((i & 3) > 2) acc -= av.z * x[(i & ~3) + 2]; }
                x[i] = acc; asm volatile("" ::: "memory"); }
            lf32* dst = isw ? Ws : Us;
#pragma unroll
            for (int i = 0; i < 64; ++i) dst[i * PST + j] = x[i]; }
        __syncthreads();
        { unsigned char* ch = ws + WS_CH + (size_t)it * CH_BYTES;
          store_afrag(Ws, nullptr, ch + CH_W, tid); store_afrag(Qs, veG, ch + CH_QD, tid); store_afrag(QKs, nullptr, ch + CH_QK, tid); store_afrag_T(Ks, veGl, ch + CH_KDT, tid); store_cfrag(Us, ch + CH_U, tid); }
    }
    __syncthreads();
}

__device__ __forceinline__ void p3_qknorm(Frame& F, const Args& a) {
    unsigned char* ws = a.ws; const int lane = F.lane;
    const int gw = blockIdx.x * NWAVES + F.wave, NGW = F.G * NWAVES;
    const float* qnw = a.in[6]; const float* knw = a.in[7];
    for (int t = gw; t < M; t += NGW) {
#pragma unroll
        for (int which = 0; which < 2; ++which) {
            bf16* p = (bf16*)(ws + (which ? WS_K : WS_Q)) + (size_t)t * 512 + 8 * lane; const float* nw = which ? knw : qnw;
            const v4u w = *(const v4u*)p; float v[8] = {bflo(w.x), bfhi(w.x), bflo(w.y), bfhi(w.y), bflo(w.z), bfhi(w.z), bflo(w.w), bfhi(w.w)};
            float s = 0.f;
#pragma unroll
            for (int i = 0; i < 8; ++i) s += v[i] * v[i];
            s += __shfl_xor(s, 1); s += __shfl_xor(s, 2); s += __shfl_xor(s, 4);
            const float r = 1.0f / sqrtf(s * (1.f / 64.f) + EPS) * (which ? 1.0f : 0.125f);
            const int d0 = (8 * lane) & 63;
#pragma unroll
            for (int i = 0; i < 8; ++i) v[i] = v[i] * r * nw[d0 + i];
            v4u o; o.x = pk2(v[0], v[1]); o.y = pk2(v[2], v[3]); o.z = pk2(v[4], v[5]); o.w = pk2(v[6], v[7]); *(v4u*)p = o;
        }
    }
}

__device__ __forceinline__ bf16x8 pack8(const f32x4& x, const f32x4& y) { v4u w; w.x = pg8::cvt_pk_bf16(x.x, x.y); w.y = pg8::cvt_pk_bf16(x.z, x.w); w.z = pg8::cvt_pk_bf16(y.x, y.y); w.w = pg8::cvt_pk_bf16(y.z, y.w); return __builtin_bit_cast(bf16x8, w); }
constexpr int OST = 68;
constexpr int SC_OP = 0, SC_OB = 2 * CH_BYTES;
__device__ __forceinline__ void scan_load(v4u (&set)[10], const unsigned char* ch, int ht) {
#pragma unroll
    for (int r = 0; r < 10; ++r) set[r] = *(const v4u*)(ch + (r * 256 + ht) * 16);
}
__device__ __forceinline__ void scan_put(const v4u (&set)[10], LAS unsigned char* dst, int ht) {
#pragma unroll
    for (int r = 0; r < 10; ++r) *(LAS v4u*)(dst + (r * 256 + ht) * 16) = set[r];
}
__device__ __forceinline__ void scan_post(const lf32* ob, const bf16* Z, bf16* Y, const float* onw, size_t row0, int h, int ht) {
    const int row = ht >> 2, q4 = ht & 3; const lf32* p = ob + row * OST + 16 * q4; f32x4 o[4]; float ss = 0.f;
#pragma unroll
    for (int i = 0; i < 4; ++i) { o[i] = *(const LAS f32x4*)(p + 4 * i); ss += (o[i].x * o[i].x + o[i].y * o[i].y) + (o[i].z * o[i].z + o[i].w * o[i].w); }
    ss += __shfl_xor(ss, 1); ss += __shfl_xor(ss, 2);
    const float rstd = 1.0f / sqrtf(ss * (1.f / 64.f) + EPS);
    const size_t off = (row0 + row) * 512 + h * 64 + 16 * q4;
    const v4u z0 = *(const v4u*)(Z + off), z1 = *(const v4u*)(Z + off + 8);
    const float zz[16] = {bflo(z0.x), bfhi(z0.x), bflo(z0.y), bfhi(z0.y), bflo(z0.z), bfhi(z0.z), bflo(z0.w), bfhi(z0.w), bflo(z1.x), bfhi(z1.x), bflo(z1.y), bfhi(z1.y), bflo(z1.z), bfhi(z1.z), bflo(z1.w), bfhi(z1.w)};
    float y[16];
#pragma unroll
    for (int i = 0; i < 4; ++i) { const f32x4 w = *(const f32x4*)(onw + 16 * q4 + 4 * i);
        y[4 * i] = o[i].x * rstd * w.x * siluf(zz[4 * i]); y[4 * i + 1] = o[i].y * rstd * w.y * siluf(zz[4 * i + 1]); y[4 * i + 2] = o[i].z * rstd * w.z * siluf(zz[4 * i + 2]); y[4 * i + 3] = o[i].w * rstd * w.w * siluf(zz[4 * i + 3]); }
    v4u w0, w1; w0.x = pk2(y[0], y[1]); w0.y = pk2(y[2], y[3]); w0.z = pk2(y[4], y[5]); w0.w = pk2(y[6], y[7]); w1.x = pk2(y[8], y[9]); w1.y = pk2(y[10], y[11]); w1.z = pk2(y[12], y[13]); w1.w = pk2(y[14], y[15]);
    *(v4u*)(Y + off) = w0; *(v4u*)(Y + off + 8) = w1;
}
__device__ __forceinline__ void scan_step(LAS unsigned char* lds, f32x4 (&S)[4], float cdv, int n, int sl, int lane) {
    const LAS unsigned char* ob = lds + SC_OP + (n & 1) * CH_BYTES; lf32* ot = (lf32*)(lds + SC_OB) + (n & 1) * 64 * OST;
    const f32x4 zero = {0.f, 0.f, 0.f, 0.f};
    const bf16x8 Sb0 = pack8(S[0], S[1]), Sb1 = pack8(S[2], S[3]);
    f32x4 vn[4], o[4];
#pragma unroll
    for (int mt = 0; mt < 4; ++mt) { const bf16x8 a0 = *(const LAS bf16x8*)(ob + CH_W + (mt * 2) * 1024 + lane * 16), a1 = *(const LAS bf16x8*)(ob + CH_W + (mt * 2 + 1) * 1024 + lane * 16);
        f32x4 acc = __builtin_amdgcn_mfma_f32_16x16x32_bf16(a0, Sb0, zero, 0, 0, 0); acc = __builtin_amdgcn_mfma_f32_16x16x32_bf16(a1, Sb1, acc, 0, 0, 0);
        const v2u uu = *(const LAS v2u*)(ob + CH_U + ((sl * 4 + mt) * 64 + lane) * 8);
        vn[mt] = (f32x4){bflo(uu.x), bfhi(uu.x), bflo(uu.y), bfhi(uu.y)} - acc; }
    const bf16x8 Vb0 = pack8(vn[0], vn[1]), Vb1 = pack8(vn[2], vn[3]);
#pragma unroll
    for (int mt = 0; mt < 4; ++mt) { const bf16x8 q0 = *(const LAS bf16x8*)(ob + CH_QD + (mt * 2) * 1024 + lane * 16), q1 = *(const LAS bf16x8*)(ob + CH_QD + (mt * 2 + 1) * 1024 + lane * 16);
        const bf16x8 k0 = *(const LAS bf16x8*)(ob + CH_QK + (mt * 2) * 1024 + lane * 16), k1 = *(const LAS bf16x8*)(ob + CH_QK + (mt * 2 + 1) * 1024 + lane * 16);
        f32x4 acc = __builtin_amdgcn_mfma_f32_16x16x32_bf16(q0, Sb0, zero, 0, 0, 0); acc = __builtin_amdgcn_mfma_f32_16x16x32_bf16(q1, Sb1, acc, 0, 0, 0);
        acc = __builtin_amdgcn_mfma_f32_16x16x32_bf16(k0, Vb0, acc, 0, 0, 0); acc = __builtin_amdgcn_mfma_f32_16x16x32_bf16(k1, Vb1, acc, 0, 0, 0); o[mt] = acc; }
#pragma unroll
    for (int mt = 0; mt < 4; ++mt) { const bf16x8 t0 = *(const LAS bf16x8*)(ob + CH_KDT + (mt * 2) * 1024 + lane * 16), t1 = *(const LAS bf16x8*)(ob + CH_KDT + (mt * 2 + 1) * 1024 + lane * 16);
        f32x4 acc = S[mt] * cdv; acc = __builtin_amdgcn_mfma_f32_16x16x32_bf16(t0, Vb0, acc, 0, 0, 0); acc = __builtin_amdgcn_mfma_f32_16x16x32_bf16(t1, Vb1, acc, 0, 0, 0); S[mt] = acc; }
    const int col = lane & 15, g = lane >> 4;
#pragma unroll
    for (int mt = 0; mt < 4; ++mt) { lf32* p = ot + (16 * mt + 4 * g) * OST + 16 * sl + col; p[0] = o[mt].x; p[OST] = o[mt].y; p[2 * OST] = o[mt].z; p[3 * OST] = o[mt].w; }
}
__device__ __forceinline__ void p4_gdn_scan(Frame& F, const Args& a, int bh) {
    unsigned char* ws = a.ws; const int h = bh & 7, b = bh >> 3, wave = F.wave, lane = F.lane, ht = F.tid - 256;
    const unsigned char* chb = ws + WS_CH + (size_t)bh * 128 * CH_BYTES; const float* cd = (const float*)(ws + WS_CD) + bh * 128;
    const bf16* Z = (const bf16*)(ws + WS_Z); bf16* Y = (bf16*)(ws + WS_YGDN); const float* onw = a.in[11];
    LAS unsigned char* lds = F.lds + RING_OFF; const size_t rowb = (size_t)b * SEQ;
    f32x4 S[4] = {(f32x4){0.f, 0.f, 0.f, 0.f}, (f32x4){0.f, 0.f, 0.f, 0.f}, (f32x4){0.f, 0.f, 0.f, 0.f}, (f32x4){0.f, 0.f, 0.f, 0.f}};
    v4u setA[10], setB[10];
    __syncthreads();
    if (wave >= 4) { scan_load(setA, chb, ht); scan_put(setA, lds + SC_OP, ht); scan_load(setA, chb + CH_BYTES, ht); scan_load(setB, chb + 2 * CH_BYTES, ht); }
    __syncthreads();
    for (int n = 0; n < 128; n += 2) {
        if (wave < 4) scan_step(lds, S, cd[n], n, wave, lane);
        else { scan_put(setA, lds + SC_OP + CH_BYTES, ht); if (n + 3 < 128) scan_load(setA, chb + (size_t)(n + 3) * CH_BYTES, ht);
               if (n >= 1) scan_post((const lf32*)(lds + SC_OB) + 64 * OST, Z, Y, onw, rowb + (size_t)(n - 1) * 64, h, ht); }
        __syncthreads();
        if (wave < 4) scan_step(lds, S, cd[n + 1], n + 1, wave, lane);
        else { if (n + 2 < 128) scan_put(setB, lds + SC_OP, ht); if (n + 4 < 128) scan_load(setB, chb + (size_t)(n + 4) * CH_BYTES, ht);
               scan_post((const lf32*)(lds + SC_OB), Z, Y, onw, rowb + (size_t)n * 64, h, ht); }
        __syncthreads();
    }
    if (wave >= 4) scan_post((const lf32*)(lds + SC_OB) + 64 * OST, Z, Y, onw, rowb + (size_t)127 * 64, h, ht);
    __syncthreads();
}

typedef float f32x16 __attribute__((ext_vector_type(16)));
constexpr int TK_KROW = 272;
constexpr int TK_KEYS = 0, TK_LIST = 2 * 128 * TK_KROW;
__device__ __forceinline__ unsigned f2ord(float f) { const unsigned u = __float_as_uint(f); return u ^ ((unsigned)((int)u >> 31) | 0x80000000u); }
__device__ __forceinline__ float ord2f(unsigned o) { const unsigned u = (o & 0x80000000u) ? (o ^ 0x80000000u) : ~o; return __uint_as_float(u); }
#define TK_CE(a, b) do { const unsigned _h = max(a, b), _l = min(a, b); a = _h; b = _l; } while (0)
__device__ __forceinline__ void sort16(unsigned (&v)[16]) {
#pragma unroll
    for (int k = 2; k <= 16; k <<= 1)
#pragma unroll
        for (int j = k >> 1; j > 0; j >>= 1)
#pragma unroll
            for (int i = 0; i < 16; ++i) { const int l = i ^ j; if (l > i) { if ((i & k) == 0) TK_CE(v[i], v[l]); else TK_CE(v[l], v[i]); } }
}
__device__ __forceinline__ void merge16(unsigned (&a)[16], const unsigned (&b)[16]) {
#pragma unroll
    for (int i = 0; i < 16; ++i) a[i] = max(a[i], b[15 - i]);
#pragma unroll
    for (int j = 8; j > 0; j >>= 1)
#pragma unroll
        for (int i = 0; i < 16; ++i) { const int l = i ^ j; if (l > i) TK_CE(a[i], a[l]); }
}
__device__ __forceinline__ void p9_topk(Frame& F, const Args& a) {
    unsigned char* ws = a.ws; const int tid = F.tid, lane = F.lane, wave = F.wave, tk = lane & 31, half = lane >> 5;
    const bf16* QP = (const bf16*)(ws + WS_QP); const bf16* SK = (const bf16*)(ws + WS_SKEY);
    LAS unsigned char* kl = F.lds + RING_OFF + TK_KEYS; LAS unsigned* lst = (LAS unsigned*)(F.lds + RING_OFF + TK_LIST) + wave * 1024;
    for (int it = blockIdx.x; it < (M / 256) * PH; it += F.G) {
        const int h = it & 7, t = (it >> 3) * 256 + wave * 32 + tk;
        __syncthreads();
        for (int i = tid; i < 2 * 128 * 16; i += 512) { const int row = i >> 4, c = i & 15; *(LAS v4u*)(kl + row * TK_KROW + c * 16) = *(const v4u*)(SK + (size_t)h * 2 * 128 * 128 + row * 128 + c * 8); }
        __syncthreads();
        unsigned top[2][16];
#pragma unroll
        for (int p = 0; p < 2; ++p) {
            bf16x8 qf[8];
#pragma unroll
            for (int ks = 0; ks < 8; ++ks) qf[ks] = *(const bf16x8*)(QP + (size_t)t * PQW + h * 256 + p * 128 + 16 * ks + 8 * half);
            unsigned best[16];
#pragma unroll
            for (int mt = 0; mt < 4; ++mt) {
                f32x16 acc = {0.f, 0.f, 0.f, 0.f, 0.f, 0.f, 0.f, 0.f, 0.f, 0.f, 0.f, 0.f, 0.f, 0.f, 0.f, 0.f};
#pragma unroll
                for (int ks = 0; ks < 8; ++ks) { const bf16x8 kf = *(const LAS bf16x8*)(kl + (p * 128 + mt * 32 + tk) * TK_KROW + ks * 32 + half * 16);
                    acc = __builtin_amdgcn_mfma_f32_32x32x16_bf16(kf, qf[ks], acc, 0, 0, 0); }
                unsigned g[16];
#pragma unroll
                for (int r = 0; r < 16; ++r) { const int key = 32 * mt + (r & 3) + 8 * (r >> 2) + 4 * half; g[r] = (f2ord(acc[r]) & ~127u) | (unsigned)(127 - key); }
                sort16(g);
                if (mt == 0) {
#pragma unroll
                    for (int r = 0; r < 16; ++r) best[r] = g[r]; }
                else merge16(best, g);
            }
            unsigned oth[16];
#pragma unroll
            for (int r = 0; r < 16; ++r) oth[r] = __shfl_xor(best[r], 32);
            merge16(best, oth);
#pragma unroll
            for (int r = 0; r < 16; ++r) top[p][r] = best[r];
        }
        if (half == 0) {
#pragma unroll
            for (int r = 0; r < 16; ++r) { lst[tk * 32 + r] = top[0][r]; lst[tk * 32 + 16 + r] = top[1][r]; } }
        float v1[16], v2[16];
#pragma unroll
        for (int r = 0; r < 16; ++r) { v1[r] = ord2f(top[0][r] & ~127u); v2[r] = ord2f(top[1][r] & ~127u); }
        unsigned c0[16], c1[16], c2[16], c3[16];
#pragma unroll
        for (int j = 0; j < 16; ++j) c0[j] = (f2ord(v1[0] + v2[j]) & ~255u) | (unsigned)(255 - j);
        { int n = 0;
#pragma unroll
          for (int i = 1; i < 16; ++i)
#pragma unroll
              for (int j = 0; j < 16; ++j) if ((i + 1) * (j + 1) <= 16) { const unsigned pk = (f2ord(v1[i] + v2[j]) & ~255u) | (unsigned)(255 - (i * 16 + j));
                  if (n < 16) c1[n] = pk; else if (n < 32) c2[n - 16] = pk; else c3[n - 32] = pk; ++n; }
#pragma unroll
          for (int r = 2; r < 16; ++r) c3[r] = 0u; }
        sort16(c1); sort16(c2); sort16(c3); merge16(c0, c1); merge16(c2, c3); merge16(c0, c2);
        LDS_WAIT(); asm volatile("" ::: "memory");
        float sm[16]; int eid[16];
#pragma unroll
        for (int r = 0; r < 16; ++r) { const int cid = 255 - (int)(c0[r] & 255u), i = cid >> 4, j = cid & 15;
            const unsigned p1 = lst[tk * 32 + i], p2 = lst[tk * 32 + 16 + j];
            sm[r] = ord2f(p1 & ~127u) + ord2f(p2 & ~127u); eid[r] = (127 - (int)(p1 & 127u)) * 128 + (127 - (int)(p2 & 127u)); }
        float den = 0.f; const float mx = sm[0];
#pragma unroll
        for (int r = 0; r < 16; ++r) { sm[r] = __expf(sm[r] - mx); den += sm[r]; }
        const float inv = 1.0f / den;
        if (half == 0) { int* eo = (int*)(ws + WS_EIDX) + (size_t)t * 128 + h * 16;
#pragma unroll
            for (int r = 0; r < 16; r += 4) *(v4u*)(eo + r) = (v4u){(unsigned)eid[r], (unsigned)eid[r + 1], (unsigned)eid[r + 2], (unsigned)eid[r + 3]}; }
        else { float* go = (float*)(ws + WS_GATE) + (size_t)t * 128 + h * 16;
#pragma unroll
            for (int r = 0; r < 16; r += 4) *(f32x4*)(go + r) = (f32x4){sm[r] * inv, sm[r + 1] * inv, sm[r + 2] * inv, sm[r + 3] * inv}; }
    }
    __syncthreads();
}
__global__ void __launch_bounds__(NWAVES * 64, 2) mk_fwd(Args args) {
    extern __shared__ __attribute__((aligned(16))) unsigned char lds[];
    Frame F;
    F.lds = (LAS unsigned char*)lds;
    F.MISC = (volatile LAS unsigned*)(F.lds + MISC_OFF);
    F.tid = threadIdx.x; F.lane = F.tid & 63; F.wave = __builtin_amdgcn_readfirstlane(F.tid >> 6);
    F.G = gridDim.x;
    unsigned char* ws = args.ws;
    F.ctl = (gu32*)(ws + WS_CTL);
    for (int u = F.tid; u < (LDS_BYTES - LDSCTL_OFF) / 4; u += NWAVES * 64) ((LAS unsigned*)(F.lds + LDSCTL_OFF))[u] = 0u;
    __syncthreads();
    const bool multi = (args.ph_hi - args.ph_lo) > 1;
    XcdBarrier bar; bar.bar = (unsigned*)(F.ctl + CW_BAR); bar.x = 0; bar.st = nullptr;
    if (multi) bar = xcd_barrier_post((unsigned*)(F.ctl + CW_BAR), F.MISC + 8);
    const int lo = args.ph_lo, hi = args.ph_hi;
#define IN(k) (lo <= (k) && (k) < hi)
#define SEAM(k) do { if (IN(k) && (k) + 1 < hi) xcd_barrier(bar); } while (0)
    const float* mod = (const float*)(ws + WS_MOD);

    if (IN(0)) { p0_prologue(F, args); } SEAM(0);
    if (IN(1)) { norm_mod_rows(F, args.in[0], args.in[4], mod, 0, (bf16*)(ws + WS_XN)); } SEAM(1);
    if (IN(2)) {
        pg8::Gemm g{(const bf16*)(ws + WS_XN), (const bf16*)(ws + WS_WIN), M, INWP, D}; pg8::StaticOrder S; S.init(M, INWP, F.G, (int)blockIdx.x);
        pg8::EpiInProj E{(bf16*)(ws + WS_Q), (bf16*)(ws + WS_K), (bf16*)(ws + WS_V), (bf16*)(ws + WS_GRAW), (bf16*)(ws + WS_Z), (bf16*)args.out, (float*)(ws + WS_AB)};
        pg8::gemm_phase<pg8::EpiInProj, pg8::StaticOrder, true, true>(F.lds + RING_OFF, g, S, E);
    } SEAM(2);
    if (IN(3)) { p3_gdn_prep(F, args); p3_qknorm(F, args); } SEAM(3);
    if (IN(4)) { if (blockIdx.x < BATCH * GH) p4_gdn_scan(F, args, (int)blockIdx.x); else { p4_attn_naive(F, args, (int)blockIdx.x - BATCH * GH, F.G - BATCH * GH); peer_tables_to_fp8(args, (int)blockIdx.x - BATCH * GH, F.G - BATCH * GH, F.tid); } } SEAM(4);
    if (IN(5)) {
        { pg8::Gemm g{(const bf16*)(ws + WS_YSB), (const bf16*)(ws + WS_WSB), M, D, 512}; pg8::StaticOrder S; S.init(M, D, F.G, (int)blockIdx.x);
          pg8::EpiMerge<0> E{(const bf16*)args.out, (bf16*)(ws + WS_MERGED)};
          pg8::gemm_phase<pg8::EpiMerge<0>, pg8::StaticOrder, true, true>(F.lds + RING_OFF, g, S, E); }
        VM_WAIT(); __syncthreads();
        if (F.tid == 0) { __builtin_amdgcn_fence(__ATOMIC_ACQ_REL, "agent"); VM_WAIT(); }
        __syncthreads();
        { pg8::Gemm g{(const bf16*)(ws + WS_YGDN), (const bf16*)(ws + WS_WGDN), M, D, 512}; pg8::StaticOrder S; S.init(M, D, F.G, (int)blockIdx.x);
          pg8::EpiMerge<1> E{(const bf16*)args.out, (bf16*)(ws + WS_MERGED)};
          pg8::gemm_phase<pg8::EpiMerge<1>, pg8::StaticOrder, true, true>(F.lds + RING_OFF, g, S, E); }
    } SEAM(5);
    if (IN(6)) {
        pg8::Gemm g{(const bf16*)(ws + WS_MERGED), (const bf16*)(ws + WS_WO), M, D, D}; pg8::StaticOrder S; S.init(M, D, F.G, (int)blockIdx.x);
        pg8::EpiWo E{args.in[0], mod, args.out};
        pg8::gemm_phase<pg8::EpiWo, pg8::StaticOrder, true, true>(F.lds + RING_OFF, g, S, E);
    } SEAM(6);
    if (IN(7)) { norm_mod_rows(F, args.out, args.in[15], mod, 3, (bf16*)(ws + WS_XN)); } SEAM(7);
    if (IN(8)) {
        pg8::Gemm g{(const bf16*)(ws + WS_XN), (const bf16*)(ws + WS_WQ), M, PQW, D}; pg8::StaticOrder S; S.init(M, PQW, F.G, (int)blockIdx.x);
        pg8::EpiBf16<0> E{(bf16*)(ws + WS_QP), PQW, nullptr, 0, 0, 1.f};
        pg8::gemm_phase<pg8::EpiBf16<0>, pg8::StaticOrder, true, true>(F.lds + RING_OFF, g, S, E);
    } SEAM(8);
    if (IN(9)) { p9_topk(F, args); } SEAM(9);
    if (IN(10)) { p10_peer(F, args); }
#undef IN
#undef SEAM
}
extern "C" void kernel_launch(void* const* d_in, const int* in_sizes, int n_in, void* d_out, int out_size, void* d_ws, size_t ws_size, hipStream_t stream) {
    static int grid = 0;
    if (grid == 0) {
        if (n_in != 20 || out_size != M * D || ws_size < WS_END) { fprintf(stderr, "kernel_launch: unexpected shapes n_in %d out %d ws %zu\n", n_in, out_size, ws_size); grid = -1; return; }
        int dev = 0, cus = 0;
        if (hipGetDevice(&dev) != hipSuccess || hipDeviceGetAttribute(&cus, hipDeviceAttributeMultiprocessorCount, dev) != hipSuccess) { grid = -1; return; }
        if (hipFuncSetAttribute((const void*)mk_fwd, hipFuncAttributeMaxDynamicSharedMemorySize, LDS_BYTES) != hipSuccess) { fprintf(stderr, "kernel_launch: hipFuncSetAttribute failed\n"); grid = -1; return; }
        (void)hipGetLastError();
        grid = cus;
    }
    if (grid < 0) return;
    (void)hipMemsetAsync((char*)d_ws + WS_CTL, 0, CTL_ZERO_BYTES, stream);
    Args a{};
    for (int i = 0; i < 20; ++i) a.in[i] = (const float*)d_in[i];
    a.out = (float*)d_out; a.ws = (unsigned char*)d_ws;
    auto mk = [&](int lo, int hi) { a.ph_lo = lo; a.ph_hi = hi; a.li = 0; hipLaunchKernelGGL(mk_fwd, dim3(grid), dim3(NWAVES * 64), LDS_BYTES, stream, a); };
    mk(0, 11);
}
```

```cpp
#include <hip/hip_runtime.h>
#include <cstdio>
#include <cstdint>
#include <cmath>

constexpr int D = 1024, BATCH = 2, SEQ = 8192, M = BATCH * SEQ;
constexpr int SBH = 8, SBD = 64, SBW = 512;
constexpr int GH = 8, GDK = 64, GDV = 64, GCONVW = 1536;
constexpr int INW = 5648, INWP = 5888;
constexpr int PH = 8, PNK = 128, PQD = 256, PHALF = 128, PTOPK = 16, PNE = 16384, PQW = PH * PQD;
constexpr float EPS = 1e-6f;

namespace pg8 {
#define PG8_LAS __attribute__((address_space(3)))
typedef unsigned short bf16_t;
typedef short bf16x8 __attribute__((ext_vector_type(8)));
typedef float f32x4 __attribute__((ext_vector_type(4)));
typedef unsigned u32x4 __attribute__((ext_vector_type(4)));
constexpr int BM = 256, BK = 64, HALF = 128, HTB = HALF * BK * 2  , STAGE_BYTES = 8 * HTB, NXCD = 8, WGM = 8;

__host__ __device__ __forceinline__ int lds_byte(int r, int c) { const int st = (r >> 4) * 2 + (c >> 5), rr = r & 15, cc = c & 31, ob = rr * 64 + cc * 2; return st * 1024 + (ob ^ (((ob >> 9) & 1) << 5)); }
__host__ __device__ __forceinline__ void stage_rc(int b, int& R, int& C) { const int st = b / 1024, sb = b % 1024, swz = sb ^ (((sb >> 9) & 1) << 5); R = (st >> 1) * 16 + swz / 64; C = (st & 1) * 32 + (swz % 64) / 2; }
__host__ __device__ __forceinline__ int perm32(int rho) { const int n = rho >> 4, i = rho & 15; return 8 * (i >> 2) + 4 * n + (i & 3); }

struct Unit { int pm, pn; };
struct Gemm { const bf16_t* A; const bf16_t* Bt; int M, N, K; };

struct StaticOrder {
    int nM, nN, nwg, G, c;
    __host__ __device__ void init(int M, int N, int G_, int c_) { nM = M / BM; nN = N / BM; nwg = nM * nN; G = G_; c = c_; }
    __host__ __device__ bool next(int i, Unit& u) const {
        const long L = (long)i * G + c; if (L >= nwg) return false;
        int wgid = (int)L; { const int q = nwg / NXCD, r = nwg % NXCD, xcd = wgid % NXCD, off = wgid / NXCD; wgid = (xcd < r ? xcd * (q + 1) : r * (q + 1) + (xcd - r) * q) + off; }
        const int nig = WGM * nN, gid = wgid / nig, fm = gid * WGM, gsz = (nM - fm) < WGM ? (nM - fm) : WGM;
        u.pm = fm + ((wgid % nig) % gsz); u.pn = (wgid % nig) / gsz; return true;
    }
    __device__ __forceinline__ void a_ready(const Unit&) const {}
    __device__ __forceinline__ void done(const Unit&) const {}
};

__device__ __forceinline__ unsigned cvt_pk_bf16(float lo, float hi) { unsigned r; asm volatile("v_cvt_pk_bf16_f32 %0, %1, %2" : "=v"(r) : "v"(lo), "v"(hi)); return r; }
typedef float f32x2 __attribute__((ext_vector_type(2)));
__device__ __forceinline__ f32x2 gelu_pk(f32x2 v) {
    const f32x2 av = __builtin_elementwise_abs(v), d = av * 0.2316418882f + 1.0f;
    f32x2 t; t.x = __builtin_amdgcn_rcpf(d.x); t.y = __builtin_amdgcn_rcpf(d.y);
    f32x2 q = t * 0.5307027145f + (-0.7265760135f); q = q * t + 0.7107068705f; q = q * t + (-0.142248368f); q = q * t + 0.127414796f; q = q * t;
    const f32x2 s = (v * v) * (-0.72134752044f);
    f32x2 e; e.x = __builtin_amdgcn_exp2f(s.x); e.y = __builtin_amdgcn_exp2f(s.y);
    const f32x2 m = v * (q * e), r = v - m;
    f32x2 o; o.x = v.x < 0.f ? m.x : r.x; o.y = v.y < 0.f ? m.y : r.y; return o;
}

template <int ACT  > struct EpiBf16 {
    static constexpr bool PERM = true, AFTER_DRAIN = false; static_assert(ACT == 0 || ACT == 1, "EpiBf16: ACT is 0 (none) or 1 (gelu_pk)");
    bf16_t* O; int ldc; const float* bias; int split_cols; size_t split_stride; float scale0;
    __device__ __forceinline__ void operator()(const f32x4 (&acc)[2][2][4][2], const Unit& u, int wr, int wc, int fr, int fq) const {
        const int row0 = u.pm * BM + wr * 64 + fr; int colt = u.pn * BM; bf16_t* base = O;
        float sc = 1.f; if (split_cols) { const int t = colt / split_cols; base += (size_t)t * split_stride; colt -= t * split_cols; if (t == 0) sc = scale0; }
        const int col0 = colt + wc * 32 + 8 * fq, bcol0 = u.pn * BM + wc * 32 + 8 * fq;
        f32x4 bv[2][2];
#pragma unroll
        for (int bj = 0; bj < 2; ++bj)
#pragma unroll
            for (int n = 0; n < 2; ++n) bv[bj][n] = bias ? *(const f32x4*)(bias + bcol0 + bj * HALF + 4 * n) : (f32x4){0.f, 0.f, 0.f, 0.f};
#pragma unroll
        for (int ai = 0; ai < 2; ++ai)
#pragma unroll
            for (int m = 0; m < 4; ++m) { bf16_t* rowp = base + (size_t)(row0 + ai * HALF + m * 16) * ldc + col0;
#pragma unroll
                for (int bj = 0; bj < 2; ++bj) { f32x4 v0 = acc[ai][bj][m][0] + bv[bj][0], v1 = acc[ai][bj][m][1] + bv[bj][1];
                    if (ACT == 1) { f32x2 a = gelu_pk((f32x2){v0[0], v0[1]}), b = gelu_pk((f32x2){v0[2], v0[3]}), c = gelu_pk((f32x2){v1[0], v1[1]}), d = gelu_pk((f32x2){v1[2], v1[3]});
                        v0 = (f32x4){a.x, a.y, b.x, b.y}; v1 = (f32x4){c.x, c.y, d.x, d.y}; }
                    v0 = v0 * sc; v1 = v1 * sc; u32x4 w; w.x = cvt_pk_bf16(v0[0], v0[1]); w.y = cvt_pk_bf16(v0[2], v0[3]); w.z = cvt_pk_bf16(v1[0], v1[1]); w.w = cvt_pk_bf16(v1[2], v1[3]);
                    *(u32x4*)(rowp + bj * HALF) = w; } }
    }
};

__device__ __forceinline__ float sigmoidf_(float x) { return __builtin_amdgcn_rcpf(1.0f + __expf(-x)); }
__device__ __forceinline__ float bf2f(unsigned short h) { return __uint_as_float((unsigned)h << 16); }
__device__ __forceinline__ float bflo(unsigned w) { return __uint_as_float(w << 16); }
__device__ __forceinline__ float bfhi(unsigned w) { return __uint_as_float(w & 0xffff0000u); }

struct EpiInProj {
    static constexpr bool PERM = true, AFTER_DRAIN = false;
    bf16_t *q, *k, *v, *graw, *z, *gates; float* ab;
    __device__ __forceinline__ void operator()(const f32x4 (&acc)[2][2][4][2], const Unit& u, int wr, int wc, int fr, int fq) const {
        const int pn = u.pn; bf16_t* base; int ldc, ct; bool sig = false;
        if (pn >= 4 && pn < 6) {
#pragma unroll
            for (int ai = 0; ai < 2; ++ai)
#pragma unroll
                for (int m = 0; m < 4; ++m) { const int r = u.pm * BM + ai * HALF + wr * 64 + m * 16 + fr; const int bb = r >> 13, t = r & 8191;
#pragma unroll
                    for (int bj = 0; bj < 2; ++bj) { const int c0 = (pn - 4) * BM + bj * HALF + wc * 32 + 8 * fq; bf16_t* dst = v + ((size_t)(bb * 8 + (c0 >> 6)) * 64 + (c0 & 63)) * 8192 + t;
                        const f32x4 v0 = acc[ai][bj][m][0], v1 = acc[ai][bj][m][1];
                        const unsigned w0 = cvt_pk_bf16(v0[0], v0[1]), w1 = cvt_pk_bf16(v0[2], v0[3]), w2 = cvt_pk_bf16(v1[0], v1[1]), w3 = cvt_pk_bf16(v1[2], v1[3]);
                        dst[0] = (bf16_t)w0; dst[8192] = (bf16_t)(w0 >> 16); dst[2 * 8192] = (bf16_t)w1; dst[3 * 8192] = (bf16_t)(w1 >> 16);
                        dst[4 * 8192] = (bf16_t)w2; dst[5 * 8192] = (bf16_t)(w2 >> 16); dst[6 * 8192] = (bf16_t)w3; dst[7 * 8192] = (bf16_t)(w3 >> 16); } }
            return;
        }
        if (pn < 2) { base = q; ldc = 512; ct = pn; } else if (pn < 4) { base = k; ldc = 512; ct = pn - 2; }
        else if (pn < 12) { base = graw; ldc = 1536; ct = pn - 6; } else if (pn < 14) { base = z; ldc = 512; ct = pn - 12; } else if (pn < 22) { base = gates; ldc = 2048; ct = pn - 14; sig = true; }
        else {
            if (wc == 0 && fq < 2) {
#pragma unroll
                for (int ai = 0; ai < 2; ++ai)
#pragma unroll
                    for (int m = 0; m < 4; ++m) { const int r = u.pm * BM + ai * HALF + wr * 64 + m * 16 + fr; float* p = ab + (size_t)r * 16 + 8 * fq;
                        *(f32x4*)p = acc[ai][0][m][0]; *(f32x4*)(p + 4) = acc[ai][0][m][1]; }
            }
            return;
        }
        const int row0 = u.pm * BM + wr * 64 + fr, col0 = ct * BM + wc * 32 + 8 * fq;
#pragma unroll
        for (int ai = 0; ai < 2; ++ai)
#pragma unroll
            for (int m = 0; m < 4; ++m) { bf16_t* rowp = base + (size_t)(row0 + ai * HALF + m * 16) * ldc + col0;
#pragma unroll
                for (int bj = 0; bj < 2; ++bj) { f32x4 v0 = acc[ai][bj][m][0], v1 = acc[ai][bj][m][1];
                    if (sig) { v0 = (f32x4){sigmoidf_(v0[0]), sigmoidf_(v0[1]), sigmoidf_(v0[2]), sigmoidf_(v0[3])}; v1 = (f32x4){sigmoidf_(v1[0]), sigmoidf_(v1[1]), sigmoidf_(v1[2]), sigmoidf_(v1[3])}; }
                    u32x4 w; w.x = cvt_pk_bf16(v0[0], v0[1]); w.y = cvt_pk_bf16(v0[2], v0[3]); w.z = cvt_pk_bf16(v1[0], v1[1]); w.w = cvt_pk_bf16(v1[2], v1[3]);
                    *(u32x4*)(rowp + bj * HALF) = w; } }
    }
};
template <int MODE> struct EpiMerge {
    static constexpr bool PERM = true, AFTER_DRAIN = false;
    const bf16_t* gates; bf16_t* merged;
    __device__ __forceinline__ void operator()(const f32x4 (&acc)[2][2][4][2], const Unit& u, int wr, int wc, int fr, int fq) const {
        const int row0 = u.pm * BM + wr * 64 + fr, col0 = u.pn * BM + wc * 32 + 8 * fq;
#pragma unroll
        for (int ai = 0; ai < 2; ++ai)
#pragma unroll
            for (int m = 0; m < 4; ++m) { const size_t r = (size_t)(row0 + ai * HALF + m * 16);
#pragma unroll
                for (int bj = 0; bj < 2; ++bj) { const int c = col0 + bj * HALF;
                    const u32x4 g = *(const u32x4*)(gates + r * 2048 + MODE * 1024 + c);
                    f32x4 v0 = acc[ai][bj][m][0], v1 = acc[ai][bj][m][1];
                    v0 = v0 * (f32x4){bflo(g.x), bfhi(g.x), bflo(g.y), bfhi(g.y)}; v1 = v1 * (f32x4){bflo(g.z), bfhi(g.z), bflo(g.w), bfhi(g.w)};
                    if (MODE == 1) { const u32x4 p = *(const u32x4*)(merged + r * 1024 + c);
                        v0 = v0 + (f32x4){bflo(p.x), bfhi(p.x), bflo(p.y), bfhi(p.y)}; v1 = v1 + (f32x4){bflo(p.z), bfhi(p.z), bflo(p.w), bfhi(p.w)}; }
                    u32x4 w; w.x = cvt_pk_bf16(v0[0], v0[1]); w.y = cvt_pk_bf16(v0[2], v0[3]); w.z = cvt_pk_bf16(v1[0], v1[1]); w.w = cvt_pk_bf16(v1[2], v1[3]);
                    *(u32x4*)(merged + r * 1024 + c) = w; } }
    }
};
struct EpiWo {
    static constexpr bool PERM = true, AFTER_DRAIN = false;
    const float* x; const float* mod; float* out;
    __device__ __forceinline__ void operator()(const f32x4 (&acc)[2][2][4][2], const Unit& u, int wr, int wc, int fr, int fq) const {
        const int row0 = u.pm * BM + wr * 64 + fr, col0 = u.pn * BM + wc * 32 + 8 * fq; const int b = (u.pm * BM) >> 13;
        const float* g1 = mod + (size_t)b * 6 * 1024 + 2 * 1024;
#pragma unroll
        for (int bj = 0; bj < 2; ++bj) { const int c = col0 + bj * HALF; const f32x4 ga = *(const f32x4*)(g1 + c), gb = *(const f32x4*)(g1 + c + 4);
#pragma unroll
            for (int ai = 0; ai < 2; ++ai)
#pragma unroll
                for (int m = 0; m < 4; ++m) { const size_t off = (size_t)(row0 + ai * HALF + m * 16) * 1024 + c;
                    const f32x4 xa = *(const f32x4*)(x + off), xb = *(const f32x4*)(x + off + 4);
                    *(f32x4*)(out + off) = xa + ga * acc[ai][bj][m][0]; *(f32x4*)(out + off + 4) = xb + gb * acc[ai][bj][m][1]; } }
    }
};
template <class Epi, class Sched, bool ALIGN_EPI = false, bool SP2 = false>
__device__ __forceinline__ void gemm_phase(PG8_LAS unsigned char* lds, const Gemm g, const Sched& S, const Epi& E) {
    const int tid = threadIdx.x, wid = __builtin_amdgcn_readfirstlane(tid >> 6), lane = tid & 63, wr = wid >> 2, wc = wid & 3, fr = lane & 15, fq = lane >> 4;
    const int K = g.K, nt = K / BK;
    unsigned voffA[2], voffB[2];
#pragma unroll
    for (int i = 0; i < 2; ++i) { int R, C; stage_rc(tid * 16 + i * 8192, R, C); const int Rb = Epi::PERM ? ((R & ~31) + perm32(R & 31)) : R;
        voffA[i] = (unsigned)(R * K + C) * 2u; voffB[i] = (unsigned)(Rb * K + C) * 2u; }
    const size_t kstep = (size_t)(BK * 2);
    const size_t hstep = (size_t)HALF * K * 2;
    const size_t tstep = 2 * hstep;
    const unsigned ldsw = (unsigned)wid * 1024u;
    const int aoff = lds_byte(wr * 64 + fr, fq * 8), boff = lds_byte(wc * 32 + fr, fq * 8);
#define PG8_SA(b, h) (((b) * 2 + (h)) * HTB)
#define PG8_SB(b, h) ((4 + (b) * 2 + (h)) * HTB)
#define PG8_STAGE(bufoff, gbase, voff) do { _Pragma("unroll") for (int _i = 0; _i < 2; ++_i) \
        __builtin_amdgcn_global_load_lds((const unsigned*)((const char*)(gbase) + (voff)[_i]), (PG8_LAS unsigned*)(lds + (bufoff) + ldsw + _i * 8192), 16, 0, 0); } while (0)
#define PG8_LDA(dst, b, h) do { _Pragma("unroll") for (int m = 0; m < 4; ++m) _Pragma("unroll") for (int k = 0; k < 2; ++k) dst[m][k] = *(const PG8_LAS bf16x8*)(lds + PG8_SA(b, h) + aoff + m * 2048 + k * 1024); } while (0)
#define PG8_LDB(dst, b, h) do { _Pragma("unroll") for (int n = 0; n < 2; ++n) _Pragma("unroll") for (int k = 0; k < 2; ++k) dst[n][k] = *(const PG8_LAS bf16x8*)(lds + PG8_SB(b, h) + boff + n * 2048 + k * 1024); } while (0)
#define PG8_MMA(ai, bj, At, Bt) do { __builtin_amdgcn_s_setprio(1); _Pragma("unroll") for (int m = 0; m < 4; ++m) _Pragma("unroll") for (int n = 0; n < 2; ++n) _Pragma("unroll") for (int k = 0; k < 2; ++k) \
        acc[ai][bj][m][n] = __builtin_amdgcn_mfma_f32_16x16x32_bf16(Bt[n][k], At[m][k], acc[ai][bj][m][n], 0, 0, 0); __builtin_amdgcn_s_setprio(0); } while (0)
#define PG8_WAIT_V(n) asm volatile("s_waitcnt vmcnt(" #n ")" ::: "memory")
#define PG8_WAIT_L(n) asm volatile("s_waitcnt lgkmcnt(" #n ")" ::: "memory")
#define PG8_BAR __builtin_amdgcn_s_barrier()
#define PG8_SCHED __builtin_amdgcn_sched_barrier(0)
    Unit cur, nxt; int ui = 0;
    if (!S.next(0, cur)) return;
    f32x4 acc[2][2][4][2];
#pragma unroll
    for (int a = 0; a < 2; ++a)
#pragma unroll
        for (int b = 0; b < 2; ++b)
#pragma unroll
            for (int m = 0; m < 4; ++m)
#pragma unroll
                for (int n = 0; n < 2; ++n) acc[a][b][m][n] = (f32x4){0.f, 0.f, 0.f, 0.f};
    bf16x8 At[4][2], B0[2][2], B1[2][2];
    const char* cA = (const char*)g.A + (size_t)cur.pm * tstep; const char* cB = (const char*)g.Bt + (size_t)cur.pn * tstep;
    S.a_ready(cur);
    if constexpr (SP2) {
        PG8_STAGE(PG8_SB(0, 0), cB, voffB); PG8_STAGE(PG8_SB(0, 1), cB + hstep, voffB); PG8_STAGE(PG8_SA(0, 0), cA, voffA); PG8_STAGE(PG8_SA(0, 1), cA + hstep, voffA);
        if (wr == 1) PG8_BAR;
        PG8_WAIT_V(2); PG8_BAR;
        PG8_STAGE(PG8_SB(1, 0), cB + kstep, voffB); PG8_STAGE(PG8_SA(1, 0), cA + kstep, voffA); PG8_STAGE(PG8_SB(1, 1), cB + hstep + kstep, voffB);
        PG8_WAIT_V(6); PG8_BAR;
    } else {
        PG8_STAGE(PG8_SB(0, 0), cB, voffB); PG8_STAGE(PG8_SA(0, 0), cA, voffA); PG8_STAGE(PG8_SB(0, 1), cB + hstep, voffB); PG8_STAGE(PG8_SA(0, 1), cA + hstep, voffA);
        if (wr == 1) PG8_BAR;
        PG8_WAIT_V(4); PG8_BAR;
        PG8_STAGE(PG8_SB(1, 0), cB + kstep, voffB); PG8_STAGE(PG8_SA(1, 0), cA + kstep, voffA); PG8_STAGE(PG8_SB(1, 1), cB + hstep + kstep, voffB);
        PG8_WAIT_V(6); PG8_BAR;
    }
    for (;;) {
        const bool has_next = S.next(ui + 1, nxt);
        const char* nA = has_next ? (const char*)g.A + (size_t)nxt.pm * tstep : cA; const char* nB = has_next ? (const char*)g.Bt + (size_t)nxt.pn * tstep : cB;
        for (int t = 0; t < nt; t += 2) {
            const bool last = (t == nt - 2);
            const char* a1 = cA + (size_t)(t + 1) * kstep;
            const char* a2 = last ? nA : cA + (size_t)(t + 2) * kstep; const char* b2 = last ? nB : cB + (size_t)(t + 2) * kstep;
            const char* a3 = a2 + kstep; const char* b3 = b2 + kstep;
            if (last && has_next) S.a_ready(nxt);
            if constexpr (SP2) {
            PG8_LDB(B0, 0, 0); PG8_LDB(B1, 0, 1); PG8_SCHED; PG8_LDA(At, 0, 0); PG8_STAGE(PG8_SA(1, 1), a1 + hstep, voffA);
            PG8_WAIT_V(8); PG8_WAIT_L(0); PG8_BAR; PG8_MMA(0, 0, At, B0); PG8_MMA(0, 1, At, B1); PG8_BAR; PG8_SCHED;
            PG8_LDA(At, 0, 1); PG8_STAGE(PG8_SB(0, 0), b2, voffB); PG8_STAGE(PG8_SB(0, 1), b2 + hstep, voffB); PG8_STAGE(PG8_SA(0, 0), a2, voffA);
            PG8_WAIT_V(8); PG8_WAIT_L(0); PG8_BAR; PG8_MMA(1, 0, At, B0); PG8_MMA(1, 1, At, B1); PG8_BAR; PG8_SCHED;
            PG8_LDB(B0, 1, 0); PG8_LDB(B1, 1, 1); PG8_SCHED; PG8_LDA(At, 1, 0); PG8_STAGE(PG8_SA(0, 1), a2 + hstep, voffA);
            PG8_WAIT_V(8); PG8_WAIT_L(0); PG8_BAR; PG8_MMA(0, 0, At, B0); PG8_MMA(0, 1, At, B1); PG8_BAR; PG8_SCHED;
            PG8_LDA(At, 1, 1); PG8_STAGE(PG8_SB(1, 0), b3, voffB); PG8_STAGE(PG8_SB(1, 1), b3 + hstep, voffB); PG8_STAGE(PG8_SA(1, 0), a3, voffA);
            PG8_WAIT_V(8); PG8_WAIT_L(0); PG8_BAR; PG8_MMA(1, 0, At, B0); PG8_MMA(1, 1, At, B1); PG8_BAR; PG8_SCHED;
            } else {
            PG8_LDB(B0, 0, 0); PG8_SCHED; PG8_LDA(At, 0, 0); PG8_STAGE(PG8_SA(1, 1), a1 + hstep, voffA);
            PG8_WAIT_L(8); PG8_BAR; PG8_WAIT_L(0); PG8_MMA(0, 0, At, B0); PG8_BAR; PG8_SCHED;
            PG8_LDB(B1, 0, 1); PG8_STAGE(PG8_SB(0, 0), b2, voffB);
            PG8_BAR; PG8_WAIT_L(0); PG8_MMA(0, 1, At, B1); PG8_BAR;
            PG8_LDA(At, 0, 1); PG8_STAGE(PG8_SA(0, 0), a2, voffA);
            PG8_BAR; PG8_WAIT_L(0); PG8_MMA(1, 0, At, B0); PG8_BAR; PG8_SCHED;
            PG8_STAGE(PG8_SB(0, 1), b2 + hstep, voffB);
            PG8_WAIT_V(6); PG8_BAR; PG8_MMA(1, 1, At, B1); PG8_BAR;
            PG8_LDB(B0, 1, 0); PG8_SCHED; PG8_LDA(At, 1, 0); PG8_STAGE(PG8_SA(0, 1), a2 + hstep, voffA);
            PG8_WAIT_L(8); PG8_BAR; PG8_WAIT_L(0); PG8_MMA(0, 0, At, B0); PG8_BAR; PG8_SCHED;
            PG8_LDB(B1, 1, 1); PG8_STAGE(PG8_SB(1, 0), b3, voffB);
            PG8_BAR; PG8_WAIT_L(0); PG8_MMA(0, 1, At, B1); PG8_BAR;
            PG8_LDA(At, 1, 1); PG8_STAGE(PG8_SA(1, 0), a3, voffA);
            PG8_BAR; PG8_WAIT_L(0); PG8_MMA(1, 0, At, B0); PG8_BAR; PG8_SCHED;
            PG8_STAGE(PG8_SB(1, 1), b3 + hstep, voffB);
            PG8_WAIT_V(6); PG8_BAR; PG8_MMA(1, 1, At, B1); PG8_BAR;
            }
        }
        if constexpr (ALIGN_EPI) { if (wr == 0) PG8_BAR; }
        if constexpr (!Epi::AFTER_DRAIN) { E(acc, cur, wr, wc, fr, fq); S.done(cur); }
        if (!has_next) break;
#pragma unroll
        for (int a = 0; a < 2; ++a)
#pragma unroll
            for (int b = 0; b < 2; ++b)
#pragma unroll
                for (int m = 0; m < 4; ++m)
#pragma unroll
                    for (int n = 0; n < 2; ++n) acc[a][b][m][n] = (f32x4){0.f, 0.f, 0.f, 0.f};
        cur = nxt; cA = nA; cB = nB; ++ui;
        if constexpr (ALIGN_EPI) { if (wr == 1) PG8_BAR; }
    }
    PG8_WAIT_V(0);
    if constexpr (!ALIGN_EPI) { if (wr == 0) PG8_BAR; }
    PG8_BAR;
    if constexpr (Epi::AFTER_DRAIN) { E.fused(acc, cur, wr, wc, fr, fq, lds, wid, lane); S.done(cur); }
#undef PG8_SA
#undef PG8_SB
#undef PG8_STAGE
#undef PG8_LDA
#undef PG8_LDB
#undef PG8_MMA
#undef PG8_WAIT_V
#undef PG8_WAIT_L
#undef PG8_BAR
#undef PG8_SCHED
}
}

constexpr int NWAVES = 8;
#define GAS __attribute__((address_space(1)))
#define LAS __attribute__((address_space(3)))
typedef unsigned short bf16;
typedef unsigned v4u __attribute__((ext_vector_type(4)));
typedef unsigned v2u __attribute__((ext_vector_type(2)));
typedef float f32x4 __attribute__((ext_vector_type(4)));
typedef float f32x2 __attribute__((ext_vector_type(2)));
typedef short bf16x8 __attribute__((ext_vector_type(8)));
typedef GAS unsigned gu32;
#define RLX_AGENT __ATOMIC_RELAXED, __HIP_MEMORY_SCOPE_AGENT
#define LDS_WAIT() asm volatile("s_waitcnt lgkmcnt(0)" ::: "memory")
#define VM_WAIT() asm volatile("s_waitcnt vmcnt(0)" ::: "memory")
__device__ __forceinline__ unsigned f2bf(float f) { unsigned u = __builtin_bit_cast(unsigned, f); return (u + 0x7fffu + ((u >> 16) & 1u)) >> 16; }
__device__ __forceinline__ unsigned pk2(float lo, float hi) { return f2bf(lo) | (f2bf(hi) << 16); }
__device__ __forceinline__ float bf2f(unsigned short h) { return __uint_as_float((unsigned)h << 16); }
__device__ __forceinline__ float bflo(unsigned w) { return __uint_as_float(w << 16); }
__device__ __forceinline__ float bfhi(unsigned w) { return __uint_as_float(w & 0xffff0000u); }
__device__ __forceinline__ float sigm(float x) { return 1.0f / (1.0f + __expf(-x)); }
__device__ __forceinline__ float siluf(float x) { return x / (1.0f + __expf(-x)); }
__device__ __forceinline__ float softplusf(float x) { return fmaxf(x, 0.f) + log1pf(__expf(-fabsf(x))); }
__device__ __forceinline__ float wave_sum(float v) {
#pragma unroll
    for (int o = 1; o < 64; o <<= 1) v += __shfl_xor(v, o);
    return v;
}

constexpr size_t MiB = 1u << 20;
constexpr size_t WS_CTL = 0, CTL_ZERO_BYTES = 1 * MiB;
constexpr size_t WS_MOD = 1 * MiB;
constexpr size_t WS_SKEY = 1 * MiB + 256 * 1024;
constexpr size_t WS_WIN = 2 * MiB;
constexpr size_t WS_WSB = 14 * MiB, WS_WGDN = 15 * MiB, WS_WO = 16 * MiB, WS_WQ = 18 * MiB;
constexpr size_t WS_AB = 22 * MiB;
constexpr size_t WS_GB = 23 * MiB;
constexpr size_t WS_XN = 24 * MiB;
constexpr size_t WS_Q = 56 * MiB, WS_K = 72 * MiB, WS_V = 88 * MiB;
constexpr size_t WS_GRAW = 104 * MiB;
constexpr size_t WS_Z = 152 * MiB;
constexpr size_t WS_YSB = 24 * MiB, WS_YGDN = 40 * MiB;
constexpr size_t WS_MERGED = 56 * MiB;
constexpr size_t WS_CH = 168 * MiB;
constexpr size_t WS_CD = 248 * MiB;
constexpr size_t WS_QP = 168 * MiB;
constexpr size_t WS_EIDX = 232 * MiB, WS_GATE = 240 * MiB;
constexpr size_t WS_UT8 = 104 * MiB, WS_VT8 = 120 * MiB;
constexpr size_t WS_END = 256 * MiB;
constexpr int CW_BAR = 4096;

constexpr int RING_OFF = 0, RING_BYTES = 131072;
constexpr int LDSCTL_OFF = RING_BYTES, MISC_OFF = LDSCTL_OFF + 320;
constexpr int LDS_BYTES = 147456;
#define XB_TMO      128
#define XB_XCNT(j)  (256  + 64 * (j))
#define XB_XSUB(j)  (1280 + 64 * (j))
#define XB_XGEN(j)  (2304 + 64 * (j))
#define XB_TOP      3328
#define XB_TOPGEN   3392
#define XCD_BAR_WORDS 3456
#define XB_SPIN_CAP (1u << 18)

__device__ __forceinline__ unsigned xb_ld(unsigned* p)              { return __hip_atomic_load(p, __ATOMIC_RELAXED, __HIP_MEMORY_SCOPE_AGENT); }
__device__ __forceinline__ unsigned xb_add(unsigned* p, unsigned v) { return __hip_atomic_fetch_add(p, v, __ATOMIC_RELAXED, __HIP_MEMORY_SCOPE_AGENT); }
__device__ __forceinline__ unsigned xb_xcc_id() { return (unsigned)__builtin_amdgcn_s_getreg((3 << 11) | 20) & 0xFu; }
#define XB_SPIN(cond, bar) do { unsigned _sp = 0; while (cond) { __builtin_amdgcn_s_sleep(1); \
    if ((++_sp & 255u) == 0u) { if (xb_ld(&(bar)[XB_TMO])) break; if (_sp > XB_SPIN_CAP) { atomicAdd(&(bar)[XB_TMO], 1u); break; } } } } while (0)

struct XcdBarrier {
    unsigned* bar; unsigned x;
    volatile LAS unsigned* st;
};

__device__ __forceinline__ XcdBarrier xcd_barrier_post(unsigned* bar, volatile LAS unsigned* st) {
    XcdBarrier b; b.bar = bar; b.x = xb_xcc_id(); b.st = st;
    if (threadIdx.x == 0) (void)xb_add(&bar[XB_XCNT(b.x)], 1u);
    return b;
}
__device__ __forceinline__ void xcd_barrier_complete(unsigned* bar, unsigned x, unsigned& nloc, unsigned& nx) {
    const unsigned G = gridDim.x * gridDim.y * gridDim.z;
    unsigned sum, cnt, mine, sp = 0u;
    for (;;) {
        sum = 0u; cnt = 0u; mine = 0u;
#pragma unroll
        for (unsigned j = 0; j < 16; ++j) { const unsigned c = xb_ld(&bar[XB_XCNT(j)]); sum += c; cnt += (c > 0u) ? 1u : 0u; mine = (j == x) ? c : mine; }
        if (sum == G) break;
        __builtin_amdgcn_s_sleep(1);
        if ((++sp & 255u) == 0u) { if (xb_ld(&bar[XB_TMO])) break; if (sp > XB_SPIN_CAP) { atomicAdd(&bar[XB_TMO], 1u); break; } }
    }
    nloc = mine > 0u ? mine : 1u; nx = cnt > 0u ? cnt : 1u;
}

__device__ __forceinline__ void xcd_barrier(const XcdBarrier& b) {
    asm volatile("s_waitcnt vmcnt(0)" ::: "memory");
    __syncthreads();
    if (threadIdx.x == 0) {
        unsigned* bar = b.bar;
        __builtin_amdgcn_s_waitcnt(0);
        unsigned nloc = b.st[0], nx = b.st[1];
        if (nloc == 0u) { xcd_barrier_complete(bar, b.x, nloc, nx); b.st[0] = nloc; b.st[1] = nx; }
        const unsigned old = xb_add(&bar[XB_XSUB(b.x)], 1u);
        const unsigned gen = old / nloc;
        if (old + 1u == (gen + 1u) * nloc) {
            __builtin_amdgcn_fence(__ATOMIC_RELEASE, "agent");
            asm volatile("s_waitcnt vmcnt(0)" ::: "memory");
            const unsigned og = xb_add(&bar[XB_TOP], 1u);
            const unsigned tg = og / nx;
            if (og + 1u == (tg + 1u) * nx) xb_add(&bar[XB_TOPGEN], 1u);
            else XB_SPIN(xb_ld(&bar[XB_TOPGEN]) == tg, bar);
            __builtin_amdgcn_fence(__ATOMIC_ACQUIRE, "agent");
            xb_add(&bar[XB_XGEN(b.x)], 1u);
            asm volatile("s_waitcnt vmcnt(0)" ::: "memory");
        } else {
            XB_SPIN(xb_ld(&bar[XB_XGEN(b.x)]) == gen, bar);
            __builtin_amdgcn_fence(__ATOMIC_ACQUIRE, "agent");
            asm volatile("s_waitcnt vmcnt(0)" ::: "memory");
        }
    }
    __syncthreads();
}

struct Args { const float* in[20]; float* out; unsigned char* ws; int ph_lo, ph_hi, li, pad; };

struct Frame {
    LAS unsigned char* lds;
    volatile LAS unsigned* MISC;
    gu32* ctl;
    int tid, lane, wave, G;
};

__device__ __forceinline__ int inproj_src_col(int n) { if (n < 3072) return n; if (n < 5632) return n + 16; if (n < 5648) return n - 5632 + 3072; return -1; }
template <bool MAP>
__device__ __forceinline__ void p0_transpose_item(const float* W, int K, int Nsrc, int Ndst, bf16* WT, LAS float* scr, int item, int lane) {
    const int nblk = Ndst / 32, kb = item / nblk, nb = item % nblk, k0 = 64 * kb, n0 = 32 * nb;
    const int nsrc = MAP ? inproj_src_col(n0 + (lane & 31)) : n0 + (lane & 31);
#pragma unroll 8
    for (int i = 0; i < 32; ++i) { const int kk = 2 * i + (lane >> 5); scr[kk * 33 + (lane & 31)] = nsrc >= 0 ? W[(size_t)(k0 + kk) * Nsrc + nsrc] : 0.f; }
    LDS_WAIT(); asm volatile("" ::: "memory");
    const int c = lane & 7;
#pragma unroll
    for (int j = 0; j < 4; ++j) { const int n = (lane >> 3) + 8 * j; const LAS float* s = scr + (8 * c) * 33 + n;
        v4u o; o.x = pk2(s[0 * 33], s[1 * 33]); o.y = pk2(s[2 * 33], s[3 * 33]); o.z = pk2(s[4 * 33], s[5 * 33]); o.w = pk2(s[6 * 33], s[7 * 33]);
        *(GAS v4u*)(WT + (size_t)(n0 + n) * K + k0 + 8 * c) = o; }
    LDS_WAIT(); asm volatile("" ::: "memory");
}
__device__ __forceinline__ void p0_prologue(Frame& F, const Args& a) {
    unsigned char* ws = a.ws;
    LAS float* scr = (LAS float*)(F.lds + RING_OFF + F.wave * 16384);
    const int gw = blockIdx.x * NWAVES + F.wave, NGW = F.G * NWAVES;
    constexpr int I_IN = (D / 64) * (INWP / 32), I_SB = (512 / 64) * (D / 32), I_O = (D / 64) * (D / 32), I_Q = (D / 64) * (PQW / 32);
    constexpr int NITEMS = I_IN + 2 * I_SB + I_O + I_Q;
    for (int it = gw; it < NITEMS; it += NGW) {
        int r = it;
        if (r < I_IN) { p0_transpose_item<true>(a.in[5], D, INW, INWP, (bf16*)(ws + WS_WIN), scr, r, F.lane); continue; } r -= I_IN;
        if (r < I_SB) { p0_transpose_item<false>(a.in[12], 512, D, D, (bf16*)(ws + WS_WSB), scr, r, F.lane); continue; } r -= I_SB;
        if (r < I_SB) { p0_transpose_item<false>(a.in[13], 512, D, D, (bf16*)(ws + WS_WGDN), scr, r, F.lane); continue; } r -= I_SB;
        if (r < I_O) { p0_transpose_item<false>(a.in[14], D, D, D, (bf16*)(ws + WS_WO), scr, r, F.lane); continue; } r -= I_O;
        p0_transpose_item<false>(a.in[16], D, PQW, PQW, (bf16*)(ws + WS_WQ), scr, r, F.lane);
    }
    { const float* sk = a.in[17]; bf16* o = (bf16*)(ws + WS_SKEY);
      for (int i = (blockIdx.x * 512 + F.tid) * 4; i < PH * 2 * PNK * PHALF; i += F.G * 512 * 4) { const f32x4 v = *(const f32x4*)(sk + i); v2u w; w.x = pk2(v.x, v.y); w.y = pk2(v.z, v.w); *(v2u*)(o + i) = w; } }
    { const float* c = a.in[1]; const float* wa = a.in[2]; const float* ba = a.in[3]; float* mod = (float*)(ws + WS_MOD);
      LAS float* red = (LAS float*)(F.lds + RING_OFF);
      for (int it = blockIdx.x; it < 6 * D / 64; it += F.G) {
          const int n = it * 64 + F.lane; float a0 = 0.f, a1 = 0.f;
          __syncthreads();
          for (int k = F.wave * 128; k < F.wave * 128 + 128; ++k) { const float w = wa[(size_t)k * (6 * D) + n]; a0 += siluf(c[k]) * w; a1 += siluf(c[D + k]) * w; }
          red[(F.wave * 2 + 0) * 64 + F.lane] = a0; red[(F.wave * 2 + 1) * 64 + F.lane] = a1;
          __syncthreads();
          if (F.wave < 2) { float s = 0.f;
#pragma unroll
              for (int w = 0; w < 8; ++w) s += red[(w * 2 + F.wave) * 64 + F.lane];
              mod[(size_t)F.wave * 6 * D + n] = s + ba[n]; }
      }
      __syncthreads(); }
}
__device__ __forceinline__ void norm_mod_rows(Frame& F, const float* x, const float* nw, const float* mod, int ch_shift, bf16* o) {
    const int gw = blockIdx.x * NWAVES + F.wave, NGW = F.G * NWAVES;
    for (int m = gw; m < M; m += NGW) {
        const GAS f32x4* xr = (const GAS f32x4*)(x + (size_t)m * D) + F.lane;
        f32x4 v[4]; float s = 0.f;
#pragma unroll
        for (int j = 0; j < 4; ++j) { v[j] = xr[64 * j]; s += (v[j].x * v[j].x + v[j].y * v[j].y) + (v[j].z * v[j].z + v[j].w * v[j].w); }
        const float rstd = 1.0f / sqrtf(wave_sum(s) * (1.f / D) + EPS);
        const float* sh = mod + (size_t)(m >> 13) * 6 * D + ch_shift * D; const float* sc = sh + D;
        GAS v2u* o8 = (GAS v2u*)(o + (size_t)m * D) + F.lane;
#pragma unroll
        for (int j = 0; j < 4; ++j) { const int c = 4 * F.lane + 256 * j; const f32x4 w = *(const f32x4*)(nw + c), a = *(const f32x4*)(sc + c), b = *(const f32x4*)(sh + c);
            const f32x4 y = v[j] * rstd * w * (a + 1.0f) + b; v2u p; p.x = pk2(y.x, y.y); p.y = pk2(y.z, y.w); o8[64 * j] = p; }
    }
}
constexpr float PEER_USCALE = 64.f, PEER_VSCALE = 8.f;
__device__ __forceinline__ void peer_tables_to_fp8(const Args& a, int blk, int nblk, int tid) {
    unsigned char* ws = a.ws;
    for (int which = 0; which < 2; ++which) { const float* src = a.in[18 + which]; v4u* dst = (v4u*)(ws + (which ? WS_VT8 : WS_UT8)); const float sc = which ? PEER_VSCALE : PEER_USCALE;
        for (int i = blk * 512 + tid; i < PNE * D / 16; i += nblk * 512) { const f32x4* p = (const f32x4*)src + (size_t)i * 4; const f32x4 a0 = p[0] * sc, a1 = p[1] * sc, a2 = p[2] * sc, a3 = p[3] * sc;
            int w0 = __builtin_amdgcn_cvt_pk_fp8_f32(a0.x, a0.y, 0, false); w0 = __builtin_amdgcn_cvt_pk_fp8_f32(a0.z, a0.w, w0, true);
            int w1 = __builtin_amdgcn_cvt_pk_fp8_f32(a1.x, a1.y, 0, false); w1 = __builtin_amdgcn_cvt_pk_fp8_f32(a1.z, a1.w, w1, true);
            int w2 = __builtin_amdgcn_cvt_pk_fp8_f32(a2.x, a2.y, 0, false); w2 = __builtin_amdgcn_cvt_pk_fp8_f32(a2.z, a2.w, w2, true);
            int w3 = __builtin_amdgcn_cvt_pk_fp8_f32(a3.x, a3.y, 0, false); w3 = __builtin_amdgcn_cvt_pk_fp8_f32(a3.z, a3.w, w3, true);
            dst[i] = (v4u){(unsigned)w0, (unsigned)w1, (unsigned)w2, (unsigned)w3}; } }
}
__device__ __forceinline__ float gelu_erf(float v) { return 0.5f * v * (1.0f + erff(v * 0.70710678118654752f)); }
__device__ __forceinline__ void fp8x16_to_f32(const v4u& w, f32x2 (&o)[8]) {
    o[0] = __builtin_amdgcn_cvt_pk_f32_fp8((int)w.x, false); o[1] = __builtin_amdgcn_cvt_pk_f32_fp8((int)w.x, true);
    o[2] = __builtin_amdgcn_cvt_pk_f32_fp8((int)w.y, false); o[3] = __builtin_amdgcn_cvt_pk_f32_fp8((int)w.y, true);
    o[4] = __builtin_amdgcn_cvt_pk_f32_fp8((int)w.z, false); o[5] = __builtin_amdgcn_cvt_pk_f32_fp8((int)w.z, true);
    o[6] = __builtin_amdgcn_cvt_pk_f32_fp8((int)w.w, false); o[7] = __builtin_amdgcn_cvt_pk_f32_fp8((int)w.w, true);
}
__device__ __forceinline__ void p10_peer(Frame& F, const Args& a) {
    unsigned char* ws = a.ws;
    const bf16* h2 = (const bf16*)(ws + WS_XN); const int* eidx = (const int*)(ws + WS_EIDX); const float* gate = (const float*)(ws + WS_GATE);
    const unsigned char* ut = ws + WS_UT8; const unsigned char* vt = ws + WS_VT8; const float* mod = (const float*)(ws + WS_MOD); float* out = a.out;
    LAS float* acts = (LAS float*)(F.lds + RING_OFF + F.wave * 1024); LAS float* coefs = acts + 128;
    const int gw = blockIdx.x * NWAVES + F.wave, NGW = F.G * NWAVES, lane = F.lane;
    for (int t = gw; t < M; t += NGW) {
        f32x2 h[8];
        { const v4u w0 = *(const v4u*)(h2 + (size_t)t * D + 16 * lane), w1 = *(const v4u*)(h2 + (size_t)t * D + 16 * lane + 8);
          h[0] = (f32x2){bflo(w0.x), bfhi(w0.x)}; h[1] = (f32x2){bflo(w0.y), bfhi(w0.y)}; h[2] = (f32x2){bflo(w0.z), bfhi(w0.z)}; h[3] = (f32x2){bflo(w0.w), bfhi(w0.w)};
          h[4] = (f32x2){bflo(w1.x), bfhi(w1.x)}; h[5] = (f32x2){bflo(w1.y), bfhi(w1.y)}; h[6] = (f32x2){bflo(w1.z), bfhi(w1.z)}; h[7] = (f32x2){bflo(w1.w), bfhi(w1.w)}; }
        const int* et = eidx + (size_t)t * 128;
        for (int i = 0; i < 16; ++i) {
            v4u rw[8];
#pragma unroll
            for (int k = 0; k < 8; ++k) rw[k] = *(const v4u*)(ut + (size_t)et[8 * i + k] * D + 16 * lane);
            float p[8];
#pragma unroll
            for (int k = 0; k < 8; ++k) { f32x2 u[8]; fp8x16_to_f32(rw[k], u); f32x2 s = u[0] * h[0];
#pragma unroll
                for (int j = 1; j < 8; ++j) s += u[j] * h[j];
                p[k] = s.x + s.y; }
            const bool hi32 = lane & 32, hi16 = lane & 16, hi8 = lane & 8;
            float q[4];
#pragma unroll
            for (int k = 0; k < 4; ++k) { const float mine = hi32 ? p[4 + k] : p[k], give = hi32 ? p[k] : p[4 + k]; q[k] = mine + __shfl_xor(give, 32); }
            float r2[2];
#pragma unroll
            for (int k = 0; k < 2; ++k) { const float mine = hi16 ? q[2 + k] : q[k], give = hi16 ? q[k] : q[2 + k]; r2[k] = mine + __shfl_xor(give, 16); }
            float s1; { const float mine = hi8 ? r2[1] : r2[0], give = hi8 ? r2[0] : r2[1]; s1 = mine + __shfl_xor(give, 8); }
            s1 += __shfl_xor(s1, 4); s1 += __shfl_xor(s1, 2); s1 += __shfl_xor(s1, 1);
            if ((lane & 7) == 0) acts[8 * i + ((lane >> 5) & 1) * 4 + ((lane >> 4) & 1) * 2 + ((lane >> 3) & 1)] = s1;
        }
        LDS_WAIT(); asm volatile("" ::: "memory");
        { const float a0 = acts[lane] * (1.0f / PEER_USCALE), a1 = acts[64 + lane] * (1.0f / PEER_USCALE);
          coefs[lane] = gate[(size_t)t * 128 + lane] * gelu_erf(a0) * (1.0f / PEER_VSCALE); coefs[64 + lane] = gate[(size_t)t * 128 + 64 + lane] * gelu_erf(a1) * (1.0f / PEER_VSCALE); }
        LDS_WAIT(); asm volatile("" ::: "memory");
        f32x2 acc[8];
#pragma unroll
        for (int j = 0; j < 8; ++j) acc[j] = (f32x2){0.f, 0.f};
        for (int i = 0; i < 16; ++i) {
            v4u rw[8];
#pragma unroll
            for (int k = 0; k < 8; ++k) rw[k] = *(const v4u*)(vt + (size_t)et[8 * i + k] * D + 16 * lane);
#pragma unroll
            for (int k = 0; k < 8; ++k) { f32x2 v[8]; fp8x16_to_f32(rw[k], v); const float cf = coefs[8 * i + k];
#pragma unroll
                for (int j = 0; j < 8; ++j) acc[j] += v[j] * cf; }
        }
        const float* g2 = mod + (size_t)(t >> 13) * 6 * D + 5 * D + 16 * lane; float* op = out + (size_t)t * D + 16 * lane;
#pragma unroll
        for (int j = 0; j < 4; ++j) { const f32x4 g = *(const f32x4*)(g2 + 4 * j); const f32x4 x1 = *(const f32x4*)(op + 4 * j);
            *(f32x4*)(op + 4 * j) = x1 + g * (f32x4){acc[2 * j].x, acc[2 * j].y, acc[2 * j + 1].x, acc[2 * j + 1].y}; }
        LDS_WAIT(); asm volatile("" ::: "memory");
    }
}

__device__ __forceinline__ void p4_attn_naive(Frame& F, const Args& a, int blk, int nblk) {
    unsigned char* ws = a.ws;
    const bf16* Q = (const bf16*)(ws + WS_Q); const bf16* K = (const bf16*)(ws + WS_K); const bf16* V = (const bf16*)(ws + WS_V);
    for (int gid = blk * 512 + F.tid; gid < BATCH * SBH * SEQ; gid += nblk * 512) {
        const int t = gid & (SEQ - 1), bh = gid >> 13, h = bh & 7, b = bh >> 3;
        const size_t row = (size_t)b * SEQ + t;
        float q[64], o[64];
#pragma unroll
        for (int i = 0; i < 8; ++i) { const v4u w = *(const v4u*)(Q + row * 512 + h * 64 + 8 * i);
            q[8 * i] = bflo(w.x); q[8 * i + 1] = bfhi(w.x); q[8 * i + 2] = bflo(w.y); q[8 * i + 3] = bfhi(w.y); q[8 * i + 4] = bflo(w.z); q[8 * i + 5] = bfhi(w.z); q[8 * i + 6] = bflo(w.w); q[8 * i + 7] = bfhi(w.w); }
#pragma unroll
        for (int i = 0; i < 64; ++i) o[i] = 0.f;
        float R = 0.f;
        for (int s = t - 1; s >= 0; --s) {
            const size_t kr = ((size_t)b * SEQ + s) * 512 + h * 64; float z = 0.f;
#pragma unroll
            for (int i = 0; i < 8; ++i) { const v4u w = *(const v4u*)(K + kr + 8 * i);
                z += q[8 * i] * bflo(w.x) + q[8 * i + 1] * bfhi(w.x) + q[8 * i + 2] * bflo(w.y) + q[8 * i + 3] * bfhi(w.y) + q[8 * i + 4] * bflo(w.z) + q[8 * i + 5] * bfhi(w.z) + q[8 * i + 6] * bflo(w.w) + q[8 * i + 7] * bfhi(w.w); }
            const float sp = softplusf(z); const float p = __expf(z - sp - R); R += sp;
#pragma unroll
            for (int i = 0; i < 8; ++i) { const v4u w = *(const v4u*)(V + kr + 8 * i);
                o[8 * i] += p * bflo(w.x); o[8 * i + 1] += p * bfhi(w.x); o[8 * i + 2] += p * bflo(w.y); o[8 * i + 3] += p * bfhi(w.y); o[8 * i + 4] += p * bflo(w.z); o[8 * i + 5] += p * bfhi(w.z); o[8 * i + 6] += p * bflo(w.w); o[8 * i + 7] += p * bfhi(w.w); }
            if (R > 105.f) break;
        }
        bf16* y = (bf16*)(ws + WS_YSB) + row * 512 + h * 64;
#pragma unroll
        for (int i = 0; i < 8; ++i) { v4u w; w.x = pk2(o[8 * i], o[8 * i + 1]); w.y = pk2(o[8 * i + 2], o[8 * i + 3]); w.z = pk2(o[8 * i + 4], o[8 * i + 5]); w.w = pk2(o[8 * i + 6], o[8 * i + 7]); *(v4u*)(y + 8 * i) = w; }
    }
}
__device__ __forceinline__ void p9_topk_naive(Frame& F, const Args& a) {
    unsigned char* ws = a.ws; const int tid = F.tid;
    const bf16* QP = (const bf16*)(ws + WS_QP); const bf16* SK = (const bf16*)(ws + WS_SKEY);
    LAS float* sv = (LAS float*)(F.lds + RING_OFF);
    LAS int* si = (LAS int*)(sv + 2 * 16 * 256);
    LAS int* ptr = si + 2 * 16 * 256;
    LAS unsigned short* keys = (LAS unsigned short*)(ptr + 16 * 256);
    const bool act = tid < 256;
    for (int it = blockIdx.x; it < (M / 256) * PH; it += F.G) {
        const int h = it & 7, t = (it >> 3) * 256 + (tid & 255);
        for (int p = 0; p < 2; ++p) {
            __syncthreads();
            for (int i = tid; i < 128 * 128 / 8; i += 512) ((LAS v4u*)keys)[i] = ((const v4u*)(SK + (size_t)(h * 2 + p) * 128 * 128))[i];
            __syncthreads();
            if (act) {
                unsigned qreg[64];
#pragma unroll
                for (int i = 0; i < 16; ++i) { const v4u w = *(const v4u*)(QP + (size_t)t * PQW + h * 256 + p * 128 + 8 * i); qreg[4 * i] = w.x; qreg[4 * i + 1] = w.y; qreg[4 * i + 2] = w.z; qreg[4 * i + 3] = w.w; }
                int cnt = 0;
                for (int key = 0; key < 128; ++key) {
                    float s = 0.f;
#pragma unroll
                    for (int i = 0; i < 16; ++i) { const v4u w = *(const LAS v4u*)(keys + key * 128 + 8 * i);
                        s += bflo(qreg[4 * i]) * bflo(w.x) + bfhi(qreg[4 * i]) * bfhi(w.x) + bflo(qreg[4 * i + 1]) * bflo(w.y) + bfhi(qreg[4 * i + 1]) * bfhi(w.y)
                           + bflo(qreg[4 * i + 2]) * bflo(w.z) + bfhi(qreg[4 * i + 2]) * bfhi(w.z) + bflo(qreg[4 * i + 3]) * bflo(w.w) + bfhi(qreg[4 * i + 3]) * bfhi(w.w); }
                    int pos = cnt < 16 ? cnt : 16;
                    while (pos > 0 && s > sv[(p * 16 + pos - 1) * 256 + tid]) { if (pos < 16) { sv[(p * 16 + pos) * 256 + tid] = sv[(p * 16 + pos - 1) * 256 + tid]; si[(p * 16 + pos) * 256 + tid] = si[(p * 16 + pos - 1) * 256 + tid]; } --pos; }
                    if (pos < 16) { sv[(p * 16 + pos) * 256 + tid] = s; si[(p * 16 + pos) * 256 + tid] = key; }
                    if (cnt < 16) ++cnt;
                }
            }
        }
        if (act) {
            for (int i = 0; i < 16; ++i) ptr[i * 256 + tid] = 0;
            float top[16]; int eid[16];
#pragma unroll
            for (int rnk = 0; rnk < 16; ++rnk) {
                float best = -INFINITY; int bi = 0;
                for (int i = 0; i < 16; ++i) { const int jj = ptr[i * 256 + tid]; if (jj < 16) { const float c = sv[i * 256 + tid] + sv[(16 + jj) * 256 + tid]; if (c > best) { best = c; bi = i; } } }
                const int bj = ptr[bi * 256 + tid]; ptr[bi * 256 + tid] = bj + 1;
                top[rnk] = best; eid[rnk] = si[bi * 256 + tid] * 128 + si[(16 + bj) * 256 + tid];
            }
            float mx = top[0], den = 0.f;
#pragma unroll
            for (int rnk = 0; rnk < 16; ++rnk) { top[rnk] = __expf(top[rnk] - mx); den += top[rnk]; }
            int* eo = (int*)(ws + WS_EIDX) + (size_t)t * 128 + h * 16; float* go = (float*)(ws + WS_GATE) + (size_t)t * 128 + h * 16;
#pragma unroll
            for (int rnk = 0; rnk < 16; ++rnk) { eo[rnk] = eid[rnk]; go[rnk] = top[rnk] / den; }
        }
    }
    __syncthreads();
}

constexpr int CH_BYTES = 40960, CH_W = 0, CH_QD = 8192, CH_QK = 16384, CH_KDT = 24576, CH_U = 32768;
constexpr int PST = 68;
typedef __attribute__((address_space(3))) float lf32;

__device__ __forceinline__ void store_afrag(const lf32* src, const lf32* rowscale, unsigned char* dst, int tid) {
    const int blk = tid >> 6, lane = tid & 63, mt = blk >> 1, ks = blk & 1, r = lane & 15, g = lane >> 4, row = 16 * mt + r, k0 = 32 * ks + 4 * g;
    f32x4 v0 = *(const LAS f32x4*)(src + row * PST + k0), v1 = *(const LAS f32x4*)(src + row * PST + k0 + 16);
    const float rs = rowscale ? rowscale[row] : 1.0f; v0 = v0 * rs; v1 = v1 * rs;
    v4u o; o.x = pk2(v0.x, v0.y); o.y = pk2(v0.z, v0.w); o.z = pk2(v1.x, v1.y); o.w = pk2(v1.z, v1.w);
    *(v4u*)(dst + tid * 16) = o;
}
__device__ __forceinline__ void store_afrag_T(const lf32* src, const lf32* kscale, unsigned char* dst, int tid) {
    const int blk = tid >> 6, lane = tid & 63, mt = blk >> 1, ks = blk & 1, r = lane & 15, g = lane >> 4, row = 16 * mt + r, k0 = 32 * ks + 4 * g;
    float v[8];
#pragma unroll
    for (int i = 0; i < 4; ++i) { v[i] = src[(k0 + i) * PST + row] * kscale[k0 + i]; v[4 + i] = src[(k0 + 16 + i) * PST + row] * kscale[k0 + 16 + i]; }
    v4u o; o.x = pk2(v[0], v[1]); o.y = pk2(v[2], v[3]); o.z = pk2(v[4], v[5]); o.w = pk2(v[6], v[7]);
    *(v4u*)(dst + tid * 16) = o;
}
__device__ __forceinline__ void store_cfrag(const lf32* src, unsigned char* dst, int tid) {
#pragma unroll
    for (int rep = 0; rep < 2; ++rep) { const int q = tid + 512 * rep, sm = q >> 6, lane = q & 63, sl = sm >> 2, mt = sm & 3, col = lane & 15, g = lane >> 4;
        const lf32* p = src + (16 * mt + 4 * g) * PST + 16 * sl + col;
        v2u o; o.x = pk2(p[0], p[PST]); o.y = pk2(p[2 * PST], p[3 * PST]); *(v2u*)(dst + q * 8) = o; }
}

__device__ __forceinline__ void p3_gdn_prep(Frame& F, const Args& a) {
    unsigned char* ws = a.ws; const int tid = F.tid;
    const bf16* graw = (const bf16*)(ws + WS_GRAW); const float* ab = (const float*)(ws + WS_AB); const float* cw = a.in[8];
    lf32* Qs = (lf32*)(F.lds + RING_OFF); lf32* Ks = Qs + 64 * PST; lf32* Vs = Ks + 64 * PST; lf32* As = Vs + 64 * PST; lf32* QKs = As + 64 * PST; lf32* Us = QKs + 64 * PST; lf32* Ws = Us + 64 * PST;
    lf32* vG = Ws + 64 * PST; lf32* vbeta = vG + 64; lf32* veG = vbeta + 64; lf32* veGl = veG + 64; lf32* vqn = veGl + 64; lf32* vkn = vqn + 64; lf32* vbw = vkn + 64;
    for (int it = blockIdx.x; it < BATCH * GH * (SEQ / 64); it += F.G) {
        const int n = it & 127, bh = it >> 7, h = bh & 7, b = bh >> 3; const size_t row0 = (size_t)b * SEQ + n * 64; const int tl0 = n * 64;
        __syncthreads();
        { const int c = tid & 63, tg = tid >> 6;
#pragma unroll
          for (int part = 0; part < 3; ++part) { const int ch = part * 512 + h * 64 + c; const bf16* src = graw + ch; lf32* dst = part == 0 ? Qs : part == 1 ? Ks : Vs;
              const float w0 = cw[ch], w1 = cw[1536 + ch], w2 = cw[2 * 1536 + ch], w3 = cw[3 * 1536 + ch];
              float xv[11];
#pragma unroll
              for (int i = 0; i < 11; ++i) { const int tt = tl0 + 8 * tg - 3 + i; xv[i] = tt >= 0 ? bf2f(src[(row0 + 8 * tg - 3 + i) * 1536]) : 0.f; }
#pragma unroll
              for (int i = 0; i < 8; ++i) dst[(8 * tg + i) * PST + c] = siluf(w0 * xv[i] + w1 * xv[i + 1] + w2 * xv[i + 2] + w3 * xv[i + 3]); } }
        __syncthreads();
        if (tid < 128) { const int row = tid & 63; const lf32* src = (tid < 64 ? Qs : Ks) + row * PST; float ss = 0.f;
#pragma unroll
            for (int i = 0; i < 16; ++i) { const f32x4 v = *(const LAS f32x4*)(src + 4 * i); ss += (v.x * v.x + v.y * v.y) + (v.z * v.z + v.w * v.w); }
            const float inv = 1.0f / sqrtf(ss + EPS); if (tid < 64) vqn[row] = inv * 0.125f; else vkn[row] = inv; }
        else if (tid < 192) { const int t = tid & 63; const float av = ab[(row0 + t) * 16 + h], bv = ab[(row0 + t) * 16 + 8 + h];
            const float g = -__expf(a.in[9][h]) * softplusf(av + a.in[10][h]); float G = g;
#pragma unroll
            for (int o = 1; o < 64; o <<= 1) { const float up = __shfl_up(G, o); if (t >= o) G += up; }
            const float Gl = __shfl(G, 63);
            vG[t] = G; { const float be = sigm(bv); vbeta[t] = be; vbw[t] = be * __expf(G); } veG[t] = __expf(G); veGl[t] = __expf(Gl - G);
            if (t == 63) ((float*)(ws + WS_CD))[it] = __expf(Gl); }
        __syncthreads();
        { const int c = tid & 63, tg = tid >> 6;
#pragma unroll
          for (int i = 0; i < 8; ++i) { const int t = 8 * tg + i; Qs[t * PST + c] *= vqn[t]; Ks[t * PST + c] *= vkn[t]; } }
        __syncthreads();
        { const int c = tid >> 3, sg = tid & 7; float kk[8], qk[8];
#pragma unroll
          for (int j = 0; j < 8; ++j) { kk[j] = 0.f; qk[j] = 0.f; }
#pragma unroll 4
          for (int i = 0; i < 16; ++i) { const f32x4 kc = *(const LAS f32x4*)(Ks + c * PST + 4 * i), qc = *(const LAS f32x4*)(Qs + c * PST + 4 * i);
#pragma unroll
              for (int j = 0; j < 8; ++j) { const f32x4 kv = *(const LAS f32x4*)(Ks + (sg + 8 * j) * PST + 4 * i);
                  kk[j] += (kc.x * kv.x + kc.y * kv.y) + (kc.z * kv.z + kc.w * kv.w); qk[j] += (qc.x * kv.x + qc.y * kv.y) + (qc.z * kv.z + qc.w * kv.w); } }
          const float Gc = vG[c], bc = vbeta[c];
#pragma unroll
          for (int j = 0; j < 8; ++j) { const int s = sg + 8 * j; const float dec = __expf(fminf(Gc - vG[s], 0.f));
              As[c * PST + s] = (c > s) ? bc * kk[j] * dec : 0.f; QKs[c * PST + s] = (c >= s) ? qk[j] * dec : 0.f; } }
        __syncthreads();
        if (tid < 128) { const int j = tid & 63; const bool isw = tid >= 64; const lf32* src = isw ? Ks : Vs; const lf32* sc = isw ? vbw : vbeta; float x[64];
#pragma unroll
            for (int i = 0; i < 64; ++i) { float acc = src[i * PST + j] * sc[i];
#pragma unroll
                for (int jj = 0; jj < (i & ~3); jj += 4) { const f32x4 av = *(const LAS f32x4*)(As + i * PST + jj); acc -= av.x * x[jj]; acc -= av.y * x[jj + 1]; acc -= av.z * x[jj + 2]; acc -= av.w * x[jj + 3]; }
                if (i & 3) { const f32x4 av = *(const LAS f32x4*)(As + i * PST + (i & ~3)); acc -= av.x * x[(i & ~3)]; if ((i & 3) > 1) acc -= av.y * x[(i & ~3) + 1]; if ((i & 3) > 2) acc -= av.z * x[(i & ~3) + 2]; }
                x[i] = acc; asm volatile("" ::: "memory"); }
            lf32* dst = isw ? Ws : Us;
#pragma unroll
            for (int i = 0; i < 64; ++i) dst[i * PST + j] = x[i]; }
        __syncthreads();
        { unsigned char* ch = ws + WS_CH + (size_t)it * CH_BYTES;
          store_afrag(Ws, nullptr, ch + CH_W, tid); store_afrag(Qs, veG, ch + CH_QD, tid); store_afrag(QKs, nullptr, ch + CH_QK, tid); store_afrag_T(Ks, veGl, ch + CH_KDT, tid); store_cfrag(Us, ch + CH_U, tid); }
    }
    __syncthreads();
}

__device__ __forceinline__ void p3_qknorm(Frame& F, const Args& a) {
    unsigned char* ws = a.ws; const int lane = F.lane;
    const int gw = blockIdx.x * NWAVES + F.wave, NGW = F.G * NWAVES;
    const float* qnw = a.in[6]; const float* knw = a.in[7];
    for (int t = gw; t < M; t += NGW) {
#pragma unroll
        for (int which = 0; which < 2; ++which) {
            bf16* p = (bf16*)(ws + (which ? WS_K : WS_Q)) + (size_t)t * 512 + 8 * lane; const float* nw = which ? knw : qnw;
            const v4u w = *(const v4u*)p; float v[8] = {bflo(w.x), bfhi(w.x), bflo(w.y), bfhi(w.y), bflo(w.z), bfhi(w.z), bflo(w.w), bfhi(w.w)};
            float s = 0.f;
#pragma unroll
            for (int i = 0; i < 8; ++i) s += v[i] * v[i];
            s += __shfl_xor(s, 1); s += __shfl_xor(s, 2); s += __shfl_xor(s, 4);
            const float r = 1.0f / sqrtf(s * (1.f / 64.f) + EPS) * (which ? 1.0f : 0.125f);
            const int d0 = (8 * lane) & 63;
#pragma unroll
            for (int i = 0; i < 8; ++i) v[i] = v[i] * r * nw[d0 + i];
            v4u o; o.x = pk2(v[0], v[1]); o.y = pk2(v[2], v[3]); o.z = pk2(v[4], v[5]); o.w = pk2(v[6], v[7]); *(v4u*)p = o;
        }
    }
}

__device__ __forceinline__ bf16x8 pack8(const f32x4& x, const f32x4& y) { v4u w; w.x = pg8::cvt_pk_bf16(x.x, x.y); w.y = pg8::cvt_pk_bf16(x.z, x.w); w.z = pg8::cvt_pk_bf16(y.x, y.y); w.w = pg8::cvt_pk_bf16(y.z, y.w); return __builtin_bit_cast(bf16x8, w); }
constexpr int OST = 68;
constexpr int SC_OP = 0, SC_OB = 2 * CH_BYTES;
__device__ __forceinline__ void scan_load(v4u (&set)[10], const unsigned char* ch, int ht) {
#pragma unroll
    for (int r = 0; r < 10; ++r) set[r] = *(const v4u*)(ch + (r * 256 + ht) * 16);
}
__device__ __forceinline__ void scan_put(const v4u (&set)[10], LAS unsigned char* dst, int ht) {
#pragma unroll
    for (int r = 0; r < 10; ++r) *(LAS v4u*)(dst + (r * 256 + ht) * 16) = set[r];
}
__device__ __forceinline__ void scan_post(const lf32* ob, const bf16* Z, bf16* Y, const float* onw, size_t row0, int h, int ht) {
    const int row = ht >> 2, q4 = ht & 3; const lf32* p = ob + row * OST + 16 * q4; f32x4 o[4]; float ss = 0.f;
#pragma unroll
    for (int i = 0; i < 4; ++i) { o[i] = *(const LAS f32x4*)(p + 4 * i); ss += (o[i].x * o[i].x + o[i].y * o[i].y) + (o[i].z * o[i].z + o[i].w * o[i].w); }
    ss += __shfl_xor(ss, 1); ss += __shfl_xor(ss, 2);
    const float rstd = 1.0f / sqrtf(ss * (1.f / 64.f) + EPS);
    const size_t off = (row0 + row) * 512 + h * 64 + 16 * q4;
    const v4u z0 = *(const v4u*)(Z + off), z1 = *(const v4u*)(Z + off + 8);
    const float zz[16] = {bflo(z0.x), bfhi(z0.x), bflo(z0.y), bfhi(z0.y), bflo(z0.z), bfhi(z0.z), bflo(z0.w), bfhi(z0.w), bflo(z1.x), bfhi(z1.x), bflo(z1.y), bfhi(z1.y), bflo(z1.z), bfhi(z1.z), bflo(z1.w), bfhi(z1.w)};
    float y[16];
#pragma unroll
    for (int i = 0; i < 4; ++i) { const f32x4 w = *(const f32x4*)(onw + 16 * q4 + 4 * i);
        y[4 * i] = o[i].x * rstd * w.x * siluf(zz[4 * i]); y[4 * i + 1] = o[i].y * rstd * w.y * siluf(zz[4 * i + 1]); y[4 * i + 2] = o[i].z * rstd * w.z * siluf(zz[4 * i + 2]); y[4 * i + 3] = o[i].w * rstd * w.w * siluf(zz[4 * i + 3]); }
    v4u w0, w1; w0.x = pk2(y[0], y[1]); w0.y = pk2(y[2], y[3]); w0.z = pk2(y[4], y[5]); w0.w = pk2(y[6], y[7]); w1.x = pk2(y[8], y[9]); w1.y = pk2(y[10], y[11]); w1.z = pk2(y[12], y[13]); w1.w = pk2(y[14], y[15]);
    *(v4u*)(Y + off) = w0; *(v4u*)(Y + off + 8) = w1;
}
__device__ __forceinline__ void scan_step(LAS unsigned char* lds, f32x4 (&S)[4], float cdv, int n, int sl, int lane) {
    const LAS unsigned char* ob = lds + SC_OP + (n & 1) * CH_BYTES; lf32* ot = (lf32*)(lds + SC_OB) + (n & 1) * 64 * OST;
    const f32x4 zero = {0.f, 0.f, 0.f, 0.f};
    const bf16x8 Sb0 = pack8(S[0], S[1]), Sb1 = pack8(S[2], S[3]);
    f32x4 vn[4], o[4];
#pragma unroll
    for (int mt = 0; mt < 4; ++mt) { const bf16x8 a0 = *(const LAS bf16x8*)(ob + CH_W + (mt * 2) * 1024 + lane * 16), a1 = *(const LAS bf16x8*)(ob + CH_W + (mt * 2 + 1) * 1024 + lane * 16);
        f32x4 acc = __builtin_amdgcn_mfma_f32_16x16x32_bf16(a0, Sb0, zero, 0, 0, 0); acc = __builtin_amdgcn_mfma_f32_16x16x32_bf16(a1, Sb1, acc, 0, 0, 0);
        const v2u uu = *(const LAS v2u*)(ob + CH_U + ((sl * 4 + mt) * 64 + lane) * 8);
        vn[mt] = (f32x4){bflo(uu.x), bfhi(uu.x), bflo(uu.y), bfhi(uu.y)} - acc; }
    const bf16x8 Vb0 = pack8(vn[0], vn[1]), Vb1 = pack8(vn[2], vn[3]);
#pragma unroll
    for (int mt = 0; mt < 4; ++mt) { const bf16x8 q0 = *(const LAS bf16x8*)(ob + CH_QD + (mt * 2) * 1024 + lane * 16), q1 = *(const LAS bf16x8*)(ob + CH_QD + (mt * 2 + 1) * 1024 + lane * 16);
        const bf16x8 k0 = *(const LAS bf16x8*)(ob + CH_QK + (mt * 2) * 1024 + lane * 16), k1 = *(const LAS bf16x8*)(ob + CH_QK + (mt * 2 + 1) * 1024 + lane * 16);
        f32x4 acc = __builtin_amdgcn_mfma_f32_16x16x32_bf16(q0, Sb0, zero, 0, 0, 0); acc = __builtin_amdgcn_mfma_f32_16x16x32_bf16(q1, Sb1, acc, 0, 0, 0);
        acc = __builtin_amdgcn_mfma_f32_16x16x32_bf16(k0, Vb0, acc, 0, 0, 0); acc = __builtin_amdgcn_mfma_f32_16x16x32_bf16(k1, Vb1, acc, 0, 0, 0); o[mt] = acc; }
#pragma unroll
    for (int mt = 0; mt < 4; ++mt) { const bf16x8 t0 = *(const LAS bf16x8*)(ob + CH_KDT + (mt * 2) * 1024 + lane * 16), t1 = *(const LAS bf16x8*)(ob + CH_KDT + (mt * 2 + 1) * 1024 + lane * 16);
        f32x4 acc = S[mt] * cdv; acc = __builtin_amdgcn_mfma_f32_16x16x32_bf16(t0, Vb0, acc, 0, 0, 0); acc = __builtin_amdgcn_mfma_f32_16x16x32_bf16(t1, Vb1, acc, 0, 0, 0); S[mt] = acc; }
    const int col = lane & 15, g = lane >> 4;
#pragma unroll
    for (int mt = 0; mt < 4; ++mt) { lf32* p = ot + (16 * mt + 4 * g) * OST + 16 * sl + col; p[0] = o[mt].x; p[OST] = o[mt].y; p[2 * OST] = o[mt].z; p[3 * OST] = o[mt].w; }
}
__device__ __forceinline__ void p4_gdn_scan(Frame& F, const Args& a, int bh) {
    unsigned char* ws = a.ws; const int h = bh & 7, b = bh >> 3, wave = F.wave, lane = F.lane, ht = F.tid - 256;
    const unsigned char* chb = ws + WS_CH + (size_t)bh * 128 * CH_BYTES; const float* cd = (const float*)(ws + WS_CD) + bh * 128;
    const bf16* Z = (const bf16*)(ws + WS_Z); bf16* Y = (bf16*)(ws + WS_YGDN); const float* onw = a.in[11];
    LAS unsigned char* lds = F.lds + RING_OFF; const size_t rowb = (size_t)b * SEQ;
    f32x4 S[4] = {(f32x4){0.f, 0.f, 0.f, 0.f}, (f32x4){0.f, 0.f, 0.f, 0.f}, (f32x4){0.f, 0.f, 0.f, 0.f}, (f32x4){0.f, 0.f, 0.f, 0.f}};
    v4u setA[10], setB[10];
    __syncthreads();
    if (wave >= 4) { scan_load(setA, chb, ht); scan_put(setA, lds + SC_OP, ht); scan_load(setA, chb + CH_BYTES, ht); scan_load(setB, chb + 2 * CH_BYTES, ht); }
    __syncthreads();
    for (int n = 0; n < 128; n += 2) {
        if (wave < 4) scan_step(lds, S, cd[n], n, wave, lane);
        else { scan_put(setA, lds + SC_OP + CH_BYTES, ht); if (n + 3 < 128) scan_load(setA, chb + (size_t)(n + 3) * CH_BYTES, ht);
               if (n >= 1) scan_post((const lf32*)(lds + SC_OB) + 64 * OST, Z, Y, onw, rowb + (size_t)(n - 1) * 64, h, ht); }
        __syncthreads();
        if (wave < 4) scan_step(lds, S, cd[n + 1], n + 1, wave, lane);
        else { if (n + 2 < 128) scan_put(setB, lds + SC_OP, ht); if (n + 4 < 128) scan_load(setB, chb + (size_t)(n + 4) * CH_BYTES, ht);
               scan_post((const lf32*)(lds + SC_OB), Z, Y, onw, rowb + (size_t)n * 64, h, ht); }
        __syncthreads();
    }
    if (wave >= 4) scan_post((const lf32*)(lds + SC_OB) + 64 * OST, Z, Y, onw, rowb + (size_t)127 * 64, h, ht);
    __syncthreads();
}

typedef float f32x16 __attribute__((ext_vector_type(16)));
constexpr int TK_KROW = 272;
constexpr int TK_KEYS = 0, TK_LIST = 2 * 128 * TK_KROW;
__device__ __forceinline__ unsigned f2ord(float f) { const unsigned u = __float_as_uint(f); return u ^ ((unsigned)((int)u >> 31) | 0x80000000u); }
__device__ __forceinline__ float ord2f(unsigned o) { const unsigned u = (o & 0x80000000u) ? (o ^ 0x80000000u) : ~o; return __uint_as_float(u); }
#define TK_CE(a, b) do { const unsigned _h = max(a, b), _l = min(a, b); a = _h; b = _l; } while (0)
__device__ __forceinline__ void sort16(unsigned (&v)[16]) {
#pragma unroll
    for (int k = 2; k <= 16; k <<= 1)
#pragma unroll
        for (int j = k >> 1; j > 0; j >>= 1)
#pragma unroll
            for (int i = 0; i < 16; ++i) { const int l = i ^ j; if (l > i) { if ((i & k) == 0) TK_CE(v[i], v[l]); else TK_CE(v[l], v[i]); } }
}
__device__ __forceinline__ void merge16(unsigned (&a)[16], const unsigned (&b)[16]) {
#pragma unroll
    for (int i = 0; i < 16; ++i) a[i] = max(a[i], b[15 - i]);
#pragma unroll
    for (int j = 8; j > 0; j >>= 1)
#pragma unroll
        for (int i = 0; i < 16; ++i) { const int l = i ^ j; if (l > i) TK_CE(a[i], a[l]); }
}
__device__ __forceinline__ void p9_topk(Frame& F, const Args& a) {
    unsigned char* ws = a.ws; const int tid = F.tid, lane = F.lane, wave = F.wave, tk = lane & 31, half = lane >> 5;
    const bf16* QP = (const bf16*)(ws + WS_QP); const bf16* SK = (const bf16*)(ws + WS_SKEY);
    LAS unsigned char* kl = F.lds + RING_OFF + TK_KEYS; LAS unsigned* lst = (LAS unsigned*)(F.lds + RING_OFF + TK_LIST) + wave * 1024;
    for (int it = blockIdx.x; it < (M / 256) * PH; it += F.G) {
        const int h = it & 7, t = (it >> 3) * 256 + wave * 32 + tk;
        __syncthreads();
        for (int i = tid; i < 2 * 128 * 16; i += 512) { const int row = i >> 4, c = i & 15; *(LAS v4u*)(kl + row * TK_KROW + c * 16) = *(const v4u*)(SK + (size_t)h * 2 * 128 * 128 + row * 128 + c * 8); }
        __syncthreads();
        unsigned top[2][16];
#pragma unroll
        for (int p = 0; p < 2; ++p) {
            bf16x8 qf[8];
#pragma unroll
            for (int ks = 0; ks < 8; ++ks) qf[ks] = *(const bf16x8*)(QP + (size_t)t * PQW + h * 256 + p * 128 + 16 * ks + 8 * half);
            unsigned best[16];
#pragma unroll
            for (int mt = 0; mt < 4; ++mt) {
                f32x16 acc = {0.f, 0.f, 0.f, 0.f, 0.f, 0.f, 0.f, 0.f, 0.f, 0.f, 0.f, 0.f, 0.f, 0.f, 0.f, 0.f};
#pragma unroll
                for (int ks = 0; ks < 8; ++ks) { const bf16x8 kf = *(const LAS bf16x8*)(kl + (p * 128 + mt * 32 + tk) * TK_KROW + ks * 32 + half * 16);
                    acc = __builtin_amdgcn_mfma_f32_32x32x16_bf16(kf, qf[ks], acc, 0, 0, 0); }
                unsigned g[16];
#pragma unroll
                for (int r = 0; r < 16; ++r) { const int key = 32 * mt + (r & 3) + 8 * (r >> 2) + 4 * half; g[r] = (f2ord(acc[r]) & ~127u) | (unsigned)(127 - key); }
                sort16(g);
                if (mt == 0) {
#pragma unroll
                    for (int r = 0; r < 16; ++r) best[r] = g[r]; }
                else merge16(best, g);
            }
            unsigned oth[16];
#pragma unroll
            for (int r = 0; r < 16; ++r) oth[r] = __shfl_xor(best[r], 32);
            merge16(best, oth);
#pragma unroll
            for (int r = 0; r < 16; ++r) top[p][r] = best[r];
        }
        if (half == 0) {
#pragma unroll
            for (int r = 0; r < 16; ++r) { lst[tk * 32 + r] = top[0][r]; lst[tk * 32 + 16 + r] = top[1][r]; } }
        float v1[16], v2[16];
#pragma unroll
        for (int r = 0; r < 16; ++r) { v1[r] = ord2f(top[0][r] & ~127u); v2[r] = ord2f(top[1][r] & ~127u); }
        unsigned c0[16], c1[16], c2[16], c3[16];
#pragma unroll
        for (int j = 0; j < 16; ++j) c0[j] = (f2ord(v1[0] + v2[j]) & ~255u) | (unsigned)(255 - j);
        { int n = 0;
#pragma unroll
          for (int i = 1; i < 16; ++i)
#pragma unroll
              for (int j = 0; j < 16; ++j) if ((i + 1) * (j + 1) <= 16) { const unsigned pk = (f2ord(v1[i] + v2[j]) & ~255u) | (unsigned)(255 - (i * 16 + j));
                  if (n < 16) c1[n] = pk; else if (n < 32) c2[n - 16] = pk; else c3[n - 32] = pk; ++n; }
#pragma unroll
          for (int r = 2; r < 16; ++r) c3[r] = 0u; }
        sort16(c1); sort16(c2); sort16(c3); merge16(c0, c1); merge16(c2, c3); merge16(c0, c2);
        LDS_WAIT(); asm volatile("" ::: "memory");
        float sm[16]; int eid[16];
#pragma unroll
        for (int r = 0; r < 16; ++r) { const int cid = 255 - (int)(c0[r] & 255u), i = cid >> 4, j = cid & 15;
            const unsigned p1 = lst[tk * 32 + i], p2 = lst[tk * 32 + 16 + j];
            sm[r] = ord2f(p1 & ~127u) + ord2f(p2 & ~127u); eid[r] = (127 - (int)(p1 & 127u)) * 128 + (127 - (int)(p2 & 127u)); }
        float den = 0.f; const float mx = sm[0];
#pragma unroll
        for (int r = 0; r < 16; ++r) { sm[r] = __expf(sm[r] - mx); den += sm[r]; }
        const float inv = 1.0f / den;
        if (half == 0) { int* eo = (int*)(ws + WS_EIDX) + (size_t)t * 128 + h * 16;
#pragma unroll
            for (int r = 0; r < 16; r += 4) *(v4u*)(eo + r) = (v4u){(unsigned)eid[r], (unsigned)eid[r + 1], (unsigned)eid[r + 2], (unsigned)eid[r + 3]}; }
        else { float* go = (float*)(ws + WS_GATE) + (size_t)t * 128 + h * 16;
#pragma unroll
            for (int r = 0; r < 16; r += 4) *(f32x4*)(go + r) = (f32x4){sm[r] * inv, sm[r + 1] * inv, sm[r + 2] * inv, sm[r + 3] * inv}; }
    }
    __syncthreads();
}

__device__ __forceinline__ float softplus_fast(float x) { return fmaxf(x, 0.f) + __logf(1.0f + __expf(-fabsf(x))); }
struct AttnTile { bf16x8 k[4]; v2u v[2][2][2]; };
__device__ __forceinline__ void attn_load(AttnTile& T, const bf16* Kb, const bf16* VTb, int key0, int tk, int half) {
#pragma unroll
    for (int ks = 0; ks < 4; ++ks) T.k[ks] = *(const bf16x8*)(Kb + (size_t)(key0 + tk) * 512 + 16 * ks + 8 * half);
#pragma unroll
    for (int mt = 0; mt < 2; ++mt)
#pragma unroll
        for (int s = 0; s < 2; ++s) { const bf16* p = VTb + (size_t)(32 * mt + tk) * SEQ + key0 + 16 * s + 4 * half; T.v[mt][s][0] = *(const v2u*)p; T.v[mt][s][1] = *(const v2u*)(p + 8); }
}
__device__ __forceinline__ void p4_attn(Frame& F, const Args& a, int blk, int nblk) {
    unsigned char* ws = a.ws; const int lane = F.lane, tk = lane & 31, half = lane >> 5;
    const bf16* Q = (const bf16*)(ws + WS_Q); const bf16* K = (const bf16*)(ws + WS_K); const bf16* VT = (const bf16*)(ws + WS_V); bf16* Y = (bf16*)(ws + WS_YSB);
    const int gwv = blk * NWAVES + F.wave, nwv = nblk * NWAVES;
    for (int u = gwv; u < BATCH * SBH * (SEQ / 32); u += nwv) {
        const int bh = u & 15, qt = u >> 4, b = bh >> 3, h = bh & 7;
        const bf16* Kb = K + (size_t)b * SEQ * 512 + h * 64; const bf16* VTb = VT + (size_t)bh * 64 * SEQ;
        bf16x8 qf[4];
#pragma unroll
        for (int ks = 0; ks < 4; ++ks) qf[ks] = *(const bf16x8*)(Q + ((size_t)b * SEQ + qt * 32 + tk) * 512 + h * 64 + 16 * ks + 8 * half);
        f32x16 o0 = {0.f, 0.f, 0.f, 0.f, 0.f, 0.f, 0.f, 0.f, 0.f, 0.f, 0.f, 0.f, 0.f, 0.f, 0.f, 0.f}, o1 = o0; const f32x16 zero16 = o0;
        float R = 0.f;
        AttnTile cur, nxt; attn_load(cur, Kb, VTb, qt * 32, tk, half);
        for (int kt = qt; kt >= 0; --kt) {
            if (kt > 0) attn_load(nxt, Kb, VTb, (kt - 1) * 32, tk, half);
            f32x16 z = __builtin_amdgcn_mfma_f32_32x32x16_bf16(cur.k[0], qf[0], zero16, 0, 0, 0);
            z = __builtin_amdgcn_mfma_f32_32x32x16_bf16(cur.k[1], qf[1], z, 0, 0, 0); z = __builtin_amdgcn_mfma_f32_32x32x16_bf16(cur.k[2], qf[2], z, 0, 0, 0); z = __builtin_amdgcn_mfma_f32_32x32x16_bf16(cur.k[3], qf[3], z, 0, 0, 0);
            const bool diag = (kt == qt);
            float sp[16], T[4];
#pragma unroll
            for (int r = 0; r < 16; ++r) { const int key = (r & 3) + 8 * (r >> 2) + 4 * half; const bool valid = !diag || key < tk; sp[r] = valid ? softplus_fast(z[r]) : 0.f; }
#pragma unroll
            for (int g = 0; g < 4; ++g) T[g] = (sp[4 * g] + sp[4 * g + 1]) + (sp[4 * g + 2] + sp[4 * g + 3]);
            float PT[4];
#pragma unroll
            for (int g = 0; g < 4; ++g) PT[g] = __shfl_xor(T[g], 32);
            float later[4]; later[3] = half ? 0.f : PT[3];
#pragma unroll
            for (int g = 2; g >= 0; --g) later[g] = later[g + 1] + T[g + 1] + (half ? PT[g + 1] : PT[g]);
            const float total = ((T[0] + T[1]) + (T[2] + T[3])) + ((PT[0] + PT[1]) + (PT[2] + PT[3]));
            float p[16];
#pragma unroll
            for (int g = 0; g < 4; ++g) { float c = R + later[g];
#pragma unroll
                for (int j = 3; j >= 0; --j) { const int r = 4 * g + j; const int key = (r & 3) + 8 * (r >> 2) + 4 * half; const bool valid = !diag || key < tk;
                    p[r] = valid ? __expf(z[r] - sp[r] - c) : 0.f; c += sp[r]; } }
            R += total;
            const bf16x8 pb0 = pack8((f32x4){p[0], p[1], p[2], p[3]}, (f32x4){p[4], p[5], p[6], p[7]}), pb1 = pack8((f32x4){p[8], p[9], p[10], p[11]}, (f32x4){p[12], p[13], p[14], p[15]});
#define VFRAG(mt, s) __builtin_bit_cast(bf16x8, (v4u){cur.v[mt][s][0].x, cur.v[mt][s][0].y, cur.v[mt][s][1].x, cur.v[mt][s][1].y})
            o0 = __builtin_amdgcn_mfma_f32_32x32x16_bf16(VFRAG(0, 0), pb0, o0, 0, 0, 0); o0 = __builtin_amdgcn_mfma_f32_32x32x16_bf16(VFRAG(0, 1), pb1, o0, 0, 0, 0);
            o1 = __builtin_amdgcn_mfma_f32_32x32x16_bf16(VFRAG(1, 0), pb0, o1, 0, 0, 0); o1 = __builtin_amdgcn_mfma_f32_32x32x16_bf16(VFRAG(1, 1), pb1, o1, 0, 0, 0);
#undef VFRAG
            if (__all(R > 105.f)) break;
            cur = nxt;
        }
        bf16* yp = Y + ((size_t)b * SEQ + qt * 32 + tk) * 512 + h * 64 + 4 * half;
#pragma unroll
        for (int g = 0; g < 4; ++g) { v2u w0, w1; w0.x = pk2(o0[4 * g], o0[4 * g + 1]); w0.y = pk2(o0[4 * g + 2], o0[4 * g + 3]); w1.x = pk2(o1[4 * g], o1[4 * g + 1]); w1.y = pk2(o1[4 * g + 2], o1[4 * g + 3]);
            *(v2u*)(yp + 8 * g) = w0; *(v2u*)(yp + 32 + 8 * g) = w1; }
    }
}
__global__ void __launch_bounds__(NWAVES * 64, 2) mk_fwd(Args args) {
    extern __shared__ __attribute__((aligned(16))) unsigned char lds[];
    Frame F;
    F.lds = (LAS unsigned char*)lds;
    F.MISC = (volatile LAS unsigned*)(F.lds + MISC_OFF);
    F.tid = threadIdx.x; F.lane = F.tid & 63; F.wave = __builtin_amdgcn_readfirstlane(F.tid >> 6);
    F.G = gridDim.x;
    unsigned char* ws = args.ws;
    F.ctl = (gu32*)(ws + WS_CTL);
    for (int u = F.tid; u < (LDS_BYTES - LDSCTL_OFF) / 4; u += NWAVES * 64) ((LAS unsigned*)(F.lds + LDSCTL_OFF))[u] = 0u;
    __syncthreads();
    const bool multi = (args.ph_hi - args.ph_lo) > 1;
    XcdBarrier bar; bar.bar = (unsigned*)(F.ctl + CW_BAR); bar.x = 0; bar.st = nullptr;
    if (multi) bar = xcd_barrier_post((unsigned*)(F.ctl + CW_BAR), F.MISC + 8);
    const int lo = args.ph_lo, hi = args.ph_hi;
#define IN(k) (lo <= (k) && (k) < hi)
#define SEAM(k) do { if (IN(k) && (k) + 1 < hi) xcd_barrier(bar); } while (0)
    const float* mod = (const float*)(ws + WS_MOD);

    if (IN(0)) { p0_prologue(F, args); } SEAM(0);
    if (IN(1)) { norm_mod_rows(F, args.in[0], args.in[4], mod, 0, (bf16*)(ws + WS_XN)); } SEAM(1);
    if (IN(2)) {
        pg8::Gemm g{(const bf16*)(ws + WS_XN), (const bf16*)(ws + WS_WIN), M, INWP, D}; pg8::StaticOrder S; S.init(M, INWP, F.G, (int)blockIdx.x);
        pg8::EpiInProj E{(bf16*)(ws + WS_Q), (bf16*)(ws + WS_K), (bf16*)(ws + WS_V), (bf16*)(ws + WS_GRAW), (bf16*)(ws + WS_Z), (bf16*)args.out, (float*)(ws + WS_AB)};
        pg8::gemm_phase<pg8::EpiInProj, pg8::StaticOrder, true, true>(F.lds + RING_OFF, g, S, E);
    } SEAM(2);
    if (IN(3)) { p3_gdn_prep(F, args); p3_qknorm(F, args); } SEAM(3);
    if (IN(4)) { if (blockIdx.x < BATCH * GH) p4_gdn_scan(F, args, (int)blockIdx.x); else { p4_attn(F, args, (int)blockIdx.x - BATCH * GH, F.G - BATCH * GH); peer_tables_to_fp8(args, (int)blockIdx.x - BATCH * GH, F.G - BATCH * GH, F.tid); } } SEAM(4);
    if (IN(5)) {
        { pg8::Gemm g{(const bf16*)(ws + WS_YSB), (const bf16*)(ws + WS_WSB), M, D, 512}; pg8::StaticOrder S; S.init(M, D, F.G, (int)blockIdx.x);
          pg8::EpiMerge<0> E{(const bf16*)args.out, (bf16*)(ws + WS_MERGED)};
          pg8::gemm_phase<pg8::EpiMerge<0>, pg8::StaticOrder, true, true>(F.lds + RING_OFF, g, S, E); }
        VM_WAIT(); __syncthreads();
        if (F.tid == 0) { __builtin_amdgcn_fence(__ATOMIC_ACQ_REL, "agent"); VM_WAIT(); }
        __syncthreads();
        { pg8::Gemm g{(const bf16*)(ws + WS_YGDN), (const bf16*)(ws + WS_WGDN), M, D, 512}; pg8::StaticOrder S; S.init(M, D, F.G, (int)blockIdx.x);
          pg8::EpiMerge<1> E{(const bf16*)args.out, (bf16*)(ws + WS_MERGED)};
          pg8::gemm_phase<pg8::EpiMerge<1>, pg8::StaticOrder, true, true>(F.lds + RING_OFF, g, S, E); }
    } SEAM(5);
    if (IN(6)) {
        pg8::Gemm g{(const bf16*)(ws + WS_MERGED), (const bf16*)(ws + WS_WO), M, D, D}; pg8::StaticOrder S; S.init(M, D, F.G, (int)blockIdx.x);
        pg8::EpiWo E{args.in[0], mod, args.out};
        pg8::gemm_phase<pg8::EpiWo, pg8::StaticOrder, true, true>(F.lds + RING_OFF, g, S, E);
    } SEAM(6);
    if (IN(7)) { norm_mod_rows(F, args.out, args.in[15], mod, 3, (bf16*)(ws + WS_XN)); } SEAM(7);
    if (IN(8)) {
        pg8::Gemm g{(const bf16*)(ws + WS_XN), (const bf16*)(ws + WS_WQ), M, PQW, D}; pg8::StaticOrder S; S.init(M, PQW, F.G, (int)blockIdx.x);
        pg8::EpiBf16<0> E{(bf16*)(ws + WS_QP), PQW, nullptr, 0, 0, 1.f};
        pg8::gemm_phase<pg8::EpiBf16<0>, pg8::StaticOrder, true, true>(F.lds + RING_OFF, g, S, E);
    } SEAM(8);
    if (IN(9)) { p9_topk(F, args); } SEAM(9);
    if (IN(10)) { p10_peer(F, args); }
#undef IN
#undef SEAM
}
extern "C" void kernel_launch(void* const* d_in, const int* in_sizes, int n_in, void* d_out, int out_size, void* d_ws, size_t ws_size, hipStream_t stream) {
    static int grid = 0;
    if (grid == 0) {
        if (n_in != 20 || out_size != M * D || ws_size < WS_END) { fprintf(stderr, "kernel_launch: unexpected shapes n_in %d out %d ws %zu\n", n_in, out_size, ws_size); grid = -1; return; }
        int dev = 0, cus = 0;
        if (hipGetDevice(&dev) != hipSuccess || hipDeviceGetAttribute(&cus, hipDeviceAttributeMultiprocessorCount, dev) != hipSuccess) { grid = -1; return; }
        if (hipFuncSetAttribute((const void*)mk_fwd, hipFuncAttributeMaxDynamicSharedMemorySize, LDS_BYTES) != hipSuccess) { fprintf(stderr, "kernel_launch: hipFuncSetAttribute failed\n"); grid = -1; return; }
        (void)hipGetLastError();
        grid = cus;
    }
    if (grid < 0) return;
    (void)hipMemsetAsync((char*)d_ws + WS_CTL, 0, CTL_ZERO_BYTES, stream);
    Args a{};
    for (int i = 0; i < 20; ++i) a.in[i] = (const float*)d_in[i];
    a.out = (float*)d_out; a.ws = (unsigned char*)d_ws;
    auto mk = [&](int lo, int hi) { a.ph_lo = lo; a.ph_hi = hi; a.li = 0; hipLaunchKernelGGL(mk_fwd, dim3(grid), dim3(NWAVES * 64), LDS_BYTES, stream, a); };
    mk(0, 11);
}
```

```cpp
#include <hip/hip_runtime.h>
#include <cstdio>
#include <cstdint>
#include <cmath>

constexpr int D = 1024, BATCH = 2, SEQ = 8192, M = BATCH * SEQ;
constexpr int SBH = 8, SBD = 64, SBW = 512;
constexpr int GH = 8, GDK = 64, GDV = 64, GCONVW = 1536;
constexpr int INW = 5648, INWP = 5888;
constexpr int PH = 8, PNK = 128, PQD = 256, PHALF = 128, PTOPK = 16, PNE = 16384, PQW = PH * PQD;
constexpr float EPS = 1e-6f;

namespace pg8 {
#define PG8_LAS __attribute__((address_space(3)))
typedef unsigned short bf16_t;
typedef short bf16x8 __attribute__((ext_vector_type(8)));
typedef float f32x4 __attribute__((ext_vector_type(4)));
typedef unsigned u32x4 __attribute__((ext_vector_type(4)));
constexpr int BM = 256, BK = 64, HALF = 128, HTB = HALF * BK * 2  , STAGE_BYTES = 8 * HTB, NXCD = 8, WGM = 8;

__host__ __device__ __forceinline__ int lds_byte(int r, int c) { const int st = (r >> 4) * 2 + (c >> 5), rr = r & 15, cc = c & 31, ob = rr * 64 + cc * 2; return st * 1024 + (ob ^ (((ob >> 9) & 1) << 5)); }
__host__ __device__ __forceinline__ void stage_rc(int b, int& R, int& C) { const int st = b / 1024, sb = b % 1024, swz = sb ^ (((sb >> 9) & 1) << 5); R = (st >> 1) * 16 + swz / 64; C = (st & 1) * 32 + (swz % 64) / 2; }
__host__ __device__ __forceinline__ int perm32(int rho) { const int n = rho >> 4, i = rho & 15; return 8 * (i >> 2) + 4 * n + (i & 3); }

struct Unit { int pm, pn; };
struct Gemm { const bf16_t* A; const bf16_t* Bt; int M, N, K; };

struct StaticOrder {
    int nM, nN, nwg, G, c;
    __host__ __device__ void init(int M, int N, int G_, int c_) { nM = M / BM; nN = N / BM; nwg = nM * nN; G = G_; c = c_; }
    __host__ __device__ bool next(int i, Unit& u) const {
        const long L = (long)i * G + c; if (L >= nwg) return false;
        int wgid = (int)L; { const int q = nwg / NXCD, r = nwg % NXCD, xcd = wgid % NXCD, off = wgid / NXCD; wgid = (xcd < r ? xcd * (q + 1) : r * (q + 1) + (xcd - r) * q) + off; }
        const int nig = WGM * nN, gid = wgid / nig, fm = gid * WGM, gsz = (nM - fm) < WGM ? (nM - fm) : WGM;
        u.pm = fm + ((wgid % nig) % gsz); u.pn = (wgid % nig) / gsz; return true;
    }
    __device__ __forceinline__ void a_ready(const Unit&) const {}
    __device__ __forceinline__ void done(const Unit&) const {}
};

__device__ __forceinline__ unsigned cvt_pk_bf16(float lo, float hi) { unsigned r; asm volatile("v_cvt_pk_bf16_f32 %0, %1, %2" : "=v"(r) : "v"(lo), "v"(hi)); return r; }
typedef float f32x2 __attribute__((ext_vector_type(2)));
__device__ __forceinline__ f32x2 gelu_pk(f32x2 v) {
    const f32x2 av = __builtin_elementwise_abs(v), d = av * 0.2316418882f + 1.0f;
    f32x2 t; t.x = __builtin_amdgcn_rcpf(d.x); t.y = __builtin_amdgcn_rcpf(d.y);
    f32x2 q = t * 0.5307027145f + (-0.7265760135f); q = q * t + 0.7107068705f; q = q * t + (-0.142248368f); q = q * t + 0.127414796f; q = q * t;
    const f32x2 s = (v * v) * (-0.72134752044f);
    f32x2 e; e.x = __builtin_amdgcn_exp2f(s.x); e.y = __builtin_amdgcn_exp2f(s.y);
    const f32x2 m = v * (q * e), r = v - m;
    f32x2 o; o.x = v.x < 0.f ? m.x : r.x; o.y = v.y < 0.f ? m.y : r.y; return o;
}

template <int ACT  > struct EpiBf16 {
    static constexpr bool PERM = true, AFTER_DRAIN = false; static_assert(ACT == 0 || ACT == 1, "EpiBf16: ACT is 0 (none) or 1 (gelu_pk)");
    bf16_t* O; int ldc; const float* bias; int split_cols; size_t split_stride; float scale0;
    __device__ __forceinline__ void operator()(const f32x4 (&acc)[2][2][4][2], const Unit& u, int wr, int wc, int fr, int fq) const {
        const int row0 = u.pm * BM + wr * 64 + fr; int colt = u.pn * BM; bf16_t* base = O;
        float sc = 1.f; if (split_cols) { const int t = colt / split_cols; base += (size_t)t * split_stride; colt -= t * split_cols; if (t == 0) sc = scale0; }
        const int col0 = colt + wc * 32 + 8 * fq, bcol0 = u.pn * BM + wc * 32 + 8 * fq;
        f32x4 bv[2][2];
#pragma unroll
        for (int bj = 0; bj < 2; ++bj)
#pragma unroll
            for (int n = 0; n < 2; ++n) bv[bj][n] = bias ? *(const f32x4*)(bias + bcol0 + bj * HALF + 4 * n) : (f32x4){0.f, 0.f, 0.f, 0.f};
#pragma unroll
        for (int ai = 0; ai < 2; ++ai)
#pragma unroll
            for (int m = 0; m < 4; ++m) { bf16_t* rowp = base + (size_t)(row0 + ai * HALF + m * 16) * ldc + col0;
#pragma unroll
                for (int bj = 0; bj < 2; ++bj) { f32x4 v0 = acc[ai][bj][m][0] + bv[bj][0], v1 = acc[ai][bj][m][1] + bv[bj][1];
                    if (ACT == 1) { f32x2 a = gelu_pk((f32x2){v0[0], v0[1]}), b = gelu_pk((f32x2){v0[2], v0[3]}), c = gelu_pk((f32x2){v1[0], v1[1]}), d = gelu_pk((f32x2){v1[2], v1[3]});
                        v0 = (f32x4){a.x, a.y, b.x, b.y}; v1 = (f32x4){c.x, c.y, d.x, d.y}; }
                    v0 = v0 * sc; v1 = v1 * sc; u32x4 w; w.x = cvt_pk_bf16(v0[0], v0[1]); w.y = cvt_pk_bf16(v0[2], v0[3]); w.z = cvt_pk_bf16(v1[0], v1[1]); w.w = cvt_pk_bf16(v1[2], v1[3]);
                    *(u32x4*)(rowp + bj * HALF) = w; } }
    }
};

__device__ __forceinline__ float sigmoidf_(float x) { return __builtin_amdgcn_rcpf(1.0f + __expf(-x)); }
__device__ __forceinline__ float bf2f(unsigned short h) { return __uint_as_float((unsigned)h << 16); }
__device__ __forceinline__ float bflo(unsigned w) { return __uint_as_float(w << 16); }
__device__ __forceinline__ float bfhi(unsigned w) { return __uint_as_float(w & 0xffff0000u); }

struct EpiInProj {
    static constexpr bool PERM = true, AFTER_DRAIN = false;
    bf16_t *q, *k, *v, *graw, *z, *gates; float* ab;
    __device__ __forceinline__ void operator()(const f32x4 (&acc)[2][2][4][2], const Unit& u, int wr, int wc, int fr, int fq) const {
        const int pn = u.pn; bf16_t* base; int ldc, ct; bool sig = false;
        if (pn >= 4 && pn < 6) {
#pragma unroll
            for (int ai = 0; ai < 2; ++ai)
#pragma unroll
                for (int m = 0; m < 4; ++m) { const int r = u.pm * BM + ai * HALF + wr * 64 + m * 16 + fr; const int bb = r >> 13, t = r & 8191;
#pragma unroll
                    for (int bj = 0; bj < 2; ++bj) { const int c0 = (pn - 4) * BM + bj * HALF + wc * 32 + 8 * fq; bf16_t* dst = v + ((size_t)(bb * 8 + (c0 >> 6)) * 64 + (c0 & 63)) * 8192 + t;
                        const f32x4 v0 = acc[ai][bj][m][0], v1 = acc[ai][bj][m][1];
                        const unsigned w0 = cvt_pk_bf16(v0[0], v0[1]), w1 = cvt_pk_bf16(v0[2], v0[3]), w2 = cvt_pk_bf16(v1[0], v1[1]), w3 = cvt_pk_bf16(v1[2], v1[3]);
                        dst[0] = (bf16_t)w0; dst[8192] = (bf16_t)(w0 >> 16); dst[2 * 8192] = (bf16_t)w1; dst[3 * 8192] = (bf16_t)(w1 >> 16);
                        dst[4 * 8192] = (bf16_t)w2; dst[5 * 8192] = (bf16_t)(w2 >> 16); dst[6 * 8192] = (bf16_t)w3; dst[7 * 8192] = (bf16_t)(w3 >> 16); } }
            return;
        }
        if (pn < 2) { base = q; ldc = 512; ct = pn; } else if (pn < 4) { base = k; ldc = 512; ct = pn - 2; }
        else if (pn < 12) { base = graw; ldc = 1536; ct = pn - 6; } else if (pn < 14) { base = z; ldc = 512; ct = pn - 12; } else if (pn < 22) { base = gates; ldc = 2048; ct = pn - 14; sig = true; }
        else {
            if (wc == 0 && fq < 2) {
#pragma unroll
                for (int ai = 0; ai < 2; ++ai)
#pragma unroll
                    for (int m = 0; m < 4; ++m) { const int r = u.pm * BM + ai * HALF + wr * 64 + m * 16 + fr; float* p = ab + (size_t)r * 16 + 8 * fq;
                        *(f32x4*)p = acc[ai][0][m][0]; *(f32x4*)(p + 4) = acc[ai][0][m][1]; }
            }
            return;
        }
        const int row0 = u.pm * BM + wr * 64 + fr, col0 = ct * BM + wc * 32 + 8 * fq;
#pragma unroll
        for (int ai = 0; ai < 2; ++ai)
#pragma unroll
            for (int m = 0; m < 4; ++m) { bf16_t* rowp = base + (size_t)(row0 + ai * HALF + m * 16) * ldc + col0;
#pragma unroll
                for (int bj = 0; bj < 2; ++bj) { f32x4 v0 = acc[ai][bj][m][0], v1 = acc[ai][bj][m][1];
                    if (sig) { v0 = (f32x4){sigmoidf_(v0[0]), sigmoidf_(v0[1]), sigmoidf_(v0[2]), sigmoidf_(v0[3])}; v1 = (f32x4){sigmoidf_(v1[0]), sigmoidf_(v1[1]), sigmoidf_(v1[2]), sigmoidf_(v1[3])}; }
                    u32x4 w; w.x = cvt_pk_bf16(v0[0], v0[1]); w.y = cvt_pk_bf16(v0[2], v0[3]); w.z = cvt_pk_bf16(v1[0], v1[1]); w.w = cvt_pk_bf16(v1[2], v1[3]);
                    *(u32x4*)(rowp + bj * HALF) = w; } }
    }
};
template <int MODE> struct EpiMerge {
    static constexpr bool PERM = true, AFTER_DRAIN = false;
    const bf16_t* gates; bf16_t* merged;
    __device__ __forceinline__ void operator()(const f32x4 (&acc)[2][2][4][2], const Unit& u, int wr, int wc, int fr, int fq) const {
        const int row0 = u.pm * BM + wr * 64 + fr, col0 = u.pn * BM + wc * 32 + 8 * fq;
#pragma unroll
        for (int ai = 0; ai < 2; ++ai)
#pragma unroll
            for (int m = 0; m < 4; ++m) { const size_t r = (size_t)(row0 + ai * HALF + m * 16);
#pragma unroll
                for (int bj = 0; bj < 2; ++bj) { const int c = col0 + bj * HALF;
                    const u32x4 g = *(const u32x4*)(gates + r * 2048 + MODE * 1024 + c);
                    f32x4 v0 = acc[ai][bj][m][0], v1 = acc[ai][bj][m][1];
                    v0 = v0 * (f32x4){bflo(g.x), bfhi(g.x), bflo(g.y), bfhi(g.y)}; v1 = v1 * (f32x4){bflo(g.z), bfhi(g.z), bflo(g.w), bfhi(g.w)};
                    if (MODE == 1) { const u32x4 p = *(const u32x4*)(merged + r * 1024 + c);
                        v0 = v0 + (f32x4){bflo(p.x), bfhi(p.x), bflo(p.y), bfhi(p.y)}; v1 = v1 + (f32x4){bflo(p.z), bfhi(p.z), bflo(p.w), bfhi(p.w)}; }
                    u32x4 w; w.x = cvt_pk_bf16(v0[0], v0[1]); w.y = cvt_pk_bf16(v0[2], v0[3]); w.z = cvt_pk_bf16(v1[0], v1[1]); w.w = cvt_pk_bf16(v1[2], v1[3]);
                    *(u32x4*)(merged + r * 1024 + c) = w; } }
    }
};
struct EpiWo {
    static constexpr bool PERM = true, AFTER_DRAIN = false;
    const float* x; const float* mod; float* out;
    __device__ __forceinline__ void operator()(const f32x4 (&acc)[2][2][4][2], const Unit& u, int wr, int wc, int fr, int fq) const {
        const int row0 = u.pm * BM + wr * 64 + fr, col0 = u.pn * BM + wc * 32 + 8 * fq; const int b = (u.pm * BM) >> 13;
        const float* g1 = mod + (size_t)b * 6 * 1024 + 2 * 1024;
#pragma unroll
        for (int bj = 0; bj < 2; ++bj) { const int c = col0 + bj * HALF; const f32x4 ga = *(const f32x4*)(g1 + c), gb = *(const f32x4*)(g1 + c + 4);
#pragma unroll
            for (int ai = 0; ai < 2; ++ai)
#pragma unroll
                for (int m = 0; m < 4; ++m) { const size_t off = (size_t)(row0 + ai * HALF + m * 16) * 1024 + c;
                    const f32x4 xa = *(const f32x4*)(x + off), xb = *(const f32x4*)(x + off + 4);
                    *(f32x4*)(out + off) = xa + ga * acc[ai][bj][m][0]; *(f32x4*)(out + off + 4) = xb + gb * acc[ai][bj][m][1]; } }
    }
};
template <class Epi, class Sched, bool ALIGN_EPI = false, bool SP2 = false>
__device__ __forceinline__ void gemm_phase(PG8_LAS unsigned char* lds, const Gemm g, const Sched& S, const Epi& E) {
    const int tid = threadIdx.x, wid = __builtin_amdgcn_readfirstlane(tid >> 6), lane = tid & 63, wr = wid >> 2, wc = wid & 3, fr = lane & 15, fq = lane >> 4;
    const int K = g.K, nt = K / BK;
    unsigned voffA[2], voffB[2];
#pragma unroll
    for (int i = 0; i < 2; ++i) { int R, C; stage_rc(tid * 16 + i * 8192, R, C); const int Rb = Epi::PERM ? ((R & ~31) + perm32(R & 31)) : R;
        voffA[i] = (unsigned)(R * K + C) * 2u; voffB[i] = (unsigned)(Rb * K + C) * 2u; }
    const size_t kstep = (size_t)(BK * 2);
    const size_t hstep = (size_t)HALF * K * 2;
    const size_t tstep = 2 * hstep;
    const unsigned ldsw = (unsigned)wid * 1024u;
    const int aoff = lds_byte(wr * 64 + fr, fq * 8), boff = lds_byte(wc * 32 + fr, fq * 8);
#define PG8_SA(b, h) (((b) * 2 + (h)) * HTB)
#define PG8_SB(b, h) ((4 + (b) * 2 + (h)) * HTB)
#define PG8_STAGE(bufoff, gbase, voff) do { _Pragma("unroll") for (int _i = 0; _i < 2; ++_i) \
        __builtin_amdgcn_global_load_lds((const unsigned*)((const char*)(gbase) + (voff)[_i]), (PG8_LAS unsigned*)(lds + (bufoff) + ldsw + _i * 8192), 16, 0, 0); } while (0)
#define PG8_LDA(dst, b, h) do { _Pragma("unroll") for (int m = 0; m < 4; ++m) _Pragma("unroll") for (int k = 0; k < 2; ++k) dst[m][k] = *(const PG8_LAS bf16x8*)(lds + PG8_SA(b, h) + aoff + m * 2048 + k * 1024); } while (0)
#define PG8_LDB(dst, b, h) do { _Pragma("unroll") for (int n = 0; n < 2; ++n) _Pragma("unroll") for (int k = 0; k < 2; ++k) dst[n][k] = *(const PG8_LAS bf16x8*)(lds + PG8_SB(b, h) + boff + n * 2048 + k * 1024); } while (0)
#define PG8_MMA(ai, bj, At, Bt) do { __builtin_amdgcn_s_setprio(1); _Pragma("unroll") for (int m = 0; m < 4; ++m) _Pragma("unroll") for (int n = 0; n < 2; ++n) _Pragma("unroll") for (int k = 0; k < 2; ++k) \
        acc[ai][bj][m][n] = __builtin_amdgcn_mfma_f32_16x16x32_bf16(Bt[n][k], At[m][k], acc[ai][bj][m][n], 0, 0, 0); __builtin_amdgcn_s_setprio(0); } while (0)
#define PG8_WAIT_V(n) asm volatile("s_waitcnt vmcnt(" #n ")" ::: "memory")
#define PG8_WAIT_L(n) asm volatile("s_waitcnt lgkmcnt(" #n ")" ::: "memory")
#define PG8_BAR __builtin_amdgcn_s_barrier()
#define PG8_SCHED __builtin_amdgcn_sched_barrier(0)
    Unit cur, nxt; int ui = 0;
    if (!S.next(0, cur)) return;
    f32x4 acc[2][2][4][2];
#pragma unroll
    for (int a = 0; a < 2; ++a)
#pragma unroll
        for (int b = 0; b < 2; ++b)
#pragma unroll
            for (int m = 0; m < 4; ++m)
#pragma unroll
                for (int n = 0; n < 2; ++n) acc[a][b][m][n] = (f32x4){0.f, 0.f, 0.f, 0.f};
    bf16x8 At[4][2], B0[2][2], B1[2][2];
    const char* cA = (const char*)g.A + (size_t)cur.pm * tstep; const char* cB = (const char*)g.Bt + (size_t)cur.pn * tstep;
    S.a_ready(cur);
    if constexpr (SP2) {
        PG8_STAGE(PG8_SB(0, 0), cB, voffB); PG8_STAGE(PG8_SB(0, 1), cB + hstep, voffB); PG8_STAGE(PG8_SA(0, 0), cA, voffA); PG8_STAGE(PG8_SA(0, 1), cA + hstep, voffA);
        if (wr == 1) PG8_BAR;
        PG8_WAIT_V(2); PG8_BAR;
        PG8_STAGE(PG8_SB(1, 0), cB + kstep, voffB); PG8_STAGE(PG8_SA(1, 0), cA + kstep, voffA); PG8_STAGE(PG8_SB(1, 1), cB + hstep + kstep, voffB);
        PG8_WAIT_V(6); PG8_BAR;
    } else {
        PG8_STAGE(PG8_SB(0, 0), cB, voffB); PG8_STAGE(PG8_SA(0, 0), cA, voffA); PG8_STAGE(PG8_SB(0, 1), cB + hstep, voffB); PG8_STAGE(PG8_SA(0, 1), cA + hstep, voffA);
        if (wr == 1) PG8_BAR;
        PG8_WAIT_V(4); PG8_BAR;
        PG8_STAGE(PG8_SB(1, 0), cB + kstep, voffB); PG8_STAGE(PG8_SA(1, 0), cA + kstep, voffA); PG8_STAGE(PG8_SB(1, 1), cB + hstep + kstep, voffB);
        PG8_WAIT_V(6); PG8_BAR;
    }
    for (;;) {
        const bool has_next = S.next(ui + 1, nxt);
        const char* nA = has_next ? (const char*)g.A + (size_t)nxt.pm * tstep : cA; const char* nB = has_next ? (const char*)g.Bt + (size_t)nxt.pn * tstep : cB;
        for (int t = 0; t < nt; t += 2) {
            const bool last = (t == nt - 2);
            const char* a1 = cA + (size_t)(t + 1) * kstep;
            const char* a2 = last ? nA : cA + (size_t)(t + 2) * kstep; const char* b2 = last ? nB : cB + (size_t)(t + 2) * kstep;
            const char* a3 = a2 + kstep; const char* b3 = b2 + kstep;
            if (last && has_next) S.a_ready(nxt);
            if constexpr (SP2) {
            PG8_LDB(B0, 0, 0); PG8_LDB(B1, 0, 1); PG8_SCHED; PG8_LDA(At, 0, 0); PG8_STAGE(PG8_SA(1, 1), a1 + hstep, voffA);
            PG8_WAIT_V(8); PG8_WAIT_L(0); PG8_BAR; PG8_MMA(0, 0, At, B0); PG8_MMA(0, 1, At, B1); PG8_BAR; PG8_SCHED;
            PG8_LDA(At, 0, 1); PG8_STAGE(PG8_SB(0, 0), b2, voffB); PG8_STAGE(PG8_SB(0, 1), b2 + hstep, voffB); PG8_STAGE(PG8_SA(0, 0), a2, voffA);
            PG8_WAIT_V(8); PG8_WAIT_L(0); PG8_BAR; PG8_MMA(1, 0, At, B0); PG8_MMA(1, 1, At, B1); PG8_BAR; PG8_SCHED;
            PG8_LDB(B0, 1, 0); PG8_LDB(B1, 1, 1); PG8_SCHED; PG8_LDA(At, 1, 0); PG8_STAGE(PG8_SA(0, 1), a2 + hstep, voffA);
            PG8_WAIT_V(8); PG8_WAIT_L(0); PG8_BAR; PG8_MMA(0, 0, At, B0); PG8_MMA(0, 1, At, B1); PG8_BAR; PG8_SCHED;
            PG8_LDA(At, 1, 1); PG8_STAGE(PG8_SB(1, 0), b3, voffB); PG8_STAGE(PG8_SB(1, 1), b3 + hstep, voffB); PG8_STAGE(PG8_SA(1, 0), a3, voffA);
            PG8_WAIT_V(8); PG8_WAIT_L(0); PG8_BAR; PG8_MMA(1, 0, At, B0); PG8_MMA(1, 1, At, B1); PG8_BAR; PG8_SCHED;
            } else {
            PG8_LDB(B0, 0, 0); PG8_SCHED; PG8_LDA(At, 0, 0); PG8_STAGE(PG8_SA(1, 1), a1 + hstep, voffA);
            PG8_WAIT_L(8); PG8_BAR; PG8_WAIT_L(0); PG8_MMA(0, 0, At, B0); PG8_BAR; PG8_SCHED;
            PG8_LDB(B1, 0, 1); PG8_STAGE(PG8_SB(0, 0), b2, voffB);
            PG8_BAR; PG8_WAIT_L(0); PG8_MMA(0, 1, At, B1); PG8_BAR;
            PG8_LDA(At, 0, 1); PG8_STAGE(PG8_SA(0, 0), a2, voffA);
            PG8_BAR; PG8_WAIT_L(0); PG8_MMA(1, 0, At, B0); PG8_BAR; PG8_SCHED;
            PG8_STAGE(PG8_SB(0, 1), b2 + hstep, voffB);
            PG8_WAIT_V(6); PG8_BAR; PG8_MMA(1, 1, At, B1); PG8_BAR;
            PG8_LDB(B0, 1, 0); PG8_SCHED; PG8_LDA(At, 1, 0); PG8_STAGE(PG8_SA(0, 1), a2 + hstep, voffA);
            PG8_WAIT_L(8); PG8_BAR; PG8_WAIT_L(0); PG8_MMA(0, 0, At, B0); PG8_BAR; PG8_SCHED;
            PG8_LDB(B1, 1, 1); PG8_STAGE(PG8_SB(1, 0), b3, voffB);
            PG8_BAR; PG8_WAIT_L(0); PG8_MMA(0, 1, At, B1); PG8_BAR;
            PG8_LDA(At, 1, 1); PG8_STAGE(PG8_SA(1, 0), a3, voffA);
            PG8_BAR; PG8_WAIT_L(0); PG8_MMA(1, 0, At, B0); PG8_BAR; PG8_SCHED;
            PG8_STAGE(PG8_SB(1, 1), b3 + hstep, voffB);
            PG8_WAIT_V(6); PG8_BAR; PG8_MMA(1, 1, At, B1); PG8_BAR;
            }
        }
        if constexpr (ALIGN_EPI) { if (wr == 0) PG8_BAR; }
        if constexpr (!Epi::AFTER_DRAIN) { E(acc, cur, wr, wc, fr, fq); S.done(cur); }
        if (!has_next) break;
#pragma unroll
        for (int a = 0; a < 2; ++a)
#pragma unroll
            for (int b = 0; b < 2; ++b)
#pragma unroll
                for (int m = 0; m < 4; ++m)
#pragma unroll
                    for (int n = 0; n < 2; ++n) acc[a][b][m][n] = (f32x4){0.f, 0.f, 0.f, 0.f};
        cur = nxt; cA = nA; cB = nB; ++ui;
        if constexpr (ALIGN_EPI) { if (wr == 1) PG8_BAR; }
    }
    PG8_WAIT_V(0);
    if constexpr (!ALIGN_EPI) { if (wr == 0) PG8_BAR; }
    PG8_BAR;
    if constexpr (Epi::AFTER_DRAIN) { E.fused(acc, cur, wr, wc, fr, fq, lds, wid, lane); S.done(cur); }
#undef PG8_SA
#undef PG8_SB
#undef PG8_STAGE
#undef PG8_LDA
#undef PG8_LDB
#undef PG8_MMA
#undef PG8_WAIT_V
#undef PG8_WAIT_L
#undef PG8_BAR
#undef PG8_SCHED
}
}

constexpr int NWAVES = 8;
#define GAS __attribute__((address_space(1)))
#define LAS __attribute__((address_space(3)))
typedef unsigned short bf16;
typedef unsigned v4u __attribute__((ext_vector_type(4)));
typedef unsigned v2u __attribute__((ext_vector_type(2)));
typedef float f32x4 __attribute__((ext_vector_type(4)));
typedef float f32x2 __attribute__((ext_vector_type(2)));
typedef short bf16x8 __attribute__((ext_vector_type(8)));
typedef GAS unsigned gu32;
#define RLX_AGENT __ATOMIC_RELAXED, __HIP_MEMORY_SCOPE_AGENT
#define LDS_WAIT() asm volatile("s_waitcnt lgkmcnt(0)" ::: "memory")
#define VM_WAIT() asm volatile("s_waitcnt vmcnt(0)" ::: "memory")
__device__ __forceinline__ unsigned f2bf(float f) { unsigned u = __builtin_bit_cast(unsigned, f); return (u + 0x7fffu + ((u >> 16) & 1u)) >> 16; }
__device__ __forceinline__ unsigned pk2(float lo, float hi) { return f2bf(lo) | (f2bf(hi) << 16); }
__device__ __forceinline__ float bf2f(unsigned short h) { return __uint_as_float((unsigned)h << 16); }
__device__ __forceinline__ float bflo(unsigned w) { return __uint_as_float(w << 16); }
__device__ __forceinline__ float bfhi(unsigned w) { return __uint_as_float(w & 0xffff0000u); }
__device__ __forceinline__ float sigm(float x) { return 1.0f / (1.0f + __expf(-x)); }
__device__ __forceinline__ float siluf(float x) { return x / (1.0f + __expf(-x)); }
__device__ __forceinline__ float softplusf(float x) { return fmaxf(x, 0.f) + log1pf(__expf(-fabsf(x))); }
__device__ __forceinline__ float wave_sum(float v) {
#pragma unroll
    for (int o = 1; o < 64; o <<= 1) v += __shfl_xor(v, o);
    return v;
}

constexpr size_t MiB = 1u << 20;
constexpr size_t WS_CTL = 0, CTL_ZERO_BYTES = 64 * 1024;
constexpr size_t WS_MOD = 1 * MiB;
constexpr size_t WS_SKEY = 1 * MiB + 256 * 1024;
constexpr size_t WS_WIN = 2 * MiB;
constexpr size_t WS_WSB = 14 * MiB, WS_WGDN = 15 * MiB, WS_WO = 16 * MiB, WS_WQ = 18 * MiB;
constexpr size_t WS_AB = 22 * MiB;
constexpr size_t WS_GB = 23 * MiB;
constexpr size_t WS_XN = 24 * MiB;
constexpr size_t WS_Q = 56 * MiB, WS_K = 72 * MiB, WS_V = 88 * MiB;
constexpr size_t WS_GRAW = 104 * MiB;
constexpr size_t WS_Z = 152 * MiB;
constexpr size_t WS_YSB = 24 * MiB, WS_YGDN = 40 * MiB;
constexpr size_t WS_MERGED = 56 * MiB;
constexpr size_t WS_CH = 168 * MiB;
constexpr size_t WS_CD = 248 * MiB;
constexpr size_t WS_QP = 168 * MiB;
constexpr size_t WS_EIDX = 232 * MiB, WS_GATE = 240 * MiB;
constexpr size_t WS_UT8 = 104 * MiB, WS_VT8 = 120 * MiB;
constexpr size_t WS_ACT = 136 * MiB;
constexpr size_t WS_H28 = 88 * MiB;
constexpr size_t WS_END = 256 * MiB;
constexpr int CW_BAR = 4096;

constexpr int RING_OFF = 0, RING_BYTES = 162816;
constexpr int LDSCTL_OFF = RING_BYTES, MISC_OFF = LDSCTL_OFF + 320;
constexpr int LDS_BYTES = 163840;
#define XB_TMO      128
#define XB_XCNT(j)  (256  + 64 * (j))
#define XB_XSUB(j)  (1280 + 64 * (j))
#define XB_XGEN(j)  (2304 + 64 * (j))
#define XB_TOP      3328
#define XB_TOPGEN   3392
#define XCD_BAR_WORDS 3456
#define XB_SPIN_CAP (1u << 18)

__device__ __forceinline__ unsigned xb_ld(unsigned* p)              { return __hip_atomic_load(p, __ATOMIC_RELAXED, __HIP_MEMORY_SCOPE_AGENT); }
__device__ __forceinline__ unsigned xb_add(unsigned* p, unsigned v) { return __hip_atomic_fetch_add(p, v, __ATOMIC_RELAXED, __HIP_MEMORY_SCOPE_AGENT); }
__device__ __forceinline__ unsigned xb_xcc_id() { return (unsigned)__builtin_amdgcn_s_getreg((3 << 11) | 20) & 0xFu; }
#define XB_SPIN(cond, bar) do { unsigned _sp = 0; while (cond) { __builtin_amdgcn_s_sleep(1); \
    if ((++_sp & 255u) == 0u) { if (xb_ld(&(bar)[XB_TMO])) break; if (_sp > XB_SPIN_CAP) { atomicAdd(&(bar)[XB_TMO], 1u); break; } } } } while (0)

struct XcdBarrier {
    unsigned* bar; unsigned x;
    volatile LAS unsigned* st;
};

__device__ __forceinline__ XcdBarrier xcd_barrier_post(unsigned* bar, volatile LAS unsigned* st) {
    XcdBarrier b; b.bar = bar; b.x = xb_xcc_id(); b.st = st;
    if (threadIdx.x == 0) (void)xb_add(&bar[XB_XCNT(b.x)], 1u);
    return b;
}
__device__ __forceinline__ void xcd_barrier_complete(unsigned* bar, unsigned x, unsigned& nloc, unsigned& nx) {
    const unsigned G = gridDim.x * gridDim.y * gridDim.z;
    unsigned sum, cnt, mine, sp = 0u;
    for (;;) {
        sum = 0u; cnt = 0u; mine = 0u;
#pragma unroll
        for (unsigned j = 0; j < 16; ++j) { const unsigned c = xb_ld(&bar[XB_XCNT(j)]); sum += c; cnt += (c > 0u) ? 1u : 0u; mine = (j == x) ? c : mine; }
        if (sum == G) break;
        __builtin_amdgcn_s_sleep(1);
        if ((++sp & 255u) == 0u) { if (xb_ld(&bar[XB_TMO])) break; if (sp > XB_SPIN_CAP) { atomicAdd(&bar[XB_TMO], 1u); break; } }
    }
    nloc = mine > 0u ? mine : 1u; nx = cnt > 0u ? cnt : 1u;
}

__device__ __forceinline__ void xcd_barrier(const XcdBarrier& b) {
    asm volatile("s_waitcnt vmcnt(0)" ::: "memory");
    __syncthreads();
    if (threadIdx.x == 0) {
        unsigned* bar = b.bar;
        __builtin_amdgcn_s_waitcnt(0);
        unsigned nloc = b.st[0], nx = b.st[1];
        if (nloc == 0u) { xcd_barrier_complete(bar, b.x, nloc, nx); b.st[0] = nloc; b.st[1] = nx; }
        const unsigned old = xb_add(&bar[XB_XSUB(b.x)], 1u);
        const unsigned gen = old / nloc;
        if (old + 1u == (gen + 1u) * nloc) {
            __builtin_amdgcn_fence(__ATOMIC_RELEASE, "agent");
            asm volatile("s_waitcnt vmcnt(0)" ::: "memory");
            const unsigned og = xb_add(&bar[XB_TOP], 1u);
            const unsigned tg = og / nx;
            if (og + 1u == (tg + 1u) * nx) xb_add(&bar[XB_TOPGEN], 1u);
            else XB_SPIN(xb_ld(&bar[XB_TOPGEN]) == tg, bar);
            __builtin_amdgcn_fence(__ATOMIC_ACQUIRE, "agent");
            xb_add(&bar[XB_XGEN(b.x)], 1u);
            asm volatile("s_waitcnt vmcnt(0)" ::: "memory");
        } else {
            XB_SPIN(xb_ld(&bar[XB_XGEN(b.x)]) == gen, bar);
            __builtin_amdgcn_fence(__ATOMIC_ACQUIRE, "agent");
            asm volatile("s_waitcnt vmcnt(0)" ::: "memory");
        }
    }
    __syncthreads();
}

struct Args { const float* in[20]; float* out; unsigned char* ws; int ph_lo, ph_hi, li, pad; };

struct Frame {
    LAS unsigned char* lds;
    volatile LAS unsigned* MISC;
    gu32* ctl;
    int tid, lane, wave, G;
};

__device__ __forceinline__ int inproj_src_col(int n) { if (n < 3072) return n; if (n < 5632) return n + 16; if (n < 5648) return n - 5632 + 3072; return -1; }
template <bool MAP>
__device__ __forceinline__ void p0_transpose_item(const float* W, int K, int Nsrc, int Ndst, bf16* WT, LAS float* scr, int item, int lane) {
    const int nblk = Ndst / 32, kb = item / nblk, nb = item % nblk, k0 = 64 * kb, n0 = 32 * nb;
    const int nsrc = MAP ? inproj_src_col(n0 + (lane & 31)) : n0 + (lane & 31);
    float wv[32];
#pragma unroll
    for (int i = 0; i < 32; ++i) { const int kk = 2 * i + (lane >> 5); wv[i] = nsrc >= 0 ? W[(size_t)(k0 + kk) * Nsrc + nsrc] : 0.f; }
#pragma unroll
    for (int i = 0; i < 32; ++i) { const int kk = 2 * i + (lane >> 5); scr[kk * 33 + (lane & 31)] = wv[i]; }
    LDS_WAIT(); asm volatile("" ::: "memory");
    const int c = lane & 7;
#pragma unroll
    for (int j = 0; j < 4; ++j) { const int n = (lane >> 3) + 8 * j; const LAS float* s = scr + (8 * c) * 33 + n;
        v4u o; o.x = pk2(s[0 * 33], s[1 * 33]); o.y = pk2(s[2 * 33], s[3 * 33]); o.z = pk2(s[4 * 33], s[5 * 33]); o.w = pk2(s[6 * 33], s[7 * 33]);
        *(GAS v4u*)(WT + (size_t)(n0 + n) * K + k0 + 8 * c) = o; }
    LDS_WAIT(); asm volatile("" ::: "memory");
}
__device__ __forceinline__ void p0_prologue(Frame& F, const Args& a) {
    unsigned char* ws = a.ws;
    LAS float* scr = (LAS float*)(F.lds + RING_OFF + F.wave * 16384);
    const int gw = blockIdx.x * NWAVES + F.wave, NGW = F.G * NWAVES;
    constexpr int I_IN = (D / 64) * (INWP / 32), I_SB = (512 / 64) * (D / 32), I_O = (D / 64) * (D / 32), I_Q = (D / 64) * (PQW / 32);
    constexpr int NITEMS = I_IN + 2 * I_SB + I_O + I_Q;
    for (int it = gw; it < NITEMS; it += NGW) {
        int r = it;
        if (r < I_IN) { p0_transpose_item<true>(a.in[5], D, INW, INWP, (bf16*)(ws + WS_WIN), scr, r, F.lane); continue; } r -= I_IN;
        if (r < I_SB) { p0_transpose_item<false>(a.in[12], 512, D, D, (bf16*)(ws + WS_WSB), scr, r, F.lane); continue; } r -= I_SB;
        if (r < I_SB) { p0_transpose_item<false>(a.in[13], 512, D, D, (bf16*)(ws + WS_WGDN), scr, r, F.lane); continue; } r -= I_SB;
        if (r < I_O) { p0_transpose_item<false>(a.in[14], D, D, D, (bf16*)(ws + WS_WO), scr, r, F.lane); continue; } r -= I_O;
        p0_transpose_item<false>(a.in[16], D, PQW, PQW, (bf16*)(ws + WS_WQ), scr, r, F.lane);
    }
    { const float* sk = a.in[17]; bf16* o = (bf16*)(ws + WS_SKEY);
      for (int i = (blockIdx.x * 512 + F.tid) * 4; i < PH * 2 * PNK * PHALF; i += F.G * 512 * 4) { const f32x4 v = *(const f32x4*)(sk + i); v2u w; w.x = pk2(v.x, v.y); w.y = pk2(v.z, v.w); *(v2u*)(o + i) = w; } }
    { const float* c = a.in[1]; const float* wa = a.in[2]; const float* ba = a.in[3]; float* mod = (float*)(ws + WS_MOD);
      LAS float* red = (LAS float*)(F.lds + RING_OFF);
      for (int it = blockIdx.x; it < 6 * D / 64; it += F.G) {
          const int n = it * 64 + F.lane; float a0 = 0.f, a1 = 0.f;
          __syncthreads();
          for (int kb = 0; kb < 4; ++kb) { const int k0 = F.wave * 128 + kb * 32; float w[32];
#pragma unroll
              for (int i = 0; i < 32; ++i) w[i] = wa[(size_t)(k0 + i) * (6 * D) + n];
#pragma unroll
              for (int i = 0; i < 32; ++i) { a0 += siluf(c[k0 + i]) * w[i]; a1 += siluf(c[D + k0 + i]) * w[i]; } }
          red[(F.wave * 2 + 0) * 64 + F.lane] = a0; red[(F.wave * 2 + 1) * 64 + F.lane] = a1;
          __syncthreads();
          if (F.wave < 2) { float s = 0.f;
#pragma unroll
              for (int w = 0; w < 8; ++w) s += red[(w * 2 + F.wave) * 64 + F.lane];
              mod[(size_t)F.wave * 6 * D + n] = s + ba[n]; }
      }
      __syncthreads(); }
}
constexpr float PEER_HSCALE = 4.f;
__device__ __forceinline__ void norm_mod_rows(Frame& F, const float* x, const float* nw, const float* mod, int ch_shift, bf16* o, unsigned char* o8) {
    const int gw = blockIdx.x * NWAVES + F.wave, NGW = F.G * NWAVES;
    f32x4 nx[4];
    if (gw < M) { const GAS f32x4* xr = (const GAS f32x4*)(x + (size_t)gw * D) + F.lane;
#pragma unroll
        for (int j = 0; j < 4; ++j) nx[j] = xr[64 * j]; }
    for (int m = gw; m < M; m += NGW) {
        f32x4 v[4]; float s = 0.f;
#pragma unroll
        for (int j = 0; j < 4; ++j) { v[j] = nx[j]; s += (v[j].x * v[j].x + v[j].y * v[j].y) + (v[j].z * v[j].z + v[j].w * v[j].w); }
        if (m + NGW < M) { const GAS f32x4* xr = (const GAS f32x4*)(x + (size_t)(m + NGW) * D) + F.lane;
#pragma unroll
            for (int j = 0; j < 4; ++j) nx[j] = xr[64 * j]; }
        const float rstd = 1.0f / sqrtf(wave_sum(s) * (1.f / D) + EPS);
        const float* sh = mod + (size_t)(m >> 13) * 6 * D + ch_shift * D; const float* sc = sh + D;
        GAS v2u* ob16 = (GAS v2u*)(o + (size_t)m * D) + F.lane;
#pragma unroll
        for (int j = 0; j < 4; ++j) { const int c = 4 * F.lane + 256 * j; const f32x4 w = *(const f32x4*)(nw + c), a = *(const f32x4*)(sc + c), b = *(const f32x4*)(sh + c);
            const f32x4 y = v[j] * rstd * w * (a + 1.0f) + b; v2u p; p.x = pk2(y.x, y.y); p.y = pk2(y.z, y.w); ob16[64 * j] = p;
            if (o8) { int q8 = __builtin_amdgcn_cvt_pk_fp8_f32(y.x * PEER_HSCALE, y.y * PEER_HSCALE, 0, false); q8 = __builtin_amdgcn_cvt_pk_fp8_f32(y.z * PEER_HSCALE, y.w * PEER_HSCALE, q8, true); *(int*)(o8 + (size_t)m * D + c) = q8; } }
    }
}
constexpr float PEER_USCALE = 64.f, PEER_VSCALE = 8.f;
__device__ __forceinline__ v4u fp8_pack16(const f32x4& a0, const f32x4& a1, const f32x4& a2, const f32x4& a3) {
    int w0 = __builtin_amdgcn_cvt_pk_fp8_f32(a0.x, a0.y, 0, false); w0 = __builtin_amdgcn_cvt_pk_fp8_f32(a0.z, a0.w, w0, true);
    int w1 = __builtin_amdgcn_cvt_pk_fp8_f32(a1.x, a1.y, 0, false); w1 = __builtin_amdgcn_cvt_pk_fp8_f32(a1.z, a1.w, w1, true);
    int w2 = __builtin_amdgcn_cvt_pk_fp8_f32(a2.x, a2.y, 0, false); w2 = __builtin_amdgcn_cvt_pk_fp8_f32(a2.z, a2.w, w2, true);
    int w3 = __builtin_amdgcn_cvt_pk_fp8_f32(a3.x, a3.y, 0, false); w3 = __builtin_amdgcn_cvt_pk_fp8_f32(a3.z, a3.w, w3, true);
    return (v4u){(unsigned)w0, (unsigned)w1, (unsigned)w2, (unsigned)w3};
}
__device__ __forceinline__ void peer_tables_to_fp8(const Args& a, int blk, int nblk, int tid) {
    unsigned char* ws = a.ws; constexpr int NPC = PNE * D / 16;
    for (int which = 0; which < 2; ++which) { const float* src = a.in[18 + which]; v4u* dst = (v4u*)(ws + (which ? WS_VT8 : WS_UT8)); const float sc = which ? PEER_VSCALE : PEER_USCALE;
        for (int i0 = blk * 512 + tid; i0 < NPC; i0 += 4 * nblk * 512) {
            f32x4 v[4][4];
#pragma unroll
            for (int u = 0; u < 4; ++u) { const int i = i0 + u * nblk * 512; if (i < NPC) { const f32x4* p = (const f32x4*)src + (size_t)i * 4; v[u][0] = p[0]; v[u][1] = p[1]; v[u][2] = p[2]; v[u][3] = p[3]; } }
#pragma unroll
            for (int u = 0; u < 4; ++u) { const int i = i0 + u * nblk * 512; if (i < NPC) {
                const int e = i >> 6, c16 = i & 63; const size_t di = which ? ((size_t)(c16 >> 3) * PNE * 8 + (size_t)e * 8 + (c16 & 7)) : (size_t)i;
                dst[di] = fp8_pack16(v[u][0] * sc, v[u][1] * sc, v[u][2] * sc, v[u][3] * sc); } } } }
}
__device__ __forceinline__ float gelu_erf(float v) { return 0.5f * v * (1.0f + erff(v * 0.70710678118654752f)); }
__device__ __forceinline__ void fp8x16_to_f32(const v4u& w, f32x2 (&o)[8]) {
    o[0] = __builtin_amdgcn_cvt_pk_f32_fp8((int)w.x, false); o[1] = __builtin_amdgcn_cvt_pk_f32_fp8((int)w.x, true);
    o[2] = __builtin_amdgcn_cvt_pk_f32_fp8((int)w.y, false); o[3] = __builtin_amdgcn_cvt_pk_f32_fp8((int)w.y, true);
    o[4] = __builtin_amdgcn_cvt_pk_f32_fp8((int)w.z, false); o[5] = __builtin_amdgcn_cvt_pk_f32_fp8((int)w.z, true);
    o[6] = __builtin_amdgcn_cvt_pk_f32_fp8((int)w.w, false); o[7] = __builtin_amdgcn_cvt_pk_f32_fp8((int)w.w, true);
}
__device__ __forceinline__ float gelu_fast(float v) { typedef float f2 __attribute__((ext_vector_type(2))); const f2 r = pg8::gelu_pk((f2){v, v}); return r.x; }
__device__ __forceinline__ f32x4 peer_u_tile(const v4u (&A)[16], const LAS unsigned char* hb, int g) {
    f32x4 acc[4] = {(f32x4){0.f, 0.f, 0.f, 0.f}, (f32x4){0.f, 0.f, 0.f, 0.f}, (f32x4){0.f, 0.f, 0.f, 0.f}, (f32x4){0.f, 0.f, 0.f, 0.f}};
#pragma unroll
    for (int s = 0; s < 16; ++s) { const v4u hv = *(const LAS v4u*)(hb + 64 * s + 16 * g);
        acc[(2 * s) & 3] = __builtin_amdgcn_mfma_f32_16x16x32_fp8_fp8((long)(((unsigned long long)A[s].y << 32) | A[s].x), (long)(((unsigned long long)hv.y << 32) | hv.x), acc[(2 * s) & 3], 0, 0, 0);
        acc[(2 * s + 1) & 3] = __builtin_amdgcn_mfma_f32_16x16x32_fp8_fp8((long)(((unsigned long long)A[s].w << 32) | A[s].z), (long)(((unsigned long long)hv.w << 32) | hv.z), acc[(2 * s + 1) & 3], 0, 0, 0); }
    return (acc[0] + acc[1]) + (acc[2] + acc[3]);
}
__device__ __forceinline__ void peer_u_rows(v4u (&A)[16], const unsigned char* ut, const LAS unsigned* lst, int k0, int n, int lane) {
    const int k = k0 + (lane >> 2); const unsigned ent = lst[k < n ? k : 0]; const unsigned char* row = ut + (size_t)(ent & 2047u) * D + 16 * (lane & 3);
    if (k < n) {
#pragma unroll
        for (int s = 0; s < 16; ++s) A[s] = *(const v4u*)(row + 64 * s); }
}
__device__ __forceinline__ void peer_u_perm(v4u (&A)[16], int r, int g) {
    const int idx = (4 * r + g) * 4;
#pragma unroll
    for (int s = 0; s < 16; ++s) { A[s].x = (unsigned)__builtin_amdgcn_ds_bpermute(idx, (int)A[s].x); A[s].y = (unsigned)__builtin_amdgcn_ds_bpermute(idx, (int)A[s].y); A[s].z = (unsigned)__builtin_amdgcn_ds_bpermute(idx, (int)A[s].z); A[s].w = (unsigned)__builtin_amdgcn_ds_bpermute(idx, (int)A[s].w); }
}
__device__ __forceinline__ void peer_u_out(const f32x4& acc, const LAS unsigned* lst, const LAS float* gl, float* coef_t, int k0, int n, int r, int g) {
    const float v = r == 0 ? acc.x : r == 1 ? acc.y : r == 2 ? acc.z : acc.w; const int k = k0 + 4 * g + r;
    if (r < 4 && k < n) { const int slot = (int)(lst[k] >> 11); coef_t[slot] = gl[slot] * gelu_fast(v * (1.0f / (PEER_USCALE * PEER_HSCALE))) * (1.0f / PEER_VSCALE); }
}
__device__ __forceinline__ void p10a_peer_u(Frame& F, const Args& a) {
    unsigned char* ws = a.ws; const int lane = F.lane, r = lane & 15, g = lane >> 4;
    const unsigned char* h8 = ws + WS_H28; const int* eidx = (const int*)(ws + WS_EIDX); const float* gate = (const float*)(ws + WS_GATE); float* coef = (float*)(ws + WS_ACT);
    const int x = blockIdx.x & 7; const unsigned char* ut = ws + WS_UT8 + (size_t)x * 2048 * D;
    LAS unsigned char* lb = F.lds + RING_OFF + F.wave * 4096;
    const int wg = (blockIdx.x >> 3) * NWAVES + F.wave, nwg = (F.G >> 3) * NWAVES;
    const int nit = (M - wg + nwg - 1) / nwg;
    const unsigned long long below = (1ull << lane) - 1ull;
    int ip = 0;
    v4u hp = *(const v4u*)(h8 + (size_t)wg * D + 16 * lane); int e0 = eidx[(size_t)wg * 128 + lane], e1 = eidx[(size_t)wg * 128 + 64 + lane]; float g0 = gate[(size_t)wg * 128 + lane], g1 = gate[(size_t)wg * 128 + 64 + lane];
#define PU_HB(b) (lb + (b) * 2048)
#define PU_LST(b) ((LAS unsigned*)(lb + (b) * 2048 + 1024))
#define PU_GL(b) ((LAS float*)(lb + (b) * 2048 + 1536))
#define PU_STAGE(b, nout) do { *(LAS v4u*)(PU_HB(b) + 16 * lane) = hp; PU_GL(b)[lane] = g0; PU_GL(b)[64 + lane] = g1; \
        const bool m0_ = (e0 >> 11) == x, m1_ = (e1 >> 11) == x; const unsigned long long b0_ = __ballot(m0_), b1_ = __ballot(m1_); const int n0_ = __popcll(b0_); \
        if (m0_) PU_LST(b)[__popcll(b0_ & below)] = ((unsigned)lane << 11) | (unsigned)(e0 & 2047); \
        if (m1_) PU_LST(b)[n0_ + __popcll(b1_ & below)] = ((unsigned)(64 + lane) << 11) | (unsigned)(e1 & 2047); \
        nout = n0_ + __popcll(b1_); LDS_WAIT(); asm volatile("" ::: "memory"); } while (0)
#define PU_PREFETCH() do { const int tn_ = wg + (ip < nit ? ip : nit - 1) * nwg; \
        hp = *(const v4u*)(h8 + (size_t)tn_ * D + 16 * lane); e0 = eidx[(size_t)tn_ * 128 + lane]; e1 = eidx[(size_t)tn_ * 128 + 64 + lane]; g0 = gate[(size_t)tn_ * 128 + lane]; g1 = gate[(size_t)tn_ * 128 + 64 + lane]; } while (0)
    int c_t = 0, c_b = 0, c_n = 0, c_k0 = 0; bool c_ok = false;
    while (ip < nit && !c_ok) { int nn; PU_STAGE(0, nn); c_t = wg + ip * nwg; ++ip; PU_PREFETCH(); if (nn > 0) { c_ok = true; c_n = nn; } }
    v4u SA[16], SB[16];
    if (c_ok) peer_u_rows(SA, ut, PU_LST(0), 0, c_n, lane);
#define PU_STEP(CUR, NXT) do { \
        int n_t = c_t, n_b = c_b, n_n = c_n, n_k0 = c_k0 + 16; bool n_ok = n_k0 < c_n; bool staged = false; \
        while (!n_ok && ip < nit) { int nn_; PU_STAGE(c_b ^ 1, nn_); n_t = wg + ip * nwg; ++ip; staged = true; if (nn_ > 0) { n_ok = true; n_b = c_b ^ 1; n_n = nn_; n_k0 = 0; } else PU_PREFETCH(); } \
        if (n_ok) peer_u_rows(NXT, ut, PU_LST(n_b), n_k0, n_n, lane); \
        if (staged && n_ok) PU_PREFETCH(); \
        __builtin_amdgcn_sched_barrier(0); \
        peer_u_perm(CUR, r, g); \
        { const f32x4 acc_ = peer_u_tile(CUR, PU_HB(c_b), g); peer_u_out(acc_, PU_LST(c_b), PU_GL(c_b), coef + (size_t)c_t * 128, c_k0, c_n, r, g); } \
        LDS_WAIT(); asm volatile("" ::: "memory"); \
        c_t = n_t; c_b = n_b; c_n = n_n; c_k0 = n_k0; c_ok = n_ok; } while (0)
    while (c_ok) { PU_STEP(SA, SB); if (!c_ok) break; PU_STEP(SB, SA); }

#undef PU_STEP
#undef PU_PREFETCH
#undef PU_STAGE
#undef PU_HB
#undef PU_LST
#undef PU_GL
}
struct PeerMeta { float a0, a1; int e0, e1; };
__device__ __forceinline__ void peer_meta_load(PeerMeta& m, const float* act, const int* eidx, int t, int lane) { const size_t o = (size_t)t * 128 + lane;
    m.a0 = act[o]; m.a1 = act[o + 64]; m.e0 = eidx[o]; m.e1 = eidx[o + 64]; }
__device__ __forceinline__ void peer_meta_stage(const PeerMeta& m, LAS float* coefs, LAS int* eids, int lane) {
    coefs[lane] = m.a0; coefs[64 + lane] = m.a1;
    eids[lane] = m.e0; eids[64 + lane] = m.e1; }
__device__ __forceinline__ void peer_vrows_issue(v4u (&rw)[16], f32x2& x1, const unsigned char* vt, const LAS int* eids, int grp, const float* xp) {
    x1 = *(const f32x2*)xp;
#pragma unroll
    for (int i = 0; i < 16; ++i) rw[i] = *(const v4u*)(vt + (size_t)eids[8 * i + grp] * 128);
}
__device__ __forceinline__ void peer_vcompute(const v4u (&rw)[16], const f32x2& x1, const LAS float* coefs, const f32x2& g2, int grp, int lane, float* op) {
    f32x2 acc[8];
#pragma unroll
    for (int j = 0; j < 8; ++j) acc[j] = (f32x2){0.f, 0.f};
#pragma unroll
    for (int i = 0; i < 16; ++i) { f32x2 v[8]; fp8x16_to_f32(rw[i], v); const float cf = coefs[8 * i + grp];
#pragma unroll
        for (int j = 0; j < 8; ++j) acc[j] += v[j] * cf; }
    const bool b5 = lane & 32, b4 = lane & 16, b3 = lane & 8;
    f32x2 q[4];
#pragma unroll
    for (int j = 0; j < 4; ++j) { const f32x2 mine = b5 ? acc[4 + j] : acc[j], give = b5 ? acc[j] : acc[4 + j]; q[j].x = mine.x + __shfl_xor(give.x, 32); q[j].y = mine.y + __shfl_xor(give.y, 32); }
    f32x2 r2[2];
#pragma unroll
    for (int j = 0; j < 2; ++j) { const f32x2 mine = b4 ? q[2 + j] : q[j], give = b4 ? q[j] : q[2 + j]; r2[j].x = mine.x + __shfl_xor(give.x, 16); r2[j].y = mine.y + __shfl_xor(give.y, 16); }
    f32x2 s1; { const f32x2 mine = b3 ? r2[1] : r2[0], give = b3 ? r2[0] : r2[1]; s1.x = mine.x + __shfl_xor(give.x, 8); s1.y = mine.y + __shfl_xor(give.y, 8); }
    *(f32x2*)op = x1 + g2 * s1;
}
__device__ __forceinline__ void p10b_peer_v(Frame& F, const Args& a, float* outw) {
    unsigned char* ws = a.ws; const int lane = F.lane;
    const int* eidx = (const int*)(ws + WS_EIDX); const float* act = (const float*)(ws + WS_ACT);
    const float* mod = (const float*)(ws + WS_MOD); const float* out = a.out;
    const int x = blockIdx.x & 7; const unsigned char* vt = ws + WS_VT8 + (size_t)x * PNE * 128 + 16 * (lane & 7);
    LAS float* coefs = (LAS float*)(F.lds + RING_OFF + F.wave * 2048); LAS int* eids = (LAS int*)(coefs + 128);
    const int wg = (blockIdx.x >> 3) * NWAVES + F.wave, nwg = (F.G >> 3) * NWAVES, grp = lane >> 3;
    const int co = 128 * x + 16 * (lane & 7) + ((lane >> 5) & 1) * 8 + ((lane >> 4) & 1) * 4 + ((lane >> 3) & 1) * 2;
    const f32x2 g2b0 = *(const f32x2*)(mod + 5 * D + co), g2b1 = *(const f32x2*)(mod + 6 * D + 5 * D + co);
    const int nit = (M - wg + nwg - 1) / nwg;
#define TOK(i) (wg + ((i) < nit ? (i) : nit - 1) * nwg)
    PeerMeta mA, mB; v4u rA[16], rB[16]; f32x2 xA, xB;
    peer_meta_load(mA, act, eidx, TOK(0), lane); peer_meta_stage(mA, coefs, eids, lane); LDS_WAIT(); asm volatile("" ::: "memory");
    peer_meta_load(mB, act, eidx, TOK(1), lane);
    peer_vrows_issue(rA, xA, vt, eids, grp, out + (size_t)TOK(0) * D + co);
    for (int i = 0; i < nit; i += 2) {
        peer_meta_stage(mB, coefs + 256, eids + 256, lane); LDS_WAIT(); asm volatile("" ::: "memory");
        peer_meta_load(mA, act, eidx, TOK(i + 2), lane);
        peer_vrows_issue(rB, xB, vt, eids + 256, grp, out + (size_t)TOK(i + 1) * D + co);
        peer_vcompute(rA, xA, coefs, (TOK(i) >> 13) ? g2b1 : g2b0, grp, lane, outw + (size_t)TOK(i) * D + co);
        LDS_WAIT(); asm volatile("" ::: "memory");
        peer_meta_stage(mA, coefs, eids, lane); LDS_WAIT(); asm volatile("" ::: "memory");
        peer_meta_load(mB, act, eidx, TOK(i + 3), lane);
        peer_vrows_issue(rA, xA, vt, eids, grp, out + (size_t)TOK(i + 2) * D + co);
        peer_vcompute(rB, xB, coefs + 256, (TOK(i + 1) >> 13) ? g2b1 : g2b0, grp, lane, outw + (size_t)TOK(i + 1) * D + co);
        LDS_WAIT(); asm volatile("" ::: "memory");
    }
#undef TOK
}

__device__ __forceinline__ void p4_attn_naive(Frame& F, const Args& a, int blk, int nblk) {
    unsigned char* ws = a.ws;
    const bf16* Q = (const bf16*)(ws + WS_Q); const bf16* K = (const bf16*)(ws + WS_K); const bf16* V = (const bf16*)(ws + WS_V);
    for (int gid = blk * 512 + F.tid; gid < BATCH * SBH * SEQ; gid += nblk * 512) {
        const int t = gid & (SEQ - 1), bh = gid >> 13, h = bh & 7, b = bh >> 3;
        const size_t row = (size_t)b * SEQ + t;
        float q[64], o[64];
#pragma unroll
        for (int i = 0; i < 8; ++i) { const v4u w = *(const v4u*)(Q + row * 512 + h * 64 + 8 * i);
            q[8 * i] = bflo(w.x); q[8 * i + 1] = bfhi(w.x); q[8 * i + 2] = bflo(w.y); q[8 * i + 3] = bfhi(w.y); q[8 * i + 4] = bflo(w.z); q[8 * i + 5] = bfhi(w.z); q[8 * i + 6] = bflo(w.w); q[8 * i + 7] = bfhi(w.w); }
#pragma unroll
        for (int i = 0; i < 64; ++i) o[i] = 0.f;
        float R = 0.f;
        for (int s = t - 1; s >= 0; --s) {
            const size_t kr = ((size_t)b * SEQ + s) * 512 + h * 64; float z = 0.f;
#pragma unroll
            for (int i = 0; i < 8; ++i) { const v4u w = *(const v4u*)(K + kr + 8 * i);
                z += q[8 * i] * bflo(w.x) + q[8 * i + 1] * bfhi(w.x) + q[8 * i + 2] * bflo(w.y) + q[8 * i + 3] * bfhi(w.y) + q[8 * i + 4] * bflo(w.z) + q[8 * i + 5] * bfhi(w.z) + q[8 * i + 6] * bflo(w.w) + q[8 * i + 7] * bfhi(w.w); }
            const float sp = softplusf(z); const float p = __expf(z - sp - R); R += sp;
#pragma unroll
            for (int i = 0; i < 8; ++i) { const v4u w = *(const v4u*)(V + kr + 8 * i);
                o[8 * i] += p * bflo(w.x); o[8 * i + 1] += p * bfhi(w.x); o[8 * i + 2] += p * bflo(w.y); o[8 * i + 3] += p * bfhi(w.y); o[8 * i + 4] += p * bflo(w.z); o[8 * i + 5] += p * bfhi(w.z); o[8 * i + 6] += p * bflo(w.w); o[8 * i + 7] += p * bfhi(w.w); }
            if (R > 105.f) break;
        }
        bf16* y = (bf16*)(ws + WS_YSB) + row * 512 + h * 64;
#pragma unroll
        for (int i = 0; i < 8; ++i) { v4u w; w.x = pk2(o[8 * i], o[8 * i + 1]); w.y = pk2(o[8 * i + 2], o[8 * i + 3]); w.z = pk2(o[8 * i + 4], o[8 * i + 5]); w.w = pk2(o[8 * i + 6], o[8 * i + 7]); *(v4u*)(y + 8 * i) = w; }
    }
}
__device__ __forceinline__ void p9_topk_naive(Frame& F, const Args& a) {
    unsigned char* ws = a.ws; const int tid = F.tid;
    const bf16* QP = (const bf16*)(ws + WS_QP); const bf16* SK = (const bf16*)(ws + WS_SKEY);
    LAS float* sv = (LAS float*)(F.lds + RING_OFF);
    LAS int* si = (LAS int*)(sv + 2 * 16 * 256);
    LAS int* ptr = si + 2 * 16 * 256;
    LAS unsigned short* keys = (LAS unsigned short*)(ptr + 16 * 256);
    const bool act = tid < 256;
    for (int it = blockIdx.x; it < (M / 256) * PH; it += F.G) {
        const int h = it & 7, t = (it >> 3) * 256 + (tid & 255);
        for (int p = 0; p < 2; ++p) {
            __syncthreads();
            for (int i = tid; i < 128 * 128 / 8; i += 512) ((LAS v4u*)keys)[i] = ((const v4u*)(SK + (size_t)(h * 2 + p) * 128 * 128))[i];
            __syncthreads();
            if (act) {
                unsigned qreg[64];
#pragma unroll
                for (int i = 0; i < 16; ++i) { const v4u w = *(const v4u*)(QP + (size_t)t * PQW + h * 256 + p * 128 + 8 * i); qreg[4 * i] = w.x; qreg[4 * i + 1] = w.y; qreg[4 * i + 2] = w.z; qreg[4 * i + 3] = w.w; }
                int cnt = 0;
                for (int key = 0; key < 128; ++key) {
                    float s = 0.f;
#pragma unroll
                    for (int i = 0; i < 16; ++i) { const v4u w = *(const LAS v4u*)(keys + key * 128 + 8 * i);
                        s += bflo(qreg[4 * i]) * bflo(w.x) + bfhi(qreg[4 * i]) * bfhi(w.x) + bflo(qreg[4 * i + 1]) * bflo(w.y) + bfhi(qreg[4 * i + 1]) * bfhi(w.y)
                           + bflo(qreg[4 * i + 2]) * bflo(w.z) + bfhi(qreg[4 * i + 2]) * bfhi(w.z) + bflo(qreg[4 * i + 3]) * bflo(w.w) + bfhi(qreg[4 * i + 3]) * bfhi(w.w); }
                    int pos = cnt < 16 ? cnt : 16;
                    while (pos > 0 && s > sv[(p * 16 + pos - 1) * 256 + tid]) { if (pos < 16) { sv[(p * 16 + pos) * 256 + tid] = sv[(p * 16 + pos - 1) * 256 + tid]; si[(p * 16 + pos) * 256 + tid] = si[(p * 16 + pos - 1) * 256 + tid]; } --pos; }
                    if (pos < 16) { sv[(p * 16 + pos) * 256 + tid] = s; si[(p * 16 + pos) * 256 + tid] = key; }
                    if (cnt < 16) ++cnt;
                }
            }
        }
        if (act) {
            for (int i = 0; i < 16; ++i) ptr[i * 256 + tid] = 0;
            float top[16]; int eid[16];
#pragma unroll
            for (int rnk = 0; rnk < 16; ++rnk) {
                float best = -INFINITY; int bi = 0;
                for (int i = 0; i < 16; ++i) { const int jj = ptr[i * 256 + tid]; if (jj < 16) { const float c = sv[i * 256 + tid] + sv[(16 + jj) * 256 + tid]; if (c > best) { best = c; bi = i; } } }
                const int bj = ptr[bi * 256 + tid]; ptr[bi * 256 + tid] = bj + 1;
                top[rnk] = best; eid[rnk] = si[bi * 256 + tid] * 128 + si[(16 + bj) * 256 + tid];
            }
            float mx = top[0], den = 0.f;
#pragma unroll
            for (int rnk = 0; rnk < 16; ++rnk) { top[rnk] = __expf(top[rnk] - mx); den += top[rnk]; }
            int* eo = (int*)(ws + WS_EIDX) + (size_t)t * 128 + h * 16; float* go = (float*)(ws + WS_GATE) + (size_t)t * 128 + h * 16;
#pragma unroll
            for (int rnk = 0; rnk < 16; ++rnk) { eo[rnk] = eid[rnk]; go[rnk] = top[rnk] / den; }
        }
    }
    __syncthreads();
}

constexpr int CH_BYTES = 40960, CH_W = 0, CH_QD = 8192, CH_QK = 16384, CH_KDT = 24576, CH_U = 32768;
constexpr int PST = 68;
typedef __attribute__((address_space(3))) float lf32;

__device__ __forceinline__ void store_afrag(const lf32* src, const lf32* rowscale, unsigned char* dst, int tid) {
    const int blk = tid >> 6, lane = tid & 63, mt = blk >> 1, ks = blk & 1, r = lane & 15, g = lane >> 4, row = 16 * mt + r, k0 = 32 * ks + 4 * g;
    f32x4 v0 = *(const LAS f32x4*)(src + row * PST + k0), v1 = *(const LAS f32x4*)(src + row * PST + k0 + 16);
    const float rs = rowscale ? rowscale[row] : 1.0f; v0 = v0 * rs; v1 = v1 * rs;
    v4u o; o.x = pk2(v0.x, v0.y); o.y = pk2(v0.z, v0.w); o.z = pk2(v1.x, v1.y); o.w = pk2(v1.z, v1.w);
    *(v4u*)(dst + tid * 16) = o;
}
__device__ __forceinline__ void store_afrag_T(const lf32* src, const lf32* kscale, unsigned char* dst, int tid) {
    const int blk = tid >> 6, lane = tid & 63, mt = blk >> 1, ks = blk & 1, r = lane & 15, g = lane >> 4, row = 16 * mt + r, k0 = 32 * ks + 4 * g;
    float v[8];
#pragma unroll
    for (int i = 0; i < 4; ++i) { v[i] = src[(k0 + i) * PST + row] * kscale[k0 + i]; v[4 + i] = src[(k0 + 16 + i) * PST + row] * kscale[k0 + 16 + i]; }
    v4u o; o.x = pk2(v[0], v[1]); o.y = pk2(v[2], v[3]); o.z = pk2(v[4], v[5]); o.w = pk2(v[6], v[7]);
    *(v4u*)(dst + tid * 16) = o;
}
__device__ __forceinline__ void store_cfrag(const lf32* src, unsigned char* dst, int tid) {
#pragma unroll
    for (int rep = 0; rep < 2; ++rep) { const int q = tid + 512 * rep, sm = q >> 6, lane = q & 63, sl = sm >> 2, mt = sm & 3, col = lane & 15, g = lane >> 4;
        const lf32* p = src + (16 * mt + 4 * g) * PST + 16 * sl + col;
        v2u o; o.x = pk2(p[0], p[PST]); o.y = pk2(p[2 * PST], p[3 * PST]); *(v2u*)(dst + q * 8) = o; }
}

constexpr int BST = 72;
__device__ __forceinline__ float quad_sum(float v) {
    v += __int_as_float(__builtin_amdgcn_mov_dpp(__float_as_int(v), 0xB1, 0xF, 0xF, true));
    v += __int_as_float(__builtin_amdgcn_mov_dpp(__float_as_int(v), 0x4E, 0xF, 0xF, true));
    return v;
}
struct ConvIn { unsigned short x[3][11]; };
__device__ __forceinline__ void conv_load(ConvIn& ci, const bf16* graw, int it, int tid) {
    const int n = it & 127, bh = it >> 7, h = bh & 7, b = bh >> 3, c = tid & 63, tg = tid >> 6; const size_t row0 = (size_t)b * SEQ + n * 64; const int tl0 = n * 64;
#pragma unroll
    for (int part = 0; part < 3; ++part) { const bf16* src = graw + part * 512 + h * 64 + c;
#pragma unroll
        for (int i = 0; i < 11; ++i) { const int tt = tl0 + 8 * tg - 3 + i; ci.x[part][i] = tt >= 0 ? src[(row0 + 8 * tg - 3 + i) * 1536] : (unsigned short)0; } }
}
__device__ __forceinline__ void p3_gdn_prep(Frame& F, const Args& a) {
    unsigned char* ws = a.ws; const int tid = F.tid, wave = F.wave, lane = F.lane;
    const bf16* graw = (const bf16*)(ws + WS_GRAW); const float* ab = (const float*)(ws + WS_AB); const float* cw = a.in[8];
    lf32* Qs = (lf32*)(F.lds + RING_OFF); lf32* Ks = Qs + 64 * PST; lf32* Vs = Ks + 64 * PST; lf32* As = Vs + 64 * PST; lf32* QKs = As + 64 * PST; lf32* Us = QKs + 64 * PST; lf32* Ws = Us + 64 * PST;
    lf32* vG = Ws + 64 * PST; lf32* vbeta = vG + 64; lf32* veG = vbeta + 64; lf32* veGl = veG + 64; lf32* vqn = veGl + 64; lf32* vkn = vqn + 64; lf32* vbw = vkn + 64;
    LAS unsigned short* Qb = (LAS unsigned short*)(vbw + 64); LAS unsigned short* Kb = Qb + 64 * BST;
    constexpr int NCH = BATCH * GH * (SEQ / 64);
    ConvIn ci; float abv0 = 0.f, abv1 = 0.f;
    int it = blockIdx.x;
    if (it < NCH) { conv_load(ci, graw, it, tid); if (wave == 2) { const size_t r = (size_t)((it >> 7) >> 3) * SEQ + (it & 127) * 64 + lane; abv0 = ab[r * 16 + ((it >> 7) & 7)]; abv1 = ab[r * 16 + 8 + ((it >> 7) & 7)]; } }
    for (; it < NCH; it += F.G) {
        const int bh = it >> 7, h = bh & 7;
        __syncthreads();
        { const int c = tid & 63, tg = tid >> 6;
#pragma unroll
          for (int part = 0; part < 3; ++part) { const int ch = part * 512 + h * 64 + c; lf32* dst = part == 0 ? Qs : part == 1 ? Ks : Vs;
              const float w0 = cw[ch], w1 = cw[1536 + ch], w2 = cw[2 * 1536 + ch], w3 = cw[3 * 1536 + ch];
              float xv[11];
#pragma unroll
              for (int i = 0; i < 11; ++i) xv[i] = bf2f(ci.x[part][i]);
#pragma unroll
              for (int i = 0; i < 8; ++i) dst[(8 * tg + i) * PST + c] = siluf(w0 * xv[i] + w1 * xv[i + 1] + w2 * xv[i + 2] + w3 * xv[i + 3]); } }
        const float av = abv0, bv = abv1;
        { const int itn = it + F.G; if (itn < NCH) { conv_load(ci, graw, itn, tid); if (wave == 2) { const size_t r = (size_t)((itn >> 7) >> 3) * SEQ + (itn & 127) * 64 + lane; abv0 = ab[r * 16 + ((itn >> 7) & 7)]; abv1 = ab[r * 16 + 8 + ((itn >> 7) & 7)]; } } }
        __syncthreads();
        if (tid < 128) { const int row = tid & 63; const lf32* src = (tid < 64 ? Qs : Ks) + row * PST; float ss = 0.f;
#pragma unroll
            for (int i = 0; i < 16; ++i) { const f32x4 v = *(const LAS f32x4*)(src + 4 * i); ss += (v.x * v.x + v.y * v.y) + (v.z * v.z + v.w * v.w); }
            const float inv = 1.0f / sqrtf(ss + EPS); if (tid < 64) vqn[row] = inv * 0.125f; else vkn[row] = inv; }
        else if (tid < 192) { const int t = tid & 63;
            const float g = -__expf(a.in[9][h]) * softplusf(av + a.in[10][h]); float G = g;
#pragma unroll
            for (int o = 1; o < 64; o <<= 1) { const float up = __shfl_up(G, o); if (t >= o) G += up; }
            const float Gl = __shfl(G, 63);
            vG[t] = G; { const float be = sigm(bv); vbeta[t] = be; vbw[t] = be * __expf(G); } veG[t] = __expf(G); veGl[t] = __expf(Gl - G);
            if (t == 63) ((float*)(ws + WS_CD))[it] = __expf(Gl); }
        __syncthreads();
        { const int c = tid & 63, tg = tid >> 6;
#pragma unroll
          for (int i = 0; i < 8; ++i) { const int t = 8 * tg + i; const float qv = Qs[t * PST + c] * vqn[t], kv = Ks[t * PST + c] * vkn[t];
              Qs[t * PST + c] = qv; Ks[t * PST + c] = kv; Qb[t * BST + c] = (unsigned short)f2bf(qv); Kb[t * BST + c] = (unsigned short)f2bf(kv); } }
        __syncthreads();
        { const int mt = wave >> 1, r = lane & 15, g = lane >> 4;
#pragma unroll
          for (int t2 = 0; t2 < 2; ++t2) { const int nt = 2 * (wave & 1) + t2; f32x4 kk = {0.f, 0.f, 0.f, 0.f}, qk = kk;
              if (nt <= mt) {
#pragma unroll
                  for (int ks = 0; ks < 2; ++ks) { const bf16x8 ka = *(const LAS bf16x8*)(Kb + (16 * mt + r) * BST + 32 * ks + 8 * g), qa = *(const LAS bf16x8*)(Qb + (16 * mt + r) * BST + 32 * ks + 8 * g);
                      const bf16x8 kb = *(const LAS bf16x8*)(Kb + (16 * nt + r) * BST + 32 * ks + 8 * g);
                      kk = __builtin_amdgcn_mfma_f32_16x16x32_bf16(ka, kb, kk, 0, 0, 0); qk = __builtin_amdgcn_mfma_f32_16x16x32_bf16(qa, kb, qk, 0, 0, 0); } }
              const int s = 16 * nt + r; const float Gs = vG[s];
#pragma unroll
              for (int e = 0; e < 4; ++e) { const int c = 16 * mt + 4 * g + e; const float dec = __expf(fminf(vG[c] - Gs, 0.f));
                  As[c * PST + (s & 3) * 16 + (s >> 2)] = (c > s) ? vbeta[c] * kk[e] * dec : 0.f; QKs[c * PST + s] = (c >= s) ? qk[e] * dec : 0.f; } } }
        __syncthreads();
        { const int col = tid >> 2, q = tid & 3, j = col & 63; const bool isw = col >= 64; const lf32* src = isw ? Ks : Vs; const lf32* sc = isw ? vbw : vbeta; lf32* dst = isw ? Ws : Us;
          const lf32* Aq = As + q * 16; float x[16];
#pragma unroll
          for (int m = 0; m < 16; ++m) x[m] = 0.f;
#pragma unroll
          for (int i = 0; i < 64; ++i) { float p0 = 0.f, p1 = 0.f;
#pragma unroll
              for (int m4 = 0; m4 < (i + 15) / 16; ++m4) { const f32x4 avv = *(const LAS f32x4*)(Aq + i * PST + 4 * m4); p0 += avv.x * x[4 * m4]; p1 += avv.y * x[4 * m4 + 1]; p0 += avv.z * x[4 * m4 + 2]; p1 += avv.w * x[4 * m4 + 3]; }
              const float xi = src[i * PST + j] * sc[i] - quad_sum(p0 + p1);
              if (q == (i & 3)) x[i >> 2] = xi;
              if (q == 0) dst[i * PST + j] = xi; } }
        __syncthreads();
        { unsigned char* ch = ws + WS_CH + (size_t)it * CH_BYTES;
          store_afrag(Ws, nullptr, ch + CH_W, tid); store_afrag(Qs, veG, ch + CH_QD, tid); store_afrag(QKs, nullptr, ch + CH_QK, tid); store_afrag_T(Ks, veGl, ch + CH_KDT, tid); store_cfrag(Us, ch + CH_U, tid); }
    }
    __syncthreads();
}

__device__ __forceinline__ void p3_qknorm(Frame& F, const Args& a) {
    unsigned char* ws = a.ws; const int lane = F.lane;
    const int gw = blockIdx.x * NWAVES + F.wave, NGW = F.G * NWAVES;
    const float* qnw = a.in[6]; const float* knw = a.in[7];
    v4u nq[2] = {(v4u){0u, 0u, 0u, 0u}, (v4u){0u, 0u, 0u, 0u}};
    if (gw < M) { nq[0] = *(const v4u*)((const bf16*)(ws + WS_Q) + (size_t)gw * 512 + 8 * lane); nq[1] = *(const v4u*)((const bf16*)(ws + WS_K) + (size_t)gw * 512 + 8 * lane); }
    for (int t = gw; t < M; t += NGW) {
        const v4u cq[2] = {nq[0], nq[1]};
        if (t + NGW < M) { nq[0] = *(const v4u*)((const bf16*)(ws + WS_Q) + (size_t)(t + NGW) * 512 + 8 * lane); nq[1] = *(const v4u*)((const bf16*)(ws + WS_K) + (size_t)(t + NGW) * 512 + 8 * lane); }
#pragma unroll
        for (int which = 0; which < 2; ++which) {
            bf16* p = (bf16*)(ws + (which ? WS_K : WS_Q)) + (size_t)t * 512 + 8 * lane; const float* nw = which ? knw : qnw;
            const v4u w = cq[which]; float v[8] = {bflo(w.x), bfhi(w.x), bflo(w.y), bfhi(w.y), bflo(w.z), bfhi(w.z), bflo(w.w), bfhi(w.w)};
            float s = 0.f;
#pragma unroll
            for (int i = 0; i < 8; ++i) s += v[i] * v[i];
            s += __shfl_xor(s, 1); s += __shfl_xor(s, 2); s += __shfl_xor(s, 4);
            const float r = 1.0f / sqrtf(s * (1.f / 64.f) + EPS) * (which ? 1.0f : 0.125f);
            const int d0 = (8 * lane) & 63;
#pragma unroll
            for (int i = 0; i < 8; ++i) v[i] = v[i] * r * nw[d0 + i];
            v4u o; o.x = pk2(v[0], v[1]); o.y = pk2(v[2], v[3]); o.z = pk2(v[4], v[5]); o.w = pk2(v[6], v[7]); *(v4u*)p = o;
        }
    }
}

__device__ __forceinline__ bf16x8 pack8(const f32x4& x, const f32x4& y) { v4u w; w.x = pg8::cvt_pk_bf16(x.x, x.y); w.y = pg8::cvt_pk_bf16(x.z, x.w); w.z = pg8::cvt_pk_bf16(y.x, y.y); w.w = pg8::cvt_pk_bf16(y.z, y.w); return __builtin_bit_cast(bf16x8, w); }
constexpr int SC_SLOT = 34816, SC_NSLOT = 4, SC_U = 32768;
constexpr int SC_OB = SC_NSLOT * SC_SLOT, OST = 20, SC_CD = SC_OB + 2 * 64 * OST * 4;
#define SC_BAR() asm volatile("s_waitcnt lgkmcnt(0)\n\ts_barrier" ::: "memory")
__device__ __forceinline__ void scan_dma(const unsigned char* ch, LAS unsigned char* slot, int lw, int sl, int lane) {
#pragma unroll
    for (int i = 0; i < 8; ++i) __builtin_amdgcn_global_load_lds((const unsigned*)(ch + lw * 8192 + i * 1024 + lane * 16), (LAS unsigned*)(slot + lw * 8192 + i * 1024), 16, 0, 0);
    const int up = lw & 1;
    __builtin_amdgcn_global_load_lds((const unsigned*)(ch + CH_U + sl * 2048 + up * 1024 + lane * 16), (LAS unsigned*)(slot + SC_U + up * 1024), 16, 0, 0);
}
__device__ __forceinline__ void scan_step(LAS unsigned char* lds, f32x4 (&S)[4], float cdv, int n, int lane) {
    const LAS unsigned char* ob = lds + (n & 3) * SC_SLOT; lf32* ot = (lf32*)(lds + SC_OB) + (n & 1) * 64 * OST;
    const f32x4 zero = {0.f, 0.f, 0.f, 0.f};
    const bf16x8 Sb0 = pack8(S[0], S[1]), Sb1 = pack8(S[2], S[3]);
    f32x4 vn[4], o[4];
#pragma unroll
    for (int mt = 0; mt < 4; ++mt) { const bf16x8 a0 = *(const LAS bf16x8*)(ob + CH_W + (mt * 2) * 1024 + lane * 16), a1 = *(const LAS bf16x8*)(ob + CH_W + (mt * 2 + 1) * 1024 + lane * 16);
        f32x4 acc = __builtin_amdgcn_mfma_f32_16x16x32_bf16(a0, Sb0, zero, 0, 0, 0); acc = __builtin_amdgcn_mfma_f32_16x16x32_bf16(a1, Sb1, acc, 0, 0, 0);
        const v2u uu = *(const LAS v2u*)(ob + SC_U + (mt * 64 + lane) * 8);
        vn[mt] = (f32x4){bflo(uu.x), bfhi(uu.x), bflo(uu.y), bfhi(uu.y)} - acc; }
    const bf16x8 Vb0 = pack8(vn[0], vn[1]), Vb1 = pack8(vn[2], vn[3]);
#pragma unroll
    for (int mt = 0; mt < 4; ++mt) { const bf16x8 t0 = *(const LAS bf16x8*)(ob + CH_KDT + (mt * 2) * 1024 + lane * 16), t1 = *(const LAS bf16x8*)(ob + CH_KDT + (mt * 2 + 1) * 1024 + lane * 16);
        f32x4 acc = S[mt] * cdv; acc = __builtin_amdgcn_mfma_f32_16x16x32_bf16(t0, Vb0, acc, 0, 0, 0); acc = __builtin_amdgcn_mfma_f32_16x16x32_bf16(t1, Vb1, acc, 0, 0, 0); vn[mt] = acc; }
#pragma unroll
    for (int mt = 0; mt < 4; ++mt) { const bf16x8 q0 = *(const LAS bf16x8*)(ob + CH_QD + (mt * 2) * 1024 + lane * 16), q1 = *(const LAS bf16x8*)(ob + CH_QD + (mt * 2 + 1) * 1024 + lane * 16);
        const bf16x8 k0 = *(const LAS bf16x8*)(ob + CH_QK + (mt * 2) * 1024 + lane * 16), k1 = *(const LAS bf16x8*)(ob + CH_QK + (mt * 2 + 1) * 1024 + lane * 16);
        f32x4 acc = __builtin_amdgcn_mfma_f32_16x16x32_bf16(q0, Sb0, zero, 0, 0, 0); acc = __builtin_amdgcn_mfma_f32_16x16x32_bf16(q1, Sb1, acc, 0, 0, 0);
        acc = __builtin_amdgcn_mfma_f32_16x16x32_bf16(k0, Vb0, acc, 0, 0, 0); acc = __builtin_amdgcn_mfma_f32_16x16x32_bf16(k1, Vb1, acc, 0, 0, 0); o[mt] = acc; }
#pragma unroll
    for (int mt = 0; mt < 4; ++mt) S[mt] = vn[mt];
    const int col = lane & 15, g = lane >> 4;
#pragma unroll
    for (int mt = 0; mt < 4; ++mt) { lf32* p = ot + (16 * mt + 4 * g) * OST + col; p[0] = o[mt].x; p[OST] = o[mt].y; p[2 * OST] = o[mt].z; p[3 * OST] = o[mt].w; }
}
__device__ __forceinline__ void scan_ostore(const lf32* ot, bf16* dst, int lane) {
    const lf32* p = ot + lane * OST; const f32x4 a0 = *(const LAS f32x4*)p, a1 = *(const LAS f32x4*)(p + 4), a2 = *(const LAS f32x4*)(p + 8), a3 = *(const LAS f32x4*)(p + 12);
    v4u w0, w1; w0.x = pk2(a0.x, a0.y); w0.y = pk2(a0.z, a0.w); w0.z = pk2(a1.x, a1.y); w0.w = pk2(a1.z, a1.w); w1.x = pk2(a2.x, a2.y); w1.y = pk2(a2.z, a2.w); w1.z = pk2(a3.x, a3.y); w1.w = pk2(a3.z, a3.w);
    *(v4u*)dst = w0; *(v4u*)(dst + 8) = w1;
}
__device__ __forceinline__ void p4_gdn_scan(Frame& F, const Args& a, int bh, int sl) {
    unsigned char* ws = a.ws; const int h = bh & 7, b = bh >> 3, wave = F.wave, lane = F.lane, tid = F.tid;
    const unsigned char* chb = ws + WS_CH + (size_t)bh * 128 * CH_BYTES; const float* cd = (const float*)(ws + WS_CD) + bh * 128;
    bf16* OG = (bf16*)(ws + WS_YGDN) + ((size_t)b * SEQ) * 512 + h * 64 + sl * 16;
    LAS unsigned char* lds = F.lds + RING_OFF;
    const lf32* cdl = (const lf32*)(lds + SC_CD);
    __syncthreads();
    if (tid < 128) ((lf32*)(lds + SC_CD))[tid] = cd[tid];
    if (wave == 0) {
        f32x4 S[4] = {(f32x4){0.f, 0.f, 0.f, 0.f}, (f32x4){0.f, 0.f, 0.f, 0.f}, (f32x4){0.f, 0.f, 0.f, 0.f}, (f32x4){0.f, 0.f, 0.f, 0.f}};
        SC_BAR();
        for (int m = 0; m < 128; ++m) { scan_step(lds, S, cdl[m], m, lane); SC_BAR(); }
        SC_BAR();
    } else if (wave <= 4) {
        const int lw = wave - 1;
        scan_dma(chb, lds, lw, sl, lane); scan_dma(chb + CH_BYTES, lds + SC_SLOT, lw, sl, lane); scan_dma(chb + 2 * CH_BYTES, lds + 2 * SC_SLOT, lw, sl, lane);
        asm volatile("s_waitcnt vmcnt(18)" ::: "memory");
        SC_BAR();
        for (int m = 0; m < 128; ++m) { const int c = m + 3 < 128 ? m + 3 : 127;
            scan_dma(chb + (size_t)c * CH_BYTES, lds + ((m + 3) & 3) * SC_SLOT, lw, sl, lane);
            asm volatile("s_waitcnt vmcnt(18)" ::: "memory");
            SC_BAR(); }
        asm volatile("s_waitcnt vmcnt(0)" ::: "memory");
        SC_BAR();
    } else if (wave == 5) {
        SC_BAR();
        for (int m = 0; m < 128; ++m) { if (m >= 1) scan_ostore((const lf32*)(lds + SC_OB) + ((m - 1) & 1) * 64 * OST, OG + (size_t)((m - 1) * 64 + lane) * 512, lane); SC_BAR(); }
        scan_ostore((const lf32*)(lds + SC_OB) + 64 * OST, OG + (size_t)(127 * 64 + lane) * 512, lane);
        SC_BAR();
    } else {
        SC_BAR();
        for (int m = 0; m < 128; ++m) SC_BAR();
        SC_BAR();
    }
    __syncthreads();
}
__device__ __forceinline__ void p4c_gdn_out(Frame& F, const Args& a) {
    unsigned char* ws = a.ws; const int lane = F.lane; bf16* Y = (bf16*)(ws + WS_YGDN); const bf16* Z = (const bf16*)(ws + WS_Z); const float* onw = a.in[11];
    const int gw = blockIdx.x * NWAVES + F.wave, NGW = F.G * NWAVES, d0 = (8 * lane) & 63;
    const f32x4 w0 = *(const f32x4*)(onw + d0), w1 = *(const f32x4*)(onw + d0 + 4);
    v4u no = {0u, 0u, 0u, 0u}, nz = no;
    if (gw < M) { no = *(const v4u*)(Y + (size_t)gw * 512 + 8 * lane); nz = *(const v4u*)(Z + (size_t)gw * 512 + 8 * lane); }
    for (int t = gw; t < M; t += NGW) {
        const v4u ow = no, zw = nz;
        if (t + NGW < M) { no = *(const v4u*)(Y + (size_t)(t + NGW) * 512 + 8 * lane); nz = *(const v4u*)(Z + (size_t)(t + NGW) * 512 + 8 * lane); }
        float o[8] = {bflo(ow.x), bfhi(ow.x), bflo(ow.y), bfhi(ow.y), bflo(ow.z), bfhi(ow.z), bflo(ow.w), bfhi(ow.w)};
        const float z[8] = {bflo(zw.x), bfhi(zw.x), bflo(zw.y), bfhi(zw.y), bflo(zw.z), bfhi(zw.z), bflo(zw.w), bfhi(zw.w)};
        float ss = 0.f;
#pragma unroll
        for (int i = 0; i < 8; ++i) ss += o[i] * o[i];
        ss += __shfl_xor(ss, 1); ss += __shfl_xor(ss, 2); ss += __shfl_xor(ss, 4);
        const float rstd = 1.0f / sqrtf(ss * (1.f / 64.f) + EPS);
        const float wv[8] = {w0.x, w0.y, w0.z, w0.w, w1.x, w1.y, w1.z, w1.w};
#pragma unroll
        for (int i = 0; i < 8; ++i) o[i] = o[i] * rstd * wv[i] * siluf(z[i]);
        v4u r; r.x = pk2(o[0], o[1]); r.y = pk2(o[2], o[3]); r.z = pk2(o[4], o[5]); r.w = pk2(o[6], o[7]);
        *(v4u*)(Y + (size_t)t * 512 + 8 * lane) = r;
    }
}

typedef float f32x16 __attribute__((ext_vector_type(16)));
constexpr int TK_KROW = 272;
constexpr int TK_KEYS = 0, TK_LIST = 2 * 128 * TK_KROW;
__device__ __forceinline__ unsigned f2ord(float f) { const unsigned u = __float_as_uint(f); return u ^ ((unsigned)((int)u >> 31) | 0x80000000u); }
__device__ __forceinline__ float ord2f(unsigned o) { const unsigned u = (o & 0x80000000u) ? (o ^ 0x80000000u) : ~o; return __uint_as_float(u); }
#define TK_CE(a, b) do { const unsigned _h = max(a, b), _l = min(a, b); a = _h; b = _l; } while (0)
__device__ __forceinline__ void sort16(unsigned (&v)[16]) {
#pragma unroll
    for (int k = 2; k <= 16; k <<= 1)
#pragma unroll
        for (int j = k >> 1; j > 0; j >>= 1)
#pragma unroll
            for (int i = 0; i < 16; ++i) { const int l = i ^ j; if (l > i) { if ((i & k) == 0) TK_CE(v[i], v[l]); else TK_CE(v[l], v[i]); } }
}
__device__ __forceinline__ void merge16(unsigned (&a)[16], const unsigned (&b)[16]) {
#pragma unroll
    for (int i = 0; i < 16; ++i) a[i] = max(a[i], b[15 - i]);
#pragma unroll
    for (int j = 8; j > 0; j >>= 1)
#pragma unroll
        for (int i = 0; i < 16; ++i) { const int l = i ^ j; if (l > i) TK_CE(a[i], a[l]); }
}
__device__ __forceinline__ void p9_topk(Frame& F, const Args& a) {
    unsigned char* ws = a.ws; const int tid = F.tid, lane = F.lane, wave = F.wave, tk = lane & 31, half = lane >> 5;
    const bf16* QP = (const bf16*)(ws + WS_QP); const bf16* SK = (const bf16*)(ws + WS_SKEY);
    LAS unsigned char* kl = F.lds + RING_OFF + TK_KEYS; LAS unsigned* lst = (LAS unsigned*)(F.lds + RING_OFF + TK_LIST) + wave * 1024;
    for (int it = blockIdx.x; it < (M / 256) * PH; it += F.G) {
        const int h = it & 7, t = (it >> 3) * 256 + wave * 32 + tk;
        __syncthreads();
        for (int i = tid; i < 2 * 128 * 16; i += 512) { const int row = i >> 4, c = i & 15; *(LAS v4u*)(kl + row * TK_KROW + c * 16) = *(const v4u*)(SK + (size_t)h * 2 * 128 * 128 + row * 128 + c * 8); }
        __syncthreads();
        unsigned top[2][16];
#pragma unroll
        for (int p = 0; p < 2; ++p) {
            bf16x8 qf[8];
#pragma unroll
            for (int ks = 0; ks < 8; ++ks) qf[ks] = *(const bf16x8*)(QP + (size_t)t * PQW + h * 256 + p * 128 + 16 * ks + 8 * half);
            unsigned best[16];
#pragma unroll
            for (int mt = 0; mt < 4; ++mt) {
                f32x16 acc = {0.f, 0.f, 0.f, 0.f, 0.f, 0.f, 0.f, 0.f, 0.f, 0.f, 0.f, 0.f, 0.f, 0.f, 0.f, 0.f};
#pragma unroll
                for (int ks = 0; ks < 8; ++ks) { const bf16x8 kf = *(const LAS bf16x8*)(kl + (p * 128 + mt * 32 + tk) * TK_KROW + ks * 32 + half * 16);
                    acc = __builtin_amdgcn_mfma_f32_32x32x16_bf16(kf, qf[ks], acc, 0, 0, 0); }
                unsigned g[16];
#pragma unroll
                for (int r = 0; r < 16; ++r) { const int key = 32 * mt + (r & 3) + 8 * (r >> 2) + 4 * half; g[r] = (f2ord(acc[r]) & ~127u) | (unsigned)(127 - key); }
                sort16(g);
                if (mt == 0) {
#pragma unroll
                    for (int r = 0; r < 16; ++r) best[r] = g[r]; }
                else merge16(best, g);
            }
            unsigned oth[16];
#pragma unroll
            for (int r = 0; r < 16; ++r) oth[r] = __shfl_xor(best[r], 32);
            merge16(best, oth);
#pragma unroll
            for (int r = 0; r < 16; ++r) top[p][r] = best[r];
        }
        if (half == 0) {
#pragma unroll
            for (int r = 0; r < 16; ++r) { lst[tk * 32 + r] = top[0][r]; lst[tk * 32 + 16 + r] = top[1][r]; } }
        float v1[16], v2[16];
#pragma unroll
        for (int r = 0; r < 16; ++r) { v1[r] = ord2f(top[0][r] & ~127u); v2[r] = ord2f(top[1][r] & ~127u); }
        unsigned c0[16], c1[16], c2[16], c3[16];
#pragma unroll
        for (int j = 0; j < 16; ++j) c0[j] = (f2ord(v1[0] + v2[j]) & ~255u) | (unsigned)(255 - j);
        { int n = 0;
#pragma unroll
          for (int i = 1; i < 16; ++i)
#pragma unroll
              for (int j = 0; j < 16; ++j) if ((i + 1) * (j + 1) <= 16) { const unsigned pk = (f2ord(v1[i] + v2[j]) & ~255u) | (unsigned)(255 - (i * 16 + j));
                  if (n < 16) c1[n] = pk; else if (n < 32) c2[n - 16] = pk; else c3[n - 32] = pk; ++n; }
#pragma unroll
          for (int r = 2; r < 16; ++r) c3[r] = 0u; }
        sort16(c1); sort16(c2); sort16(c3); merge16(c0, c1); merge16(c2, c3); merge16(c0, c2);
        LDS_WAIT(); asm volatile("" ::: "memory");
        float sm[16]; int eid[16];
#pragma unroll
        for (int r = 0; r < 16; ++r) { const int cid = 255 - (int)(c0[r] & 255u), i = cid >> 4, j = cid & 15;
            const unsigned p1 = lst[tk * 32 + i], p2 = lst[tk * 32 + 16 + j];
            sm[r] = ord2f(p1 & ~127u) + ord2f(p2 & ~127u); eid[r] = (127 - (int)(p1 & 127u)) * 128 + (127 - (int)(p2 & 127u)); }
        float den = 0.f; const float mx = sm[0];
#pragma unroll
        for (int r = 0; r < 16; ++r) { sm[r] = __expf(sm[r] - mx); den += sm[r]; }
        const float inv = 1.0f / den;
        if (half == 0) { int* eo = (int*)(ws + WS_EIDX) + (size_t)t * 128 + h * 16;
#pragma unroll
            for (int r = 0; r < 16; r += 4) *(v4u*)(eo + r) = (v4u){(unsigned)eid[r], (unsigned)eid[r + 1], (unsigned)eid[r + 2], (unsigned)eid[r + 3]}; }
        else { float* go = (float*)(ws + WS_GATE) + (size_t)t * 128 + h * 16;
#pragma unroll
            for (int r = 0; r < 16; r += 4) *(f32x4*)(go + r) = (f32x4){sm[r] * inv, sm[r + 1] * inv, sm[r + 2] * inv, sm[r + 3] * inv}; }
    }
    __syncthreads();
}

__device__ __forceinline__ float softplus_fast(float x) { return fmaxf(x, 0.f) + __logf(1.0f + __expf(-fabsf(x))); }
struct AttnTile { bf16x8 k[4]; v2u v[2][2][2]; };
__device__ __forceinline__ void attn_load(AttnTile& T, const bf16* Kb, const bf16* VTb, int key0, int tk, int half) {
#pragma unroll
    for (int ks = 0; ks < 4; ++ks) T.k[ks] = *(const bf16x8*)(Kb + (size_t)(key0 + tk) * 512 + 16 * ks + 8 * half);
#pragma unroll
    for (int mt = 0; mt < 2; ++mt)
#pragma unroll
        for (int s = 0; s < 2; ++s) { const bf16* p = VTb + (size_t)(32 * mt + tk) * SEQ + key0 + 16 * s + 4 * half; T.v[mt][s][0] = *(const v2u*)p; T.v[mt][s][1] = *(const v2u*)(p + 8); }
}
__device__ __forceinline__ void p4_attn(Frame& F, const Args& a, int blk, int nblk) {
    unsigned char* ws = a.ws; const int lane = F.lane, tk = lane & 31, half = lane >> 5;
    const bf16* Q = (const bf16*)(ws + WS_Q); const bf16* K = (const bf16*)(ws + WS_K); const bf16* VT = (const bf16*)(ws + WS_V); bf16* Y = (bf16*)(ws + WS_YSB);
    const int gwv = blk * NWAVES + F.wave, nwv = nblk * NWAVES;
    for (int u = gwv; u < BATCH * SBH * (SEQ / 32); u += nwv) {
        const int bh = u & 15, qt = u >> 4, b = bh >> 3, h = bh & 7;
        const bf16* Kb = K + (size_t)b * SEQ * 512 + h * 64; const bf16* VTb = VT + (size_t)bh * 64 * SEQ;
        bf16x8 qf[4];
#pragma unroll
        for (int ks = 0; ks < 4; ++ks) qf[ks] = *(const bf16x8*)(Q + ((size_t)b * SEQ + qt * 32 + tk) * 512 + h * 64 + 16 * ks + 8 * half);
        f32x16 o0 = {0.f, 0.f, 0.f, 0.f, 0.f, 0.f, 0.f, 0.f, 0.f, 0.f, 0.f, 0.f, 0.f, 0.f, 0.f, 0.f}, o1 = o0; const f32x16 zero16 = o0;
        float R = 0.f;
        AttnTile cur, nxt; attn_load(cur, Kb, VTb, qt * 32, tk, half);
        for (int kt = qt; kt >= 0; --kt) {
            if (kt > 0) attn_load(nxt, Kb, VTb, (kt - 1) * 32, tk, half);
            f32x16 z = __builtin_amdgcn_mfma_f32_32x32x16_bf16(cur.k[0], qf[0], zero16, 0, 0, 0);
            z = __builtin_amdgcn_mfma_f32_32x32x16_bf16(cur.k[1], qf[1], z, 0, 0, 0); z = __builtin_amdgcn_mfma_f32_32x32x16_bf16(cur.k[2], qf[2], z, 0, 0, 0); z = __builtin_amdgcn_mfma_f32_32x32x16_bf16(cur.k[3], qf[3], z, 0, 0, 0);
            const bool diag = (kt == qt);
            float sp[16], T[4];
#pragma unroll
            for (int r = 0; r < 16; ++r) { const int key = (r & 3) + 8 * (r >> 2) + 4 * half; const bool valid = !diag || key < tk; sp[r] = valid ? softplus_fast(z[r]) : 0.f; }
#pragma unroll
            for (int g = 0; g < 4; ++g) T[g] = (sp[4 * g] + sp[4 * g + 1]) + (sp[4 * g + 2] + sp[4 * g + 3]);
            float PT[4];
#pragma unroll
            for (int g = 0; g < 4; ++g) PT[g] = __shfl_xor(T[g], 32);
            float later[4]; later[3] = half ? 0.f : PT[3];
#pragma unroll
            for (int g = 2; g >= 0; --g) later[g] = later[g + 1] + T[g + 1] + (half ? PT[g + 1] : PT[g]);
            const float total = ((T[0] + T[1]) + (T[2] + T[3])) + ((PT[0] + PT[1]) + (PT[2] + PT[3]));
            float p[16];
#pragma unroll
            for (int g = 0; g < 4; ++g) { float c = R + later[g];
#pragma unroll
                for (int j = 3; j >= 0; --j) { const int r = 4 * g + j; const int key = (r & 3) + 8 * (r >> 2) + 4 * half; const bool valid = !diag || key < tk;
                    p[r] = valid ? __expf(z[r] - sp[r] - c) : 0.f; c += sp[r]; } }
            R += total;
            const bf16x8 pb0 = pack8((f32x4){p[0], p[1], p[2], p[3]}, (f32x4){p[4], p[5], p[6], p[7]}), pb1 = pack8((f32x4){p[8], p[9], p[10], p[11]}, (f32x4){p[12], p[13], p[14], p[15]});
#define VFRAG(mt, s) __builtin_bit_cast(bf16x8, (v4u){cur.v[mt][s][0].x, cur.v[mt][s][0].y, cur.v[mt][s][1].x, cur.v[mt][s][1].y})
            o0 = __builtin_amdgcn_mfma_f32_32x32x16_bf16(VFRAG(0, 0), pb0, o0, 0, 0, 0); o0 = __builtin_amdgcn_mfma_f32_32x32x16_bf16(VFRAG(0, 1), pb1, o0, 0, 0, 0);
            o1 = __builtin_amdgcn_mfma_f32_32x32x16_bf16(VFRAG(1, 0), pb0, o1, 0, 0, 0); o1 = __builtin_amdgcn_mfma_f32_32x32x16_bf16(VFRAG(1, 1), pb1, o1, 0, 0, 0);
#undef VFRAG
            if (__all(R > 105.f)) break;
            cur = nxt;
        }
        bf16* yp = Y + ((size_t)b * SEQ + qt * 32 + tk) * 512 + h * 64 + 4 * half;
#pragma unroll
        for (int g = 0; g < 4; ++g) { v2u w0, w1; w0.x = pk2(o0[4 * g], o0[4 * g + 1]); w0.y = pk2(o0[4 * g + 2], o0[4 * g + 3]); w1.x = pk2(o1[4 * g], o1[4 * g + 1]); w1.y = pk2(o1[4 * g + 2], o1[4 * g + 3]);
            *(v2u*)(yp + 8 * g) = w0; *(v2u*)(yp + 32 + 8 * g) = w1; }
    }
}
#ifndef PROBE_PH
#define PROBE_PH (-1)
#define PROBE_N 1
#endif
#ifndef PROBE_MASK
#define PROBE_MASK 0
#endif
#ifndef PROBE_VAR
#define PROBE_VAR 0
#endif
__global__ void __launch_bounds__(NWAVES * 64, 2) mk_fwd(Args args) {
    extern __shared__ __attribute__((aligned(16))) unsigned char lds[];
    Frame F;
    F.lds = (LAS unsigned char*)lds;
    F.MISC = (volatile LAS unsigned*)(F.lds + MISC_OFF);
    F.tid = threadIdx.x; F.lane = F.tid & 63; F.wave = __builtin_amdgcn_readfirstlane(F.tid >> 6);
    F.G = gridDim.x;
    unsigned char* ws = args.ws;
    F.ctl = (gu32*)(ws + WS_CTL);
    for (int u = F.tid; u < (LDS_BYTES - LDSCTL_OFF) / 4; u += NWAVES * 64) ((LAS unsigned*)(F.lds + LDSCTL_OFF))[u] = 0u;
    __syncthreads();
    const bool multi = (args.ph_hi - args.ph_lo) > 1;
    XcdBarrier bar; bar.bar = (unsigned*)(F.ctl + CW_BAR); bar.x = 0; bar.st = nullptr;
    if (multi) bar = xcd_barrier_post((unsigned*)(F.ctl + CW_BAR), F.MISC + 8);
    const int lo = args.ph_lo, hi = args.ph_hi;
#define IN(k) (lo <= (k) && (k) < hi)
#define REP(k) for (int _r = 0; _r < ((k) == PROBE_PH ? PROBE_N : 1); ++_r)
#define SEAM(k) do { if (IN(k) && (k) + 1 < hi) { xcd_barrier(bar); if (PROBE_PH == 99) { xcd_barrier(bar); xcd_barrier(bar); } } } while (0)
    const float* mod = (const float*)(ws + WS_MOD);
#define STAMP(i) do { if (PROBE_PH >= 100 && blockIdx.x == 0 && F.tid == 0) F.MISC[16 + (i)] = (unsigned)__builtin_amdgcn_s_memrealtime(); } while (0)
    STAMP(0);

    if (IN(0)) { REP(0) p0_prologue(F, args); } SEAM(0); STAMP(1);
    if (IN(1)) { REP(1) norm_mod_rows(F, args.in[0], args.in[4], mod, 0, (bf16*)(ws + WS_XN), nullptr); } SEAM(1); STAMP(2);
    if (IN(2)) {
#define BODY2 \
        pg8::Gemm g{(const bf16*)(ws + WS_XN), (const bf16*)(ws + WS_WIN), M, INWP, D}; pg8::StaticOrder S; S.init(M, INWP, F.G, (int)blockIdx.x); \
        pg8::EpiInProj E{(bf16*)(ws + WS_Q), (bf16*)(ws + WS_K), (bf16*)(ws + WS_V), (bf16*)(ws + WS_GRAW), (bf16*)(ws + WS_Z), (bf16*)args.out, (float*)(ws + WS_AB)}; \
        pg8::gemm_phase<pg8::EpiInProj, pg8::StaticOrder, true, true>(F.lds + RING_OFF, g, S, E);
        BODY2
        if (PROBE_PH == 2) { BODY2 }
#undef BODY2
    } SEAM(2); STAMP(3);
    if (IN(3)) { REP(3) p3_gdn_prep(F, args); p3_qknorm(F, args); } SEAM(3); STAMP(4);
    if (IN(4)) { constexpr int NSC = BATCH * GH * 4;
        if (blockIdx.x < NSC) { REP(4) p4_gdn_scan(F, args, (int)(blockIdx.x & 7) + 8 * (int)(blockIdx.x >> 5), (int)(blockIdx.x >> 3) & 3); }
        else REP(40) { p4_attn(F, args, (int)blockIdx.x - NSC, F.G - NSC); peer_tables_to_fp8(args, (int)blockIdx.x - NSC, F.G - NSC, F.tid); }
        xcd_barrier(bar);
        p4c_gdn_out(F, args); } SEAM(4); STAMP(5);
    if (IN(5)) {
#define BODY5 \
        { pg8::Gemm g{(const bf16*)(ws + WS_YSB), (const bf16*)(ws + WS_WSB), M, D, 512}; pg8::StaticOrder S; S.init(M, D, F.G, (int)blockIdx.x); \
          pg8::EpiMerge<0> E{(const bf16*)args.out, (bf16*)(ws + WS_MERGED)}; \
          pg8::gemm_phase<pg8::EpiMerge<0>, pg8::StaticOrder, true, true>(F.lds + RING_OFF, g, S, E); } \
        VM_WAIT(); __syncthreads(); \
        if (F.tid == 0) { __builtin_amdgcn_fence(__ATOMIC_ACQ_REL, "agent"); VM_WAIT(); } \
        __syncthreads(); \
        { pg8::Gemm g{(const bf16*)(ws + WS_YGDN), (const bf16*)(ws + WS_WGDN), M, D, 512}; pg8::StaticOrder S; S.init(M, D, F.G, (int)blockIdx.x); \
          pg8::EpiMerge<1> E{(const bf16*)args.out, (bf16*)(ws + WS_MERGED)}; \
          pg8::gemm_phase<pg8::EpiMerge<1>, pg8::StaticOrder, true, true>(F.lds + RING_OFF, g, S, E); }
        BODY5
        if (PROBE_PH == 5) { BODY5 }
#undef BODY5
    } SEAM(5); STAMP(6);
    if (IN(6)) {
#define BODY6 \
        pg8::Gemm g{(const bf16*)(ws + WS_MERGED), (const bf16*)(ws + WS_WO), M, D, D}; pg8::StaticOrder S; S.init(M, D, F.G, (int)blockIdx.x); \
        pg8::EpiWo E{args.in[0], mod, args.out}; \
        pg8::gemm_phase<pg8::EpiWo, pg8::StaticOrder, true, true>(F.lds + RING_OFF, g, S, E);
        BODY6
        if (PROBE_PH == 6) { BODY6 }
#undef BODY6
    } SEAM(6); STAMP(7);
    if (IN(7)) { REP(7) norm_mod_rows(F, args.out, args.in[15], mod, 3, (bf16*)(ws + WS_XN), ws + WS_H28); } SEAM(7); STAMP(8);
    if (IN(8)) {
#define BODY8 \
        pg8::Gemm g{(const bf16*)(ws + WS_XN), (const bf16*)(ws + WS_WQ), M, PQW, D}; pg8::StaticOrder S; S.init(M, PQW, F.G, (int)blockIdx.x); \
        pg8::EpiBf16<0> E{(bf16*)(ws + WS_QP), PQW, nullptr, 0, 0, 1.f}; \
        pg8::gemm_phase<pg8::EpiBf16<0>, pg8::StaticOrder, true, true>(F.lds + RING_OFF, g, S, E);
        BODY8
        if (PROBE_PH == 8) { BODY8 }
#undef BODY8
    } SEAM(8); STAMP(9);
    if (IN(9)) REP(9) { p9_topk(F, args); } SEAM(9); STAMP(10);
    if (IN(10)) { REP(10) p10a_peer_u(F, args); xcd_barrier(bar); REP(11) p10b_peer_v(F, args, _r == 0 ? args.out : (float*)(ws + WS_QP)); }
    STAMP(11);
    if (PROBE_PH >= 100 && blockIdx.x == 0 && F.tid == 0) { unsigned d = 0; for (int k = 0; k < 11; ++k) if ((PROBE_MASK >> k) & 1) d += F.MISC[16 + k + 1] - F.MISC[16 + k];
        const unsigned t0 = (unsigned)__builtin_amdgcn_s_memrealtime(); while ((unsigned)__builtin_amdgcn_s_memrealtime() - t0 < d) __builtin_amdgcn_s_sleep(8); }
#undef IN
#undef REP
#undef SEAM
}
extern "C" void kernel_launch(void* const* d_in, const int* in_sizes, int n_in, void* d_out, int out_size, void* d_ws, size_t ws_size, hipStream_t stream) {
    static int grid = 0;
    if (grid == 0) {
        if (n_in != 20 || out_size != M * D || ws_size < WS_END) { fprintf(stderr, "kernel_launch: unexpected shapes n_in %d out %d ws %zu\n", n_in, out_size, ws_size); grid = -1; return; }
        int dev = 0, cus = 0;
        if (hipGetDevice(&dev) != hipSuccess || hipDeviceGetAttribute(&cus, hipDeviceAttributeMultiprocessorCount, dev) != hipSuccess) { grid = -1; return; }
        if (hipFuncSetAttribute((const void*)mk_fwd, hipFuncAttributeMaxDynamicSharedMemorySize, LDS_BYTES) != hipSuccess) { fprintf(stderr, "kernel_launch: hipFuncSetAttribute failed\n"); grid = -1; return; }
        (void)hipGetLastError();
        grid = cus;
    }
    if (grid < 0) return;
    (void)hipMemsetAsync((char*)d_ws + WS_CTL, 0, CTL_ZERO_BYTES, stream);
    Args a{};
    for (int i = 0; i < 20; ++i) a.in[i] = (const float*)d_in[i];
    a.out = (float*)d_out; a.ws = (unsigned char*)d_ws;
    auto mk = [&](int lo, int hi) { a.ph_lo = lo; a.ph_hi = hi; a.li = 0; hipLaunchKernelGGL(mk_fwd, dim3(grid), dim3(NWAVES * 64), LDS_BYTES, stream, a); };
    mk(0, 11);
}
```

```cpp
#include <hip/hip_runtime.h>
#include <cstdio>
#include <cstdint>
#include <cmath>

constexpr int D = 1024, BATCH = 2, SEQ = 8192, M = BATCH * SEQ;
constexpr int SBH = 8, SBD = 64, SBW = 512;
constexpr int GH = 8, GDK = 64, GDV = 64, GCONVW = 1536;
constexpr int INW = 5648, INWP = 5888;
constexpr int PH = 8, PNK = 128, PQD = 256, PHALF = 128, PTOPK = 16, PNE = 16384, PQW = PH * PQD;
constexpr float EPS = 1e-6f;

namespace pg8 {
#define PG8_LAS __attribute__((address_space(3)))
typedef unsigned short bf16_t;
typedef short bf16x8 __attribute__((ext_vector_type(8)));
typedef float f32x4 __attribute__((ext_vector_type(4)));
typedef unsigned u32x4 __attribute__((ext_vector_type(4)));
constexpr int BM = 256, BK = 64, HALF = 128, HTB = HALF * BK * 2  , STAGE_BYTES = 8 * HTB, NXCD = 8, WGM = 8;

__host__ __device__ __forceinline__ int lds_byte(int r, int c) { const int st = (r >> 4) * 2 + (c >> 5), rr = r & 15, cc = c & 31, ob = rr * 64 + cc * 2; return st * 1024 + (ob ^ (((ob >> 9) & 1) << 5)); }
__host__ __device__ __forceinline__ void stage_rc(int b, int& R, int& C) { const int st = b / 1024, sb = b % 1024, swz = sb ^ (((sb >> 9) & 1) << 5); R = (st >> 1) * 16 + swz / 64; C = (st & 1) * 32 + (swz % 64) / 2; }
__host__ __device__ __forceinline__ int perm32(int rho) { const int n = rho >> 4, i = rho & 15; return 8 * (i >> 2) + 4 * n + (i & 3); }

struct Unit { int pm, pn; };
struct Gemm { const bf16_t* A; const bf16_t* Bt; int M, N, K; };

struct StaticOrder {
    int nM, nN, nwg, G, c;
    __host__ __device__ void init(int M, int N, int G_, int c_) { nM = M / BM; nN = N / BM; nwg = nM * nN; G = G_; c = c_; }
    __host__ __device__ bool next(int i, Unit& u) const {
        const long L = (long)i * G + c; if (L >= nwg) return false;
        int wgid = (int)L; { const int q = nwg / NXCD, r = nwg % NXCD, xcd = wgid % NXCD, off = wgid / NXCD; wgid = (xcd < r ? xcd * (q + 1) : r * (q + 1) + (xcd - r) * q) + off; }
        const int nig = WGM * nN, gid = wgid / nig, fm = gid * WGM, gsz = (nM - fm) < WGM ? (nM - fm) : WGM;
        u.pm = fm + ((wgid % nig) % gsz); u.pn = (wgid % nig) / gsz; return true;
    }
    __device__ __forceinline__ void a_ready(const Unit&) const {}
    __device__ __forceinline__ void done(const Unit&) const {}
};

__device__ __forceinline__ unsigned cvt_pk_bf16(float lo, float hi) { unsigned r; asm volatile("v_cvt_pk_bf16_f32 %0, %1, %2" : "=v"(r) : "v"(lo), "v"(hi)); return r; }
typedef float f32x2 __attribute__((ext_vector_type(2)));
__device__ __forceinline__ f32x2 gelu_pk(f32x2 v) {
    const f32x2 av = __builtin_elementwise_abs(v), d = av * 0.2316418882f + 1.0f;
    f32x2 t; t.x = __builtin_amdgcn_rcpf(d.x); t.y = __builtin_amdgcn_rcpf(d.y);
    f32x2 q = t * 0.5307027145f + (-0.7265760135f); q = q * t + 0.7107068705f; q = q * t + (-0.142248368f); q = q * t + 0.127414796f; q = q * t;
    const f32x2 s = (v * v) * (-0.72134752044f);
    f32x2 e; e.x = __builtin_amdgcn_exp2f(s.x); e.y = __builtin_amdgcn_exp2f(s.y);
    const f32x2 m = v * (q * e), r = v - m;
    f32x2 o; o.x = v.x < 0.f ? m.x : r.x; o.y = v.y < 0.f ? m.y : r.y; return o;
}

template <int ACT  > struct EpiBf16 {
    static constexpr bool PERM = true, AFTER_DRAIN = false; static_assert(ACT == 0 || ACT == 1, "EpiBf16: ACT is 0 (none) or 1 (gelu_pk)");
    bf16_t* O; int ldc; const float* bias; int split_cols; size_t split_stride; float scale0;
    __device__ __forceinline__ void operator()(const f32x4 (&acc)[2][2][4][2], const Unit& u, int wr, int wc, int fr, int fq) const {
        const int row0 = u.pm * BM + wr * 64 + fr; int colt = u.pn * BM; bf16_t* base = O;
        float sc = 1.f; if (split_cols) { const int t = colt / split_cols; base += (size_t)t * split_stride; colt -= t * split_cols; if (t == 0) sc = scale0; }
        const int col0 = colt + wc * 32 + 8 * fq, bcol0 = u.pn * BM + wc * 32 + 8 * fq;
        f32x4 bv[2][2];
#pragma unroll
        for (int bj = 0; bj < 2; ++bj)
#pragma unroll
            for (int n = 0; n < 2; ++n) bv[bj][n] = bias ? *(const f32x4*)(bias + bcol0 + bj * HALF + 4 * n) : (f32x4){0.f, 0.f, 0.f, 0.f};
#pragma unroll
        for (int ai = 0; ai < 2; ++ai)
#pragma unroll
            for (int m = 0; m < 4; ++m) { bf16_t* rowp = base + (size_t)(row0 + ai * HALF + m * 16) * ldc + col0;
#pragma unroll
                for (int bj = 0; bj < 2; ++bj) { f32x4 v0 = acc[ai][bj][m][0] + bv[bj][0], v1 = acc[ai][bj][m][1] + bv[bj][1];
                    if (ACT == 1) { f32x2 a = gelu_pk((f32x2){v0[0], v0[1]}), b = gelu_pk((f32x2){v0[2], v0[3]}), c = gelu_pk((f32x2){v1[0], v1[1]}), d = gelu_pk((f32x2){v1[2], v1[3]});
                        v0 = (f32x4){a.x, a.y, b.x, b.y}; v1 = (f32x4){c.x, c.y, d.x, d.y}; }
                    v0 = v0 * sc; v1 = v1 * sc; u32x4 w; w.x = cvt_pk_bf16(v0[0], v0[1]); w.y = cvt_pk_bf16(v0[2], v0[3]); w.z = cvt_pk_bf16(v1[0], v1[1]); w.w = cvt_pk_bf16(v1[2], v1[3]);
                    *(u32x4*)(rowp + bj * HALF) = w; } }
    }
};

__device__ __forceinline__ float sigmoidf_(float x) { return __builtin_amdgcn_rcpf(1.0f + __expf(-x)); }
__device__ __forceinline__ float bf2f(unsigned short h) { return __uint_as_float((unsigned)h << 16); }
__device__ __forceinline__ float bflo(unsigned w) { return __uint_as_float(w << 16); }
__device__ __forceinline__ float bfhi(unsigned w) { return __uint_as_float(w & 0xffff0000u); }

struct EpiInProj {
    static constexpr bool PERM = true, AFTER_DRAIN = false;
    bf16_t *q, *k, *v, *graw, *z, *gates; float* ab;
    __device__ __forceinline__ void operator()(const f32x4 (&acc)[2][2][4][2], const Unit& u, int wr, int wc, int fr, int fq) const {
        const int pn = u.pn; bf16_t* base; int ldc, ct; bool sig = false;
        if (pn >= 4 && pn < 6) {
#pragma unroll
            for (int ai = 0; ai < 2; ++ai)
#pragma unroll
                for (int m = 0; m < 4; ++m) { const int r = u.pm * BM + ai * HALF + wr * 64 + m * 16 + fr; const int bb = r >> 13, t = r & 8191;
#pragma unroll
                    for (int bj = 0; bj < 2; ++bj) { const int c0 = (pn - 4) * BM + bj * HALF + wc * 32 + 8 * fq; bf16_t* dst = v + ((size_t)(bb * 8 + (c0 >> 6)) * 64 + (c0 & 63)) * 8192 + t;
                        const f32x4 v0 = acc[ai][bj][m][0], v1 = acc[ai][bj][m][1];
                        const unsigned w0 = cvt_pk_bf16(v0[0], v0[1]), w1 = cvt_pk_bf16(v0[2], v0[3]), w2 = cvt_pk_bf16(v1[0], v1[1]), w3 = cvt_pk_bf16(v1[2], v1[3]);
                        dst[0] = (bf16_t)w0; dst[8192] = (bf16_t)(w0 >> 16); dst[2 * 8192] = (bf16_t)w1; dst[3 * 8192] = (bf16_t)(w1 >> 16);
                        dst[4 * 8192] = (bf16_t)w2; dst[5 * 8192] = (bf16_t)(w2 >> 16); dst[6 * 8192] = (bf16_t)w3; dst[7 * 8192] = (bf16_t)(w3 >> 16); } }
            return;
        }
        if (pn < 2) { base = q; ldc = 512; ct = pn; } else if (pn < 4) { base = k; ldc = 512; ct = pn - 2; }
        else if (pn < 12) { base = graw; ldc = 1536; ct = pn - 6; } else if (pn < 14) { base = z; ldc = 512; ct = pn - 12; } else if (pn < 22) { base = gates; ldc = 2048; ct = pn - 14; sig = true; }
        else {
            if (wc == 0 && fq < 2) {
#pragma unroll
                for (int ai = 0; ai < 2; ++ai)
#pragma unroll
                    for (int m = 0; m < 4; ++m) { const int r = u.pm * BM + ai * HALF + wr * 64 + m * 16 + fr; float* p = ab + (size_t)r * 16 + 8 * fq;
                        *(f32x4*)p = acc[ai][0][m][0]; *(f32x4*)(p + 4) = acc[ai][0][m][1]; }
            }
            return;
        }
        const int row0 = u.pm * BM + wr * 64 + fr, col0 = ct * BM + wc * 32 + 8 * fq;
#pragma unroll
        for (int ai = 0; ai < 2; ++ai)
#pragma unroll
            for (int m = 0; m < 4; ++m) { bf16_t* rowp = base + (size_t)(row0 + ai * HALF + m * 16) * ldc + col0;
#pragma unroll
                for (int bj = 0; bj < 2; ++bj) { f32x4 v0 = acc[ai][bj][m][0], v1 = acc[ai][bj][m][1];
                    if (sig) { v0 = (f32x4){sigmoidf_(v0[0]), sigmoidf_(v0[1]), sigmoidf_(v0[2]), sigmoidf_(v0[3])}; v1 = (f32x4){sigmoidf_(v1[0]), sigmoidf_(v1[1]), sigmoidf_(v1[2]), sigmoidf_(v1[3])}; }
                    u32x4 w; w.x = cvt_pk_bf16(v0[0], v0[1]); w.y = cvt_pk_bf16(v0[2], v0[3]); w.z = cvt_pk_bf16(v1[0], v1[1]); w.w = cvt_pk_bf16(v1[2], v1[3]);
                    *(u32x4*)(rowp + bj * HALF) = w; } }
    }
};
template <int MODE> struct EpiMerge {
    static constexpr bool PERM = true, AFTER_DRAIN = false;
    const bf16_t* gates; bf16_t* merged;
    __device__ __forceinline__ void operator()(const f32x4 (&acc)[2][2][4][2], const Unit& u, int wr, int wc, int fr, int fq) const {
        const int row0 = u.pm * BM + wr * 64 + fr, col0 = u.pn * BM + wc * 32 + 8 * fq;
#pragma unroll
        for (int ai = 0; ai < 2; ++ai)
#pragma unroll
            for (int m = 0; m < 4; ++m) { const size_t r = (size_t)(row0 + ai * HALF + m * 16);
#pragma unroll
                for (int bj = 0; bj < 2; ++bj) { const int c = col0 + bj * HALF;
                    const u32x4 g = *(const u32x4*)(gates + r * 2048 + MODE * 1024 + c);
                    f32x4 v0 = acc[ai][bj][m][0], v1 = acc[ai][bj][m][1];
                    v0 = v0 * (f32x4){bflo(g.x), bfhi(g.x), bflo(g.y), bfhi(g.y)}; v1 = v1 * (f32x4){bflo(g.z), bfhi(g.z), bflo(g.w), bfhi(g.w)};
                    if (MODE == 1) { const u32x4 p = *(const u32x4*)(merged + r * 1024 + c);
                        v0 = v0 + (f32x4){bflo(p.x), bfhi(p.x), bflo(p.y), bfhi(p.y)}; v1 = v1 + (f32x4){bflo(p.z), bfhi(p.z), bflo(p.w), bfhi(p.w)}; }
                    u32x4 w; w.x = cvt_pk_bf16(v0[0], v0[1]); w.y = cvt_pk_bf16(v0[2], v0[3]); w.z = cvt_pk_bf16(v1[0], v1[1]); w.w = cvt_pk_bf16(v1[2], v1[3]);
                    *(u32x4*)(merged + r * 1024 + c) = w; } }
    }
};
struct EpiWo {
    static constexpr bool PERM = true, AFTER_DRAIN = false;
    const float* x; const float* mod; float* out;
    __device__ __forceinline__ void operator()(const f32x4 (&acc)[2][2][4][2], const Unit& u, int wr, int wc, int fr, int fq) const {
        const int row0 = u.pm * BM + wr * 64 + fr, col0 = u.pn * BM + wc * 32 + 8 * fq; const int b = (u.pm * BM) >> 13;
        const float* g1 = mod + (size_t)b * 6 * 1024 + 2 * 1024;
#pragma unroll
        for (int bj = 0; bj < 2; ++bj) { const int c = col0 + bj * HALF; const f32x4 ga = *(const f32x4*)(g1 + c), gb = *(const f32x4*)(g1 + c + 4);
#pragma unroll
            for (int ai = 0; ai < 2; ++ai)
#pragma unroll
                for (int m = 0; m < 4; ++m) { const size_t off = (size_t)(row0 + ai * HALF + m * 16) * 1024 + c;
                    const f32x4 xa = *(const f32x4*)(x + off), xb = *(const f32x4*)(x + off + 4);
                    *(f32x4*)(out + off) = xa + ga * acc[ai][bj][m][0]; *(f32x4*)(out + off + 4) = xb + gb * acc[ai][bj][m][1]; } }
    }
};
template <class Epi, class Sched, bool ALIGN_EPI = false, bool SP2 = false>
__device__ __forceinline__ void gemm_phase(PG8_LAS unsigned char* lds, const Gemm g, const Sched& S, const Epi& E) {
    const int tid = threadIdx.x, wid = __builtin_amdgcn_readfirstlane(tid >> 6), lane = tid & 63, wr = wid >> 2, wc = wid & 3, fr = lane & 15, fq = lane >> 4;
    const int K = g.K, nt = K / BK;
    unsigned voffA[2], voffB[2];
#pragma unroll
    for (int i = 0; i < 2; ++i) { int R, C; stage_rc(tid * 16 + i * 8192, R, C); const int Rb = Epi::PERM ? ((R & ~31) + perm32(R & 31)) : R;
        voffA[i] = (unsigned)(R * K + C) * 2u; voffB[i] = (unsigned)(Rb * K + C) * 2u; }
    const size_t kstep = (size_t)(BK * 2);
    const size_t hstep = (size_t)HALF * K * 2;
    const size_t tstep = 2 * hstep;
    const unsigned ldsw = (unsigned)wid * 1024u;
    const int aoff = lds_byte(wr * 64 + fr, fq * 8), boff = lds_byte(wc * 32 + fr, fq * 8);
#define PG8_SA(b, h) (((b) * 2 + (h)) * HTB)
#define PG8_SB(b, h) ((4 + (b) * 2 + (h)) * HTB)
#define PG8_STAGE(bufoff, gbase, voff) do { _Pragma("unroll") for (int _i = 0; _i < 2; ++_i) \
        __builtin_amdgcn_global_load_lds((const unsigned*)((const char*)(gbase) + (voff)[_i]), (PG8_LAS unsigned*)(lds + (bufoff) + ldsw + _i * 8192), 16, 0, 0); } while (0)
#define PG8_LDA(dst, b, h) do { _Pragma("unroll") for (int m = 0; m < 4; ++m) _Pragma("unroll") for (int k = 0; k < 2; ++k) dst[m][k] = *(const PG8_LAS bf16x8*)(lds + PG8_SA(b, h) + aoff + m * 2048 + k * 1024); } while (0)
#define PG8_LDB(dst, b, h) do { _Pragma("unroll") for (int n = 0; n < 2; ++n) _Pragma("unroll") for (int k = 0; k < 2; ++k) dst[n][k] = *(const PG8_LAS bf16x8*)(lds + PG8_SB(b, h) + boff + n * 2048 + k * 1024); } while (0)
#define PG8_MMA(ai, bj, At, Bt) do { __builtin_amdgcn_s_setprio(1); _Pragma("unroll") for (int m = 0; m < 4; ++m) _Pragma("unroll") for (int n = 0; n < 2; ++n) _Pragma("unroll") for (int k = 0; k < 2; ++k) \
        acc[ai][bj][m][n] = __builtin_amdgcn_mfma_f32_16x16x32_bf16(Bt[n][k], At[m][k], acc[ai][bj][m][n], 0, 0, 0); __builtin_amdgcn_s_setprio(0); } while (0)
#define PG8_WAIT_V(n) asm volatile("s_waitcnt vmcnt(" #n ")" ::: "memory")
#define PG8_WAIT_L(n) asm volatile("s_waitcnt lgkmcnt(" #n ")" ::: "memory")
#define PG8_BAR __builtin_amdgcn_s_barrier()
#define PG8_SCHED __builtin_amdgcn_sched_barrier(0)
    Unit cur, nxt; int ui = 0;
    if (!S.next(0, cur)) return;
    f32x4 acc[2][2][4][2];
#pragma unroll
    for (int a = 0; a < 2; ++a)
#pragma unroll
        for (int b = 0; b < 2; ++b)
#pragma unroll
            for (int m = 0; m < 4; ++m)
#pragma unroll
                for (int n = 0; n < 2; ++n) acc[a][b][m][n] = (f32x4){0.f, 0.f, 0.f, 0.f};
    bf16x8 At[4][2], B0[2][2], B1[2][2];
    const char* cA = (const char*)g.A + (size_t)cur.pm * tstep; const char* cB = (const char*)g.Bt + (size_t)cur.pn * tstep;
    S.a_ready(cur);
    if constexpr (SP2) {
        PG8_STAGE(PG8_SB(0, 0), cB, voffB); PG8_STAGE(PG8_SB(0, 1), cB + hstep, voffB); PG8_STAGE(PG8_SA(0, 0), cA, voffA); PG8_STAGE(PG8_SA(0, 1), cA + hstep, voffA);
        if (wr == 1) PG8_BAR;
        PG8_WAIT_V(2); PG8_BAR;
        PG8_STAGE(PG8_SB(1, 0), cB + kstep, voffB); PG8_STAGE(PG8_SA(1, 0), cA + kstep, voffA); PG8_STAGE(PG8_SB(1, 1), cB + hstep + kstep, voffB);
        PG8_WAIT_V(6); PG8_BAR;
    } else {
        PG8_STAGE(PG8_SB(0, 0), cB, voffB); PG8_STAGE(PG8_SA(0, 0), cA, voffA); PG8_STAGE(PG8_SB(0, 1), cB + hstep, voffB); PG8_STAGE(PG8_SA(0, 1), cA + hstep, voffA);
        if (wr == 1) PG8_BAR;
        PG8_WAIT_V(4); PG8_BAR;
        PG8_STAGE(PG8_SB(1, 0), cB + kstep, voffB); PG8_STAGE(PG8_SA(1, 0), cA + kstep, voffA); PG8_STAGE(PG8_SB(1, 1), cB + hstep + kstep, voffB);
        PG8_WAIT_V(6); PG8_BAR;
    }
    for (;;) {
        const bool has_next = S.next(ui + 1, nxt);
        const char* nA = has_next ? (const char*)g.A + (size_t)nxt.pm * tstep : cA; const char* nB = has_next ? (const char*)g.Bt + (size_t)nxt.pn * tstep : cB;
        for (int t = 0; t < nt; t += 2) {
            const bool last = (t == nt - 2);
            const char* a1 = cA + (size_t)(t + 1) * kstep;
            const char* a2 = last ? nA : cA + (size_t)(t + 2) * kstep; const char* b2 = last ? nB : cB + (size_t)(t + 2) * kstep;
            const char* a3 = a2 + kstep; const char* b3 = b2 + kstep;
            if (last && has_next) S.a_ready(nxt);
            if constexpr (SP2) {
            PG8_LDB(B0, 0, 0); PG8_LDB(B1, 0, 1); PG8_SCHED; PG8_LDA(At, 0, 0); PG8_STAGE(PG8_SA(1, 1), a1 + hstep, voffA);
            PG8_WAIT_V(8); PG8_WAIT_L(0); PG8_BAR; PG8_MMA(0, 0, At, B0); PG8_MMA(0, 1, At, B1); PG8_BAR; PG8_SCHED;
            PG8_LDA(At, 0, 1); PG8_STAGE(PG8_SB(0, 0), b2, voffB); PG8_STAGE(PG8_SB(0, 1), b2 + hstep, voffB); PG8_STAGE(PG8_SA(0, 0), a2, voffA);
            PG8_WAIT_V(8); PG8_WAIT_L(0); PG8_BAR; PG8_MMA(1, 0, At, B0); PG8_MMA(1, 1, At, B1); PG8_BAR; PG8_SCHED;
            PG8_LDB(B0, 1, 0); PG8_LDB(B1, 1, 1); PG8_SCHED; PG8_LDA(At, 1, 0); PG8_STAGE(PG8_SA(0, 1), a2 + hstep, voffA);
            PG8_WAIT_V(8); PG8_WAIT_L(0); PG8_BAR; PG8_MMA(0, 0, At, B0); PG8_MMA(0, 1, At, B1); PG8_BAR; PG8_SCHED;
            PG8_LDA(At, 1, 1); PG8_STAGE(PG8_SB(1, 0), b3, voffB); PG8_STAGE(PG8_SB(1, 1), b3 + hstep, voffB); PG8_STAGE(PG8_SA(1, 0), a3, voffA);
            PG8_WAIT_V(8); PG8_WAIT_L(0); PG8_BAR; PG8_MMA(1, 0, At, B0); PG8_MMA(1, 1, At, B1); PG8_BAR; PG8_SCHED;
            } else {
            PG8_LDB(B0, 0, 0); PG8_SCHED; PG8_LDA(At, 0, 0); PG8_STAGE(PG8_SA(1, 1), a1 + hstep, voffA);
            PG8_WAIT_L(8); PG8_BAR; PG8_WAIT_L(0); PG8_MMA(0, 0, At, B0); PG8_BAR; PG8_SCHED;
            PG8_LDB(B1, 0, 1); PG8_STAGE(PG8_SB(0, 0), b2, voffB);
            PG8_BAR; PG8_WAIT_L(0); PG8_MMA(0, 1, At, B1); PG8_BAR;
            PG8_LDA(At, 0, 1); PG8_STAGE(PG8_SA(0, 0), a2, voffA);
            PG8_BAR; PG8_WAIT_L(0); PG8_MMA(1, 0, At, B0); PG8_BAR; PG8_SCHED;
            PG8_STAGE(PG8_SB(0, 1), b2 + hstep, voffB);
            PG8_WAIT_V(6); PG8_BAR; PG8_MMA(1, 1, At, B1); PG8_BAR;
            PG8_LDB(B0, 1, 0); PG8_SCHED; PG8_LDA(At, 1, 0); PG8_STAGE(PG8_SA(0, 1), a2 + hstep, voffA);
            PG8_WAIT_L(8); PG8_BAR; PG8_WAIT_L(0); PG8_MMA(0, 0, At, B0); PG8_BAR; PG8_SCHED;
            PG8_LDB(B1, 1, 1); PG8_STAGE(PG8_SB(1, 0), b3, voffB);
            PG8_BAR; PG8_WAIT_L(0); PG8_MMA(0, 1, At, B1); PG8_BAR;
            PG8_LDA(At, 1, 1); PG8_STAGE(PG8_SA(1, 0), a3, voffA);
            PG8_BAR; PG8_WAIT_L(0); PG8_MMA(1, 0, At, B0); PG8_BAR; PG8_SCHED;
            PG8_STAGE(PG8_SB(1, 1), b3 + hstep, voffB);
            PG8_WAIT_V(6); PG8_BAR; PG8_MMA(1, 1, At, B1); PG8_BAR;
            }
        }
        if constexpr (ALIGN_EPI) { if (wr == 0) PG8_BAR; }
        if constexpr (!Epi::AFTER_DRAIN) { E(acc, cur, wr, wc, fr, fq); S.done(cur); }
        if (!has_next) break;
#pragma unroll
        for (int a = 0; a < 2; ++a)
#pragma unroll
            for (int b = 0; b < 2; ++b)
#pragma unroll
                for (int m = 0; m < 4; ++m)
#pragma unroll
                    for (int n = 0; n < 2; ++n) acc[a][b][m][n] = (f32x4){0.f, 0.f, 0.f, 0.f};
        cur = nxt; cA = nA; cB = nB; ++ui;
        if constexpr (ALIGN_EPI) { if (wr == 1) PG8_BAR; }
    }
    PG8_WAIT_V(0);
    if constexpr (!ALIGN_EPI) { if (wr == 0) PG8_BAR; }
    PG8_BAR;
    if constexpr (Epi::AFTER_DRAIN) { E.fused(acc, cur, wr, wc, fr, fq, lds, wid, lane); S.done(cur); }
#undef PG8_SA
#undef PG8_SB
#undef PG8_STAGE
#undef PG8_LDA
#undef PG8_LDB
#undef PG8_MMA
#undef PG8_WAIT_V
#undef PG8_WAIT_L
#undef PG8_BAR
#undef PG8_SCHED
}
}

constexpr int NWAVES = 8;
#define GAS __attribute__((address_space(1)))
#define LAS __attribute__((address_space(3)))
typedef unsigned short bf16;
typedef unsigned v4u __attribute__((ext_vector_type(4)));
typedef unsigned v2u __attribute__((ext_vector_type(2)));
typedef float f32x4 __attribute__((ext_vector_type(4)));
typedef float f32x2 __attribute__((ext_vector_type(2)));
typedef short bf16x8 __attribute__((ext_vector_type(8)));
typedef GAS unsigned gu32;
#define RLX_AGENT __ATOMIC_RELAXED, __HIP_MEMORY_SCOPE_AGENT
#define LDS_WAIT() asm volatile("s_waitcnt lgkmcnt(0)" ::: "memory")
#define VM_WAIT() asm volatile("s_waitcnt vmcnt(0)" ::: "memory")
__device__ __forceinline__ unsigned f2bf(float f) { unsigned u = __builtin_bit_cast(unsigned, f); return (u + 0x7fffu + ((u >> 16) & 1u)) >> 16; }
__device__ __forceinline__ unsigned pk2(float lo, float hi) { return f2bf(lo) | (f2bf(hi) << 16); }
__device__ __forceinline__ float bf2f(unsigned short h) { return __uint_as_float((unsigned)h << 16); }
__device__ __forceinline__ float bflo(unsigned w) { return __uint_as_float(w << 16); }
__device__ __forceinline__ float bfhi(unsigned w) { return __uint_as_float(w & 0xffff0000u); }
__device__ __forceinline__ float sigm(float x) { return 1.0f / (1.0f + __expf(-x)); }
__device__ __forceinline__ float siluf(float x) { return x / (1.0f + __expf(-x)); }
__device__ __forceinline__ float softplusf(float x) { return fmaxf(x, 0.f) + log1pf(__expf(-fabsf(x))); }
__device__ __forceinline__ float wave_sum(float v) {
#pragma unroll
    for (int o = 1; o < 64; o <<= 1) v += __shfl_xor(v, o);
    return v;
}

constexpr size_t MiB = 1u << 20;
constexpr size_t WS_CTL = 0, CTL_ZERO_BYTES = 64 * 1024;
constexpr size_t WS_MOD = 1 * MiB;
constexpr size_t WS_SKEY = 1 * MiB + 256 * 1024;
constexpr size_t WS_WIN = 2 * MiB;
constexpr size_t WS_WSB = 14 * MiB, WS_WGDN = 15 * MiB, WS_WO = 16 * MiB, WS_WQ = 18 * MiB;
constexpr size_t WS_AB = 22 * MiB;
constexpr size_t WS_GB = 23 * MiB;
constexpr size_t WS_XN = 24 * MiB;
constexpr size_t WS_Q = 56 * MiB, WS_K = 72 * MiB, WS_V = 88 * MiB;
constexpr size_t WS_GRAW = 104 * MiB;
constexpr size_t WS_Z = 152 * MiB;
constexpr size_t WS_YSB = 24 * MiB, WS_YGDN = 40 * MiB;
constexpr size_t WS_MERGED = 56 * MiB;
constexpr size_t WS_CH = 168 * MiB;
constexpr size_t WS_CD = 248 * MiB;
constexpr size_t WS_QP = 168 * MiB;
constexpr size_t WS_EIDX = 232 * MiB, WS_GATE = 240 * MiB;
constexpr size_t WS_UT8 = 104 * MiB, WS_VT8 = 120 * MiB;
constexpr size_t WS_ACT = 136 * MiB;
constexpr size_t WS_H28 = 88 * MiB;
constexpr size_t WS_END = 256 * MiB;
constexpr int CW_BAR = 4096;

constexpr int RING_OFF = 0, RING_BYTES = 162816;
constexpr int LDSCTL_OFF = RING_BYTES, MISC_OFF = LDSCTL_OFF + 320;
constexpr int LDS_BYTES = 163840;
#define XB_TMO      128
#define XB_XCNT(j)  (256  + 64 * (j))
#define XB_XSUB(j)  (1280 + 64 * (j))
#define XB_XGEN(j)  (2304 + 64 * (j))
#define XB_TOP      3328
#define XB_TOPGEN   3392
#define XCD_BAR_WORDS 3456
#define XB_SPIN_CAP (1u << 18)

__device__ __forceinline__ unsigned xb_ld(unsigned* p)              { return __hip_atomic_load(p, __ATOMIC_RELAXED, __HIP_MEMORY_SCOPE_AGENT); }
__device__ __forceinline__ unsigned xb_add(unsigned* p, unsigned v) { return __hip_atomic_fetch_add(p, v, __ATOMIC_RELAXED, __HIP_MEMORY_SCOPE_AGENT); }
__device__ __forceinline__ unsigned xb_xcc_id() { return (unsigned)__builtin_amdgcn_s_getreg((3 << 11) | 20) & 0xFu; }
#define XB_SPIN(cond, bar) do { unsigned _sp = 0; while (cond) { __builtin_amdgcn_s_sleep(1); \
    if ((++_sp & 255u) == 0u) { if (xb_ld(&(bar)[XB_TMO])) break; if (_sp > XB_SPIN_CAP) { atomicAdd(&(bar)[XB_TMO], 1u); break; } } } } while (0)

struct XcdBarrier {
    unsigned* bar; unsigned x;
    volatile LAS unsigned* st;
};

__device__ __forceinline__ XcdBarrier xcd_barrier_post(unsigned* bar, volatile LAS unsigned* st) {
    XcdBarrier b; b.bar = bar; b.x = xb_xcc_id(); b.st = st;
    if (threadIdx.x == 0) (void)xb_add(&bar[XB_XCNT(b.x)], 1u);
    return b;
}
__device__ __forceinline__ void xcd_barrier_complete(unsigned* bar, unsigned x, unsigned& nloc, unsigned& nx) {
    const unsigned G = gridDim.x * gridDim.y * gridDim.z;
    unsigned sum, cnt, mine, sp = 0u;
    for (;;) {
        sum = 0u; cnt = 0u; mine = 0u;
#pragma unroll
        for (unsigned j = 0; j < 16; ++j) { const unsigned c = xb_ld(&bar[XB_XCNT(j)]); sum += c; cnt += (c > 0u) ? 1u : 0u; mine = (j == x) ? c : mine; }
        if (sum == G) break;
        __builtin_amdgcn_s_sleep(1);
        if ((++sp & 255u) == 0u) { if (xb_ld(&bar[XB_TMO])) break; if (sp > XB_SPIN_CAP) { atomicAdd(&bar[XB_TMO], 1u); break; } }
    }
    nloc = mine > 0u ? mine : 1u; nx = cnt > 0u ? cnt : 1u;
}

__device__ __forceinline__ void xcd_barrier(const XcdBarrier& b) {
    asm volatile("s_waitcnt vmcnt(0)" ::: "memory");
    __syncthreads();
    if (threadIdx.x == 0) {
        unsigned* bar = b.bar;
        __builtin_amdgcn_s_waitcnt(0);
        unsigned nloc = b.st[0], nx = b.st[1];
        if (nloc == 0u) { xcd_barrier_complete(bar, b.x, nloc, nx); b.st[0] = nloc; b.st[1] = nx; }
        const unsigned old = xb_add(&bar[XB_XSUB(b.x)], 1u);
        const unsigned gen = old / nloc;
        if (old + 1u == (gen + 1u) * nloc) {
            __builtin_amdgcn_fence(__ATOMIC_RELEASE, "agent");
            asm volatile("s_waitcnt vmcnt(0)" ::: "memory");
            const unsigned og = xb_add(&bar[XB_TOP], 1u);
            const unsigned tg = og / nx;
            if (og + 1u == (tg + 1u) * nx) xb_add(&bar[XB_TOPGEN], 1u);
            else XB_SPIN(xb_ld(&bar[XB_TOPGEN]) == tg, bar);
            __builtin_amdgcn_fence(__ATOMIC_ACQUIRE, "agent");
            xb_add(&bar[XB_XGEN(b.x)], 1u);
            asm volatile("s_waitcnt vmcnt(0)" ::: "memory");
        } else {
            XB_SPIN(xb_ld(&bar[XB_XGEN(b.x)]) == gen, bar);
            __builtin_amdgcn_fence(__ATOMIC_ACQUIRE, "agent");
            asm volatile("s_waitcnt vmcnt(0)" ::: "memory");
        }
    }
    __syncthreads();
}

struct Args { const float* in[20]; float* out; unsigned char* ws; int ph_lo, ph_hi, li, pad; };

struct Frame {
    LAS unsigned char* lds;
    volatile LAS unsigned* MISC;
    gu32* ctl;
    int tid, lane, wave, G;
};

__device__ __forceinline__ int inproj_src_col(int n) { if (n < 3072) return n; if (n < 5632) return n + 16; if (n < 5648) return n - 5632 + 3072; return -1; }
template <bool MAP>
__device__ __forceinline__ void p0_transpose_item(const float* W, int K, int Nsrc, int Ndst, bf16* WT, LAS float* scr, int item, int lane) {
    const int nblk = Ndst / 32, kb = item / nblk, nb = item % nblk, k0 = 64 * kb, n0 = 32 * nb;
    const int nsrc = MAP ? inproj_src_col(n0 + (lane & 31)) : n0 + (lane & 31);
    float wv[32];
#pragma unroll
    for (int i = 0; i < 32; ++i) { const int kk = 2 * i + (lane >> 5); wv[i] = nsrc >= 0 ? W[(size_t)(k0 + kk) * Nsrc + nsrc] : 0.f; }
#pragma unroll
    for (int i = 0; i < 32; ++i) { const int kk = 2 * i + (lane >> 5); scr[kk * 33 + (lane & 31)] = wv[i]; }
    LDS_WAIT(); asm volatile("" ::: "memory");
    const int c = lane & 7;
#pragma unroll
    for (int j = 0; j < 4; ++j) { const int n = (lane >> 3) + 8 * j; const LAS float* s = scr + (8 * c) * 33 + n;
        v4u o; o.x = pk2(s[0 * 33], s[1 * 33]); o.y = pk2(s[2 * 33], s[3 * 33]); o.z = pk2(s[4 * 33], s[5 * 33]); o.w = pk2(s[6 * 33], s[7 * 33]);
        *(GAS v4u*)(WT + (size_t)(n0 + n) * K + k0 + 8 * c) = o; }
    LDS_WAIT(); asm volatile("" ::: "memory");
}
__device__ __forceinline__ void p0_prologue(Frame& F, const Args& a) {
    unsigned char* ws = a.ws;
    LAS float* scr = (LAS float*)(F.lds + RING_OFF + F.wave * 16384);
    const int gw = blockIdx.x * NWAVES + F.wave, NGW = F.G * NWAVES;
    constexpr int I_IN = (D / 64) * (INWP / 32), I_SB = (512 / 64) * (D / 32), I_O = (D / 64) * (D / 32), I_Q = (D / 64) * (PQW / 32);
    constexpr int NITEMS = I_IN + 2 * I_SB + I_O + I_Q;
    for (int it = gw; it < NITEMS; it += NGW) {
        int r = it;
        if (r < I_IN) { p0_transpose_item<true>(a.in[5], D, INW, INWP, (bf16*)(ws + WS_WIN), scr, r, F.lane); continue; } r -= I_IN;
        if (r < I_SB) { p0_transpose_item<false>(a.in[12], 512, D, D, (bf16*)(ws + WS_WSB), scr, r, F.lane); continue; } r -= I_SB;
        if (r < I_SB) { p0_transpose_item<false>(a.in[13], 512, D, D, (bf16*)(ws + WS_WGDN), scr, r, F.lane); continue; } r -= I_SB;
        if (r < I_O) { p0_transpose_item<false>(a.in[14], D, D, D, (bf16*)(ws + WS_WO), scr, r, F.lane); continue; } r -= I_O;
        p0_transpose_item<false>(a.in[16], D, PQW, PQW, (bf16*)(ws + WS_WQ), scr, r, F.lane);
    }
    { const float* sk = a.in[17]; bf16* o = (bf16*)(ws + WS_SKEY);
      for (int i = (blockIdx.x * 512 + F.tid) * 4; i < PH * 2 * PNK * PHALF; i += F.G * 512 * 4) { const f32x4 v = *(const f32x4*)(sk + i); v2u w; w.x = pk2(v.x, v.y); w.y = pk2(v.z, v.w); *(v2u*)(o + i) = w; } }
    { const float* c = a.in[1]; const float* wa = a.in[2]; const float* ba = a.in[3]; float* mod = (float*)(ws + WS_MOD);
      LAS float* red = (LAS float*)(F.lds + RING_OFF);
      for (int it = blockIdx.x; it < 6 * D / 64; it += F.G) {
          const int n = it * 64 + F.lane; float a0 = 0.f, a1 = 0.f;
          __syncthreads();
          for (int kb = 0; kb < 4; ++kb) { const int k0 = F.wave * 128 + kb * 32; float w[32];
#pragma unroll
              for (int i = 0; i < 32; ++i) w[i] = wa[(size_t)(k0 + i) * (6 * D) + n];
#pragma unroll
              for (int i = 0; i < 32; ++i) { a0 += siluf(c[k0 + i]) * w[i]; a1 += siluf(c[D + k0 + i]) * w[i]; } }
          red[(F.wave * 2 + 0) * 64 + F.lane] = a0; red[(F.wave * 2 + 1) * 64 + F.lane] = a1;
          __syncthreads();
          if (F.wave < 2) { float s = 0.f;
#pragma unroll
              for (int w = 0; w < 8; ++w) s += red[(w * 2 + F.wave) * 64 + F.lane];
              mod[(size_t)F.wave * 6 * D + n] = s + ba[n]; }
      }
      __syncthreads(); }
}
constexpr float PEER_HSCALE = 4.f;
__device__ __forceinline__ void norm_mod_rows(Frame& F, const float* x, const float* nw, const float* mod, int ch_shift, bf16* o, unsigned char* o8) {
    const int gw = blockIdx.x * NWAVES + F.wave, NGW = F.G * NWAVES;
    f32x4 nx[4];
    if (gw < M) { const GAS f32x4* xr = (const GAS f32x4*)(x + (size_t)gw * D) + F.lane;
#pragma unroll
        for (int j = 0; j < 4; ++j) nx[j] = xr[64 * j]; }
    for (int m = gw; m < M; m += NGW) {
        f32x4 v[4]; float s = 0.f;
#pragma unroll
        for (int j = 0; j < 4; ++j) { v[j] = nx[j]; s += (v[j].x * v[j].x + v[j].y * v[j].y) + (v[j].z * v[j].z + v[j].w * v[j].w); }
        if (m + NGW < M) { const GAS f32x4* xr = (const GAS f32x4*)(x + (size_t)(m + NGW) * D) + F.lane;
#pragma unroll
            for (int j = 0; j < 4; ++j) nx[j] = xr[64 * j]; }
        const float rstd = 1.0f / sqrtf(wave_sum(s) * (1.f / D) + EPS);
        const float* sh = mod + (size_t)(m >> 13) * 6 * D + ch_shift * D; const float* sc = sh + D;
        GAS v2u* ob16 = (GAS v2u*)(o + (size_t)m * D) + F.lane;
#pragma unroll
        for (int j = 0; j < 4; ++j) { const int c = 4 * F.lane + 256 * j; const f32x4 w = *(const f32x4*)(nw + c), a = *(const f32x4*)(sc + c), b = *(const f32x4*)(sh + c);
            const f32x4 y = v[j] * rstd * w * (a + 1.0f) + b; v2u p; p.x = pk2(y.x, y.y); p.y = pk2(y.z, y.w); ob16[64 * j] = p;
            if (o8) { int q8 = __builtin_amdgcn_cvt_pk_fp8_f32(y.x * PEER_HSCALE, y.y * PEER_HSCALE, 0, false); q8 = __builtin_amdgcn_cvt_pk_fp8_f32(y.z * PEER_HSCALE, y.w * PEER_HSCALE, q8, true); *(int*)(o8 + (size_t)m * D + c) = q8; } }
    }
}
constexpr float PEER_USCALE = 64.f, PEER_VSCALE = 8.f;
__device__ __forceinline__ v4u fp8_pack16(const f32x4& a0, const f32x4& a1, const f32x4& a2, const f32x4& a3) {
    int w0 = __builtin_amdgcn_cvt_pk_fp8_f32(a0.x, a0.y, 0, false); w0 = __builtin_amdgcn_cvt_pk_fp8_f32(a0.z, a0.w, w0, true);
    int w1 = __builtin_amdgcn_cvt_pk_fp8_f32(a1.x, a1.y, 0, false); w1 = __builtin_amdgcn_cvt_pk_fp8_f32(a1.z, a1.w, w1, true);
    int w2 = __builtin_amdgcn_cvt_pk_fp8_f32(a2.x, a2.y, 0, false); w2 = __builtin_amdgcn_cvt_pk_fp8_f32(a2.z, a2.w, w2, true);
    int w3 = __builtin_amdgcn_cvt_pk_fp8_f32(a3.x, a3.y, 0, false); w3 = __builtin_amdgcn_cvt_pk_fp8_f32(a3.z, a3.w, w3, true);
    return (v4u){(unsigned)w0, (unsigned)w1, (unsigned)w2, (unsigned)w3};
}
__device__ __forceinline__ void peer_tables_to_fp8(const Args& a, int blk, int nblk, int tid) {
    unsigned char* ws = a.ws; constexpr int NPC = PNE * D / 16;
    for (int which = 0; which < 2; ++which) { const float* src = a.in[18 + which]; v4u* dst = (v4u*)(ws + (which ? WS_VT8 : WS_UT8)); const float sc = which ? PEER_VSCALE : PEER_USCALE;
        for (int i0 = blk * 512 + tid; i0 < NPC; i0 += 4 * nblk * 512) {
            f32x4 v[4][4];
#pragma unroll
            for (int u = 0; u < 4; ++u) { const int i = i0 + u * nblk * 512; if (i < NPC) { const f32x4* p = (const f32x4*)src + (size_t)i * 4; v[u][0] = p[0]; v[u][1] = p[1]; v[u][2] = p[2]; v[u][3] = p[3]; } }
#pragma unroll
            for (int u = 0; u < 4; ++u) { const int i = i0 + u * nblk * 512; if (i < NPC) {
                const int e = i >> 6, c16 = i & 63; const size_t di = which ? ((size_t)(c16 >> 3) * PNE * 8 + (size_t)e * 8 + (c16 & 7)) : (size_t)i;
                dst[di] = fp8_pack16(v[u][0] * sc, v[u][1] * sc, v[u][2] * sc, v[u][3] * sc); } } } }
}
__device__ __forceinline__ float gelu_erf(float v) { return 0.5f * v * (1.0f + erff(v * 0.70710678118654752f)); }
__device__ __forceinline__ void gstore1_asm(float* p, float v) { asm volatile("global_store_dword %0, %1, off" :: "v"(p), "v"(v) : "memory"); }
__device__ __forceinline__ void gstore2_asm(float* p, f32x2 v) { asm volatile("global_store_dwordx2 %0, %1, off" :: "v"(p), "v"(v) : "memory"); }
__device__ __forceinline__ void fp8x16_to_f32(const v4u& w, f32x2 (&o)[8]) {
    o[0] = __builtin_amdgcn_cvt_pk_f32_fp8((int)w.x, false); o[1] = __builtin_amdgcn_cvt_pk_f32_fp8((int)w.x, true);
    o[2] = __builtin_amdgcn_cvt_pk_f32_fp8((int)w.y, false); o[3] = __builtin_amdgcn_cvt_pk_f32_fp8((int)w.y, true);
    o[4] = __builtin_amdgcn_cvt_pk_f32_fp8((int)w.z, false); o[5] = __builtin_amdgcn_cvt_pk_f32_fp8((int)w.z, true);
    o[6] = __builtin_amdgcn_cvt_pk_f32_fp8((int)w.w, false); o[7] = __builtin_amdgcn_cvt_pk_f32_fp8((int)w.w, true);
}
__device__ __forceinline__ float gelu_fast(float v) { typedef float f2 __attribute__((ext_vector_type(2))); const f2 r = pg8::gelu_pk((f2){v, v}); return r.x; }
__device__ __forceinline__ f32x4 peer_u_tile(const v4u (&A)[16], const LAS unsigned char* hb, int g) {
    f32x4 acc[4] = {(f32x4){0.f, 0.f, 0.f, 0.f}, (f32x4){0.f, 0.f, 0.f, 0.f}, (f32x4){0.f, 0.f, 0.f, 0.f}, (f32x4){0.f, 0.f, 0.f, 0.f}};
#pragma unroll
    for (int s = 0; s < 16; ++s) { const v4u hv = *(const LAS v4u*)(hb + 64 * s + 16 * g);
        acc[(2 * s) & 3] = __builtin_amdgcn_mfma_f32_16x16x32_fp8_fp8((long)(((unsigned long long)A[s].y << 32) | A[s].x), (long)(((unsigned long long)hv.y << 32) | hv.x), acc[(2 * s) & 3], 0, 0, 0);
        acc[(2 * s + 1) & 3] = __builtin_amdgcn_mfma_f32_16x16x32_fp8_fp8((long)(((unsigned long long)A[s].w << 32) | A[s].z), (long)(((unsigned long long)hv.w << 32) | hv.z), acc[(2 * s + 1) & 3], 0, 0, 0); }
    return (acc[0] + acc[1]) + (acc[2] + acc[3]);
}
__device__ __forceinline__ void peer_u_rows(v4u (&A)[16], const unsigned char* ut, const LAS unsigned* lst, int k0, int n, int lane) {
    const int k = k0 + (lane >> 2); const unsigned ent = lst[k < n ? k : 0]; const unsigned char* row = ut + (size_t)(ent & 2047u) * D + 16 * (lane & 3);
    if (k < n) {
#pragma unroll
        for (int s = 0; s < 16; ++s) A[s] = *(const v4u*)(row + 64 * s); }
}
__device__ __forceinline__ void peer_u_perm(v4u (&A)[16], int r, int g) {
    const int idx = (4 * r + g) * 4;
#pragma unroll
    for (int s = 0; s < 16; ++s) { A[s].x = (unsigned)__builtin_amdgcn_ds_bpermute(idx, (int)A[s].x); A[s].y = (unsigned)__builtin_amdgcn_ds_bpermute(idx, (int)A[s].y); A[s].z = (unsigned)__builtin_amdgcn_ds_bpermute(idx, (int)A[s].z); A[s].w = (unsigned)__builtin_amdgcn_ds_bpermute(idx, (int)A[s].w); }
}
__device__ __forceinline__ void peer_u_out(const f32x4& acc, const LAS unsigned* lst, const LAS float* gl, float* coef_t, int k0, int n, int r, int g) {
    const float v = r == 0 ? acc.x : r == 1 ? acc.y : r == 2 ? acc.z : acc.w; const int k = k0 + 4 * g + r;
    if (r < 4 && k < n) { const int slot = (int)(lst[k] >> 11); gstore1_asm(coef_t + slot, gl[slot] * gelu_fast(v * (1.0f / (PEER_USCALE * PEER_HSCALE))) * (1.0f / PEER_VSCALE)); }
}
__device__ __forceinline__ f32x4 peer_u_tile_m(const v4u (&A)[16], const LAS unsigned char* lanebase) {
    f32x4 acc[4] = {(f32x4){0.f, 0.f, 0.f, 0.f}, (f32x4){0.f, 0.f, 0.f, 0.f}, (f32x4){0.f, 0.f, 0.f, 0.f}, (f32x4){0.f, 0.f, 0.f, 0.f}};
#pragma unroll
    for (int s = 0; s < 16; ++s) { const v4u hv = *(const LAS v4u*)(lanebase + 64 * s);
        acc[(2 * s) & 3] = __builtin_amdgcn_mfma_f32_16x16x32_fp8_fp8((long)(((unsigned long long)A[s].y << 32) | A[s].x), (long)(((unsigned long long)hv.y << 32) | hv.x), acc[(2 * s) & 3], 0, 0, 0);
        acc[(2 * s + 1) & 3] = __builtin_amdgcn_mfma_f32_16x16x32_fp8_fp8((long)(((unsigned long long)A[s].w << 32) | A[s].z), (long)(((unsigned long long)hv.w << 32) | hv.z), acc[(2 * s + 1) & 3], 0, 0, 0); }
    return (acc[0] + acc[1]) + (acc[2] + acc[3]);
}
__device__ __forceinline__ void peer_u_out_m(const f32x4& acc, const LAS unsigned* lst, const LAS float* gl, float* coef_t, int k0, int n, int lane) {
    const int j = lane & 15, Gq = lane >> 4, pc = j >> 2;
    float v = pc == 0 ? acc.x : pc == 1 ? acc.y : pc == 2 ? acc.z : acc.w;
    v += __int_as_float(__builtin_amdgcn_mov_dpp(__float_as_int(v), 0x128, 0xF, 0xF, true));
    v += __int_as_float(__builtin_amdgcn_mov_dpp(__float_as_int(v), 0x124, 0xF, 0xF, true));
    const int k = k0 + 4 * j + Gq;
    if (j < 4 && k < n) { const int slot = (int)(lst[k] >> 11); gstore1_asm(coef_t + slot, gl[slot] * gelu_fast(v * (1.0f / (PEER_USCALE * PEER_HSCALE))) * (1.0f / PEER_VSCALE)); }
}
__device__ __forceinline__ void glds16_asm(const void* gsrc, unsigned lds_dst) { unsigned keep;
    asm volatile("s_mov_b32 %0, m0\n\ts_mov_b32 m0, %2\n\ts_nop 0\n\tglobal_load_lds_dwordx4 %1, off\n\ts_mov_b32 m0, %0" : "=&s"(keep) : "v"(gsrc), "s"(lds_dst) : "memory"); }
#define PU_LD(d, p, off) asm volatile("global_load_dwordx4 %0, %1, off offset:" #off : "+v"(d) : "v"(p) : "memory")
__device__ __forceinline__ void peer_u_rows_asm(v4u (&A)[16], const unsigned char* ut, const LAS unsigned* lst, int k0, int n, int lane) {
    const int k = k0 + (lane >> 2); const unsigned ent = lst[k < n ? k : 0]; const unsigned char* row = ut + (size_t)(ent & 2047u) * D + 16 * (lane & 3);
    if (k < n) {
        PU_LD(A[0], row, 0); PU_LD(A[1], row, 64); PU_LD(A[2], row, 128); PU_LD(A[3], row, 192); PU_LD(A[4], row, 256); PU_LD(A[5], row, 320); PU_LD(A[6], row, 384); PU_LD(A[7], row, 448);
        PU_LD(A[8], row, 512); PU_LD(A[9], row, 576); PU_LD(A[10], row, 640); PU_LD(A[11], row, 704); PU_LD(A[12], row, 768); PU_LD(A[13], row, 832); PU_LD(A[14], row, 896); PU_LD(A[15], row, 960); }
}
#define PU_WAIT(n, A) asm volatile("s_waitcnt vmcnt(" #n ")" : "+v"(A[0]), "+v"(A[1]), "+v"(A[2]), "+v"(A[3]), "+v"(A[4]), "+v"(A[5]), "+v"(A[6]), "+v"(A[7]), "+v"(A[8]), "+v"(A[9]), "+v"(A[10]), "+v"(A[11]), "+v"(A[12]), "+v"(A[13]), "+v"(A[14]), "+v"(A[15]) :: "memory")
__device__ __forceinline__ void p10a_peer_u(Frame& F, const Args& a) {
    unsigned char* ws = a.ws; const int lane = F.lane, r = lane & 15, g = lane >> 4;
    const unsigned char* h8 = ws + WS_H28; const int* eidx = (const int*)(ws + WS_EIDX); const float* gate = (const float*)(ws + WS_GATE); float* coef = (float*)(ws + WS_ACT);
    const int x = blockIdx.x & 7; const unsigned char* ut = ws + WS_UT8 + (size_t)x * 2048 * D;
    LAS unsigned char* wb = F.lds + RING_OFF + F.wave * 17408;
    const unsigned wb_addr = (unsigned)(unsigned long)wb;
    const int wg = (blockIdx.x >> 3) * NWAVES + F.wave, nwg = (F.G >> 3) * NWAVES;
    const int nit = (M - wg + nwg - 1) / nwg;
    const unsigned long long below = (1ull << lane) - 1ull;
    LAS unsigned char* zreg = F.lds + RING_OFF + NWAVES * 17408;
    __syncthreads();
    if (F.tid < 64) *(LAS v4u*)(zreg + 16 * F.tid) = (v4u){0u, 0u, 0u, 0u};
    __syncthreads();
    const bool bsel = (lane >> 4) == (lane & 3); const int boff = 16 * ((lane & 15) >> 2);
#define PU_SLOT(j) (wb + ((j) & 7) * 2048)
#define PU_LST(b) ((LAS unsigned*)(wb + 16384 + (b) * 512))
#define PU_DMA(j) do { const int jj_ = (j) < nit ? (j) : nit - 1; const size_t t_ = (size_t)wg + (size_t)jj_ * nwg; const unsigned sl_ = wb_addr + (unsigned)(((j) & 7) * 2048); \
        glds16_asm(h8 + t_ * D + 16 * lane, sl_); \
        glds16_asm(lane < 32 ? (const void*)((const unsigned char*)(eidx + t_ * 128) + 16 * lane) : (const void*)((const unsigned char*)(gate + t_ * 128) + 16 * (lane - 32)), sl_ + 1024u); } while (0)
#define PU_STAGE(j, b, nout) do { const LAS int* es_ = (const LAS int*)(PU_SLOT(j) + 1024); const int e0_ = es_[lane], e1_ = es_[64 + lane]; \
        const bool m0_ = (e0_ >> 11) == x, m1_ = (e1_ >> 11) == x; const unsigned long long b0_ = __ballot(m0_), b1_ = __ballot(m1_); const int n0_ = __popcll(b0_); \
        if (m0_) PU_LST(b)[__popcll(b0_ & below)] = ((unsigned)lane << 11) | (unsigned)(e0_ & 2047); \
        if (m1_) PU_LST(b)[n0_ + __popcll(b1_ & below)] = ((unsigned)(64 + lane) << 11) | (unsigned)(e1_ & 2047); \
        nout = n0_ + __popcll(b1_); LDS_WAIT(); asm volatile("" ::: "memory"); } while (0)
    int ip = 0;
    PU_DMA(0); PU_DMA(1); PU_DMA(2);
    asm volatile("s_waitcnt vmcnt(0)" ::: "memory");
    int c_j = 0, c_b = 0, c_n = 0, c_k0 = 0; bool c_ok = false;
    while (ip < nit && !c_ok) { int nn; PU_STAGE(ip, 0, nn); c_j = ip; ++ip; if (nn > 0) { c_ok = true; c_n = nn; } else { PU_DMA(c_j + 3); asm volatile("s_waitcnt vmcnt(0)" ::: "memory"); } }
    v4u SA[16], SB[16];
#pragma unroll
    for (int i = 0; i < 16; ++i) { SA[i] = (v4u){0u, 0u, 0u, 0u}; SB[i] = SA[i]; }
    if (c_ok) { peer_u_rows_asm(SA, ut, PU_LST(0), 0, c_n, lane); PU_DMA(c_j + 3); PU_DMA(c_j + 3); }
#define PU_STEP(CUR, NXT) do { \
        int n_j = c_j, n_b = c_b, n_n = c_n, n_k0 = c_k0 + 16; bool n_ok = n_k0 < c_n; bool staged = false; \
        while (!n_ok && ip < nit) { int nn_; if (staged) { PU_DMA(n_j + 3); asm volatile("s_waitcnt vmcnt(0)" ::: "memory"); } \
            PU_STAGE(ip, c_b ^ 1, nn_); n_j = ip; ++ip; staged = true; if (nn_ > 0) { n_ok = true; n_b = c_b ^ 1; n_n = nn_; n_k0 = 0; } } \
        if (n_ok) peer_u_rows_asm(NXT, ut, PU_LST(n_b), n_k0, n_n, lane); \
        if (staged) PU_DMA(n_j + 3); else PU_DMA(ip + 2); \
        if (n_ok) PU_WAIT(21, CUR); else PU_WAIT(0, CUR); \
        { const LAS unsigned char* sl_ = PU_SLOT(c_j); const f32x4 acc_ = peer_u_tile_m(CUR, bsel ? sl_ + boff : zreg); \
          peer_u_out_m(acc_, PU_LST(c_b), (const LAS float*)(sl_ + 1536), coef + ((size_t)wg + (size_t)c_j * nwg) * 128, c_k0, c_n, lane); } \
        LDS_WAIT(); asm volatile("" ::: "memory"); \
        c_j = n_j; c_b = n_b; c_n = n_n; c_k0 = n_k0; c_ok = n_ok; } while (0)
    while (c_ok) { PU_STEP(SA, SB); if (!c_ok) break; PU_STEP(SB, SA); }
    asm volatile("s_waitcnt vmcnt(0)" ::: "memory");
#undef PU_STEP
#undef PU_STAGE
#undef PU_DMA
#undef PU_SLOT
#undef PU_LST
}
struct PeerMeta { float a0, a1; int e0, e1; };
__device__ __forceinline__ void peer_meta_load(PeerMeta& m, const float* act, const int* eidx, int t, int lane) { const size_t o = (size_t)t * 128 + lane;
    m.a0 = act[o]; m.a1 = act[o + 64]; m.e0 = eidx[o]; m.e1 = eidx[o + 64]; }
__device__ __forceinline__ void peer_meta_stage(const PeerMeta& m, LAS float* coefs, LAS int* eids, int lane) {
    coefs[lane] = m.a0; coefs[64 + lane] = m.a1;
    eids[lane] = m.e0; eids[64 + lane] = m.e1; }
__device__ __forceinline__ void peer_vrows_issue(v4u (&rw)[16], f32x2& x1, const unsigned char* vt, const LAS int* eids, int grp, const float* xp) {
    x1 = *(const f32x2*)xp;
#pragma unroll
    for (int i = 0; i < 16; ++i) rw[i] = *(const v4u*)(vt + (size_t)eids[8 * i + grp] * 128);
}
__device__ __forceinline__ void peer_vcompute(const v4u (&rw)[16], const f32x2& x1, const LAS float* coefs, const f32x2& g2, int grp, int lane, float* op) {
    f32x2 acc[8];
#pragma unroll
    for (int j = 0; j < 8; ++j) acc[j] = (f32x2){0.f, 0.f};
#pragma unroll
    for (int i = 0; i < 16; ++i) { f32x2 v[8]; fp8x16_to_f32(rw[i], v); const float cf = coefs[8 * i + grp];
#pragma unroll
        for (int j = 0; j < 8; ++j) acc[j] += v[j] * cf; }
    const bool b5 = lane & 32, b4 = lane & 16, b3 = lane & 8;
    f32x2 q[4];
#pragma unroll
    for (int j = 0; j < 4; ++j) { const f32x2 mine = b5 ? acc[4 + j] : acc[j], give = b5 ? acc[j] : acc[4 + j]; q[j].x = mine.x + __shfl_xor(give.x, 32); q[j].y = mine.y + __shfl_xor(give.y, 32); }
    f32x2 r2[2];
#pragma unroll
    for (int j = 0; j < 2; ++j) { const f32x2 mine = b4 ? q[2 + j] : q[j], give = b4 ? q[j] : q[2 + j]; r2[j].x = mine.x + __shfl_xor(give.x, 16); r2[j].y = mine.y + __shfl_xor(give.y, 16); }
    f32x2 s1; { const f32x2 mine = b3 ? r2[1] : r2[0], give = b3 ? r2[0] : r2[1]; s1.x = mine.x + __shfl_xor(give.x, 8); s1.y = mine.y + __shfl_xor(give.y, 8); }
    gstore2_asm(op, x1 + g2 * s1);
}
__device__ __forceinline__ void p10b_peer_v(Frame& F, const Args& a, float* outw) {
    unsigned char* ws = a.ws; const int lane = F.lane;
    const int* eidx = (const int*)(ws + WS_EIDX); const float* act = (const float*)(ws + WS_ACT);
    const float* mod = (const float*)(ws + WS_MOD); const float* out = a.out;
    const int x = blockIdx.x & 7; const unsigned char* vt = ws + WS_VT8 + (size_t)x * PNE * 128 + 16 * (lane & 7);
    LAS float* coefs = (LAS float*)(F.lds + RING_OFF + F.wave * 2048); LAS int* eids = (LAS int*)(coefs + 128);
    const int wg = (blockIdx.x >> 3) * NWAVES + F.wave, nwg = (F.G >> 3) * NWAVES, grp = lane >> 3;
    const int co = 128 * x + 16 * (lane & 7) + ((lane >> 5) & 1) * 8 + ((lane >> 4) & 1) * 4 + ((lane >> 3) & 1) * 2;
    const f32x2 g2b0 = *(const f32x2*)(mod + 5 * D + co), g2b1 = *(const f32x2*)(mod + 6 * D + 5 * D + co);
    const int nit = (M - wg + nwg - 1) / nwg;
#define TOK(i) (wg + ((i) < nit ? (i) : nit - 1) * nwg)
    PeerMeta mA, mB; v4u rA[16], rB[16]; f32x2 xA, xB;
    peer_meta_load(mA, act, eidx, TOK(0), lane); peer_meta_stage(mA, coefs, eids, lane); LDS_WAIT(); asm volatile("" ::: "memory");
    peer_meta_load(mB, act, eidx, TOK(1), lane);
    peer_vrows_issue(rA, xA, vt, eids, grp, out + (size_t)TOK(0) * D + co);
    for (int i = 0; i < nit; i += 2) {
        peer_meta_stage(mB, coefs + 256, eids + 256, lane); LDS_WAIT(); asm volatile("" ::: "memory");
        peer_meta_load(mA, act, eidx, TOK(i + 2), lane);
        peer_vrows_issue(rB, xB, vt, eids + 256, grp, out + (size_t)TOK(i + 1) * D + co);
        peer_vcompute(rA, xA, coefs, (TOK(i) >> 13) ? g2b1 : g2b0, grp, lane, outw + (size_t)TOK(i) * D + co);
        LDS_WAIT(); asm volatile("" ::: "memory");
        peer_meta_stage(mA, coefs, eids, lane); LDS_WAIT(); asm volatile("" ::: "memory");
        peer_meta_load(mB, act, eidx, TOK(i + 3), lane);
        peer_vrows_issue(rA, xA, vt, eids, grp, out + (size_t)TOK(i + 2) * D + co);
        peer_vcompute(rB, xB, coefs + 256, (TOK(i + 1) >> 13) ? g2b1 : g2b0, grp, lane, outw + (size_t)TOK(i + 1) * D + co);
        LDS_WAIT(); asm volatile("" ::: "memory");
    }
#undef TOK
}

__device__ __forceinline__ void p4_attn_naive(Frame& F, const Args& a, int blk, int nblk) {
    unsigned char* ws = a.ws;
    const bf16* Q = (const bf16*)(ws + WS_Q); const bf16* K = (const bf16*)(ws + WS_K); const bf16* V = (const bf16*)(ws + WS_V);
    for (int gid = blk * 512 + F.tid; gid < BATCH * SBH * SEQ; gid += nblk * 512) {
        const int t = gid & (SEQ - 1), bh = gid >> 13, h = bh & 7, b = bh >> 3;
        const size_t row = (size_t)b * SEQ + t;
        float q[64], o[64];
#pragma unroll
        for (int i = 0; i < 8; ++i) { const v4u w = *(const v4u*)(Q + row * 512 + h * 64 + 8 * i);
            q[8 * i] = bflo(w.x); q[8 * i + 1] = bfhi(w.x); q[8 * i + 2] = bflo(w.y); q[8 * i + 3] = bfhi(w.y); q[8 * i + 4] = bflo(w.z); q[8 * i + 5] = bfhi(w.z); q[8 * i + 6] = bflo(w.w); q[8 * i + 7] = bfhi(w.w); }
#pragma unroll
        for (int i = 0; i < 64; ++i) o[i] = 0.f;
        float R = 0.f;
        for (int s = t - 1; s >= 0; --s) {
            const size_t kr = ((size_t)b * SEQ + s) * 512 + h * 64; float z = 0.f;
#pragma unroll
            for (int i = 0; i < 8; ++i) { const v4u w = *(const v4u*)(K + kr + 8 * i);
                z += q[8 * i] * bflo(w.x) + q[8 * i + 1] * bfhi(w.x) + q[8 * i + 2] * bflo(w.y) + q[8 * i + 3] * bfhi(w.y) + q[8 * i + 4] * bflo(w.z) + q[8 * i + 5] * bfhi(w.z) + q[8 * i + 6] * bflo(w.w) + q[8 * i + 7] * bfhi(w.w); }
            const float sp = softplusf(z); const float p = __expf(z - sp - R); R += sp;
#pragma unroll
            for (int i = 0; i < 8; ++i) { const v4u w = *(const v4u*)(V + kr + 8 * i);
                o[8 * i] += p * bflo(w.x); o[8 * i + 1] += p * bfhi(w.x); o[8 * i + 2] += p * bflo(w.y); o[8 * i + 3] += p * bfhi(w.y); o[8 * i + 4] += p * bflo(w.z); o[8 * i + 5] += p * bfhi(w.z); o[8 * i + 6] += p * bflo(w.w); o[8 * i + 7] += p * bfhi(w.w); }
            if (R > 105.f) break;
        }
        bf16* y = (bf16*)(ws + WS_YSB) + row * 512 + h * 64;
#pragma unroll
        for (int i = 0; i < 8; ++i) { v4u w; w.x = pk2(o[8 * i], o[8 * i + 1]); w.y = pk2(o[8 * i + 2], o[8 * i + 3]); w.z = pk2(o[8 * i + 4], o[8 * i + 5]); w.w = pk2(o[8 * i + 6], o[8 * i + 7]); *(v4u*)(y + 8 * i) = w; }
    }
}
__device__ __forceinline__ void p9_topk_naive(Frame& F, const Args& a) {
    unsigned char* ws = a.ws; const int tid = F.tid;
    const bf16* QP = (const bf16*)(ws + WS_QP); const bf16* SK = (const bf16*)(ws + WS_SKEY);
    LAS float* sv = (LAS float*)(F.lds + RING_OFF);
    LAS int* si = (LAS int*)(sv + 2 * 16 * 256);
    LAS int* ptr = si + 2 * 16 * 256;
    LAS unsigned short* keys = (LAS unsigned short*)(ptr + 16 * 256);
    const bool act = tid < 256;
    for (int it = blockIdx.x; it < (M / 256) * PH; it += F.G) {
        const int h = it & 7, t = (it >> 3) * 256 + (tid & 255);
        for (int p = 0; p < 2; ++p) {
            __syncthreads();
            for (int i = tid; i < 128 * 128 / 8; i += 512) ((LAS v4u*)keys)[i] = ((const v4u*)(SK + (size_t)(h * 2 + p) * 128 * 128))[i];
            __syncthreads();
            if (act) {
                unsigned qreg[64];
#pragma unroll
                for (int i = 0; i < 16; ++i) { const v4u w = *(const v4u*)(QP + (size_t)t * PQW + h * 256 + p * 128 + 8 * i); qreg[4 * i] = w.x; qreg[4 * i + 1] = w.y; qreg[4 * i + 2] = w.z; qreg[4 * i + 3] = w.w; }
                int cnt = 0;
                for (int key = 0; key < 128; ++key) {
                    float s = 0.f;
#pragma unroll
                    for (int i = 0; i < 16; ++i) { const v4u w = *(const LAS v4u*)(keys + key * 128 + 8 * i);
                        s += bflo(qreg[4 * i]) * bflo(w.x) + bfhi(qreg[4 * i]) * bfhi(w.x) + bflo(qreg[4 * i + 1]) * bflo(w.y) + bfhi(qreg[4 * i + 1]) * bfhi(w.y)
                           + bflo(qreg[4 * i + 2]) * bflo(w.z) + bfhi(qreg[4 * i + 2]) * bfhi(w.z) + bflo(qreg[4 * i + 3]) * bflo(w.w) + bfhi(qreg[4 * i + 3]) * bfhi(w.w); }
                    int pos = cnt < 16 ? cnt : 16;
                    while (pos > 0 && s > sv[(p * 16 + pos - 1) * 256 + tid]) { if (pos < 16) { sv[(p * 16 + pos) * 256 + tid] = sv[(p * 16 + pos - 1) * 256 + tid]; si[(p * 16 + pos) * 256 + tid] = si[(p * 16 + pos - 1) * 256 + tid]; } --pos; }
                    if (pos < 16) { sv[(p * 16 + pos) * 256 + tid] = s; si[(p * 16 + pos) * 256 + tid] = key; }
                    if (cnt < 16) ++cnt;
                }
            }
        }
        if (act) {
            for (int i = 0; i < 16; ++i) ptr[i * 256 + tid] = 0;
            float top[16]; int eid[16];
#pragma unroll
            for (int rnk = 0; rnk < 16; ++rnk) {
                float best = -INFINITY; int bi = 0;
                for (int i = 0; i < 16; ++i) { const int jj = ptr[i * 256 + tid]; if (jj < 16) { const float c = sv[i * 256 + tid] + sv[(16 + jj) * 256 + tid]; if (c > best) { best = c; bi = i; } } }
                const int bj = ptr[bi * 256 + tid]; ptr[bi * 256 + tid] = bj + 1;
                top[rnk] = best; eid[rnk] = si[bi * 256 + tid] * 128 + si[(16 + bj) * 256 + tid];
            }
            float mx = top[0], den = 0.f;
#pragma unroll
            for (int rnk = 0; rnk < 16; ++rnk) { top[rnk] = __expf(top[rnk] - mx); den += top[rnk]; }
            int* eo = (int*)(ws + WS_EIDX) + (size_t)t * 128 + h * 16; float* go = (float*)(ws + WS_GATE) + (size_t)t * 128 + h * 16;
#pragma unroll
            for (int rnk = 0; rnk < 16; ++rnk) { eo[rnk] = eid[rnk]; go[rnk] = top[rnk] / den; }
        }
    }
    __syncthreads();
}

constexpr int CH_BYTES = 40960, CH_W = 0, CH_QD = 8192, CH_QK = 16384, CH_KDT = 24576, CH_U = 32768;
constexpr int PST = 68;
typedef __attribute__((address_space(3))) float lf32;

__device__ __forceinline__ void store_afrag(const lf32* src, const lf32* rowscale, unsigned char* dst, int tid) {
    const int blk = tid >> 6, lane = tid & 63, mt = blk >> 1, ks = blk & 1, r = lane & 15, g = lane >> 4, row = 16 * mt + r, k0 = 32 * ks + 4 * g;
    f32x4 v0 = *(const LAS f32x4*)(src + row * PST + k0), v1 = *(const LAS f32x4*)(src + row * PST + k0 + 16);
    const float rs = rowscale ? rowscale[row] : 1.0f; v0 = v0 * rs; v1 = v1 * rs;
    v4u o; o.x = pk2(v0.x, v0.y); o.y = pk2(v0.z, v0.w); o.z = pk2(v1.x, v1.y); o.w = pk2(v1.z, v1.w);
    *(v4u*)(dst + tid * 16) = o;
}
__device__ __forceinline__ void store_afrag_T(const lf32* src, const lf32* kscale, unsigned char* dst, int tid) {
    const int blk = tid >> 6, lane = tid & 63, mt = blk >> 1, ks = blk & 1, r = lane & 15, g = lane >> 4, row = 16 * mt + r, k0 = 32 * ks + 4 * g;
    float v[8];
#pragma unroll
    for (int i = 0; i < 4; ++i) { v[i] = src[(k0 + i) * PST + row] * kscale[k0 + i]; v[4 + i] = src[(k0 + 16 + i) * PST + row] * kscale[k0 + 16 + i]; }
    v4u o; o.x = pk2(v[0], v[1]); o.y = pk2(v[2], v[3]); o.z = pk2(v[4], v[5]); o.w = pk2(v[6], v[7]);
    *(v4u*)(dst + tid * 16) = o;
}
__device__ __forceinline__ void store_cfrag(const lf32* src, unsigned char* dst, int tid) {
#pragma unroll
    for (int rep = 0; rep < 2; ++rep) { const int q = tid + 512 * rep, sm = q >> 6, lane = q & 63, sl = sm >> 2, mt = sm & 3, col = lane & 15, g = lane >> 4;
        const lf32* p = src + (16 * mt + 4 * g) * PST + 16 * sl + col;
        v2u o; o.x = pk2(p[0], p[PST]); o.y = pk2(p[2 * PST], p[3 * PST]); *(v2u*)(dst + q * 8) = o; }
}

constexpr int BST = 72;
__device__ __forceinline__ float quad_sum(float v) {
    v += __int_as_float(__builtin_amdgcn_mov_dpp(__float_as_int(v), 0xB1, 0xF, 0xF, true));
    v += __int_as_float(__builtin_amdgcn_mov_dpp(__float_as_int(v), 0x4E, 0xF, 0xF, true));
    return v;
}
struct ConvIn { unsigned short x[3][11]; };
__device__ __forceinline__ void conv_load(ConvIn& ci, const bf16* graw, int it, int tid) {
    const int n = it & 127, bh = it >> 7, h = bh & 7, b = bh >> 3, c = tid & 63, tg = tid >> 6; const size_t row0 = (size_t)b * SEQ + n * 64; const int tl0 = n * 64;
#pragma unroll
    for (int part = 0; part < 3; ++part) { const bf16* src = graw + part * 512 + h * 64 + c;
#pragma unroll
        for (int i = 0; i < 11; ++i) { const int tt = tl0 + 8 * tg - 3 + i; ci.x[part][i] = tt >= 0 ? src[(row0 + 8 * tg - 3 + i) * 1536] : (unsigned short)0; } }
}
__device__ __forceinline__ void p3_gdn_prep(Frame& F, const Args& a) {
    unsigned char* ws = a.ws; const int tid = F.tid, wave = F.wave, lane = F.lane;
    const bf16* graw = (const bf16*)(ws + WS_GRAW); const float* ab = (const float*)(ws + WS_AB); const float* cw = a.in[8];
    lf32* Qs = (lf32*)(F.lds + RING_OFF); lf32* Ks = Qs + 64 * PST; lf32* Vs = Ks + 64 * PST; lf32* As = Vs + 64 * PST; lf32* QKs = As + 64 * PST; lf32* Us = QKs + 64 * PST; lf32* Ws = Us + 64 * PST;
    lf32* vG = Ws + 64 * PST; lf32* vbeta = vG + 64; lf32* veG = vbeta + 64; lf32* veGl = veG + 64; lf32* vqn = veGl + 64; lf32* vkn = vqn + 64; lf32* vbw = vkn + 64;
    LAS unsigned short* Qb = (LAS unsigned short*)(vbw + 64); LAS unsigned short* Kb = Qb + 64 * BST;
    constexpr int NCH = BATCH * GH * (SEQ / 64);
    ConvIn ci; float abv0 = 0.f, abv1 = 0.f;
    int it = blockIdx.x;
    if (it < NCH) { conv_load(ci, graw, it, tid); if (wave == 2) { const size_t r = (size_t)((it >> 7) >> 3) * SEQ + (it & 127) * 64 + lane; abv0 = ab[r * 16 + ((it >> 7) & 7)]; abv1 = ab[r * 16 + 8 + ((it >> 7) & 7)]; } }
    for (; it < NCH; it += F.G) {
        const int bh = it >> 7, h = bh & 7;
        __syncthreads();
        { const int c = tid & 63, tg = tid >> 6;
#pragma unroll
          for (int part = 0; part < 3; ++part) { const int ch = part * 512 + h * 64 + c; lf32* dst = part == 0 ? Qs : part == 1 ? Ks : Vs;
              const float w0 = cw[ch], w1 = cw[1536 + ch], w2 = cw[2 * 1536 + ch], w3 = cw[3 * 1536 + ch];
              float xv[11];
#pragma unroll
              for (int i = 0; i < 11; ++i) xv[i] = bf2f(ci.x[part][i]);
#pragma unroll
              for (int i = 0; i < 8; ++i) dst[(8 * tg + i) * PST + c] = siluf(w0 * xv[i] + w1 * xv[i + 1] + w2 * xv[i + 2] + w3 * xv[i + 3]); } }
        const float av = abv0, bv = abv1;
        { const int itn = it + F.G; if (itn < NCH) { conv_load(ci, graw, itn, tid); if (wave == 2) { const size_t r = (size_t)((itn >> 7) >> 3) * SEQ + (itn & 127) * 64 + lane; abv0 = ab[r * 16 + ((itn >> 7) & 7)]; abv1 = ab[r * 16 + 8 + ((itn >> 7) & 7)]; } } }
        __syncthreads();
        if (tid < 128) { const int row = tid & 63; const lf32* src = (tid < 64 ? Qs : Ks) + row * PST; float ss = 0.f;
#pragma unroll
            for (int i = 0; i < 16; ++i) { const f32x4 v = *(const LAS f32x4*)(src + 4 * i); ss += (v.x * v.x + v.y * v.y) + (v.z * v.z + v.w * v.w); }
            const float inv = 1.0f / sqrtf(ss + EPS); if (tid < 64) vqn[row] = inv * 0.125f; else vkn[row] = inv; }
        else if (tid < 192) { const int t = tid & 63;
            const float g = -__expf(a.in[9][h]) * softplusf(av + a.in[10][h]); float G = g;
#pragma unroll
            for (int o = 1; o < 64; o <<= 1) { const float up = __shfl_up(G, o); if (t >= o) G += up; }
            const float Gl = __shfl(G, 63);
            vG[t] = G; { const float be = sigm(bv); vbeta[t] = be; vbw[t] = be * __expf(G); } veG[t] = __expf(G); veGl[t] = __expf(Gl - G);
            if (t == 63) ((float*)(ws + WS_CD))[it] = __expf(Gl); }
        __syncthreads();
        { const int c = tid & 63, tg = tid >> 6;
#pragma unroll
          for (int i = 0; i < 8; ++i) { const int t = 8 * tg + i; const float qv = Qs[t * PST + c] * vqn[t], kv = Ks[t * PST + c] * vkn[t];
              Qs[t * PST + c] = qv; Ks[t * PST + c] = kv; Qb[t * BST + c] = (unsigned short)f2bf(qv); Kb[t * BST + c] = (unsigned short)f2bf(kv); } }
        __syncthreads();
        { const int mt = wave >> 1, r = lane & 15, g = lane >> 4;
#pragma unroll
          for (int t2 = 0; t2 < 2; ++t2) { const int nt = 2 * (wave & 1) + t2; f32x4 kk = {0.f, 0.f, 0.f, 0.f}, qk = kk;
              if (nt <= mt) {
#pragma unroll
                  for (int ks = 0; ks < 2; ++ks) { const bf16x8 ka = *(const LAS bf16x8*)(Kb + (16 * mt + r) * BST + 32 * ks + 8 * g), qa = *(const LAS bf16x8*)(Qb + (16 * mt + r) * BST + 32 * ks + 8 * g);
                      const bf16x8 kb = *(const LAS bf16x8*)(Kb + (16 * nt + r) * BST + 32 * ks + 8 * g);
                      kk = __builtin_amdgcn_mfma_f32_16x16x32_bf16(ka, kb, kk, 0, 0, 0); qk = __builtin_amdgcn_mfma_f32_16x16x32_bf16(qa, kb, qk, 0, 0, 0); } }
              const int s = 16 * nt + r; const float Gs = vG[s];
#pragma unroll
              for (int e = 0; e < 4; ++e) { const int c = 16 * mt + 4 * g + e; const float dec = __expf(fminf(vG[c] - Gs, 0.f));
                  As[c * PST + (s & 3) * 16 + (s >> 2)] = (c > s) ? vbeta[c] * kk[e] * dec : 0.f; QKs[c * PST + s] = (c >= s) ? qk[e] * dec : 0.f; } } }
        __syncthreads();
        { const int col = tid >> 2, q = tid & 3, j = col & 63; const bool isw = col >= 64; const lf32* src = isw ? Ks : Vs; const lf32* sc = isw ? vbw : vbeta; lf32* dst = isw ? Ws : Us;
          const lf32* Aq = As + q * 16; float x[16];
#pragma unroll
          for (int m = 0; m < 16; ++m) x[m] = 0.f;
#pragma unroll
          for (int i = 0; i < 64; ++i) { float p0 = 0.f, p1 = 0.f;
#pragma unroll
              for (int m4 = 0; m4 < (i + 15) / 16; ++m4) { const f32x4 avv = *(const LAS f32x4*)(Aq + i * PST + 4 * m4); p0 += avv.x * x[4 * m4]; p1 += avv.y * x[4 * m4 + 1]; p0 += avv.z * x[4 * m4 + 2]; p1 += avv.w * x[4 * m4 + 3]; }
              const float xi = src[i * PST + j] * sc[i] - quad_sum(p0 + p1);
              if (q == (i & 3)) x[i >> 2] = xi;
              if (q == 0) dst[i * PST + j] = xi; } }
        __syncthreads();
        { unsigned char* ch = ws + WS_CH + (size_t)it * CH_BYTES;
          store_afrag(Ws, nullptr, ch + CH_W, tid); store_afrag(Qs, veG, ch + CH_QD, tid); store_afrag(QKs, nullptr, ch + CH_QK, tid); store_afrag_T(Ks, veGl, ch + CH_KDT, tid); store_cfrag(Us, ch + CH_U, tid); }
    }
    __syncthreads();
}

__device__ __forceinline__ void p3_qknorm(Frame& F, const Args& a) {
    unsigned char* ws = a.ws; const int lane = F.lane;
    const int gw = blockIdx.x * NWAVES + F.wave, NGW = F.G * NWAVES;
    const float* qnw = a.in[6]; const float* knw = a.in[7];
    v4u nq[2] = {(v4u){0u, 0u, 0u, 0u}, (v4u){0u, 0u, 0u, 0u}};
    if (gw < M) { nq[0] = *(const v4u*)((const bf16*)(ws + WS_Q) + (size_t)gw * 512 + 8 * lane); nq[1] = *(const v4u*)((const bf16*)(ws + WS_K) + (size_t)gw * 512 + 8 * lane); }
    for (int t = gw; t < M; t += NGW) {
        const v4u cq[2] = {nq[0], nq[1]};
        if (t + NGW < M) { nq[0] = *(const v4u*)((const bf16*)(ws + WS_Q) + (size_t)(t + NGW) * 512 + 8 * lane); nq[1] = *(const v4u*)((const bf16*)(ws + WS_K) + (size_t)(t + NGW) * 512 + 8 * lane); }
#pragma unroll
        for (int which = 0; which < 2; ++which) {
            bf16* p = (bf16*)(ws + (which ? WS_K : WS_Q)) + (size_t)t * 512 + 8 * lane; const float* nw = which ? knw : qnw;
            const v4u w = cq[which]; float v[8] = {bflo(w.x), bfhi(w.x), bflo(w.y), bfhi(w.y), bflo(w.z), bfhi(w.z), bflo(w.w), bfhi(w.w)};
            float s = 0.f;
#pragma unroll
            for (int i = 0; i < 8; ++i) s += v[i] * v[i];
            s += __shfl_xor(s, 1); s += __shfl_xor(s, 2); s += __shfl_xor(s, 4);
            const float r = 1.0f / sqrtf(s * (1.f / 64.f) + EPS) * (which ? 1.0f : 0.125f);
            const int d0 = (8 * lane) & 63;
#pragma unroll
            for (int i = 0; i < 8; ++i) v[i] = v[i] * r * nw[d0 + i];
            v4u o; o.x = pk2(v[0], v[1]); o.y = pk2(v[2], v[3]); o.z = pk2(v[4], v[5]); o.w = pk2(v[6], v[7]); *(v4u*)p = o;
        }
    }
}

__device__ __forceinline__ bf16x8 pack8(const f32x4& x, const f32x4& y) { v4u w; w.x = pg8::cvt_pk_bf16(x.x, x.y); w.y = pg8::cvt_pk_bf16(x.z, x.w); w.z = pg8::cvt_pk_bf16(y.x, y.y); w.w = pg8::cvt_pk_bf16(y.z, y.w); return __builtin_bit_cast(bf16x8, w); }
constexpr int SC_SLOT = 34816, SC_NSLOT = 4, SC_U = 32768;
constexpr int SC_OB = SC_NSLOT * SC_SLOT, OST = 20, SC_CD = SC_OB + 2 * 64 * OST * 4;
#define SC_BAR() asm volatile("s_waitcnt lgkmcnt(0)\n\ts_barrier" ::: "memory")
__device__ __forceinline__ void scan_dma(const unsigned char* ch, LAS unsigned char* slot, int lw, int sl, int lane) {
#pragma unroll
    for (int i = 0; i < 8; ++i) __builtin_amdgcn_global_load_lds((const unsigned*)(ch + lw * 8192 + i * 1024 + lane * 16), (LAS unsigned*)(slot + lw * 8192 + i * 1024), 16, 0, 0);
    const int up = lw & 1;
    __builtin_amdgcn_global_load_lds((const unsigned*)(ch + CH_U + sl * 2048 + up * 1024 + lane * 16), (LAS unsigned*)(slot + SC_U + up * 1024), 16, 0, 0);
}
__device__ __forceinline__ void scan_step(LAS unsigned char* lds, f32x4 (&S)[4], float cdv, int n, int lane) {
    const LAS unsigned char* ob = lds + (n & 3) * SC_SLOT; lf32* ot = (lf32*)(lds + SC_OB) + (n & 1) * 64 * OST;
    const f32x4 zero = {0.f, 0.f, 0.f, 0.f};
    const bf16x8 Sb0 = pack8(S[0], S[1]), Sb1 = pack8(S[2], S[3]);
    f32x4 vn[4], o[4];
#pragma unroll
    for (int mt = 0; mt < 4; ++mt) { const bf16x8 a0 = *(const LAS bf16x8*)(ob + CH_W + (mt * 2) * 1024 + lane * 16), a1 = *(const LAS bf16x8*)(ob + CH_W + (mt * 2 + 1) * 1024 + lane * 16);
        f32x4 acc = __builtin_amdgcn_mfma_f32_16x16x32_bf16(a0, Sb0, zero, 0, 0, 0); acc = __builtin_amdgcn_mfma_f32_16x16x32_bf16(a1, Sb1, acc, 0, 0, 0);
        const v2u uu = *(const LAS v2u*)(ob + SC_U + (mt * 64 + lane) * 8);
        vn[mt] = (f32x4){bflo(uu.x), bfhi(uu.x), bflo(uu.y), bfhi(uu.y)} - acc; }
    const bf16x8 Vb0 = pack8(vn[0], vn[1]), Vb1 = pack8(vn[2], vn[3]);
#pragma unroll
    for (int mt = 0; mt < 4; ++mt) { const bf16x8 t0 = *(const LAS bf16x8*)(ob + CH_KDT + (mt * 2) * 1024 + lane * 16), t1 = *(const LAS bf16x8*)(ob + CH_KDT + (mt * 2 + 1) * 1024 + lane * 16);
        f32x4 acc = S[mt] * cdv; acc = __builtin_amdgcn_mfma_f32_16x16x32_bf16(t0, Vb0, acc, 0, 0, 0); acc = __builtin_amdgcn_mfma_f32_16x16x32_bf16(t1, Vb1, acc, 0, 0, 0); vn[mt] = acc; }
#pragma unroll
    for (int mt = 0; mt < 4; ++mt) { const bf16x8 q0 = *(const LAS bf16x8*)(ob + CH_QD + (mt * 2) * 1024 + lane * 16), q1 = *(const LAS bf16x8*)(ob + CH_QD + (mt * 2 + 1) * 1024 + lane * 16);
        const bf16x8 k0 = *(const LAS bf16x8*)(ob + CH_QK + (mt * 2) * 1024 + lane * 16), k1 = *(const LAS bf16x8*)(ob + CH_QK + (mt * 2 + 1) * 1024 + lane * 16);
        f32x4 acc = __builtin_amdgcn_mfma_f32_16x16x32_bf16(q0, Sb0, zero, 0, 0, 0); acc = __builtin_amdgcn_mfma_f32_16x16x32_bf16(q1, Sb1, acc, 0, 0, 0);
        acc = __builtin_amdgcn_mfma_f32_16x16x32_bf16(k0, Vb0, acc, 0, 0, 0); acc = __builtin_amdgcn_mfma_f32_16x16x32_bf16(k1, Vb1, acc, 0, 0, 0); o[mt] = acc; }
#pragma unroll
    for (int mt = 0; mt < 4; ++mt) S[mt] = vn[mt];
    const int col = lane & 15, g = lane >> 4;
#pragma unroll
    for (int mt = 0; mt < 4; ++mt) { lf32* p = ot + (16 * mt + 4 * g) * OST + col; p[0] = o[mt].x; p[OST] = o[mt].y; p[2 * OST] = o[mt].z; p[3 * OST] = o[mt].w; }
}
__device__ __forceinline__ void scan_ostore(const lf32* ot, bf16* dst, int lane) {
    const lf32* p = ot + lane * OST; const f32x4 a0 = *(const LAS f32x4*)p, a1 = *(const LAS f32x4*)(p + 4), a2 = *(const LAS f32x4*)(p + 8), a3 = *(const LAS f32x4*)(p + 12);
    v4u w0, w1; w0.x = pk2(a0.x, a0.y); w0.y = pk2(a0.z, a0.w); w0.z = pk2(a1.x, a1.y); w0.w = pk2(a1.z, a1.w); w1.x = pk2(a2.x, a2.y); w1.y = pk2(a2.z, a2.w); w1.z = pk2(a3.x, a3.y); w1.w = pk2(a3.z, a3.w);
    *(v4u*)dst = w0; *(v4u*)(dst + 8) = w1;
}
__device__ __forceinline__ void p4_gdn_scan(Frame& F, const Args& a, int bh, int sl) {
    unsigned char* ws = a.ws; const int h = bh & 7, b = bh >> 3, wave = F.wave, lane = F.lane, tid = F.tid;
    const unsigned char* chb = ws + WS_CH + (size_t)bh * 128 * CH_BYTES; const float* cd = (const float*)(ws + WS_CD) + bh * 128;
    bf16* OG = (bf16*)(ws + WS_YGDN) + ((size_t)b * SEQ) * 512 + h * 64 + sl * 16;
    LAS unsigned char* lds = F.lds + RING_OFF;
    const lf32* cdl = (const lf32*)(lds + SC_CD);
    __syncthreads();
    if (tid < 128) ((lf32*)(lds + SC_CD))[tid] = cd[tid];
    if (wave == 0) {
        f32x4 S[4] = {(f32x4){0.f, 0.f, 0.f, 0.f}, (f32x4){0.f, 0.f, 0.f, 0.f}, (f32x4){0.f, 0.f, 0.f, 0.f}, (f32x4){0.f, 0.f, 0.f, 0.f}};
        SC_BAR();
        for (int m = 0; m < 128; ++m) { scan_step(lds, S, cdl[m], m, lane); SC_BAR(); }
        SC_BAR();
    } else if (wave <= 4) {
        const int lw = wave - 1;
        scan_dma(chb, lds, lw, sl, lane); scan_dma(chb + CH_BYTES, lds + SC_SLOT, lw, sl, lane); scan_dma(chb + 2 * CH_BYTES, lds + 2 * SC_SLOT, lw, sl, lane);
        asm volatile("s_waitcnt vmcnt(18)" ::: "memory");
        SC_BAR();
        for (int m = 0; m < 128; ++m) { const int c = m + 3 < 128 ? m + 3 : 127;
            scan_dma(chb + (size_t)c * CH_BYTES, lds + ((m + 3) & 3) * SC_SLOT, lw, sl, lane);
            asm volatile("s_waitcnt vmcnt(18)" ::: "memory");
            SC_BAR(); }
        asm volatile("s_waitcnt vmcnt(0)" ::: "memory");
        SC_BAR();
    } else if (wave == 5) {
        SC_BAR();
        for (int m = 0; m < 128; ++m) { if (m >= 1) scan_ostore((const lf32*)(lds + SC_OB) + ((m - 1) & 1) * 64 * OST, OG + (size_t)((m - 1) * 64 + lane) * 512, lane); SC_BAR(); }
        scan_ostore((const lf32*)(lds + SC_OB) + 64 * OST, OG + (size_t)(127 * 64 + lane) * 512, lane);
        SC_BAR();
    } else {
        SC_BAR();
        for (int m = 0; m < 128; ++m) SC_BAR();
        SC_BAR();
    }
    __syncthreads();
}
__device__ __forceinline__ void p4c_gdn_out(Frame& F, const Args& a) {
    unsigned char* ws = a.ws; const int lane = F.lane; bf16* Y = (bf16*)(ws + WS_YGDN); const bf16* Z = (const bf16*)(ws + WS_Z); const float* onw = a.in[11];
    const int gw = blockIdx.x * NWAVES + F.wave, NGW = F.G * NWAVES, d0 = (8 * lane) & 63;
    const f32x4 w0 = *(const f32x4*)(onw + d0), w1 = *(const f32x4*)(onw + d0 + 4);
    v4u no = {0u, 0u, 0u, 0u}, nz = no;
    if (gw < M) { no = *(const v4u*)(Y + (size_t)gw * 512 + 8 * lane); nz = *(const v4u*)(Z + (size_t)gw * 512 + 8 * lane); }
    for (int t = gw; t < M; t += NGW) {
        const v4u ow = no, zw = nz;
        if (t + NGW < M) { no = *(const v4u*)(Y + (size_t)(t + NGW) * 512 + 8 * lane); nz = *(const v4u*)(Z + (size_t)(t + NGW) * 512 + 8 * lane); }
        float o[8] = {bflo(ow.x), bfhi(ow.x), bflo(ow.y), bfhi(ow.y), bflo(ow.z), bfhi(ow.z), bflo(ow.w), bfhi(ow.w)};
        const float z[8] = {bflo(zw.x), bfhi(zw.x), bflo(zw.y), bfhi(zw.y), bflo(zw.z), bfhi(zw.z), bflo(zw.w), bfhi(zw.w)};
        float ss = 0.f;
#pragma unroll
        for (int i = 0; i < 8; ++i) ss += o[i] * o[i];
        ss += __shfl_xor(ss, 1); ss += __shfl_xor(ss, 2); ss += __shfl_xor(ss, 4);
        const float rstd = 1.0f / sqrtf(ss * (1.f / 64.f) + EPS);
        const float wv[8] = {w0.x, w0.y, w0.z, w0.w, w1.x, w1.y, w1.z, w1.w};
#pragma unroll
        for (int i = 0; i < 8; ++i) o[i] = o[i] * rstd * wv[i] * siluf(z[i]);
        v4u r; r.x = pk2(o[0], o[1]); r.y = pk2(o[2], o[3]); r.z = pk2(o[4], o[5]); r.w = pk2(o[6], o[7]);
        *(v4u*)(Y + (size_t)t * 512 + 8 * lane) = r;
    }
}

typedef float f32x16 __attribute__((ext_vector_type(16)));
constexpr int TK_KROW = 272;
constexpr int TK_KEYS = 0, TK_LIST = 2 * 128 * TK_KROW;
__device__ __forceinline__ unsigned f2ord(float f) { const unsigned u = __float_as_uint(f); return u ^ ((unsigned)((int)u >> 31) | 0x80000000u); }
__device__ __forceinline__ float ord2f(unsigned o) { const unsigned u = (o & 0x80000000u) ? (o ^ 0x80000000u) : ~o; return __uint_as_float(u); }
#define TK_CE(a, b) do { const unsigned _h = max(a, b), _l = min(a, b); a = _h; b = _l; } while (0)
__device__ __forceinline__ void sort16(unsigned (&v)[16]) {
#pragma unroll
    for (int k = 2; k <= 16; k <<= 1)
#pragma unroll
        for (int j = k >> 1; j > 0; j >>= 1)
#pragma unroll
            for (int i = 0; i < 16; ++i) { const int l = i ^ j; if (l > i) { if ((i & k) == 0) TK_CE(v[i], v[l]); else TK_CE(v[l], v[i]); } }
}
__device__ __forceinline__ void merge16(unsigned (&a)[16], const unsigned (&b)[16]) {
#pragma unroll
    for (int i = 0; i < 16; ++i) a[i] = max(a[i], b[15 - i]);
#pragma unroll
    for (int j = 8; j > 0; j >>= 1)
#pragma unroll
        for (int i = 0; i < 16; ++i) { const int l = i ^ j; if (l > i) TK_CE(a[i], a[l]); }
}
__device__ __forceinline__ void p9_topk(Frame& F, const Args& a) {
    unsigned char* ws = a.ws; const int tid = F.tid, lane = F.lane, wave = F.wave, tk = lane & 31, half = lane >> 5;
    const bf16* QP = (const bf16*)(ws + WS_QP); const bf16* SK = (const bf16*)(ws + WS_SKEY);
    LAS unsigned char* kl = F.lds + RING_OFF + TK_KEYS; LAS unsigned* lst = (LAS unsigned*)(F.lds + RING_OFF + TK_LIST) + wave * 1024;
    for (int it = blockIdx.x; it < (M / 256) * PH; it += F.G) {
        const int h = it & 7, t = (it >> 3) * 256 + wave * 32 + tk;
        __syncthreads();
        for (int i = tid; i < 2 * 128 * 16; i += 512) { const int row = i >> 4, c = i & 15; *(LAS v4u*)(kl + row * TK_KROW + c * 16) = *(const v4u*)(SK + (size_t)h * 2 * 128 * 128 + row * 128 + c * 8); }
        __syncthreads();
        unsigned top[2][16];
#pragma unroll
        for (int p = 0; p < 2; ++p) {
            bf16x8 qf[8];
#pragma unroll
            for (int ks = 0; ks < 8; ++ks) qf[ks] = *(const bf16x8*)(QP + (size_t)t * PQW + h * 256 + p * 128 + 16 * ks + 8 * half);
            unsigned best[16];
#pragma unroll
            for (int mt = 0; mt < 4; ++mt) {
                f32x16 acc = {0.f, 0.f, 0.f, 0.f, 0.f, 0.f, 0.f, 0.f, 0.f, 0.f, 0.f, 0.f, 0.f, 0.f, 0.f, 0.f};
#pragma unroll
                for (int ks = 0; ks < 8; ++ks) { const bf16x8 kf = *(const LAS bf16x8*)(kl + (p * 128 + mt * 32 + tk) * TK_KROW + ks * 32 + half * 16);
                    acc = __builtin_amdgcn_mfma_f32_32x32x16_bf16(kf, qf[ks], acc, 0, 0, 0); }
                unsigned g[16];
#pragma unroll
                for (int r = 0; r < 16; ++r) { const int key = 32 * mt + (r & 3) + 8 * (r >> 2) + 4 * half; g[r] = (f2ord(acc[r]) & ~127u) | (unsigned)(127 - key); }
                sort16(g);
                if (mt == 0) {
#pragma unroll
                    for (int r = 0; r < 16; ++r) best[r] = g[r]; }
                else merge16(best, g);
            }
            unsigned oth[16];
#pragma unroll
            for (int r = 0; r < 16; ++r) oth[r] = __shfl_xor(best[r], 32);
            merge16(best, oth);
#pragma unroll
            for (int r = 0; r < 16; ++r) top[p][r] = best[r];
        }
        if (half == 0) {
#pragma unroll
            for (int r = 0; r < 16; ++r) { lst[tk * 32 + r] = top[0][r]; lst[tk * 32 + 16 + r] = top[1][r]; } }
        float v1[16], v2[16];
#pragma unroll
        for (int r = 0; r < 16; ++r) { v1[r] = ord2f(top[0][r] & ~127u); v2[r] = ord2f(top[1][r] & ~127u); }
        unsigned c0[16], c1[16], c2[16], c3[16];
#pragma unroll
        for (int j = 0; j < 16; ++j) c0[j] = (f2ord(v1[0] + v2[j]) & ~255u) | (unsigned)(255 - j);
        { int n = 0;
#pragma unroll
          for (int i = 1; i < 16; ++i)
#pragma unroll
              for (int j = 0; j < 16; ++j) if ((i + 1) * (j + 1) <= 16) { const unsigned pk = (f2ord(v1[i] + v2[j]) & ~255u) | (unsigned)(255 - (i * 16 + j));
                  if (n < 16) c1[n] = pk; else if (n < 32) c2[n - 16] = pk; else c3[n - 32] = pk; ++n; }
#pragma unroll
          for (int r = 2; r < 16; ++r) c3[r] = 0u; }
        sort16(c1); sort16(c2); sort16(c3); merge16(c0, c1); merge16(c2, c3); merge16(c0, c2);
        LDS_WAIT(); asm volatile("" ::: "memory");
        float sm[16]; int eid[16];
#pragma unroll
        for (int r = 0; r < 16; ++r) { const int cid = 255 - (int)(c0[r] & 255u), i = cid >> 4, j = cid & 15;
            const unsigned p1 = lst[tk * 32 + i], p2 = lst[tk * 32 + 16 + j];
            sm[r] = ord2f(p1 & ~127u) + ord2f(p2 & ~127u); eid[r] = (127 - (int)(p1 & 127u)) * 128 + (127 - (int)(p2 & 127u)); }
        float den = 0.f; const float mx = sm[0];
#pragma unroll
        for (int r = 0; r < 16; ++r) { sm[r] = __expf(sm[r] - mx); den += sm[r]; }
        const float inv = 1.0f / den;
        if (half == 0) { int* eo = (int*)(ws + WS_EIDX) + (size_t)t * 128 + h * 16;
#pragma unroll
            for (int r = 0; r < 16; r += 4) *(v4u*)(eo + r) = (v4u){(unsigned)eid[r], (unsigned)eid[r + 1], (unsigned)eid[r + 2], (unsigned)eid[r + 3]}; }
        else { float* go = (float*)(ws + WS_GATE) + (size_t)t * 128 + h * 16;
#pragma unroll
            for (int r = 0; r < 16; r += 4) *(f32x4*)(go + r) = (f32x4){sm[r] * inv, sm[r + 1] * inv, sm[r + 2] * inv, sm[r + 3] * inv}; }
    }
    __syncthreads();
}

__device__ __forceinline__ float softplus_fast(float x) { return fmaxf(x, 0.f) + __logf(1.0f + __expf(-fabsf(x))); }
struct AttnTile { bf16x8 k[4]; v2u v[2][2][2]; };
__device__ __forceinline__ void attn_load(AttnTile& T, const bf16* Kb, const bf16* VTb, int key0, int tk, int half) {
#pragma unroll
    for (int ks = 0; ks < 4; ++ks) T.k[ks] = *(const bf16x8*)(Kb + (size_t)(key0 + tk) * 512 + 16 * ks + 8 * half);
#pragma unroll
    for (int mt = 0; mt < 2; ++mt)
#pragma unroll
        for (int s = 0; s < 2; ++s) { const bf16* p = VTb + (size_t)(32 * mt + tk) * SEQ + key0 + 16 * s + 4 * half; T.v[mt][s][0] = *(const v2u*)p; T.v[mt][s][1] = *(const v2u*)(p + 8); }
}
__device__ __forceinline__ void p4_attn(Frame& F, const Args& a, int blk, int nblk) {
    unsigned char* ws = a.ws; const int lane = F.lane, tk = lane & 31, half = lane >> 5;
    const bf16* Q = (const bf16*)(ws + WS_Q); const bf16* K = (const bf16*)(ws + WS_K); const bf16* VT = (const bf16*)(ws + WS_V); bf16* Y = (bf16*)(ws + WS_YSB);
    const int gwv = blk * NWAVES + F.wave, nwv = nblk * NWAVES;
    for (int u = gwv; u < BATCH * SBH * (SEQ / 32); u += nwv) {
        const int bh = u & 15, qt = u >> 4, b = bh >> 3, h = bh & 7;
        const bf16* Kb = K + (size_t)b * SEQ * 512 + h * 64; const bf16* VTb = VT + (size_t)bh * 64 * SEQ;
        bf16x8 qf[4];
#pragma unroll
        for (int ks = 0; ks < 4; ++ks) qf[ks] = *(const bf16x8*)(Q + ((size_t)b * SEQ + qt * 32 + tk) * 512 + h * 64 + 16 * ks + 8 * half);
        f32x16 o0 = {0.f, 0.f, 0.f, 0.f, 0.f, 0.f, 0.f, 0.f, 0.f, 0.f, 0.f, 0.f, 0.f, 0.f, 0.f, 0.f}, o1 = o0; const f32x16 zero16 = o0;
        float R = 0.f;
        AttnTile cur, nxt; attn_load(cur, Kb, VTb, qt * 32, tk, half);
        for (int kt = qt; kt >= 0; --kt) {
            if (kt > 0) attn_load(nxt, Kb, VTb, (kt - 1) * 32, tk, half);
            f32x16 z = __builtin_amdgcn_mfma_f32_32x32x16_bf16(cur.k[0], qf[0], zero16, 0, 0, 0);
            z = __builtin_amdgcn_mfma_f32_32x32x16_bf16(cur.k[1], qf[1], z, 0, 0, 0); z = __builtin_amdgcn_mfma_f32_32x32x16_bf16(cur.k[2], qf[2], z, 0, 0, 0); z = __builtin_amdgcn_mfma_f32_32x32x16_bf16(cur.k[3], qf[3], z, 0, 0, 0);
            const bool diag = (kt == qt);
            float sp[16], T[4];
#pragma unroll
            for (int r = 0; r < 16; ++r) { const int key = (r & 3) + 8 * (r >> 2) + 4 * half; const bool valid = !diag || key < tk; sp[r] = valid ? softplus_fast(z[r]) : 0.f; }
#pragma unroll
            for (int g = 0; g < 4; ++g) T[g] = (sp[4 * g] + sp[4 * g + 1]) + (sp[4 * g + 2] + sp[4 * g + 3]);
            float PT[4];
#pragma unroll
            for (int g = 0; g < 4; ++g) PT[g] = __shfl_xor(T[g], 32);
            float later[4]; later[3] = half ? 0.f : PT[3];
#pragma unroll
            for (int g = 2; g >= 0; --g) later[g] = later[g + 1] + T[g + 1] + (half ? PT[g + 1] : PT[g]);
            const float total = ((T[0] + T[1]) + (T[2] + T[3])) + ((PT[0] + PT[1]) + (PT[2] + PT[3]));
            float p[16];
#pragma unroll
            for (int g = 0; g < 4; ++g) { float c = R + later[g];
#pragma unroll
                for (int j = 3; j >= 0; --j) { const int r = 4 * g + j; const int key = (r & 3) + 8 * (r >> 2) + 4 * half; const bool valid = !diag || key < tk;
                    p[r] = valid ? __expf(z[r] - sp[r] - c) : 0.f; c += sp[r]; } }
            R += total;
            const bf16x8 pb0 = pack8((f32x4){p[0], p[1], p[2], p[3]}, (f32x4){p[4], p[5], p[6], p[7]}), pb1 = pack8((f32x4){p[8], p[9], p[10], p[11]}, (f32x4){p[12], p[13], p[14], p[15]});
#define VFRAG(mt, s) __builtin_bit_cast(bf16x8, (v4u){cur.v[mt][s][0].x, cur.v[mt][s][0].y, cur.v[mt][s][1].x, cur.v[mt][s][1].y})
            o0 = __builtin_amdgcn_mfma_f32_32x32x16_bf16(VFRAG(0, 0), pb0, o0, 0, 0, 0); o0 = __builtin_amdgcn_mfma_f32_32x32x16_bf16(VFRAG(0, 1), pb1, o0, 0, 0, 0);
            o1 = __builtin_amdgcn_mfma_f32_32x32x16_bf16(VFRAG(1, 0), pb0, o1, 0, 0, 0); o1 = __builtin_amdgcn_mfma_f32_32x32x16_bf16(VFRAG(1, 1), pb1, o1, 0, 0, 0);
#undef VFRAG
            if (__all(R > 105.f)) break;
            cur = nxt;
        }
        bf16* yp = Y + ((size_t)b * SEQ + qt * 32 + tk) * 512 + h * 64 + 4 * half;
#pragma unroll
        for (int g = 0; g < 4; ++g) { v2u w0, w1; w0.x = pk2(o0[4 * g], o0[4 * g + 1]); w0.y = pk2(o0[4 * g + 2], o0[4 * g + 3]); w1.x = pk2(o1[4 * g], o1[4 * g + 1]); w1.y = pk2(o1[4 * g + 2], o1[4 * g + 3]);
            *(v2u*)(yp + 8 * g) = w0; *(v2u*)(yp + 32 + 8 * g) = w1; }
    }
}
#ifndef PROBE_PH
#define PROBE_PH (-1)
#define PROBE_N 1
#endif
#ifndef PROBE_MASK
#define PROBE_MASK 0
#endif
#ifndef PROBE_VAR
#define PROBE_VAR 0
#endif
__global__ void __launch_bounds__(NWAVES * 64, 2) mk_fwd(Args args) {
    extern __shared__ __attribute__((aligned(16))) unsigned char lds[];
    Frame F;
    F.lds = (LAS unsigned char*)lds;
    F.MISC = (volatile LAS unsigned*)(F.lds + MISC_OFF);
    F.tid = threadIdx.x; F.lane = F.tid & 63; F.wave = __builtin_amdgcn_readfirstlane(F.tid >> 6);
    F.G = gridDim.x;
    unsigned char* ws = args.ws;
    F.ctl = (gu32*)(ws + WS_CTL);
    for (int u = F.tid; u < (LDS_BYTES - LDSCTL_OFF) / 4; u += NWAVES * 64) ((LAS unsigned*)(F.lds + LDSCTL_OFF))[u] = 0u;
    __syncthreads();
    const bool multi = (args.ph_hi - args.ph_lo) > 1;
    XcdBarrier bar; bar.bar = (unsigned*)(F.ctl + CW_BAR); bar.x = 0; bar.st = nullptr;
    if (multi) bar = xcd_barrier_post((unsigned*)(F.ctl + CW_BAR), F.MISC + 8);
    const int lo = args.ph_lo, hi = args.ph_hi;
#define IN(k) (lo <= (k) && (k) < hi)
#define REP(k) for (int _r = 0; _r < ((k) == PROBE_PH ? PROBE_N : 1); ++_r)
#define SEAM(k) do { if (IN(k) && (k) + 1 < hi) { xcd_barrier(bar); if (PROBE_PH == 99) { xcd_barrier(bar); xcd_barrier(bar); } } } while (0)
    const float* mod = (const float*)(ws + WS_MOD);
#define STAMP(i) do { if (PROBE_PH >= 100 && blockIdx.x == 0 && F.tid == 0) F.MISC[16 + (i)] = (unsigned)__builtin_amdgcn_s_memrealtime(); } while (0)
    STAMP(0);

    if (IN(0)) { REP(0) p0_prologue(F, args); } SEAM(0); STAMP(1);
    if (IN(1)) { REP(1) norm_mod_rows(F, args.in[0], args.in[4], mod, 0, (bf16*)(ws + WS_XN), nullptr); } SEAM(1); STAMP(2);
    if (IN(2)) {
#define BODY2 \
        pg8::Gemm g{(const bf16*)(ws + WS_XN), (const bf16*)(ws + WS_WIN), M, INWP, D}; pg8::StaticOrder S; S.init(M, INWP, F.G, (int)blockIdx.x); \
        pg8::EpiInProj E{(bf16*)(ws + WS_Q), (bf16*)(ws + WS_K), (bf16*)(ws + WS_V), (bf16*)(ws + WS_GRAW), (bf16*)(ws + WS_Z), (bf16*)args.out, (float*)(ws + WS_AB)}; \
        pg8::gemm_phase<pg8::EpiInProj, pg8::StaticOrder, true, true>(F.lds + RING_OFF, g, S, E);
        BODY2
        if (PROBE_PH == 2) { BODY2 }
#undef BODY2
    } SEAM(2); STAMP(3);
    if (IN(3)) { REP(3) p3_gdn_prep(F, args); p3_qknorm(F, args); } SEAM(3); STAMP(4);
    if (IN(4)) { constexpr int NSC = BATCH * GH * 4;
        if (blockIdx.x < NSC) { REP(4) p4_gdn_scan(F, args, (int)(blockIdx.x & 7) + 8 * (int)(blockIdx.x >> 5), (int)(blockIdx.x >> 3) & 3); }
        else REP(40) { p4_attn(F, args, (int)blockIdx.x - NSC, F.G - NSC); peer_tables_to_fp8(args, (int)blockIdx.x - NSC, F.G - NSC, F.tid); }
        xcd_barrier(bar);
        p4c_gdn_out(F, args); } SEAM(4); STAMP(5);
    if (IN(5)) {
#define BODY5 \
        { pg8::Gemm g{(const bf16*)(ws + WS_YSB), (const bf16*)(ws + WS_WSB), M, D, 512}; pg8::StaticOrder S; S.init(M, D, F.G, (int)blockIdx.x); \
          pg8::EpiMerge<0> E{(const bf16*)args.out, (bf16*)(ws + WS_MERGED)}; \
          pg8::gemm_phase<pg8::EpiMerge<0>, pg8::StaticOrder, true, true>(F.lds + RING_OFF, g, S, E); } \
        VM_WAIT(); __syncthreads(); \
        if (F.tid == 0) { __builtin_amdgcn_fence(__ATOMIC_ACQ_REL, "agent"); VM_WAIT(); } \
        __syncthreads(); \
        { pg8::Gemm g{(const bf16*)(ws + WS_YGDN), (const bf16*)(ws + WS_WGDN), M, D, 512}; pg8::StaticOrder S; S.init(M, D, F.G, (int)blockIdx.x); \
          pg8::EpiMerge<1> E{(const bf16*)args.out, (bf16*)(ws + WS_MERGED)}; \
          pg8::gemm_phase<pg8::EpiMerge<1>, pg8::StaticOrder, true, true>(F.lds + RING_OFF, g, S, E); }
        BODY5
        if (PROBE_PH == 5) { BODY5 }
#undef BODY5
    } SEAM(5); STAMP(6);
    if (IN(6)) {
#define BODY6 \
        pg8::Gemm g{(const bf16*)(ws + WS_MERGED), (const bf16*)(ws + WS_WO), M, D, D}; pg8::StaticOrder S; S.init(M, D, F.G, (int)blockIdx.x); \
        pg8::EpiWo E{args.in[0], mod, args.out}; \
        pg8::gemm_phase<pg8::EpiWo, pg8::StaticOrder, true, true>(F.lds + RING_OFF, g, S, E);
        BODY6
        if (PROBE_PH == 6) { BODY6 }
#undef BODY6
    } SEAM(6); STAMP(7);
    if (IN(7)) { REP(7) norm_mod_rows(F, args.out, args.in[15], mod, 3, (bf16*)(ws + WS_XN), ws + WS_H28); } SEAM(7); STAMP(8);
    if (IN(8)) {
#define BODY8 \
        pg8::Gemm g{(const bf16*)(ws + WS_XN), (const bf16*)(ws + WS_WQ), M, PQW, D}; pg8::StaticOrder S; S.init(M, PQW, F.G, (int)blockIdx.x); \
        pg8::EpiBf16<0> E{(bf16*)(ws + WS_QP), PQW, nullptr, 0, 0, 1.f}; \
        pg8::gemm_phase<pg8::EpiBf16<0>, pg8::StaticOrder, true, true>(F.lds + RING_OFF, g, S, E);
        BODY8
        if (PROBE_PH == 8) { BODY8 }
#undef BODY8
    } SEAM(8); STAMP(9);
    if (IN(9)) REP(9) { p9_topk(F, args); } SEAM(9); STAMP(10);
    if (IN(10)) { p10a_peer_u(F, args); if (PROBE_PH == 10) { p10a_peer_u(F, args); p10a_peer_u(F, args); } xcd_barrier(bar); REP(11) p10b_peer_v(F, args, _r == 0 ? args.out : (float*)(ws + WS_QP)); }
    STAMP(11);
    if (PROBE_PH >= 100 && blockIdx.x == 0 && F.tid == 0) { unsigned d = 0; for (int k = 0; k < 11; ++k) if ((PROBE_MASK >> k) & 1) d += F.MISC[16 + k + 1] - F.MISC[16 + k];
        const unsigned t0 = (unsigned)__builtin_amdgcn_s_memrealtime(); while ((unsigned)__builtin_amdgcn_s_memrealtime() - t0 < d) __builtin_amdgcn_s_sleep(8); }
#undef IN
#undef REP
#undef SEAM
}
extern "C" void kernel_launch(void* const* d_in, const int* in_sizes, int n_in, void* d_out, int out_size, void* d_ws, size_t ws_size, hipStream_t stream) {
    static int grid = 0;
    if (grid == 0) {
        if (n_in != 20 || out_size != M * D || ws_size < WS_END) { fprintf(stderr, "kernel_launch: unexpected shapes n_in %d out %d ws %zu\n", n_in, out_size, ws_size); grid = -1; return; }
        int dev = 0, cus = 0;
        if (hipGetDevice(&dev) != hipSuccess || hipDeviceGetAttribute(&cus, hipDeviceAttributeMultiprocessorCount, dev) != hipSuccess) { grid = -1; return; }
        if (hipFuncSetAttribute((const void*)mk_fwd, hipFuncAttributeMaxDynamicSharedMemorySize, LDS_BYTES) != hipSuccess) { fprintf(stderr, "kernel_launch: hipFuncSetAttribute failed\n"); grid = -1; return; }
        (void)hipGetLastError();
        grid = cus;
    }
    if (grid < 0) return;
    (void)hipMemsetAsync((char*)d_ws + WS_CTL, 0, CTL_ZERO_BYTES, stream);
    Args a{};
    for (int i = 0; i < 20; ++i) a.in[i] = (const float*)d_in[i];
    a.out = (float*)d_out; a.ws = (unsigned char*)d_ws;
    auto mk = [&](int lo, int hi) { a.ph_lo = lo; a.ph_hi = hi; a.li = 0; hipLaunchKernelGGL(mk_fwd, dim3(grid), dim3(NWAVES * 64), LDS_BYTES, stream, a); };
    mk(0, 11);
}
```

```cpp
#include <hip/hip_runtime.h>
#include <cstdio>
#include <cstdint>
#include <cmath>

constexpr int D = 1024, BATCH = 2, SEQ = 8192, M = BATCH * SEQ;
constexpr int SBH = 8, SBD = 64, SBW = 512;
constexpr int GH = 8, GDK = 64, GDV = 64, GCONVW = 1536;
constexpr int INW = 5648, INWP = 5888;
constexpr int PH = 8, PNK = 128, PQD = 256, PHALF = 128, PTOPK = 16, PNE = 16384, PQW = PH * PQD;
constexpr float EPS = 1e-6f;

namespace pg8 {
#define PG8_LAS __attribute__((address_space(3)))
typedef unsigned short bf16_t;
typedef short bf16x8 __attribute__((ext_vector_type(8)));
typedef float f32x4 __attribute__((ext_vector_type(4)));
typedef unsigned u32x4 __attribute__((ext_vector_type(4)));
constexpr int BM = 256, BK = 64, HALF = 128, HTB = HALF * BK * 2  , STAGE_BYTES = 8 * HTB, NXCD = 8, WGM = 8;

__host__ __device__ __forceinline__ int lds_byte(int r, int c) { const int st = (r >> 4) * 2 + (c >> 5), rr = r & 15, cc = c & 31, ob = rr * 64 + cc * 2; return st * 1024 + (ob ^ (((ob >> 9) & 1) << 5)); }
__host__ __device__ __forceinline__ void stage_rc(int b, int& R, int& C) { const int st = b / 1024, sb = b % 1024, swz = sb ^ (((sb >> 9) & 1) << 5); R = (st >> 1) * 16 + swz / 64; C = (st & 1) * 32 + (swz % 64) / 2; }
__host__ __device__ __forceinline__ int perm32(int rho) { const int n = rho >> 4, i = rho & 15; return 8 * (i >> 2) + 4 * n + (i & 3); }

struct Unit { int pm, pn; };
struct Gemm { const bf16_t* A; const bf16_t* Bt; int M, N, K; };

struct StaticOrder {
    int nM, nN, nwg, G, c;
    __host__ __device__ void init(int M, int N, int G_, int c_) { nM = M / BM; nN = N / BM; nwg = nM * nN; G = G_; c = c_; }
    __host__ __device__ bool next(int i, Unit& u) const {
        const long L = (long)i * G + c; if (L >= nwg) return false;
        int wgid = (int)L; { const int q = nwg / NXCD, r = nwg % NXCD, xcd = wgid % NXCD, off = wgid / NXCD; wgid = (xcd < r ? xcd * (q + 1) : r * (q + 1) + (xcd - r) * q) + off; }
        const int nig = WGM * nN, gid = wgid / nig, fm = gid * WGM, gsz = (nM - fm) < WGM ? (nM - fm) : WGM;
        u.pm = fm + ((wgid % nig) % gsz); u.pn = (wgid % nig) / gsz; return true;
    }
    __device__ __forceinline__ void a_ready(const Unit&) const {}
    __device__ __forceinline__ void done(const Unit&) const {}
};

__device__ __forceinline__ unsigned cvt_pk_bf16(float lo, float hi) { unsigned r; asm volatile("v_cvt_pk_bf16_f32 %0, %1, %2" : "=v"(r) : "v"(lo), "v"(hi)); return r; }
typedef float f32x2 __attribute__((ext_vector_type(2)));
__device__ __forceinline__ f32x2 gelu_pk(f32x2 v) {
    const f32x2 av = __builtin_elementwise_abs(v), d = av * 0.2316418882f + 1.0f;
    f32x2 t; t.x = __builtin_amdgcn_rcpf(d.x); t.y = __builtin_amdgcn_rcpf(d.y);
    f32x2 q = t * 0.5307027145f + (-0.7265760135f); q = q * t + 0.7107068705f; q = q * t + (-0.142248368f); q = q * t + 0.127414796f; q = q * t;
    const f32x2 s = (v * v) * (-0.72134752044f);
    f32x2 e; e.x = __builtin_amdgcn_exp2f(s.x); e.y = __builtin_amdgcn_exp2f(s.y);
    const f32x2 m = v * (q * e), r = v - m;
    f32x2 o; o.x = v.x < 0.f ? m.x : r.x; o.y = v.y < 0.f ? m.y : r.y; return o;
}

template <int ACT  > struct EpiBf16 {
    static constexpr bool PERM = true, AFTER_DRAIN = false; static_assert(ACT == 0 || ACT == 1, "EpiBf16: ACT is 0 (none) or 1 (gelu_pk)");
    bf16_t* O; int ldc; const float* bias; int split_cols; size_t split_stride; float scale0;
    __device__ __forceinline__ void operator()(const f32x4 (&acc)[2][2][4][2], const Unit& u, int wr, int wc, int fr, int fq) const {
        const int row0 = u.pm * BM + wr * 64 + fr; int colt = u.pn * BM; bf16_t* base = O;
        float sc = 1.f; if (split_cols) { const int t = colt / split_cols; base += (size_t)t * split_stride; colt -= t * split_cols; if (t == 0) sc = scale0; }
        const int col0 = colt + wc * 32 + 8 * fq, bcol0 = u.pn * BM + wc * 32 + 8 * fq;
        f32x4 bv[2][2];
#pragma unroll
        for (int bj = 0; bj < 2; ++bj)
#pragma unroll
            for (int n = 0; n < 2; ++n) bv[bj][n] = bias ? *(const f32x4*)(bias + bcol0 + bj * HALF + 4 * n) : (f32x4){0.f, 0.f, 0.f, 0.f};
#pragma unroll
        for (int ai = 0; ai < 2; ++ai)
#pragma unroll
            for (int m = 0; m < 4; ++m) { bf16_t* rowp = base + (size_t)(row0 + ai * HALF + m * 16) * ldc + col0;
#pragma unroll
                for (int bj = 0; bj < 2; ++bj) { f32x4 v0 = acc[ai][bj][m][0] + bv[bj][0], v1 = acc[ai][bj][m][1] + bv[bj][1];
                    if (ACT == 1) { f32x2 a = gelu_pk((f32x2){v0[0], v0[1]}), b = gelu_pk((f32x2){v0[2], v0[3]}), c = gelu_pk((f32x2){v1[0], v1[1]}), d = gelu_pk((f32x2){v1[2], v1[3]});
                        v0 = (f32x4){a.x, a.y, b.x, b.y}; v1 = (f32x4){c.x, c.y, d.x, d.y}; }
                    v0 = v0 * sc; v1 = v1 * sc; u32x4 w; w.x = cvt_pk_bf16(v0[0], v0[1]); w.y = cvt_pk_bf16(v0[2], v0[3]); w.z = cvt_pk_bf16(v1[0], v1[1]); w.w = cvt_pk_bf16(v1[2], v1[3]);
                    *(u32x4*)(rowp + bj * HALF) = w; } }
    }
};

__device__ __forceinline__ float sigmoidf_(float x) { return __builtin_amdgcn_rcpf(1.0f + __expf(-x)); }
__device__ __forceinline__ float bf2f(unsigned short h) { return __uint_as_float((unsigned)h << 16); }
__device__ __forceinline__ float bflo(unsigned w) { return __uint_as_float(w << 16); }
__device__ __forceinline__ float bfhi(unsigned w) { return __uint_as_float(w & 0xffff0000u); }

struct EpiInProj {
    static constexpr bool PERM = true, AFTER_DRAIN = false;
    bf16_t *q, *k, *v, *graw, *z, *gates; float* ab;
    __device__ __forceinline__ void operator()(const f32x4 (&acc)[2][2][4][2], const Unit& u, int wr, int wc, int fr, int fq) const {
        const int pn = u.pn; bf16_t* base; int ldc, ct; bool sig = false;
        if (pn >= 4 && pn < 6) {
#pragma unroll
            for (int ai = 0; ai < 2; ++ai)
#pragma unroll
                for (int m = 0; m < 4; ++m) { const int r = u.pm * BM + ai * HALF + wr * 64 + m * 16 + fr; const int bb = r >> 13, t = r & 8191;
#pragma unroll
                    for (int bj = 0; bj < 2; ++bj) { const int c0 = (pn - 4) * BM + bj * HALF + wc * 32 + 8 * fq; bf16_t* dst = v + ((size_t)(bb * 8 + (c0 >> 6)) * 64 + (c0 & 63)) * 8192 + t;
                        const f32x4 v0 = acc[ai][bj][m][0], v1 = acc[ai][bj][m][1];
                        const unsigned w0 = cvt_pk_bf16(v0[0], v0[1]), w1 = cvt_pk_bf16(v0[2], v0[3]), w2 = cvt_pk_bf16(v1[0], v1[1]), w3 = cvt_pk_bf16(v1[2], v1[3]);
                        dst[0] = (bf16_t)w0; dst[8192] = (bf16_t)(w0 >> 16); dst[2 * 8192] = (bf16_t)w1; dst[3 * 8192] = (bf16_t)(w1 >> 16);
                        dst[4 * 8192] = (bf16_t)w2; dst[5 * 8192] = (bf16_t)(w2 >> 16); dst[6 * 8192] = (bf16_t)w3; dst[7 * 8192] = (bf16_t)(w3 >> 16); } }
            return;
        }
        if (pn < 2) { base = q; ldc = 512; ct = pn; } else if (pn < 4) { base = k; ldc = 512; ct = pn - 2; }
        else if (pn < 12) { base = graw; ldc = 1536; ct = pn - 6; } else if (pn < 14) { base = z; ldc = 512; ct = pn - 12; } else if (pn < 22) { base = gates; ldc = 2048; ct = pn - 14; sig = true; }
        else {
            if (wc == 0 && fq < 2) {
#pragma unroll
                for (int ai = 0; ai < 2; ++ai)
#pragma unroll
                    for (int m = 0; m < 4; ++m) { const int r = u.pm * BM + ai * HALF + wr * 64 + m * 16 + fr; float* p = ab + (size_t)r * 16 + 8 * fq;
                        *(f32x4*)p = acc[ai][0][m][0]; *(f32x4*)(p + 4) = acc[ai][0][m][1]; }
            }
            return;
        }
        const int row0 = u.pm * BM + wr * 64 + fr, col0 = ct * BM + wc * 32 + 8 * fq;
#pragma unroll
        for (int ai = 0; ai < 2; ++ai)
#pragma unroll
            for (int m = 0; m < 4; ++m) { bf16_t* rowp = base + (size_t)(row0 + ai * HALF + m * 16) * ldc + col0;
#pragma unroll
                for (int bj = 0; bj < 2; ++bj) { f32x4 v0 = acc[ai][bj][m][0], v1 = acc[ai][bj][m][1];
                    if (sig) { v0 = (f32x4){sigmoidf_(v0[0]), sigmoidf_(v0[1]), sigmoidf_(v0[2]), sigmoidf_(v0[3])}; v1 = (f32x4){sigmoidf_(v1[0]), sigmoidf_(v1[1]), sigmoidf_(v1[2]), sigmoidf_(v1[3])}; }
                    u32x4 w; w.x = cvt_pk_bf16(v0[0], v0[1]); w.y = cvt_pk_bf16(v0[2], v0[3]); w.z = cvt_pk_bf16(v1[0], v1[1]); w.w = cvt_pk_bf16(v1[2], v1[3]);
                    *(u32x4*)(rowp + bj * HALF) = w; } }
    }
};
template <int MODE> struct EpiMerge {
    static constexpr bool PERM = true, AFTER_DRAIN = false;
    const bf16_t* gates; bf16_t* merged;
    __device__ __forceinline__ void operator()(const f32x4 (&acc)[2][2][4][2], const Unit& u, int wr, int wc, int fr, int fq) const {
        const int row0 = u.pm * BM + wr * 64 + fr, col0 = u.pn * BM + wc * 32 + 8 * fq;
#pragma unroll
        for (int ai = 0; ai < 2; ++ai)
#pragma unroll
            for (int m = 0; m < 4; ++m) { const size_t r = (size_t)(row0 + ai * HALF + m * 16);
#pragma unroll
                for (int bj = 0; bj < 2; ++bj) { const int c = col0 + bj * HALF;
                    const u32x4 g = *(const u32x4*)(gates + r * 2048 + MODE * 1024 + c);
                    f32x4 v0 = acc[ai][bj][m][0], v1 = acc[ai][bj][m][1];
                    v0 = v0 * (f32x4){bflo(g.x), bfhi(g.x), bflo(g.y), bfhi(g.y)}; v1 = v1 * (f32x4){bflo(g.z), bfhi(g.z), bflo(g.w), bfhi(g.w)};
                    if (MODE == 1) { const u32x4 p = *(const u32x4*)(merged + r * 1024 + c);
                        v0 = v0 + (f32x4){bflo(p.x), bfhi(p.x), bflo(p.y), bfhi(p.y)}; v1 = v1 + (f32x4){bflo(p.z), bfhi(p.z), bflo(p.w), bfhi(p.w)}; }
                    u32x4 w; w.x = cvt_pk_bf16(v0[0], v0[1]); w.y = cvt_pk_bf16(v0[2], v0[3]); w.z = cvt_pk_bf16(v1[0], v1[1]); w.w = cvt_pk_bf16(v1[2], v1[3]);
                    *(u32x4*)(merged + r * 1024 + c) = w; } }
    }
};
struct EpiWo {
    static constexpr bool PERM = true, AFTER_DRAIN = false;
    const float* x; const float* mod; float* out;
    __device__ __forceinline__ void operator()(const f32x4 (&acc)[2][2][4][2], const Unit& u, int wr, int wc, int fr, int fq) const {
        const int row0 = u.pm * BM + wr * 64 + fr, col0 = u.pn * BM + wc * 32 + 8 * fq; const int b = (u.pm * BM) >> 13;
        const float* g1 = mod + (size_t)b * 6 * 1024 + 2 * 1024;
#pragma unroll
        for (int bj = 0; bj < 2; ++bj) { const int c = col0 + bj * HALF; const f32x4 ga = *(const f32x4*)(g1 + c), gb = *(const f32x4*)(g1 + c + 4);
#pragma unroll
            for (int ai = 0; ai < 2; ++ai)
#pragma unroll
                for (int m = 0; m < 4; ++m) { const size_t off = (size_t)(row0 + ai * HALF + m * 16) * 1024 + c;
                    const f32x4 xa = *(const f32x4*)(x + off), xb = *(const f32x4*)(x + off + 4);
                    *(f32x4*)(out + off) = xa + ga * acc[ai][bj][m][0]; *(f32x4*)(out + off + 4) = xb + gb * acc[ai][bj][m][1]; } }
    }
};
template <class Epi, class Sched, bool ALIGN_EPI = false, bool SP2 = false>
__device__ __forceinline__ void gemm_phase(PG8_LAS unsigned char* lds, const Gemm g, const Sched& S, const Epi& E) {
    const int tid = threadIdx.x, wid = __builtin_amdgcn_readfirstlane(tid >> 6), lane = tid & 63, wr = wid >> 2, wc = wid & 3, fr = lane & 15, fq = lane >> 4;
    const int K = g.K, nt = K / BK;
    unsigned voffA[2], voffB[2];
#pragma unroll
    for (int i = 0; i < 2; ++i) { int R, C; stage_rc(tid * 16 + i * 8192, R, C); const int Rb = Epi::PERM ? ((R & ~31) + perm32(R & 31)) : R;
        voffA[i] = (unsigned)(R * K + C) * 2u; voffB[i] = (unsigned)(Rb * K + C) * 2u; }
    const size_t kstep = (size_t)(BK * 2);
    const size_t hstep = (size_t)HALF * K * 2;
    const size_t tstep = 2 * hstep;
    const unsigned ldsw = (unsigned)wid * 1024u;
    const int aoff = lds_byte(wr * 64 + fr, fq * 8), boff = lds_byte(wc * 32 + fr, fq * 8);
#define PG8_SA(b, h) (((b) * 2 + (h)) * HTB)
#define PG8_SB(b, h) ((4 + (b) * 2 + (h)) * HTB)
#define PG8_STAGE(bufoff, gbase, voff) do { _Pragma("unroll") for (int _i = 0; _i < 2; ++_i) \
        __builtin_amdgcn_global_load_lds((const unsigned*)((const char*)(gbase) + (voff)[_i]), (PG8_LAS unsigned*)(lds + (bufoff) + ldsw + _i * 8192), 16, 0, 0); } while (0)
#define PG8_LDA(dst, b, h) do { _Pragma("unroll") for (int m = 0; m < 4; ++m) _Pragma("unroll") for (int k = 0; k < 2; ++k) dst[m][k] = *(const PG8_LAS bf16x8*)(lds + PG8_SA(b, h) + aoff + m * 2048 + k * 1024); } while (0)
#define PG8_LDB(dst, b, h) do { _Pragma("unroll") for (int n = 0; n < 2; ++n) _Pragma("unroll") for (int k = 0; k < 2; ++k) dst[n][k] = *(const PG8_LAS bf16x8*)(lds + PG8_SB(b, h) + boff + n * 2048 + k * 1024); } while (0)
#define PG8_MMA(ai, bj, At, Bt) do { __builtin_amdgcn_s_setprio(1); _Pragma("unroll") for (int m = 0; m < 4; ++m) _Pragma("unroll") for (int n = 0; n < 2; ++n) _Pragma("unroll") for (int k = 0; k < 2; ++k) \
        acc[ai][bj][m][n] = __builtin_amdgcn_mfma_f32_16x16x32_bf16(Bt[n][k], At[m][k], acc[ai][bj][m][n], 0, 0, 0); __builtin_amdgcn_s_setprio(0); } while (0)
#define PG8_WAIT_V(n) asm volatile("s_waitcnt vmcnt(" #n ")" ::: "memory")
#define PG8_WAIT_L(n) asm volatile("s_waitcnt lgkmcnt(" #n ")" ::: "memory")
#define PG8_BAR __builtin_amdgcn_s_barrier()
#define PG8_SCHED __builtin_amdgcn_sched_barrier(0)
    Unit cur, nxt; int ui = 0;
    if (!S.next(0, cur)) return;
    f32x4 acc[2][2][4][2];
#pragma unroll
    for (int a = 0; a < 2; ++a)
#pragma unroll
        for (int b = 0; b < 2; ++b)
#pragma unroll
            for (int m = 0; m < 4; ++m)
#pragma unroll
                for (int n = 0; n < 2; ++n) acc[a][b][m][n] = (f32x4){0.f, 0.f, 0.f, 0.f};
    bf16x8 At[4][2], B0[2][2], B1[2][2];
    const char* cA = (const char*)g.A + (size_t)cur.pm * tstep; const char* cB = (const char*)g.Bt + (size_t)cur.pn * tstep;
    S.a_ready(cur);
    if constexpr (SP2) {
        PG8_STAGE(PG8_SB(0, 0), cB, voffB); PG8_STAGE(PG8_SB(0, 1), cB + hstep, voffB); PG8_STAGE(PG8_SA(0, 0), cA, voffA); PG8_STAGE(PG8_SA(0, 1), cA + hstep, voffA);
        if (wr == 1) PG8_BAR;
        PG8_WAIT_V(2); PG8_BAR;
        PG8_STAGE(PG8_SB(1, 0), cB + kstep, voffB); PG8_STAGE(PG8_SA(1, 0), cA + kstep, voffA); PG8_STAGE(PG8_SB(1, 1), cB + hstep + kstep, voffB);
        PG8_WAIT_V(6); PG8_BAR;
    } else {
        PG8_STAGE(PG8_SB(0, 0), cB, voffB); PG8_STAGE(PG8_SA(0, 0), cA, voffA); PG8_STAGE(PG8_SB(0, 1), cB + hstep, voffB); PG8_STAGE(PG8_SA(0, 1), cA + hstep, voffA);
        if (wr == 1) PG8_BAR;
        PG8_WAIT_V(4); PG8_BAR;
        PG8_STAGE(PG8_SB(1, 0), cB + kstep, voffB); PG8_STAGE(PG8_SA(1, 0), cA + kstep, voffA); PG8_STAGE(PG8_SB(1, 1), cB + hstep + kstep, voffB);
        PG8_WAIT_V(6); PG8_BAR;
    }
    for (;;) {
        const bool has_next = S.next(ui + 1, nxt);
        const char* nA = has_next ? (const char*)g.A + (size_t)nxt.pm * tstep : cA; const char* nB = has_next ? (const char*)g.Bt + (size_t)nxt.pn * tstep : cB;
        for (int t = 0; t < nt; t += 2) {
            const bool last = (t == nt - 2);
            const char* a1 = cA + (size_t)(t + 1) * kstep;
            const char* a2 = last ? nA : cA + (size_t)(t + 2) * kstep; const char* b2 = last ? nB : cB + (size_t)(t + 2) * kstep;
            const char* a3 = a2 + kstep; const char* b3 = b2 + kstep;
            if (last && has_next) S.a_ready(nxt);
            if constexpr (SP2) {
            PG8_LDB(B0, 0, 0); PG8_LDB(B1, 0, 1); PG8_SCHED; PG8_LDA(At, 0, 0); PG8_STAGE(PG8_SA(1, 1), a1 + hstep, voffA);
            PG8_WAIT_V(8); PG8_WAIT_L(0); PG8_BAR; PG8_MMA(0, 0, At, B0); PG8_MMA(0, 1, At, B1); PG8_BAR; PG8_SCHED;
            PG8_LDA(At, 0, 1); PG8_STAGE(PG8_SB(0, 0), b2, voffB); PG8_STAGE(PG8_SB(0, 1), b2 + hstep, voffB); PG8_STAGE(PG8_SA(0, 0), a2, voffA);
            PG8_WAIT_V(8); PG8_WAIT_L(0); PG8_BAR; PG8_MMA(1, 0, At, B0); PG8_MMA(1, 1, At, B1); PG8_BAR; PG8_SCHED;
            PG8_LDB(B0, 1, 0); PG8_LDB(B1, 1, 1); PG8_SCHED; PG8_LDA(At, 1, 0); PG8_STAGE(PG8_SA(0, 1), a2 + hstep, voffA);
            PG8_WAIT_V(8); PG8_WAIT_L(0); PG8_BAR; PG8_MMA(0, 0, At, B0); PG8_MMA(0, 1, At, B1); PG8_BAR; PG8_SCHED;
            PG8_LDA(At, 1, 1); PG8_STAGE(PG8_SB(1, 0), b3, voffB); PG8_STAGE(PG8_SB(1, 1), b3 + hstep, voffB); PG8_STAGE(PG8_SA(1, 0), a3, voffA);
            PG8_WAIT_V(8); PG8_WAIT_L(0); PG8_BAR; PG8_MMA(1, 0, At, B0); PG8_MMA(1, 1, At, B1); PG8_BAR; PG8_SCHED;
            } else {
            PG8_LDB(B0, 0, 0); PG8_SCHED; PG8_LDA(At, 0, 0); PG8_STAGE(PG8_SA(1, 1), a1 + hstep, voffA);
            PG8_WAIT_L(8); PG8_BAR; PG8_WAIT_L(0); PG8_MMA(0, 0, At, B0); PG8_BAR; PG8_SCHED;
            PG8_LDB(B1, 0, 1); PG8_STAGE(PG8_SB(0, 0), b2, voffB);
            PG8_BAR; PG8_WAIT_L(0); PG8_MMA(0, 1, At, B1); PG8_BAR;
            PG8_LDA(At, 0, 1); PG8_STAGE(PG8_SA(0, 0), a2, voffA);
            PG8_BAR; PG8_WAIT_L(0); PG8_MMA(1, 0, At, B0); PG8_BAR; PG8_SCHED;
            PG8_STAGE(PG8_SB(0, 1), b2 + hstep, voffB);
            PG8_WAIT_V(6); PG8_BAR; PG8_MMA(1, 1, At, B1); PG8_BAR;
            PG8_LDB(B0, 1, 0); PG8_SCHED; PG8_LDA(At, 1, 0); PG8_STAGE(PG8_SA(0, 1), a2 + hstep, voffA);
            PG8_WAIT_L(8); PG8_BAR; PG8_WAIT_L(0); PG8_MMA(0, 0, At, B0); PG8_BAR; PG8_SCHED;
            PG8_LDB(B1, 1, 1); PG8_STAGE(PG8_SB(1, 0), b3, voffB);
            PG8_BAR; PG8_WAIT_L(0); PG8_MMA(0, 1, At, B1); PG8_BAR;
            PG8_LDA(At, 1, 1); PG8_STAGE(PG8_SA(1, 0), a3, voffA);
            PG8_BAR; PG8_WAIT_L(0); PG8_MMA(1, 0, At, B0); PG8_BAR; PG8_SCHED;
            PG8_STAGE(PG8_SB(1, 1), b3 + hstep, voffB);
            PG8_WAIT_V(6); PG8_BAR; PG8_MMA(1, 1, At, B1); PG8_BAR;
            }
        }
        if constexpr (ALIGN_EPI) { if (wr == 0) PG8_BAR; }
        if constexpr (!Epi::AFTER_DRAIN) { E(acc, cur, wr, wc, fr, fq); S.done(cur); }
        if (!has_next) break;
#pragma unroll
        for (int a = 0; a < 2; ++a)
#pragma unroll
            for (int b = 0; b < 2; ++b)
#pragma unroll
                for (int m = 0; m < 4; ++m)
#pragma unroll
                    for (int n = 0; n < 2; ++n) acc[a][b][m][n] = (f32x4){0.f, 0.f, 0.f, 0.f};
        cur = nxt; cA = nA; cB = nB; ++ui;
        if constexpr (ALIGN_EPI) { if (wr == 1) PG8_BAR; }
    }
    PG8_WAIT_V(0);
    if constexpr (!ALIGN_EPI) { if (wr == 0) PG8_BAR; }
    PG8_BAR;
    if constexpr (Epi::AFTER_DRAIN) { E.fused(acc, cur, wr, wc, fr, fq, lds, wid, lane); S.done(cur); }
#undef PG8_SA
#undef PG8_SB
#undef PG8_STAGE
#undef PG8_LDA
#undef PG8_LDB
#undef PG8_MMA
#undef PG8_WAIT_V
#undef PG8_WAIT_L
#undef PG8_BAR
#undef PG8_SCHED
}
}

constexpr int NWAVES = 8;
#define GAS __attribute__((address_space(1)))
#define LAS __attribute__((address_space(3)))
typedef unsigned short bf16;
typedef unsigned v4u __attribute__((ext_vector_type(4)));
typedef unsigned v2u __attribute__((ext_vector_type(2)));
typedef float f32x4 __attribute__((ext_vector_type(4)));
typedef float f32x2 __attribute__((ext_vector_type(2)));
typedef short bf16x8 __attribute__((ext_vector_type(8)));
typedef GAS unsigned gu32;
#define RLX_AGENT __ATOMIC_RELAXED, __HIP_MEMORY_SCOPE_AGENT
#define LDS_WAIT() asm volatile("s_waitcnt lgkmcnt(0)" ::: "memory")
#define VM_WAIT() asm volatile("s_waitcnt vmcnt(0)" ::: "memory")
__device__ __forceinline__ unsigned f2bf(float f) { unsigned u = __builtin_bit_cast(unsigned, f); return (u + 0x7fffu + ((u >> 16) & 1u)) >> 16; }
__device__ __forceinline__ unsigned pk2(float lo, float hi) { return f2bf(lo) | (f2bf(hi) << 16); }
__device__ __forceinline__ float bf2f(unsigned short h) { return __uint_as_float((unsigned)h << 16); }
__device__ __forceinline__ float bflo(unsigned w) { return __uint_as_float(w << 16); }
__device__ __forceinline__ float bfhi(unsigned w) { return __uint_as_float(w & 0xffff0000u); }
__device__ __forceinline__ float sigm(float x) { return 1.0f / (1.0f + __expf(-x)); }
__device__ __forceinline__ float siluf(float x) { return x / (1.0f + __expf(-x)); }
__device__ __forceinline__ float softplusf(float x) { return fmaxf(x, 0.f) + log1pf(__expf(-fabsf(x))); }
__device__ __forceinline__ float wave_sum(float v) {
#pragma unroll
    for (int o = 1; o < 64; o <<= 1) v += __shfl_xor(v, o);
    return v;
}

constexpr size_t MiB = 1u << 20;
constexpr size_t WS_CTL = 0, CTL_ZERO_BYTES = 64 * 1024;
constexpr size_t WS_MOD = 1 * MiB;
constexpr size_t WS_SKEY = 1 * MiB + 256 * 1024;
constexpr size_t WS_WIN = 2 * MiB;
constexpr size_t WS_WSB = 14 * MiB, WS_WGDN = 15 * MiB, WS_WO = 16 * MiB, WS_WQ = 18 * MiB;
constexpr size_t WS_AB = 22 * MiB;
constexpr size_t WS_GB = 23 * MiB;
constexpr size_t WS_XN = 24 * MiB;
constexpr size_t WS_Q = 56 * MiB, WS_K = 72 * MiB, WS_V = 88 * MiB;
constexpr size_t WS_GRAW = 104 * MiB;
constexpr size_t WS_Z = 152 * MiB;
constexpr size_t WS_YSB = 24 * MiB, WS_YGDN = 40 * MiB;
constexpr size_t WS_MERGED = 56 * MiB;
constexpr size_t WS_CH = 168 * MiB;
constexpr size_t WS_CD = 248 * MiB;
constexpr size_t WS_QP = 168 * MiB;
constexpr size_t WS_EIDX = 232 * MiB, WS_GATE = 240 * MiB;
constexpr size_t WS_UT8 = 104 * MiB, WS_VT8 = 120 * MiB;
constexpr size_t WS_ACT = 136 * MiB;
constexpr size_t WS_H28 = 88 * MiB;
constexpr size_t WS_END = 256 * MiB;
constexpr int CW_BAR = 4096;

constexpr int RING_OFF = 0, RING_BYTES = 162816;
constexpr int LDSCTL_OFF = RING_BYTES, MISC_OFF = LDSCTL_OFF + 320;
constexpr int LDS_BYTES = 163840;
#define XB_TMO      128
#define XB_XCNT(j)  (256  + 64 * (j))
#define XB_XSUB(j)  (1280 + 64 * (j))
#define XB_XGEN(j)  (2304 + 64 * (j))
#define XB_TOP      3328
#define XB_TOPGEN   3392
#define XCD_BAR_WORDS 3456
#define XB_SPIN_CAP (1u << 18)

__device__ __forceinline__ unsigned xb_ld(unsigned* p)              { return __hip_atomic_load(p, __ATOMIC_RELAXED, __HIP_MEMORY_SCOPE_AGENT); }
__device__ __forceinline__ unsigned xb_add(unsigned* p, unsigned v) { return __hip_atomic_fetch_add(p, v, __ATOMIC_RELAXED, __HIP_MEMORY_SCOPE_AGENT); }
__device__ __forceinline__ unsigned xb_xcc_id() { return (unsigned)__builtin_amdgcn_s_getreg((3 << 11) | 20) & 0xFu; }
#define XB_SPIN(cond, bar) do { unsigned _sp = 0; while (cond) { __builtin_amdgcn_s_sleep(1); \
    if ((++_sp & 255u) == 0u) { if (xb_ld(&(bar)[XB_TMO])) break; if (_sp > XB_SPIN_CAP) { atomicAdd(&(bar)[XB_TMO], 1u); break; } } } } while (0)

struct XcdBarrier {
    unsigned* bar; unsigned x;
    volatile LAS unsigned* st;
};

__device__ __forceinline__ XcdBarrier xcd_barrier_post(unsigned* bar, volatile LAS unsigned* st) {
    XcdBarrier b; b.bar = bar; b.x = xb_xcc_id(); b.st = st;
    if (threadIdx.x == 0) (void)xb_add(&bar[XB_XCNT(b.x)], 1u);
    return b;
}
__device__ __forceinline__ void xcd_barrier_complete(unsigned* bar, unsigned x, unsigned& nloc, unsigned& nx) {
    const unsigned G = gridDim.x * gridDim.y * gridDim.z;
    unsigned sum, cnt, mine, sp = 0u;
    for (;;) {
        sum = 0u; cnt = 0u; mine = 0u;
#pragma unroll
        for (unsigned j = 0; j < 16; ++j) { const unsigned c = xb_ld(&bar[XB_XCNT(j)]); sum += c; cnt += (c > 0u) ? 1u : 0u; mine = (j == x) ? c : mine; }
        if (sum == G) break;
        __builtin_amdgcn_s_sleep(1);
        if ((++sp & 255u) == 0u) { if (xb_ld(&bar[XB_TMO])) break; if (sp > XB_SPIN_CAP) { atomicAdd(&bar[XB_TMO], 1u); break; } }
    }
    nloc = mine > 0u ? mine : 1u; nx = cnt > 0u ? cnt : 1u;
}

__device__ __forceinline__ void xcd_barrier(const XcdBarrier& b) {
    asm volatile("s_waitcnt vmcnt(0)" ::: "memory");
    __syncthreads();
    if (threadIdx.x == 0) {
        unsigned* bar = b.bar;
        __builtin_amdgcn_s_waitcnt(0);
        unsigned nloc = b.st[0], nx = b.st[1];
        if (nloc == 0u) { xcd_barrier_complete(bar, b.x, nloc, nx); b.st[0] = nloc; b.st[1] = nx; }
        const unsigned old = xb_add(&bar[XB_XSUB(b.x)], 1u);
        const unsigned gen = old / nloc;
        if (old + 1u == (gen + 1u) * nloc) {
            __builtin_amdgcn_fence(__ATOMIC_RELEASE, "agent");
            asm volatile("s_waitcnt vmcnt(0)" ::: "memory");
            const unsigned og = xb_add(&bar[XB_TOP], 1u);
            const unsigned tg = og / nx;
            if (og + 1u == (tg + 1u) * nx) xb_add(&bar[XB_TOPGEN], 1u);
            else XB_SPIN(xb_ld(&bar[XB_TOPGEN]) == tg, bar);
            __builtin_amdgcn_fence(__ATOMIC_ACQUIRE, "agent");
            xb_add(&bar[XB_XGEN(b.x)], 1u);
            asm volatile("s_waitcnt vmcnt(0)" ::: "memory");
        } else {
            XB_SPIN(xb_ld(&bar[XB_XGEN(b.x)]) == gen, bar);
            __builtin_amdgcn_fence(__ATOMIC_ACQUIRE, "agent");
            asm volatile("s_waitcnt vmcnt(0)" ::: "memory");
        }
    }
    __syncthreads();
}

struct Args { const float* in[20]; float* out; unsigned char* ws; int ph_lo, ph_hi, li, pad; };

struct Frame {
    LAS unsigned char* lds;
    volatile LAS unsigned* MISC;
    gu32* ctl;
    int tid, lane, wave, G;
};

__device__ __forceinline__ int inproj_src_col(int n) { if (n < 3072) return n; if (n < 5632) return n + 16; if (n < 5648) return n - 5632 + 3072; return -1; }
template <bool MAP>
__device__ __forceinline__ void p0_transpose_item(const float* W, int K, int Nsrc, int Ndst, bf16* WT, LAS float* scr, int item, int lane) {
    const int nblk = Ndst / 32, kb = item / nblk, nb = item % nblk, k0 = 64 * kb, n0 = 32 * nb;
    const int nsrc = MAP ? inproj_src_col(n0 + (lane & 31)) : n0 + (lane & 31);
    float wv[32];
#pragma unroll
    for (int i = 0; i < 32; ++i) { const int kk = 2 * i + (lane >> 5); wv[i] = nsrc >= 0 ? W[(size_t)(k0 + kk) * Nsrc + nsrc] : 0.f; }
#pragma unroll
    for (int i = 0; i < 32; ++i) { const int kk = 2 * i + (lane >> 5); scr[kk * 33 + (lane & 31)] = wv[i]; }
    LDS_WAIT(); asm volatile("" ::: "memory");
    const int c = lane & 7;
#pragma unroll
    for (int j = 0; j < 4; ++j) { const int n = (lane >> 3) + 8 * j; const LAS float* s = scr + (8 * c) * 33 + n;
        v4u o; o.x = pk2(s[0 * 33], s[1 * 33]); o.y = pk2(s[2 * 33], s[3 * 33]); o.z = pk2(s[4 * 33], s[5 * 33]); o.w = pk2(s[6 * 33], s[7 * 33]);
        *(GAS v4u*)(WT + (size_t)(n0 + n) * K + k0 + 8 * c) = o; }
    LDS_WAIT(); asm volatile("" ::: "memory");
}
__device__ __forceinline__ void p0_prologue(Frame& F, const Args& a) {
    unsigned char* ws = a.ws;
    LAS float* scr = (LAS float*)(F.lds + RING_OFF + F.wave * 16384);
    const int gw = blockIdx.x * NWAVES + F.wave, NGW = F.G * NWAVES;
    constexpr int I_IN = (D / 64) * (INWP / 32), I_SB = (512 / 64) * (D / 32), I_O = (D / 64) * (D / 32), I_Q = (D / 64) * (PQW / 32);
    constexpr int NITEMS = I_IN + 2 * I_SB + I_O + I_Q;
    for (int it = gw; it < NITEMS; it += NGW) {
        int r = it;
        if (r < I_IN) { p0_transpose_item<true>(a.in[5], D, INW, INWP, (bf16*)(ws + WS_WIN), scr, r, F.lane); continue; } r -= I_IN;
        if (r < I_SB) { p0_transpose_item<false>(a.in[12], 512, D, D, (bf16*)(ws + WS_WSB), scr, r, F.lane); continue; } r -= I_SB;
        if (r < I_SB) { p0_transpose_item<false>(a.in[13], 512, D, D, (bf16*)(ws + WS_WGDN), scr, r, F.lane); continue; } r -= I_SB;
        if (r < I_O) { p0_transpose_item<false>(a.in[14], D, D, D, (bf16*)(ws + WS_WO), scr, r, F.lane); continue; } r -= I_O;
        p0_transpose_item<false>(a.in[16], D, PQW, PQW, (bf16*)(ws + WS_WQ), scr, r, F.lane);
    }
    { const float* sk = a.in[17]; bf16* o = (bf16*)(ws + WS_SKEY);
      for (int i = (blockIdx.x * 512 + F.tid) * 4; i < PH * 2 * PNK * PHALF; i += F.G * 512 * 4) { const f32x4 v = *(const f32x4*)(sk + i); v2u w; w.x = pk2(v.x, v.y); w.y = pk2(v.z, v.w); *(v2u*)(o + i) = w; } }
    { const float* c = a.in[1]; const float* wa = a.in[2]; const float* ba = a.in[3]; float* mod = (float*)(ws + WS_MOD);
      LAS float* red = (LAS float*)(F.lds + RING_OFF);
      for (int it = blockIdx.x; it < 6 * D / 64; it += F.G) {
          const int n = it * 64 + F.lane; float a0 = 0.f, a1 = 0.f;
          __syncthreads();
          for (int kb = 0; kb < 4; ++kb) { const int k0 = F.wave * 128 + kb * 32; float w[32];
#pragma unroll
              for (int i = 0; i < 32; ++i) w[i] = wa[(size_t)(k0 + i) * (6 * D) + n];
#pragma unroll
              for (int i = 0; i < 32; ++i) { a0 += siluf(c[k0 + i]) * w[i]; a1 += siluf(c[D + k0 + i]) * w[i]; } }
          red[(F.wave * 2 + 0) * 64 + F.lane] = a0; red[(F.wave * 2 + 1) * 64 + F.lane] = a1;
          __syncthreads();
          if (F.wave < 2) { float s = 0.f;
#pragma unroll
              for (int w = 0; w < 8; ++w) s += red[(w * 2 + F.wave) * 64 + F.lane];
              mod[(size_t)F.wave * 6 * D + n] = s + ba[n]; }
      }
      __syncthreads(); }
}
constexpr float PEER_HSCALE = 4.f;
__device__ __forceinline__ void norm_mod_rows(Frame& F, const float* x, const float* nw, const float* mod, int ch_shift, bf16* o, unsigned char* o8) {
    const int gw = blockIdx.x * NWAVES + F.wave, NGW = F.G * NWAVES;
    f32x4 nx[4];
    if (gw < M) { const GAS f32x4* xr = (const GAS f32x4*)(x + (size_t)gw * D) + F.lane;
#pragma unroll
        for (int j = 0; j < 4; ++j) nx[j] = xr[64 * j]; }
    for (int m = gw; m < M; m += NGW) {
        f32x4 v[4]; float s = 0.f;
#pragma unroll
        for (int j = 0; j < 4; ++j) { v[j] = nx[j]; s += (v[j].x * v[j].x + v[j].y * v[j].y) + (v[j].z * v[j].z + v[j].w * v[j].w); }
        if (m + NGW < M) { const GAS f32x4* xr = (const GAS f32x4*)(x + (size_t)(m + NGW) * D) + F.lane;
#pragma unroll
            for (int j = 0; j < 4; ++j) nx[j] = xr[64 * j]; }
        const float rstd = 1.0f / sqrtf(wave_sum(s) * (1.f / D) + EPS);
        const float* sh = mod + (size_t)(m >> 13) * 6 * D + ch_shift * D; const float* sc = sh + D;
        GAS v2u* ob16 = (GAS v2u*)(o + (size_t)m * D) + F.lane;
#pragma unroll
        for (int j = 0; j < 4; ++j) { const int c = 4 * F.lane + 256 * j; const f32x4 w = *(const f32x4*)(nw + c), a = *(const f32x4*)(sc + c), b = *(const f32x4*)(sh + c);
            const f32x4 y = v[j] * rstd * w * (a + 1.0f) + b; v2u p; p.x = pk2(y.x, y.y); p.y = pk2(y.z, y.w); ob16[64 * j] = p;
            if (o8) { int q8 = __builtin_amdgcn_cvt_pk_fp8_f32(y.x * PEER_HSCALE, y.y * PEER_HSCALE, 0, false); q8 = __builtin_amdgcn_cvt_pk_fp8_f32(y.z * PEER_HSCALE, y.w * PEER_HSCALE, q8, true); *(int*)(o8 + (size_t)m * D + c) = q8; } }
    }
}
constexpr float PEER_USCALE = 64.f, PEER_VSCALE = 8.f;
__device__ __forceinline__ v4u fp8_pack16(const f32x4& a0, const f32x4& a1, const f32x4& a2, const f32x4& a3) {
    int w0 = __builtin_amdgcn_cvt_pk_fp8_f32(a0.x, a0.y, 0, false); w0 = __builtin_amdgcn_cvt_pk_fp8_f32(a0.z, a0.w, w0, true);
    int w1 = __builtin_amdgcn_cvt_pk_fp8_f32(a1.x, a1.y, 0, false); w1 = __builtin_amdgcn_cvt_pk_fp8_f32(a1.z, a1.w, w1, true);
    int w2 = __builtin_amdgcn_cvt_pk_fp8_f32(a2.x, a2.y, 0, false); w2 = __builtin_amdgcn_cvt_pk_fp8_f32(a2.z, a2.w, w2, true);
    int w3 = __builtin_amdgcn_cvt_pk_fp8_f32(a3.x, a3.y, 0, false); w3 = __builtin_amdgcn_cvt_pk_fp8_f32(a3.z, a3.w, w3, true);
    return (v4u){(unsigned)w0, (unsigned)w1, (unsigned)w2, (unsigned)w3};
}
__device__ __forceinline__ void peer_tables_to_fp8(const Args& a, int blk, int nblk, int tid) {
    unsigned char* ws = a.ws; constexpr int NPC = PNE * D / 16;
    for (int which = 0; which < 2; ++which) { const float* src = a.in[18 + which]; v4u* dst = (v4u*)(ws + (which ? WS_VT8 : WS_UT8)); const float sc = which ? PEER_VSCALE : PEER_USCALE;
        for (int i0 = blk * 512 + tid; i0 < NPC; i0 += 4 * nblk * 512) {
            f32x4 v[4][4];
#pragma unroll
            for (int u = 0; u < 4; ++u) { const int i = i0 + u * nblk * 512; if (i < NPC) { const f32x4* p = (const f32x4*)src + (size_t)i * 4; v[u][0] = p[0]; v[u][1] = p[1]; v[u][2] = p[2]; v[u][3] = p[3]; } }
#pragma unroll
            for (int u = 0; u < 4; ++u) { const int i = i0 + u * nblk * 512; if (i < NPC) {
                const int e = i >> 6, c16 = i & 63; const size_t di = which ? ((size_t)(c16 >> 3) * PNE * 8 + (size_t)e * 8 + (c16 & 7)) : (size_t)i;
                dst[di] = fp8_pack16(v[u][0] * sc, v[u][1] * sc, v[u][2] * sc, v[u][3] * sc); } } } }
}
__device__ __forceinline__ float gelu_erf(float v) { return 0.5f * v * (1.0f + erff(v * 0.70710678118654752f)); }
__device__ __forceinline__ void gstore1_asm(float* p, float v) { asm volatile("global_store_dword %0, %1, off" :: "v"(p), "v"(v) : "memory"); }
__device__ __forceinline__ void gstore2_asm(float* p, f32x2 v) { asm volatile("global_store_dwordx2 %0, %1, off" :: "v"(p), "v"(v) : "memory"); }
__device__ __forceinline__ void fp8x16_to_f32(const v4u& w, f32x2 (&o)[8]) {
    o[0] = __builtin_amdgcn_cvt_pk_f32_fp8((int)w.x, false); o[1] = __builtin_amdgcn_cvt_pk_f32_fp8((int)w.x, true);
    o[2] = __builtin_amdgcn_cvt_pk_f32_fp8((int)w.y, false); o[3] = __builtin_amdgcn_cvt_pk_f32_fp8((int)w.y, true);
    o[4] = __builtin_amdgcn_cvt_pk_f32_fp8((int)w.z, false); o[5] = __builtin_amdgcn_cvt_pk_f32_fp8((int)w.z, true);
    o[6] = __builtin_amdgcn_cvt_pk_f32_fp8((int)w.w, false); o[7] = __builtin_amdgcn_cvt_pk_f32_fp8((int)w.w, true);
}
__device__ __forceinline__ float gelu_fast(float v) { typedef float f2 __attribute__((ext_vector_type(2))); const f2 r = pg8::gelu_pk((f2){v, v}); return r.x; }
__device__ __forceinline__ f32x4 peer_u_tile(const v4u (&A)[16], const LAS unsigned char* hb, int g) {
    f32x4 acc[4] = {(f32x4){0.f, 0.f, 0.f, 0.f}, (f32x4){0.f, 0.f, 0.f, 0.f}, (f32x4){0.f, 0.f, 0.f, 0.f}, (f32x4){0.f, 0.f, 0.f, 0.f}};
#pragma unroll
    for (int s = 0; s < 16; ++s) { const v4u hv = *(const LAS v4u*)(hb + 64 * s + 16 * g);
        acc[(2 * s) & 3] = __builtin_amdgcn_mfma_f32_16x16x32_fp8_fp8((long)(((unsigned long long)A[s].y << 32) | A[s].x), (long)(((unsigned long long)hv.y << 32) | hv.x), acc[(2 * s) & 3], 0, 0, 0);
        acc[(2 * s + 1) & 3] = __builtin_amdgcn_mfma_f32_16x16x32_fp8_fp8((long)(((unsigned long long)A[s].w << 32) | A[s].z), (long)(((unsigned long long)hv.w << 32) | hv.z), acc[(2 * s + 1) & 3], 0, 0, 0); }
    return (acc[0] + acc[1]) + (acc[2] + acc[3]);
}
__device__ __forceinline__ void peer_u_rows(v4u (&A)[16], const unsigned char* ut, const LAS unsigned* lst, int k0, int n, int lane) {
    const int k = k0 + (lane >> 2); const unsigned ent = lst[k < n ? k : 0]; const unsigned char* row = ut + (size_t)(ent & 2047u) * D + 16 * (lane & 3);
    if (k < n) {
#pragma unroll
        for (int s = 0; s < 16; ++s) A[s] = *(const v4u*)(row + 64 * s); }
}
__device__ __forceinline__ void peer_u_perm(v4u (&A)[16], int r, int g) {
    const int idx = (4 * r + g) * 4;
#pragma unroll
    for (int s = 0; s < 16; ++s) { A[s].x = (unsigned)__builtin_amdgcn_ds_bpermute(idx, (int)A[s].x); A[s].y = (unsigned)__builtin_amdgcn_ds_bpermute(idx, (int)A[s].y); A[s].z = (unsigned)__builtin_amdgcn_ds_bpermute(idx, (int)A[s].z); A[s].w = (unsigned)__builtin_amdgcn_ds_bpermute(idx, (int)A[s].w); }
}
__device__ __forceinline__ void peer_u_out(const f32x4& acc, const LAS unsigned* lst, const LAS float* gl, float* coef_t, int k0, int n, int r, int g) {
    const float v = r == 0 ? acc.x : r == 1 ? acc.y : r == 2 ? acc.z : acc.w; const int k = k0 + 4 * g + r;
    if (r < 4 && k < n) { const int slot = (int)(lst[k] >> 11); gstore1_asm(coef_t + slot, gl[slot] * gelu_fast(v * (1.0f / (PEER_USCALE * PEER_HSCALE))) * (1.0f / PEER_VSCALE)); }
}
__device__ __forceinline__ f32x4 peer_u_tile_m(const v4u (&A)[16], const LAS unsigned char* lanebase) {
    f32x4 acc[4] = {(f32x4){0.f, 0.f, 0.f, 0.f}, (f32x4){0.f, 0.f, 0.f, 0.f}, (f32x4){0.f, 0.f, 0.f, 0.f}, (f32x4){0.f, 0.f, 0.f, 0.f}};
#pragma unroll
    for (int s = 0; s < 16; ++s) { const v4u hv = *(const LAS v4u*)(lanebase + 64 * s);
        acc[(2 * s) & 3] = __builtin_amdgcn_mfma_f32_16x16x32_fp8_fp8((long)(((unsigned long long)A[s].y << 32) | A[s].x), (long)(((unsigned long long)hv.y << 32) | hv.x), acc[(2 * s) & 3], 0, 0, 0);
        acc[(2 * s + 1) & 3] = __builtin_amdgcn_mfma_f32_16x16x32_fp8_fp8((long)(((unsigned long long)A[s].w << 32) | A[s].z), (long)(((unsigned long long)hv.w << 32) | hv.z), acc[(2 * s + 1) & 3], 0, 0, 0); }
    return (acc[0] + acc[1]) + (acc[2] + acc[3]);
}
__device__ __forceinline__ void peer_u_out_m(const f32x4& acc, const LAS unsigned* lst, const LAS float* gl, float* coef_t, int k0, int n, int lane) {
    const int j = lane & 15, Gq = lane >> 4, pc = j >> 2;
    float v = pc == 0 ? acc.x : pc == 1 ? acc.y : pc == 2 ? acc.z : acc.w;
    v += __int_as_float(__builtin_amdgcn_mov_dpp(__float_as_int(v), 0x128, 0xF, 0xF, true));
    v += __int_as_float(__builtin_amdgcn_mov_dpp(__float_as_int(v), 0x124, 0xF, 0xF, true));
    const int k = k0 + 4 * j + Gq;
    if (j < 4 && k < n) { const int slot = (int)(lst[k] >> 11); gstore1_asm(coef_t + slot, gl[slot] * gelu_fast(v * (1.0f / (PEER_USCALE * PEER_HSCALE))) * (1.0f / PEER_VSCALE)); }
}
__device__ __forceinline__ void glds16_asm(const void* gsrc, unsigned lds_dst) { unsigned keep;
    asm volatile("s_mov_b32 %0, m0\n\ts_mov_b32 m0, %2\n\ts_nop 0\n\tglobal_load_lds_dwordx4 %1, off\n\ts_mov_b32 m0, %0" : "=&s"(keep) : "v"(gsrc), "s"(lds_dst) : "memory"); }
#define PU_LD(d, p, off) asm volatile("global_load_dwordx4 %0, %1, off offset:" #off : "+v"(d) : "v"(p) : "memory")
__device__ __forceinline__ void peer_u_rows_asm(v4u (&A)[16], const unsigned char* ut, const LAS unsigned* lst, int k0, int n, int lane) {
    const int k = k0 + (lane >> 2); const unsigned ent = lst[k < n ? k : 0]; const unsigned char* row = ut + (size_t)(ent & 2047u) * D + 16 * (lane & 3);
    if (k < n) {
        PU_LD(A[0], row, 0); PU_LD(A[1], row, 64); PU_LD(A[2], row, 128); PU_LD(A[3], row, 192); PU_LD(A[4], row, 256); PU_LD(A[5], row, 320); PU_LD(A[6], row, 384); PU_LD(A[7], row, 448);
        PU_LD(A[8], row, 512); PU_LD(A[9], row, 576); PU_LD(A[10], row, 640); PU_LD(A[11], row, 704); PU_LD(A[12], row, 768); PU_LD(A[13], row, 832); PU_LD(A[14], row, 896); PU_LD(A[15], row, 960); }
}
#define PU_WAIT(n, A) asm volatile("s_waitcnt vmcnt(" #n ")" : "+v"(A[0]), "+v"(A[1]), "+v"(A[2]), "+v"(A[3]), "+v"(A[4]), "+v"(A[5]), "+v"(A[6]), "+v"(A[7]), "+v"(A[8]), "+v"(A[9]), "+v"(A[10]), "+v"(A[11]), "+v"(A[12]), "+v"(A[13]), "+v"(A[14]), "+v"(A[15]) :: "memory")
__device__ __forceinline__ void p10a_peer_u(Frame& F, const Args& a) {
    unsigned char* ws = a.ws; const int lane = F.lane, r = lane & 15, g = lane >> 4;
    const unsigned char* h8 = ws + WS_H28; const int* eidx = (const int*)(ws + WS_EIDX); const float* gate = (const float*)(ws + WS_GATE); float* coef = (float*)(ws + WS_ACT);
    const int x = blockIdx.x & 7; const unsigned char* ut = ws + WS_UT8 + (size_t)x * 2048 * D;
    LAS unsigned char* wb = F.lds + RING_OFF + F.wave * 17408;
    const unsigned wb_addr = (unsigned)(unsigned long)wb;
    const int wg = (blockIdx.x >> 3) * NWAVES + F.wave, nwg = (F.G >> 3) * NWAVES;
    const int nit = (M - wg + nwg - 1) / nwg;
    const unsigned long long below = (1ull << lane) - 1ull;
    LAS unsigned char* zreg = F.lds + RING_OFF + NWAVES * 17408;
    __syncthreads();
    if (F.tid < 64) *(LAS v4u*)(zreg + 16 * F.tid) = (v4u){0u, 0u, 0u, 0u};
    __syncthreads();
    const bool bsel = (lane >> 4) == (lane & 3); const int boff = 16 * ((lane & 15) >> 2);
#define PU_SLOT(j) (wb + ((j) & 7) * 2048)
#define PU_LST(b) ((LAS unsigned*)(wb + 16384 + (b) * 512))
#define PU_DMA(j) do { const int jj_ = (j) < nit ? (j) : nit - 1; const size_t t_ = (size_t)wg + (size_t)jj_ * nwg; const unsigned sl_ = wb_addr + (unsigned)(((j) & 7) * 2048); \
        glds16_asm(h8 + t_ * D + 16 * lane, sl_); \
        glds16_asm(lane < 32 ? (const void*)((const unsigned char*)(eidx + t_ * 128) + 16 * lane) : (const void*)((const unsigned char*)(gate + t_ * 128) + 16 * (lane - 32)), sl_ + 1024u); } while (0)
#define PU_STAGE(j, b, nout) do { const LAS int* es_ = (const LAS int*)(PU_SLOT(j) + 1024); const int e0_ = es_[lane], e1_ = es_[64 + lane]; \
        const bool m0_ = (e0_ >> 11) == x, m1_ = (e1_ >> 11) == x; const unsigned long long b0_ = __ballot(m0_), b1_ = __ballot(m1_); const int n0_ = __popcll(b0_); \
        if (m0_) PU_LST(b)[__popcll(b0_ & below)] = ((unsigned)lane << 11) | (unsigned)(e0_ & 2047); \
        if (m1_) PU_LST(b)[n0_ + __popcll(b1_ & below)] = ((unsigned)(64 + lane) << 11) | (unsigned)(e1_ & 2047); \
        nout = n0_ + __popcll(b1_); LDS_WAIT(); asm volatile("" ::: "memory"); } while (0)
    int ip = 0;
    const float* dmy = (const float*)(ws + WS_MOD) + lane; unsigned dmyr = 0;
    PU_DMA(0); PU_DMA(1); PU_DMA(2);
    asm volatile("s_waitcnt vmcnt(0)" ::: "memory");
    int c_j = 0, c_b = 0, c_n = 0, c_k0 = 0; bool c_ok = false;
    while (ip < nit && !c_ok) { int nn; PU_STAGE(ip, 0, nn); c_j = ip; ++ip; if (nn > 0) { c_ok = true; c_n = nn; } else { PU_DMA(c_j + 3); asm volatile("s_waitcnt vmcnt(0)" ::: "memory"); } }
    v4u SA[16], SB[16];
#pragma unroll
    for (int i = 0; i < 16; ++i) { SA[i] = (v4u){0u, 0u, 0u, 0u}; SB[i] = SA[i]; }
    if (c_ok) { peer_u_rows_asm(SA, ut, PU_LST(0), 0, c_n, lane); PU_DMA(c_j + 3); PU_DMA(c_j + 3); }
#define PU_STEP(CUR, NXT) do { \
        int n_j = c_j, n_b = c_b, n_n = c_n, n_k0 = c_k0 + 16; bool n_ok = n_k0 < c_n; bool staged = false; \
        while (!n_ok && ip < nit) { int nn_; if (staged) { PU_DMA(n_j + 3); asm volatile("s_waitcnt vmcnt(0)" ::: "memory"); } \
            PU_STAGE(ip, c_b ^ 1, nn_); n_j = ip; ++ip; staged = true; if (nn_ > 0) { n_ok = true; n_b = c_b ^ 1; n_n = nn_; n_k0 = 0; } } \
        if (n_ok) peer_u_rows_asm(NXT, ut, PU_LST(n_b), n_k0, n_n, lane); \
        if (staged) PU_DMA(n_j + 3); else PU_DMA(ip + 2);       \
        if (n_ok) PU_WAIT(20, CUR); else PU_WAIT(0, CUR); \
        { const LAS unsigned char* sl_ = PU_SLOT(c_j); const f32x4 acc_ = peer_u_tile_m(CUR, bsel ? sl_ + boff : zreg); \
          peer_u_out_m(acc_, PU_LST(c_b), (const LAS float*)(sl_ + 1536), coef + ((size_t)wg + (size_t)c_j * nwg) * 128, c_k0, c_n, lane); } \
        LDS_WAIT(); asm volatile("" ::: "memory"); \
        c_j = n_j; c_b = n_b; c_n = n_n; c_k0 = n_k0; c_ok = n_ok; } while (0)
    while (c_ok) { PU_STEP(SA, SB); if (!c_ok) break; PU_STEP(SB, SA); }
    asm volatile("s_waitcnt vmcnt(0)" : "+v"(dmyr) :: "memory");
#undef PU_STEP
#undef PU_STAGE
#undef PU_DMA
#undef PU_SLOT
#undef PU_LST
}
struct PeerMeta { float a0, a1; int e0, e1; };
#define PV_LD4(d, p) asm volatile("global_load_dword %0, %1, off" : "=v"(d) : "v"(p) : "memory")
__device__ __forceinline__ void peer_meta_load(PeerMeta& m, const float* act, const int* eidx, int t, int lane) { const size_t o = (size_t)t * 128 + lane;
    PV_LD4(m.a0, act + o); PV_LD4(m.a1, act + o + 64); PV_LD4(m.e0, eidx + o); PV_LD4(m.e1, eidx + o + 64); }
#define PV_WAIT_META(n, m) asm volatile("s_waitcnt vmcnt(" #n ")" : "+v"(m.a0), "+v"(m.a1), "+v"(m.e0), "+v"(m.e1) :: "memory")
__device__ __forceinline__ void peer_meta_stage(const PeerMeta& m, LAS float* coefs, LAS int* eids, int lane) {
    coefs[lane] = m.a0; coefs[64 + lane] = m.a1;
    eids[lane] = m.e0 << 7; eids[64 + lane] = m.e1 << 7; }
__device__ __forceinline__ void peer_vrows_issue(v4u (&rw)[16], f32x2& x1, const unsigned char* vts, unsigned lo16, const LAS int* eoff, int grp, const float* xp) {
    asm volatile("global_load_dwordx2 %0, %1, off" : "=v"(x1) : "v"(xp) : "memory");
#pragma unroll
    for (int i = 0; i < 16; ++i) { const unsigned vo = (unsigned)eoff[8 * i + grp] + lo16;
        asm volatile("global_load_dwordx4 %0, %1, %2" : "=v"(rw[i]) : "v"(vo), "s"(vts) : "memory"); }
}
#define PV_WAIT_ROWS(n, R, X) asm volatile("s_waitcnt vmcnt(" #n ")" : "+v"(R[0]), "+v"(R[1]), "+v"(R[2]), "+v"(R[3]), "+v"(R[4]), "+v"(R[5]), "+v"(R[6]), "+v"(R[7]), "+v"(R[8]), "+v"(R[9]), "+v"(R[10]), "+v"(R[11]), "+v"(R[12]), "+v"(R[13]), "+v"(R[14]), "+v"(R[15]), "+v"(X) :: "memory")
__device__ __forceinline__ void peer_vcompute(const v4u (&rw)[16], const f32x2& x1, const LAS float* coefs, const f32x2& g2, int grp, int lane, float* op) {
    f32x2 acc[8];
#pragma unroll
    for (int j = 0; j < 8; ++j) acc[j] = (f32x2){0.f, 0.f};
#pragma unroll
    for (int i = 0; i < 16; ++i) { f32x2 v[8]; fp8x16_to_f32(rw[i], v); const float cf = coefs[8 * i + grp];
#pragma unroll
        for (int j = 0; j < 8; ++j) acc[j] += v[j] * cf; }
    const bool b5 = lane & 32, b4 = lane & 16, b3 = lane & 8;
    f32x2 q[4];
#pragma unroll
    for (int j = 0; j < 4; ++j) { const f32x2 mine = b5 ? acc[4 + j] : acc[j], give = b5 ? acc[j] : acc[4 + j]; q[j].x = mine.x + __shfl_xor(give.x, 32); q[j].y = mine.y + __shfl_xor(give.y, 32); }
    f32x2 r2[2];
#pragma unroll
    for (int j = 0; j < 2; ++j) { const f32x2 mine = b4 ? q[2 + j] : q[j], give = b4 ? q[j] : q[2 + j]; r2[j].x = mine.x + __shfl_xor(give.x, 16); r2[j].y = mine.y + __shfl_xor(give.y, 16); }
    f32x2 s1; { const f32x2 mine = b3 ? r2[1] : r2[0], give = b3 ? r2[0] : r2[1]; s1.x = mine.x + __shfl_xor(give.x, 8); s1.y = mine.y + __shfl_xor(give.y, 8); }
    gstore2_asm(op, x1 + g2 * s1);
}
__device__ __forceinline__ void p10b_peer_v(Frame& F, const Args& a, float* outw) {
    unsigned char* ws = a.ws; const int lane = F.lane;
    const int* eidx = (const int*)(ws + WS_EIDX); const float* act = (const float*)(ws + WS_ACT);
    const float* mod = (const float*)(ws + WS_MOD); const float* out = a.out;
    const int x = blockIdx.x & 7; const unsigned char* vts = ws + WS_VT8 + (size_t)x * PNE * 128; const unsigned lo16 = 16u * (unsigned)(lane & 7);
    LAS float* coefs = (LAS float*)(F.lds + RING_OFF + F.wave * 2048); LAS int* eids = (LAS int*)(coefs + 128);
    const int wg = (blockIdx.x >> 3) * NWAVES + F.wave, nwg = (F.G >> 3) * NWAVES, grp = lane >> 3;
    const int co = 128 * x + 16 * (lane & 7) + ((lane >> 5) & 1) * 8 + ((lane >> 4) & 1) * 4 + ((lane >> 3) & 1) * 2;
    f32x2 g2b0, g2b1;
    asm volatile("global_load_dwordx2 %0, %2, off\n\tglobal_load_dwordx2 %1, %3, off\n\ts_waitcnt vmcnt(0)" : "=&v"(g2b0), "=&v"(g2b1) : "v"(mod + 5 * D + co), "v"(mod + 6 * D + 5 * D + co) : "memory");
    const int nit = (M - wg + nwg - 1) / nwg;
#define TOK(i) (wg + ((i) < nit ? (i) : nit - 1) * nwg)
    PeerMeta mA, mB; v4u rA[16], rB[16]; f32x2 xA, xB;
    peer_meta_load(mA, act, eidx, TOK(0), lane); PV_WAIT_META(0, mA); peer_meta_stage(mA, coefs, eids, lane); LDS_WAIT(); asm volatile("" ::: "memory");
    peer_meta_load(mB, act, eidx, TOK(1), lane);
    peer_vrows_issue(rA, xA, vts, lo16, eids, grp, out + (size_t)TOK(0) * D + co);
    for (int i = 0; i < nit; i += 2) {
        PV_WAIT_META(17, mB); peer_meta_stage(mB, coefs + 256, eids + 256, lane); LDS_WAIT(); asm volatile("" ::: "memory");
        peer_meta_load(mA, act, eidx, TOK(i + 2), lane);
        peer_vrows_issue(rB, xB, vts, lo16, eids + 256, grp, out + (size_t)TOK(i + 1) * D + co);
        PV_WAIT_ROWS(21, rA, xA);
        peer_vcompute(rA, xA, coefs, (TOK(i) >> 13) ? g2b1 : g2b0, grp, lane, outw + (size_t)TOK(i) * D + co);
        LDS_WAIT(); asm volatile("" ::: "memory");
        PV_WAIT_META(17, mA); peer_meta_stage(mA, coefs, eids, lane); LDS_WAIT(); asm volatile("" ::: "memory");
        peer_meta_load(mB, act, eidx, TOK(i + 3), lane);
        peer_vrows_issue(rA, xA, vts, lo16, eids, grp, out + (size_t)TOK(i + 2) * D + co);
        PV_WAIT_ROWS(21, rB, xB);
        peer_vcompute(rB, xB, coefs + 256, (TOK(i + 1) >> 13) ? g2b1 : g2b0, grp, lane, outw + (size_t)TOK(i + 1) * D + co);
        LDS_WAIT(); asm volatile("" ::: "memory");
    }
    asm volatile("s_waitcnt vmcnt(0)" ::: "memory");
#undef TOK
}

__device__ __forceinline__ void p4_attn_naive(Frame& F, const Args& a, int blk, int nblk) {
    unsigned char* ws = a.ws;
    const bf16* Q = (const bf16*)(ws + WS_Q); const bf16* K = (const bf16*)(ws + WS_K); const bf16* V = (const bf16*)(ws + WS_V);
    for (int gid = blk * 512 + F.tid; gid < BATCH * SBH * SEQ; gid += nblk * 512) {
        const int t = gid & (SEQ - 1), bh = gid >> 13, h = bh & 7, b = bh >> 3;
        const size_t row = (size_t)b * SEQ + t;
        float q[64], o[64];
#pragma unroll
        for (int i = 0; i < 8; ++i) { const v4u w = *(const v4u*)(Q + row * 512 + h * 64 + 8 * i);
            q[8 * i] = bflo(w.x); q[8 * i + 1] = bfhi(w.x); q[8 * i + 2] = bflo(w.y); q[8 * i + 3] = bfhi(w.y); q[8 * i + 4] = bflo(w.z); q[8 * i + 5] = bfhi(w.z); q[8 * i + 6] = bflo(w.w); q[8 * i + 7] = bfhi(w.w); }
#pragma unroll
        for (int i = 0; i < 64; ++i) o[i] = 0.f;
        float R = 0.f;
        for (int s = t - 1; s >= 0; --s) {
            const size_t kr = ((size_t)b * SEQ + s) * 512 + h * 64; float z = 0.f;
#pragma unroll
            for (int i = 0; i < 8; ++i) { const v4u w = *(const v4u*)(K + kr + 8 * i);
                z += q[8 * i] * bflo(w.x) + q[8 * i + 1] * bfhi(w.x) + q[8 * i + 2] * bflo(w.y) + q[8 * i + 3] * bfhi(w.y) + q[8 * i + 4] * bflo(w.z) + q[8 * i + 5] * bfhi(w.z) + q[8 * i + 6] * bflo(w.w) + q[8 * i + 7] * bfhi(w.w); }
            const float sp = softplusf(z); const float p = __expf(z - sp - R); R += sp;
#pragma unroll
            for (int i = 0; i < 8; ++i) { const v4u w = *(const v4u*)(V + kr + 8 * i);
                o[8 * i] += p * bflo(w.x); o[8 * i + 1] += p * bfhi(w.x); o[8 * i + 2] += p * bflo(w.y); o[8 * i + 3] += p * bfhi(w.y); o[8 * i + 4] += p * bflo(w.z); o[8 * i + 5] += p * bfhi(w.z); o[8 * i + 6] += p * bflo(w.w); o[8 * i + 7] += p * bfhi(w.w); }
            if (R > 105.f) break;
        }
        bf16* y = (bf16*)(ws + WS_YSB) + row * 512 + h * 64;
#pragma unroll
        for (int i = 0; i < 8; ++i) { v4u w; w.x = pk2(o[8 * i], o[8 * i + 1]); w.y = pk2(o[8 * i + 2], o[8 * i + 3]); w.z = pk2(o[8 * i + 4], o[8 * i + 5]); w.w = pk2(o[8 * i + 6], o[8 * i + 7]); *(v4u*)(y + 8 * i) = w; }
    }
}
__device__ __forceinline__ void p9_topk_naive(Frame& F, const Args& a) {
    unsigned char* ws = a.ws; const int tid = F.tid;
    const bf16* QP = (const bf16*)(ws + WS_QP); const bf16* SK = (const bf16*)(ws + WS_SKEY);
    LAS float* sv = (LAS float*)(F.lds + RING_OFF);
    LAS int* si = (LAS int*)(sv + 2 * 16 * 256);
    LAS int* ptr = si + 2 * 16 * 256;
    LAS unsigned short* keys = (LAS unsigned short*)(ptr + 16 * 256);
    const bool act = tid < 256;
    for (int it = blockIdx.x; it < (M / 256) * PH; it += F.G) {
        const int h = it & 7, t = (it >> 3) * 256 + (tid & 255);
        for (int p = 0; p < 2; ++p) {
            __syncthreads();
            for (int i = tid; i < 128 * 128 / 8; i += 512) ((LAS v4u*)keys)[i] = ((const v4u*)(SK + (size_t)(h * 2 + p) * 128 * 128))[i];
            __syncthreads();
            if (act) {
                unsigned qreg[64];
#pragma unroll
                for (int i = 0; i < 16; ++i) { const v4u w = *(const v4u*)(QP + (size_t)t * PQW + h * 256 + p * 128 + 8 * i); qreg[4 * i] = w.x; qreg[4 * i + 1] = w.y; qreg[4 * i + 2] = w.z; qreg[4 * i + 3] = w.w; }
                int cnt = 0;
                for (int key = 0; key < 128; ++key) {
                    float s = 0.f;
#pragma unroll
                    for (int i = 0; i < 16; ++i) { const v4u w = *(const LAS v4u*)(keys + key * 128 + 8 * i);
                        s += bflo(qreg[4 * i]) * bflo(w.x) + bfhi(qreg[4 * i]) * bfhi(w.x) + bflo(qreg[4 * i + 1]) * bflo(w.y) + bfhi(qreg[4 * i + 1]) * bfhi(w.y)
                           + bflo(qreg[4 * i + 2]) * bflo(w.z) + bfhi(qreg[4 * i + 2]) * bfhi(w.z) + bflo(qreg[4 * i + 3]) * bflo(w.w) + bfhi(qreg[4 * i + 3]) * bfhi(w.w); }
                    int pos = cnt < 16 ? cnt : 16;
                    while (pos > 0 && s > sv[(p * 16 + pos - 1) * 256 + tid]) { if (pos < 16) { sv[(p * 16 + pos) * 256 + tid] = sv[(p * 16 + pos - 1) * 256 + tid]; si[(p * 16 + pos) * 256 + tid] = si[(p * 16 + pos - 1) * 256 + tid]; } --pos; }
                    if (pos < 16) { sv[(p * 16 + pos) * 256 + tid] = s; si[(p * 16 + pos) * 256 + tid] = key; }
                    if (cnt < 16) ++cnt;
                }
            }
        }
        if (act) {
            for (int i = 0; i < 16; ++i) ptr[i * 256 + tid] = 0;
            float top[16]; int eid[16];
#pragma unroll
            for (int rnk = 0; rnk < 16; ++rnk) {
                float best = -INFINITY; int bi = 0;
                for (int i = 0; i < 16; ++i) { const int jj = ptr[i * 256 + tid]; if (jj < 16) { const float c = sv[i * 256 + tid] + sv[(16 + jj) * 256 + tid]; if (c > best) { best = c; bi = i; } } }
                const int bj = ptr[bi * 256 + tid]; ptr[bi * 256 + tid] = bj + 1;
                top[rnk] = best; eid[rnk] = si[bi * 256 + tid] * 128 + si[(16 + bj) * 256 + tid];
            }
            float mx = top[0], den = 0.f;
#pragma unroll
            for (int rnk = 0; rnk < 16; ++rnk) { top[rnk] = __expf(top[rnk] - mx); den += top[rnk]; }
            int* eo = (int*)(ws + WS_EIDX) + (size_t)t * 128 + h * 16; float* go = (float*)(ws + WS_GATE) + (size_t)t * 128 + h * 16;
#pragma unroll
            for (int rnk = 0; rnk < 16; ++rnk) { eo[rnk] = eid[rnk]; go[rnk] = top[rnk] / den; }
        }
    }
    __syncthreads();
}

constexpr int CH_BYTES = 40960, CH_W = 0, CH_QD = 8192, CH_QK = 16384, CH_KDT = 24576, CH_U = 32768;
constexpr int PST = 68;
typedef __attribute__((address_space(3))) float lf32;

__device__ __forceinline__ void store_afrag(const lf32* src, const lf32* rowscale, unsigned char* dst, int tid) {
    const int blk = tid >> 6, lane = tid & 63, mt = blk >> 1, ks = blk & 1, r = lane & 15, g = lane >> 4, row = 16 * mt + r, k0 = 32 * ks + 4 * g;
    f32x4 v0 = *(const LAS f32x4*)(src + row * PST + k0), v1 = *(const LAS f32x4*)(src + row * PST + k0 + 16);
    const float rs = rowscale ? rowscale[row] : 1.0f; v0 = v0 * rs; v1 = v1 * rs;
    v4u o; o.x = pk2(v0.x, v0.y); o.y = pk2(v0.z, v0.w); o.z = pk2(v1.x, v1.y); o.w = pk2(v1.z, v1.w);
    *(v4u*)(dst + tid * 16) = o;
}
__device__ __forceinline__ void store_afrag_T(const lf32* src, const lf32* kscale, unsigned char* dst, int tid) {
    const int blk = tid >> 6, lane = tid & 63, mt = blk >> 1, ks = blk & 1, r = lane & 15, g = lane >> 4, row = 16 * mt + r, k0 = 32 * ks + 4 * g;
    float v[8];
#pragma unroll
    for (int i = 0; i < 4; ++i) { v[i] = src[(k0 + i) * PST + row] * kscale[k0 + i]; v[4 + i] = src[(k0 + 16 + i) * PST + row] * kscale[k0 + 16 + i]; }
    v4u o; o.x = pk2(v[0], v[1]); o.y = pk2(v[2], v[3]); o.z = pk2(v[4], v[5]); o.w = pk2(v[6], v[7]);
    *(v4u*)(dst + tid * 16) = o;
}
__device__ __forceinline__ void store_cfrag(const lf32* src, unsigned char* dst, int tid) {
#pragma unroll
    for (int rep = 0; rep < 2; ++rep) { const int q = tid + 512 * rep, sm = q >> 6, lane = q & 63, sl = sm >> 2, mt = sm & 3, col = lane & 15, g = lane >> 4;
        const lf32* p = src + (16 * mt + 4 * g) * PST + 16 * sl + col;
        v2u o; o.x = pk2(p[0], p[PST]); o.y = pk2(p[2 * PST], p[3 * PST]); *(v2u*)(dst + q * 8) = o; }
}

constexpr int BST = 72;
__device__ __forceinline__ float quad_sum(float v) {
    v += __int_as_float(__builtin_amdgcn_mov_dpp(__float_as_int(v), 0xB1, 0xF, 0xF, true));
    v += __int_as_float(__builtin_amdgcn_mov_dpp(__float_as_int(v), 0x4E, 0xF, 0xF, true));
    return v;
}
struct ConvIn { unsigned short x[3][11]; float w[3][4]; };
__device__ __forceinline__ void conv_load(ConvIn& ci, const bf16* graw, const float* cw, int it, int tid) {
    const int n = it & 127, bh = it >> 7, h = bh & 7, b = bh >> 3, c = tid & 63, tg = tid >> 6; const size_t row0 = (size_t)b * SEQ + n * 64; const int tl0 = n * 64;
#pragma unroll
    for (int part = 0; part < 3; ++part) { const bf16* src = graw + part * 512 + h * 64 + c;
#pragma unroll
        for (int i = 0; i < 11; ++i) { const int tt = tl0 + 8 * tg - 3 + i; ci.x[part][i] = tt >= 0 ? src[(row0 + 8 * tg - 3 + i) * 1536] : (unsigned short)0; }
#pragma unroll
        for (int j = 0; j < 4; ++j) ci.w[part][j] = cw[j * 1536 + part * 512 + h * 64 + c]; }
}
__device__ __forceinline__ void p3_gdn_prep(Frame& F, const Args& a) {
    unsigned char* ws = a.ws; const int tid = F.tid, wave = F.wave, lane = F.lane;
    const bf16* graw = (const bf16*)(ws + WS_GRAW); const float* ab = (const float*)(ws + WS_AB); const float* cw = a.in[8];
    lf32* Qs = (lf32*)(F.lds + RING_OFF); lf32* Ks = Qs + 64 * PST; lf32* Vs = Ks + 64 * PST; lf32* As = Vs + 64 * PST; lf32* QKs = As + 64 * PST; lf32* Us = QKs + 64 * PST; lf32* Ws = Us + 64 * PST;
    lf32* vG = Ws + 64 * PST; lf32* vbeta = vG + 64; lf32* veG = vbeta + 64; lf32* veGl = veG + 64; lf32* vqn = veGl + 64; lf32* vkn = vqn + 64; lf32* vbw = vkn + 64;
    LAS unsigned short* Qb = (LAS unsigned short*)(vbw + 64); LAS unsigned short* Kb = Qb + 64 * BST;
    constexpr int NCH = BATCH * GH * (SEQ / 64);
    ConvIn ci; float abv0 = 0.f, abv1 = 0.f;
    int it = blockIdx.x;
    if (it < NCH) { conv_load(ci, graw, cw, it, tid); if (wave == 2) { const size_t r = (size_t)((it >> 7) >> 3) * SEQ + (it & 127) * 64 + lane; abv0 = ab[r * 16 + ((it >> 7) & 7)]; abv1 = ab[r * 16 + 8 + ((it >> 7) & 7)]; } }
    for (; it < NCH; it += F.G) {
        const int bh = it >> 7, h = bh & 7;
        __syncthreads();
        { const int c = tid & 63, tg = tid >> 6;
#pragma unroll
          for (int part = 0; part < 3; ++part) { lf32* dst = part == 0 ? Qs : part == 1 ? Ks : Vs;
              const float w0 = ci.w[part][0], w1 = ci.w[part][1], w2 = ci.w[part][2], w3 = ci.w[part][3];
              float xv[11];
#pragma unroll
              for (int i = 0; i < 11; ++i) xv[i] = bf2f(ci.x[part][i]);
#pragma unroll
              for (int i = 0; i < 8; ++i) dst[(8 * tg + i) * PST + c] = siluf(w0 * xv[i] + w1 * xv[i + 1] + w2 * xv[i + 2] + w3 * xv[i + 3]); } }
        const float av = abv0, bv = abv1;
        { const int itn = it + F.G; if (itn < NCH) { conv_load(ci, graw, cw, itn, tid); if (wave == 2) { const size_t r = (size_t)((itn >> 7) >> 3) * SEQ + (itn & 127) * 64 + lane; abv0 = ab[r * 16 + ((itn >> 7) & 7)]; abv1 = ab[r * 16 + 8 + ((itn >> 7) & 7)]; } } }
        __syncthreads();
        if (tid < 128) { const int row = tid & 63; const lf32* src = (tid < 64 ? Qs : Ks) + row * PST; float ss = 0.f;
#pragma unroll
            for (int i = 0; i < 16; ++i) { const f32x4 v = *(const LAS f32x4*)(src + 4 * i); ss += (v.x * v.x + v.y * v.y) + (v.z * v.z + v.w * v.w); }
            const float inv = 1.0f / sqrtf(ss + EPS); if (tid < 64) vqn[row] = inv * 0.125f; else vkn[row] = inv; }
        else if (tid < 192) { const int t = tid & 63;
            const float g = -__expf(a.in[9][h]) * softplusf(av + a.in[10][h]); float G = g;
#pragma unroll
            for (int o = 1; o < 64; o <<= 1) { const float up = __shfl_up(G, o); if (t >= o) G += up; }
            const float Gl = __shfl(G, 63);
            vG[t] = G; { const float be = sigm(bv); vbeta[t] = be; vbw[t] = be * __expf(G); } veG[t] = __expf(G); veGl[t] = __expf(Gl - G);
            if (t == 63) ((float*)(ws + WS_CD))[it] = __expf(Gl); }
        __syncthreads();
        { const int c = tid & 63, tg = tid >> 6;
#pragma unroll
          for (int i = 0; i < 8; ++i) { const int t = 8 * tg + i; const float qv = Qs[t * PST + c] * vqn[t], kv = Ks[t * PST + c] * vkn[t];
              Qs[t * PST + c] = qv; Ks[t * PST + c] = kv; Qb[t * BST + c] = (unsigned short)f2bf(qv); Kb[t * BST + c] = (unsigned short)f2bf(kv); } }
        __syncthreads();
        { const int mt = wave >> 1, r = lane & 15, g = lane >> 4;
#pragma unroll
          for (int t2 = 0; t2 < 2; ++t2) { const int nt = 2 * (wave & 1) + t2; f32x4 kk = {0.f, 0.f, 0.f, 0.f}, qk = kk;
              if (nt <= mt) {
#pragma unroll
                  for (int ks = 0; ks < 2; ++ks) { const bf16x8 ka = *(const LAS bf16x8*)(Kb + (16 * mt + r) * BST + 32 * ks + 8 * g), qa = *(const LAS bf16x8*)(Qb + (16 * mt + r) * BST + 32 * ks + 8 * g);
                      const bf16x8 kb = *(const LAS bf16x8*)(Kb + (16 * nt + r) * BST + 32 * ks + 8 * g);
                      kk = __builtin_amdgcn_mfma_f32_16x16x32_bf16(ka, kb, kk, 0, 0, 0); qk = __builtin_amdgcn_mfma_f32_16x16x32_bf16(qa, kb, qk, 0, 0, 0); } }
              const int s = 16 * nt + r; const float Gs = vG[s];
#pragma unroll
              for (int e = 0; e < 4; ++e) { const int c = 16 * mt + 4 * g + e; const float dec = __expf(fminf(vG[c] - Gs, 0.f));
                  As[c * PST + (s & 3) * 16 + (s >> 2)] = (c > s) ? vbeta[c] * kk[e] * dec : 0.f; QKs[c * PST + s] = (c >= s) ? qk[e] * dec : 0.f; } } }
        __syncthreads();
        { const int col = tid >> 2, q = tid & 3, j = col & 63; const bool isw = col >= 64; const lf32* src = isw ? Ks : Vs; const lf32* sc = isw ? vbw : vbeta; lf32* dst = isw ? Ws : Us;
          const lf32* Aq = As + q * 16; float x[16];
#pragma unroll
          for (int m = 0; m < 16; ++m) x[m] = 0.f;
#pragma unroll
          for (int i = 0; i < 64; ++i) { float p0 = 0.f, p1 = 0.f;
#pragma unroll
              for (int m4 = 0; m4 < (i + 15) / 16; ++m4) { const f32x4 avv = *(const LAS f32x4*)(Aq + i * PST + 4 * m4); p0 += avv.x * x[4 * m4]; p1 += avv.y * x[4 * m4 + 1]; p0 += avv.z * x[4 * m4 + 2]; p1 += avv.w * x[4 * m4 + 3]; }
              const float xi = src[i * PST + j] * sc[i] - quad_sum(p0 + p1);
              if (q == (i & 3)) x[i >> 2] = xi;
              if (q == 0) dst[i * PST + j] = xi; } }
        __syncthreads();
        { unsigned char* ch = ws + WS_CH + (size_t)it * CH_BYTES;
          store_afrag(Ws, nullptr, ch + CH_W, tid); store_afrag(Qs, veG, ch + CH_QD, tid); store_afrag(QKs, nullptr, ch + CH_QK, tid); store_afrag_T(Ks, veGl, ch + CH_KDT, tid); store_cfrag(Us, ch + CH_U, tid); }
    }
    __syncthreads();
}

__device__ __forceinline__ void p3_qknorm(Frame& F, const Args& a) {
    unsigned char* ws = a.ws; const int lane = F.lane;
    const int gw = blockIdx.x * NWAVES + F.wave, NGW = F.G * NWAVES;
    const float* qnw = a.in[6]; const float* knw = a.in[7];
    v4u nq[2] = {(v4u){0u, 0u, 0u, 0u}, (v4u){0u, 0u, 0u, 0u}};
    if (gw < M) { nq[0] = *(const v4u*)((const bf16*)(ws + WS_Q) + (size_t)gw * 512 + 8 * lane); nq[1] = *(const v4u*)((const bf16*)(ws + WS_K) + (size_t)gw * 512 + 8 * lane); }
    for (int t = gw; t < M; t += NGW) {
        const v4u cq[2] = {nq[0], nq[1]};
        if (t + NGW < M) { nq[0] = *(const v4u*)((const bf16*)(ws + WS_Q) + (size_t)(t + NGW) * 512 + 8 * lane); nq[1] = *(const v4u*)((const bf16*)(ws + WS_K) + (size_t)(t + NGW) * 512 + 8 * lane); }
#pragma unroll
        for (int which = 0; which < 2; ++which) {
            bf16* p = (bf16*)(ws + (which ? WS_K : WS_Q)) + (size_t)t * 512 + 8 * lane; const float* nw = which ? knw : qnw;
            const v4u w = cq[which]; float v[8] = {bflo(w.x), bfhi(w.x), bflo(w.y), bfhi(w.y), bflo(w.z), bfhi(w.z), bflo(w.w), bfhi(w.w)};
            float s = 0.f;
#pragma unroll
            for (int i = 0; i < 8; ++i) s += v[i] * v[i];
            s += __shfl_xor(s, 1); s += __shfl_xor(s, 2); s += __shfl_xor(s, 4);
            const float r = 1.0f / sqrtf(s * (1.f / 64.f) + EPS) * (which ? 1.0f : 0.125f);
            const int d0 = (8 * lane) & 63;
#pragma unroll
            for (int i = 0; i < 8; ++i) v[i] = v[i] * r * nw[d0 + i];
            v4u o; o.x = pk2(v[0], v[1]); o.y = pk2(v[2], v[3]); o.z = pk2(v[4], v[5]); o.w = pk2(v[6], v[7]); *(v4u*)p = o;
        }
    }
}

__device__ __forceinline__ bf16x8 pack8(const f32x4& x, const f32x4& y) { v4u w; w.x = pg8::cvt_pk_bf16(x.x, x.y); w.y = pg8::cvt_pk_bf16(x.z, x.w); w.z = pg8::cvt_pk_bf16(y.x, y.y); w.w = pg8::cvt_pk_bf16(y.z, y.w); return __builtin_bit_cast(bf16x8, w); }
constexpr int SC_SLOT = 34816, SC_NSLOT = 4, SC_U = 32768;
constexpr int SC_OB = SC_NSLOT * SC_SLOT, OST = 20, SC_CD = SC_OB + 2 * 64 * OST * 4;
#define SC_BAR() asm volatile("s_waitcnt lgkmcnt(0)\n\ts_barrier" ::: "memory")
__device__ __forceinline__ void scan_dma(const unsigned char* ch, LAS unsigned char* slot, int lw, int sl, int lane) {
#pragma unroll
    for (int i = 0; i < 8; ++i) __builtin_amdgcn_global_load_lds((const unsigned*)(ch + lw * 8192 + i * 1024 + lane * 16), (LAS unsigned*)(slot + lw * 8192 + i * 1024), 16, 0, 0);
    const int up = lw & 1;
    __builtin_amdgcn_global_load_lds((const unsigned*)(ch + CH_U + sl * 2048 + up * 1024 + lane * 16), (LAS unsigned*)(slot + SC_U + up * 1024), 16, 0, 0);
}
__device__ __forceinline__ void scan_step(LAS unsigned char* lds, f32x4 (&S)[4], float cdv, int n, int lane) {
    const LAS unsigned char* ob = lds + (n & 3) * SC_SLOT; lf32* ot = (lf32*)(lds + SC_OB) + (n & 1) * 64 * OST;
    const f32x4 zero = {0.f, 0.f, 0.f, 0.f};
    const bf16x8 Sb0 = pack8(S[0], S[1]), Sb1 = pack8(S[2], S[3]);
    f32x4 vn[4], o[4];
#pragma unroll
    for (int mt = 0; mt < 4; ++mt) { const bf16x8 a0 = *(const LAS bf16x8*)(ob + CH_W + (mt * 2) * 1024 + lane * 16), a1 = *(const LAS bf16x8*)(ob + CH_W + (mt * 2 + 1) * 1024 + lane * 16);
        f32x4 acc = __builtin_amdgcn_mfma_f32_16x16x32_bf16(a0, Sb0, zero, 0, 0, 0); acc = __builtin_amdgcn_mfma_f32_16x16x32_bf16(a1, Sb1, acc, 0, 0, 0);
        const v2u uu = *(const LAS v2u*)(ob + SC_U + (mt * 64 + lane) * 8);
        vn[mt] = (f32x4){bflo(uu.x), bfhi(uu.x), bflo(uu.y), bfhi(uu.y)} - acc; }
    const bf16x8 Vb0 = pack8(vn[0], vn[1]), Vb1 = pack8(vn[2], vn[3]);
#pragma unroll
    for (int mt = 0; mt < 4; ++mt) { const bf16x8 t0 = *(const LAS bf16x8*)(ob + CH_KDT + (mt * 2) * 1024 + lane * 16), t1 = *(const LAS bf16x8*)(ob + CH_KDT + (mt * 2 + 1) * 1024 + lane * 16);
        f32x4 acc = S[mt] * cdv; acc = __builtin_amdgcn_mfma_f32_16x16x32_bf16(t0, Vb0, acc, 0, 0, 0); acc = __builtin_amdgcn_mfma_f32_16x16x32_bf16(t1, Vb1, acc, 0, 0, 0); vn[mt] = acc; }
#pragma unroll
    for (int mt = 0; mt < 4; ++mt) { const bf16x8 q0 = *(const LAS bf16x8*)(ob + CH_QD + (mt * 2) * 1024 + lane * 16), q1 = *(const LAS bf16x8*)(ob + CH_QD + (mt * 2 + 1) * 1024 + lane * 16);
        const bf16x8 k0 = *(const LAS bf16x8*)(ob + CH_QK + (mt * 2) * 1024 + lane * 16), k1 = *(const LAS bf16x8*)(ob + CH_QK + (mt * 2 + 1) * 1024 + lane * 16);
        f32x4 acc = __builtin_amdgcn_mfma_f32_16x16x32_bf16(q0, Sb0, zero, 0, 0, 0); acc = __builtin_amdgcn_mfma_f32_16x16x32_bf16(q1, Sb1, acc, 0, 0, 0);
        acc = __builtin_amdgcn_mfma_f32_16x16x32_bf16(k0, Vb0, acc, 0, 0, 0); acc = __builtin_amdgcn_mfma_f32_16x16x32_bf16(k1, Vb1, acc, 0, 0, 0); o[mt] = acc; }
#pragma unroll
    for (int mt = 0; mt < 4; ++mt) S[mt] = vn[mt];
    const int col = lane & 15, g = lane >> 4;
#pragma unroll
    for (int mt = 0; mt < 4; ++mt) { lf32* p = ot + (16 * mt + 4 * g) * OST + col; p[0] = o[mt].x; p[OST] = o[mt].y; p[2 * OST] = o[mt].z; p[3 * OST] = o[mt].w; }
}
__device__ __forceinline__ void scan_ostore(const lf32* ot, bf16* dst, int lane) {
    const lf32* p = ot + lane * OST; const f32x4 a0 = *(const LAS f32x4*)p, a1 = *(const LAS f32x4*)(p + 4), a2 = *(const LAS f32x4*)(p + 8), a3 = *(const LAS f32x4*)(p + 12);
    v4u w0, w1; w0.x = pk2(a0.x, a0.y); w0.y = pk2(a0.z, a0.w); w0.z = pk2(a1.x, a1.y); w0.w = pk2(a1.z, a1.w); w1.x = pk2(a2.x, a2.y); w1.y = pk2(a2.z, a2.w); w1.z = pk2(a3.x, a3.y); w1.w = pk2(a3.z, a3.w);
    *(v4u*)dst = w0; *(v4u*)(dst + 8) = w1;
}
__device__ __forceinline__ void p4_gdn_scan(Frame& F, const Args& a, int bh, int sl) {
    unsigned char* ws = a.ws; const int h = bh & 7, b = bh >> 3, wave = F.wave, lane = F.lane, tid = F.tid;
    const unsigned char* chb = ws + WS_CH + (size_t)bh * 128 * CH_BYTES; const float* cd = (const float*)(ws + WS_CD) + bh * 128;
    bf16* OG = (bf16*)(ws + WS_YGDN) + ((size_t)b * SEQ) * 512 + h * 64 + sl * 16;
    LAS unsigned char* lds = F.lds + RING_OFF;
    const lf32* cdl = (const lf32*)(lds + SC_CD);
    __syncthreads();
    if (tid < 128) ((lf32*)(lds + SC_CD))[tid] = cd[tid];
    if (wave == 0) {
        f32x4 S[4] = {(f32x4){0.f, 0.f, 0.f, 0.f}, (f32x4){0.f, 0.f, 0.f, 0.f}, (f32x4){0.f, 0.f, 0.f, 0.f}, (f32x4){0.f, 0.f, 0.f, 0.f}};
        SC_BAR();
        for (int m = 0; m < 128; ++m) { scan_step(lds, S, cdl[m], m, lane); SC_BAR(); }
        SC_BAR();
    } else if (wave <= 4) {
        const int lw = wave - 1;
        scan_dma(chb, lds, lw, sl, lane); scan_dma(chb + CH_BYTES, lds + SC_SLOT, lw, sl, lane); scan_dma(chb + 2 * CH_BYTES, lds + 2 * SC_SLOT, lw, sl, lane);
        asm volatile("s_waitcnt vmcnt(18)" ::: "memory");
        SC_BAR();
        for (int m = 0; m < 128; ++m) { const int c = m + 3 < 128 ? m + 3 : 127;
            scan_dma(chb + (size_t)c * CH_BYTES, lds + ((m + 3) & 3) * SC_SLOT, lw, sl, lane);
            asm volatile("s_waitcnt vmcnt(18)" ::: "memory");
            SC_BAR(); }
        asm volatile("s_waitcnt vmcnt(0)" ::: "memory");
        SC_BAR();
    } else if (wave == 5) {
        SC_BAR();
        for (int m = 0; m < 128; ++m) { if (m >= 1) scan_ostore((const lf32*)(lds + SC_OB) + ((m - 1) & 1) * 64 * OST, OG + (size_t)((m - 1) * 64 + lane) * 512, lane); SC_BAR(); }
        scan_ostore((const lf32*)(lds + SC_OB) + 64 * OST, OG + (size_t)(127 * 64 + lane) * 512, lane);
        SC_BAR();
    } else {
        SC_BAR();
        for (int m = 0; m < 128; ++m) SC_BAR();
        SC_BAR();
    }
    __syncthreads();
}
__device__ __forceinline__ void p4c_gdn_out(Frame& F, const Args& a) {
    unsigned char* ws = a.ws; const int lane = F.lane; bf16* Y = (bf16*)(ws + WS_YGDN); const bf16* Z = (const bf16*)(ws + WS_Z); const float* onw = a.in[11];
    const int gw = blockIdx.x * NWAVES + F.wave, NGW = F.G * NWAVES, d0 = (8 * lane) & 63;
    const f32x4 w0 = *(const f32x4*)(onw + d0), w1 = *(const f32x4*)(onw + d0 + 4);
    v4u no = {0u, 0u, 0u, 0u}, nz = no;
    if (gw < M) { no = *(const v4u*)(Y + (size_t)gw * 512 + 8 * lane); nz = *(const v4u*)(Z + (size_t)gw * 512 + 8 * lane); }
    for (int t = gw; t < M; t += NGW) {
        const v4u ow = no, zw = nz;
        if (t + NGW < M) { no = *(const v4u*)(Y + (size_t)(t + NGW) * 512 + 8 * lane); nz = *(const v4u*)(Z + (size_t)(t + NGW) * 512 + 8 * lane); }
        float o[8] = {bflo(ow.x), bfhi(ow.x), bflo(ow.y), bfhi(ow.y), bflo(ow.z), bfhi(ow.z), bflo(ow.w), bfhi(ow.w)};
        const float z[8] = {bflo(zw.x), bfhi(zw.x), bflo(zw.y), bfhi(zw.y), bflo(zw.z), bfhi(zw.z), bflo(zw.w), bfhi(zw.w)};
        float ss = 0.f;
#pragma unroll
        for (int i = 0; i < 8; ++i) ss += o[i] * o[i];
        ss += __shfl_xor(ss, 1); ss += __shfl_xor(ss, 2); ss += __shfl_xor(ss, 4);
        const float rstd = 1.0f / sqrtf(ss * (1.f / 64.f) + EPS);
        const float wv[8] = {w0.x, w0.y, w0.z, w0.w, w1.x, w1.y, w1.z, w1.w};
#pragma unroll
        for (int i = 0; i < 8; ++i) o[i] = o[i] * rstd * wv[i] * siluf(z[i]);
        v4u r; r.x = pk2(o[0], o[1]); r.y = pk2(o[2], o[3]); r.z = pk2(o[4], o[5]); r.w = pk2(o[6], o[7]);
        *(v4u*)(Y + (size_t)t * 512 + 8 * lane) = r;
    }
}

typedef float f32x16 __attribute__((ext_vector_type(16)));
constexpr int TK_KROW = 272;
constexpr int TK_KEYS = 0, TK_LIST = 2 * 128 * TK_KROW;
__device__ __forceinline__ unsigned f2ord(float f) { const unsigned u = __float_as_uint(f); return u ^ ((unsigned)((int)u >> 31) | 0x80000000u); }
__device__ __forceinline__ float ord2f(unsigned o) { const unsigned u = (o & 0x80000000u) ? (o ^ 0x80000000u) : ~o; return __uint_as_float(u); }
#define TK_CE(a, b) do { const unsigned _h = max(a, b), _l = min(a, b); a = _h; b = _l; } while (0)
__device__ __forceinline__ void sort16(unsigned (&v)[16]) {
#pragma unroll
    for (int k = 2; k <= 16; k <<= 1)
#pragma unroll
        for (int j = k >> 1; j > 0; j >>= 1)
#pragma unroll
            for (int i = 0; i < 16; ++i) { const int l = i ^ j; if (l > i) { if ((i & k) == 0) TK_CE(v[i], v[l]); else TK_CE(v[l], v[i]); } }
}
__device__ __forceinline__ void merge16(unsigned (&a)[16], const unsigned (&b)[16]) {
#pragma unroll
    for (int i = 0; i < 16; ++i) a[i] = max(a[i], b[15 - i]);
#pragma unroll
    for (int j = 8; j > 0; j >>= 1)
#pragma unroll
        for (int i = 0; i < 16; ++i) { const int l = i ^ j; if (l > i) TK_CE(a[i], a[l]); }
}
__device__ __forceinline__ void p9_topk(Frame& F, const Args& a) {
    unsigned char* ws = a.ws; const int tid = F.tid, lane = F.lane, wave = F.wave, tk = lane & 31, half = lane >> 5;
    const bf16* QP = (const bf16*)(ws + WS_QP); const bf16* SK = (const bf16*)(ws + WS_SKEY);
    LAS unsigned char* kl = F.lds + RING_OFF + TK_KEYS; LAS unsigned* lst = (LAS unsigned*)(F.lds + RING_OFF + TK_LIST) + wave * 1024;
    for (int it = blockIdx.x; it < (M / 256) * PH; it += F.G) {
        const int h = it & 7, t = (it >> 3) * 256 + wave * 32 + tk;
        __syncthreads();
        for (int i = tid; i < 2 * 128 * 16; i += 512) { const int row = i >> 4, c = i & 15; *(LAS v4u*)(kl + row * TK_KROW + c * 16) = *(const v4u*)(SK + (size_t)h * 2 * 128 * 128 + row * 128 + c * 8); }
        __syncthreads();
        unsigned top[2][16];
#pragma unroll
        for (int p = 0; p < 2; ++p) {
            bf16x8 qf[8];
#pragma unroll
            for (int ks = 0; ks < 8; ++ks) qf[ks] = *(const bf16x8*)(QP + (size_t)t * PQW + h * 256 + p * 128 + 16 * ks + 8 * half);
            unsigned best[16];
#pragma unroll
            for (int mt = 0; mt < 4; ++mt) {
                f32x16 acc = {0.f, 0.f, 0.f, 0.f, 0.f, 0.f, 0.f, 0.f, 0.f, 0.f, 0.f, 0.f, 0.f, 0.f, 0.f, 0.f};
#pragma unroll
                for (int ks = 0; ks < 8; ++ks) { const bf16x8 kf = *(const LAS bf16x8*)(kl + (p * 128 + mt * 32 + tk) * TK_KROW + ks * 32 + half * 16);
                    acc = __builtin_amdgcn_mfma_f32_32x32x16_bf16(kf, qf[ks], acc, 0, 0, 0); }
                unsigned g[16];
#pragma unroll
                for (int r = 0; r < 16; ++r) { const int key = 32 * mt + (r & 3) + 8 * (r >> 2) + 4 * half; g[r] = (f2ord(acc[r]) & ~127u) | (unsigned)(127 - key); }
                sort16(g);
                if (mt == 0) {
#pragma unroll
                    for (int r = 0; r < 16; ++r) best[r] = g[r]; }
                else merge16(best, g);
            }
            unsigned oth[16];
#pragma unroll
            for (int r = 0; r < 16; ++r) oth[r] = __shfl_xor(best[r], 32);
            merge16(best, oth);
#pragma unroll
            for (int r = 0; r < 16; ++r) top[p][r] = best[r];
        }
        if (half == 0) {
#pragma unroll
            for (int r = 0; r < 16; ++r) { lst[tk * 32 + r] = top[0][r]; lst[tk * 32 + 16 + r] = top[1][r]; } }
        float v1[16], v2[16];
#pragma unroll
        for (int r = 0; r < 16; ++r) { v1[r] = ord2f(top[0][r] & ~127u); v2[r] = ord2f(top[1][r] & ~127u); }
        unsigned c0[16], c1[16], c2[16], c3[16];
#pragma unroll
        for (int j = 0; j < 16; ++j) c0[j] = (f2ord(v1[0] + v2[j]) & ~255u) | (unsigned)(255 - j);
        { int n = 0;
#pragma unroll
          for (int i = 1; i < 16; ++i)
#pragma unroll
              for (int j = 0; j < 16; ++j) if ((i + 1) * (j + 1) <= 16) { const unsigned pk = (f2ord(v1[i] + v2[j]) & ~255u) | (unsigned)(255 - (i * 16 + j));
                  if (n < 16) c1[n] = pk; else if (n < 32) c2[n - 16] = pk; else c3[n - 32] = pk; ++n; }
#pragma unroll
          for (int r = 2; r < 16; ++r) c3[r] = 0u; }
        sort16(c1); sort16(c2); sort16(c3); merge16(c0, c1); merge16(c2, c3); merge16(c0, c2);
        LDS_WAIT(); asm volatile("" ::: "memory");
        float sm[16]; int eid[16];
#pragma unroll
        for (int r = 0; r < 16; ++r) { const int cid = 255 - (int)(c0[r] & 255u), i = cid >> 4, j = cid & 15;
            const unsigned p1 = lst[tk * 32 + i], p2 = lst[tk * 32 + 16 + j];
            sm[r] = ord2f(p1 & ~127u) + ord2f(p2 & ~127u); eid[r] = (127 - (int)(p1 & 127u)) * 128 + (127 - (int)(p2 & 127u)); }
        float den = 0.f; const float mx = sm[0];
#pragma unroll
        for (int r = 0; r < 16; ++r) { sm[r] = __expf(sm[r] - mx); den += sm[r]; }
        const float inv = 1.0f / den;
        if (half == 0) { int* eo = (int*)(ws + WS_EIDX) + (size_t)t * 128 + h * 16;
#pragma unroll
            for (int r = 0; r < 16; r += 4) *(v4u*)(eo + r) = (v4u){(unsigned)eid[r], (unsigned)eid[r + 1], (unsigned)eid[r + 2], (unsigned)eid[r + 3]}; }
        else { float* go = (float*)(ws + WS_GATE) + (size_t)t * 128 + h * 16;
#pragma unroll
            for (int r = 0; r < 16; r += 4) *(f32x4*)(go + r) = (f32x4){sm[r] * inv, sm[r + 1] * inv, sm[r + 2] * inv, sm[r + 3] * inv}; }
    }
    __syncthreads();
}

__device__ __forceinline__ float softplus_fast(float x) { return fmaxf(x, 0.f) + __logf(1.0f + __expf(-fabsf(x))); }
struct AttnTile { bf16x8 k[4]; v2u v[2][2][2]; };
__device__ __forceinline__ void attn_load(AttnTile& T, const bf16* Kb, const bf16* VTb, int key0, int tk, int half) {
#pragma unroll
    for (int ks = 0; ks < 4; ++ks) T.k[ks] = *(const bf16x8*)(Kb + (size_t)(key0 + tk) * 512 + 16 * ks + 8 * half);
#pragma unroll
    for (int mt = 0; mt < 2; ++mt)
#pragma unroll
        for (int s = 0; s < 2; ++s) { const bf16* p = VTb + (size_t)(32 * mt + tk) * SEQ + key0 + 16 * s + 4 * half; T.v[mt][s][0] = *(const v2u*)p; T.v[mt][s][1] = *(const v2u*)(p + 8); }
}
__device__ __forceinline__ void p4_attn(Frame& F, const Args& a, int blk, int nblk) {
    unsigned char* ws = a.ws; const int lane = F.lane, tk = lane & 31, half = lane >> 5;
    const bf16* Q = (const bf16*)(ws + WS_Q); const bf16* K = (const bf16*)(ws + WS_K); const bf16* VT = (const bf16*)(ws + WS_V); bf16* Y = (bf16*)(ws + WS_YSB);
    const int gwv = blk * NWAVES + F.wave, nwv = nblk * NWAVES;
    for (int u = gwv; u < BATCH * SBH * (SEQ / 32); u += nwv) {
        const int bh = u & 15, qt = u >> 4, b = bh >> 3, h = bh & 7;
        const bf16* Kb = K + (size_t)b * SEQ * 512 + h * 64; const bf16* VTb = VT + (size_t)bh * 64 * SEQ;
        bf16x8 qf[4];
#pragma unroll
        for (int ks = 0; ks < 4; ++ks) qf[ks] = *(const bf16x8*)(Q + ((size_t)b * SEQ + qt * 32 + tk) * 512 + h * 64 + 16 * ks + 8 * half);
        f32x16 o0 = {0.f, 0.f, 0.f, 0.f, 0.f, 0.f, 0.f, 0.f, 0.f, 0.f, 0.f, 0.f, 0.f, 0.f, 0.f, 0.f}, o1 = o0; const f32x16 zero16 = o0;
        float R = 0.f;
        AttnTile cur, nxt; attn_load(cur, Kb, VTb, qt * 32, tk, half);
        for (int kt = qt; kt >= 0; --kt) {
            if (kt > 0) attn_load(nxt, Kb, VTb, (kt - 1) * 32, tk, half);
            f32x16 z = __builtin_amdgcn_mfma_f32_32x32x16_bf16(cur.k[0], qf[0], zero16, 0, 0, 0);
            z = __builtin_amdgcn_mfma_f32_32x32x16_bf16(cur.k[1], qf[1], z, 0, 0, 0); z = __builtin_amdgcn_mfma_f32_32x32x16_bf16(cur.k[2], qf[2], z, 0, 0, 0); z = __builtin_amdgcn_mfma_f32_32x32x16_bf16(cur.k[3], qf[3], z, 0, 0, 0);
            const bool diag = (kt == qt);
            float sp[16], T[4];
#pragma unroll
            for (int r = 0; r < 16; ++r) { const int key = (r & 3) + 8 * (r >> 2) + 4 * half; const bool valid = !diag || key < tk; sp[r] = valid ? softplus_fast(z[r]) : 0.f; }
#pragma unroll
            for (int g = 0; g < 4; ++g) T[g] = (sp[4 * g] + sp[4 * g + 1]) + (sp[4 * g + 2] + sp[4 * g + 3]);
            float PT[4];
#pragma unroll
            for (int g = 0; g < 4; ++g) PT[g] = __shfl_xor(T[g], 32);
            float later[4]; later[3] = half ? 0.f : PT[3];
#pragma unroll
            for (int g = 2; g >= 0; --g) later[g] = later[g + 1] + T[g + 1] + (half ? PT[g + 1] : PT[g]);
            const float total = ((T[0] + T[1]) + (T[2] + T[3])) + ((PT[0] + PT[1]) + (PT[2] + PT[3]));
            float p[16];
#pragma unroll
            for (int g = 0; g < 4; ++g) { float c = R + later[g];
#pragma unroll
                for (int j = 3; j >= 0; --j) { const int r = 4 * g + j; const int key = (r & 3) + 8 * (r >> 2) + 4 * half; const bool valid = !diag || key < tk;
                    p[r] = valid ? __expf(z[r] - sp[r] - c) : 0.f; c += sp[r]; } }
            R += total;
            const bf16x8 pb0 = pack8((f32x4){p[0], p[1], p[2], p[3]}, (f32x4){p[4], p[5], p[6], p[7]}), pb1 = pack8((f32x4){p[8], p[9], p[10], p[11]}, (f32x4){p[12], p[13], p[14], p[15]});
#define VFRAG(mt, s) __builtin_bit_cast(bf16x8, (v4u){cur.v[mt][s][0].x, cur.v[mt][s][0].y, cur.v[mt][s][1].x, cur.v[mt][s][1].y})
            o0 = __builtin_amdgcn_mfma_f32_32x32x16_bf16(VFRAG(0, 0), pb0, o0, 0, 0, 0); o0 = __builtin_amdgcn_mfma_f32_32x32x16_bf16(VFRAG(0, 1), pb1, o0, 0, 0, 0);
            o1 = __builtin_amdgcn_mfma_f32_32x32x16_bf16(VFRAG(1, 0), pb0, o1, 0, 0, 0); o1 = __builtin_amdgcn_mfma_f32_32x32x16_bf16(VFRAG(1, 1), pb1, o1, 0, 0, 0);
#undef VFRAG
            if (__all(R > 105.f)) break;
            cur = nxt;
        }
        bf16* yp = Y + ((size_t)b * SEQ + qt * 32 + tk) * 512 + h * 64 + 4 * half;
#pragma unroll
        for (int g = 0; g < 4; ++g) { v2u w0, w1; w0.x = pk2(o0[4 * g], o0[4 * g + 1]); w0.y = pk2(o0[4 * g + 2], o0[4 * g + 3]); w1.x = pk2(o1[4 * g], o1[4 * g + 1]); w1.y = pk2(o1[4 * g + 2], o1[4 * g + 3]);
            *(v2u*)(yp + 8 * g) = w0; *(v2u*)(yp + 32 + 8 * g) = w1; }
    }
}
#ifndef PROBE_PH
#define PROBE_PH (-1)
#define PROBE_N 1
#endif
#ifndef PROBE_MASK
#define PROBE_MASK 0
#endif
#ifndef PROBE_VAR
#define PROBE_VAR 0
#endif
__global__ void __launch_bounds__(NWAVES * 64, 2) mk_fwd(Args args) {
    extern __shared__ __attribute__((aligned(16))) unsigned char lds[];
    Frame F;
    F.lds = (LAS unsigned char*)lds;
    F.MISC = (volatile LAS unsigned*)(F.lds + MISC_OFF);
    F.tid = threadIdx.x; F.lane = F.tid & 63; F.wave = __builtin_amdgcn_readfirstlane(F.tid >> 6);
    F.G = gridDim.x;
    unsigned char* ws = args.ws;
    F.ctl = (gu32*)(ws + WS_CTL);
    for (int u = F.tid; u < (LDS_BYTES - LDSCTL_OFF) / 4; u += NWAVES * 64) ((LAS unsigned*)(F.lds + LDSCTL_OFF))[u] = 0u;
    __syncthreads();
    const bool multi = (args.ph_hi - args.ph_lo) > 1;
    XcdBarrier bar; bar.bar = (unsigned*)(F.ctl + CW_BAR); bar.x = 0; bar.st = nullptr;
    if (multi) bar = xcd_barrier_post((unsigned*)(F.ctl + CW_BAR), F.MISC + 8);
    const int lo = args.ph_lo, hi = args.ph_hi;
#define IN(k) (lo <= (k) && (k) < hi)
#define REP(k) for (int _r = 0; _r < ((k) == PROBE_PH ? PROBE_N : 1); ++_r)
#define SEAM(k) do { if (IN(k) && (k) + 1 < hi) { xcd_barrier(bar); if (PROBE_PH == 99) { xcd_barrier(bar); xcd_barrier(bar); } } } while (0)
    const float* mod = (const float*)(ws + WS_MOD);
#define STAMP(i) do { if (PROBE_PH >= 100 && blockIdx.x == 0 && F.tid == 0) F.MISC[16 + (i)] = (unsigned)__builtin_amdgcn_s_memrealtime(); } while (0)
    STAMP(0);

    if (IN(0)) { REP(0) p0_prologue(F, args); } SEAM(0); STAMP(1);
    if (IN(1)) { REP(1) norm_mod_rows(F, args.in[0], args.in[4], mod, 0, (bf16*)(ws + WS_XN), nullptr); } SEAM(1); STAMP(2);
    if (IN(2)) {
#define BODY2 \
        pg8::Gemm g{(const bf16*)(ws + WS_XN), (const bf16*)(ws + WS_WIN), M, INWP, D}; pg8::StaticOrder S; S.init(M, INWP, F.G, (int)blockIdx.x); \
        pg8::EpiInProj E{(bf16*)(ws + WS_Q), (bf16*)(ws + WS_K), (bf16*)(ws + WS_V), (bf16*)(ws + WS_GRAW), (bf16*)(ws + WS_Z), (bf16*)args.out, (float*)(ws + WS_AB)}; \
        pg8::gemm_phase<pg8::EpiInProj, pg8::StaticOrder, true, true>(F.lds + RING_OFF, g, S, E);
        BODY2
        if (PROBE_PH == 2) { BODY2 }
#undef BODY2
    } SEAM(2); STAMP(3);
    if (IN(3)) { REP(3) p3_gdn_prep(F, args); p3_qknorm(F, args); } SEAM(3); STAMP(4);
    if (IN(4)) { constexpr int NSC = BATCH * GH * 4;
        if (blockIdx.x < NSC) { REP(4) p4_gdn_scan(F, args, (int)(blockIdx.x & 7) + 8 * (int)(blockIdx.x >> 5), (int)(blockIdx.x >> 3) & 3); }
        else REP(40) { p4_attn(F, args, (int)blockIdx.x - NSC, F.G - NSC); peer_tables_to_fp8(args, (int)blockIdx.x - NSC, F.G - NSC, F.tid); }
        xcd_barrier(bar);
        p4c_gdn_out(F, args); } SEAM(4); STAMP(5);
    if (IN(5)) {
#define BODY5 \
        { pg8::Gemm g{(const bf16*)(ws + WS_YSB), (const bf16*)(ws + WS_WSB), M, D, 512}; pg8::StaticOrder S; S.init(M, D, F.G, (int)blockIdx.x); \
          pg8::EpiMerge<0> E{(const bf16*)args.out, (bf16*)(ws + WS_MERGED)}; \
          pg8::gemm_phase<pg8::EpiMerge<0>, pg8::StaticOrder, true, true>(F.lds + RING_OFF, g, S, E); } \
        VM_WAIT(); __syncthreads(); \
        if (F.tid == 0) { __builtin_amdgcn_fence(__ATOMIC_ACQ_REL, "agent"); VM_WAIT(); } \
        __syncthreads(); \
        { pg8::Gemm g{(const bf16*)(ws + WS_YGDN), (const bf16*)(ws + WS_WGDN), M, D, 512}; pg8::StaticOrder S; S.init(M, D, F.G, (int)blockIdx.x); \
          pg8::EpiMerge<1> E{(const bf16*)args.out, (bf16*)(ws + WS_MERGED)}; \
          pg8::gemm_phase<pg8::EpiMerge<1>, pg8::StaticOrder, true, true>(F.lds + RING_OFF, g, S, E); }
        BODY5
        if (PROBE_PH == 5) { BODY5 }
#undef BODY5
    } SEAM(5); STAMP(6);
    if (IN(6)) {
#define BODY6 \
        pg8::Gemm g{(const bf16*)(ws + WS_MERGED), (const bf16*)(ws + WS_WO), M, D, D}; pg8::StaticOrder S; S.init(M, D, F.G, (int)blockIdx.x); \
        pg8::EpiWo E{args.in[0], mod, args.out}; \
        pg8::gemm_phase<pg8::EpiWo, pg8::StaticOrder, true, true>(F.lds + RING_OFF, g, S, E);
        BODY6
        if (PROBE_PH == 6) { BODY6 }
#undef BODY6
    } SEAM(6); STAMP(7);
    if (IN(7)) { REP(7) norm_mod_rows(F, args.out, args.in[15], mod, 3, (bf16*)(ws + WS_XN), ws + WS_H28); } SEAM(7); STAMP(8);
    if (IN(8)) {
#define BODY8 \
        pg8::Gemm g{(const bf16*)(ws + WS_XN), (const bf16*)(ws + WS_WQ), M, PQW, D}; pg8::StaticOrder S; S.init(M, PQW, F.G, (int)blockIdx.x); \
        pg8::EpiBf16<0> E{(bf16*)(ws + WS_QP), PQW, nullptr, 0, 0, 1.f}; \
        pg8::gemm_phase<pg8::EpiBf16<0>, pg8::StaticOrder, true, true>(F.lds + RING_OFF, g, S, E);
        BODY8
        if (PROBE_PH == 8) { BODY8 }
#undef BODY8
    } SEAM(8); STAMP(9);
    if (IN(9)) REP(9) { p9_topk(F, args); } SEAM(9); STAMP(10);
    if (IN(10)) { p10a_peer_u(F, args); if (PROBE_PH == 10) { p10a_peer_u(F, args); p10a_peer_u(F, args); } xcd_barrier(bar); REP(11) p10b_peer_v(F, args, _r == 0 ? args.out : (float*)(ws + WS_QP)); }
    STAMP(11);
    if (PROBE_PH >= 100 && blockIdx.x == 0 && F.tid == 0) { unsigned d = 0; for (int k = 0; k < 11; ++k) if ((PROBE_MASK >> k) & 1) d += F.MISC[16 + k + 1] - F.MISC[16 + k];
        const unsigned t0 = (unsigned)__builtin_amdgcn_s_memrealtime(); while ((unsigned)__builtin_amdgcn_s_memrealtime() - t0 < d) __builtin_amdgcn_s_sleep(8); }
#undef IN
#undef REP
#undef SEAM
}
extern "C" void kernel_launch(void* const* d_in, const int* in_sizes, int n_in, void* d_out, int out_size, void* d_ws, size_t ws_size, hipStream_t stream) {
    static int grid = 0;
    if (grid == 0) {
        if (n_in != 20 || out_size != M * D || ws_size < WS_END) { fprintf(stderr, "kernel_launch: unexpected shapes n_in %d out %d ws %zu\n", n_in, out_size, ws_size); grid = -1; return; }
        int dev = 0, cus = 0;
        if (hipGetDevice(&dev) != hipSuccess || hipDeviceGetAttribute(&cus, hipDeviceAttributeMultiprocessorCount, dev) != hipSuccess) { grid = -1; return; }
        if (hipFuncSetAttribute((const void*)mk_fwd, hipFuncAttributeMaxDynamicSharedMemorySize, LDS_BYTES) != hipSuccess) { fprintf(stderr, "kernel_launch: hipFuncSetAttribute failed\n"); grid = -1; return; }
        (void)hipGetLastError();
        grid = cus;
    }
    if (grid < 0) return;
    (void)hipMemsetAsync((char*)d_ws + WS_CTL, 0, CTL_ZERO_BYTES, stream);
    Args a{};
    for (int i = 0; i < 20; ++i) a.in[i] = (const float*)d_in[i];
    a.out = (float*)d_out; a.ws = (unsigned char*)d_ws;
    auto mk = [&](int lo, int hi) { a.ph_lo = lo; a.ph_hi = hi; a.li = 0; hipLaunchKernelGGL(mk_fwd, dim3(grid), dim3(NWAVES * 64), LDS_BYTES, stream, a); };
    mk(0, 11);
}
```
